# Optimizing an MI355X kernel written in HIP

```python
import jax
import jax.numpy as jnp
from jax import lax
import numpy as np

D_MODEL = 1024
BATCH = 8
SEQ = 2048
DEPTH = 4

N_MIXERS = 3
ROPE_THETA = 10000.0
Q_BLOCK = 128
LN_EPS = 1e-5
RMS_EPS = 1e-6
NEG_INF = -1e30
DEEPNORM_ALPHA = (2 * DEPTH) ** 0.25
DEEPNORM_BETA = (8 * DEPTH) ** -0.25
N_MLA_LAYERS = (DEPTH + 2) // 3
N_NSA_LAYERS = (DEPTH + 1) // 3
N_SB_LAYERS = DEPTH // 3

MLA_HEADS = 8
MLA_D_NOPE = 128
MLA_D_ROPE = 64
MLA_D_V = 128
MLA_Q_RANK = 256
MLA_KV_RANK = 256

NSA_HEADS = 8
NSA_KV_HEADS = 2
NSA_HEAD_DIM = 128
NSA_CMP_BLOCK = 32
NSA_CMP_STRIDE = 16
NSA_CMP_HIDDEN = 128
NSA_SLC_BLOCK = 64
NSA_SLC_TOPK = 8
NSA_SLC_Q_CHUNK = 64
NSA_WINDOW = 512
NSA_FORCE_BONUS = 1e3

SB_HEADS = 8
SB_HEAD_DIM = 128

MOE_GROUPS = 4
MOE_EXPERTS_PER_GROUP = 8
MOE_EXPERTS = MOE_GROUPS * MOE_EXPERTS_PER_GROUP
MOE_TOPK = 2
MOE_D_FF = 512
MOE_ROW_BLOCK = 128

kernel_name = 'hybrid_mla_nsa_stickbreak_hmoe_deepnorm'


def layer_norm(x, g, b):
    xf = x.astype(jnp.float32)
    mu = jnp.mean(xf, -1, keepdims=True)
    var = jnp.mean(jnp.square(xf - mu), -1, keepdims=True)
    return ((xf - mu) * lax.rsqrt(var + LN_EPS)).astype(x.dtype) * g + b


def rms_norm(x, g):
    xf = x.astype(jnp.float32)
    return (xf * lax.rsqrt(jnp.mean(xf * xf, -1, keepdims=True) + RMS_EPS)).astype(x.dtype) * g


def rope_tables(positions, dim):
    inv_freq = 1.0 / (ROPE_THETA ** (jnp.arange(0, dim, 2, dtype=jnp.float32) / dim))
    ang = positions.astype(jnp.float32)[..., None] * inv_freq
    return jnp.cos(ang), jnp.sin(ang)


def apply_rope(x, cos, sin):
    bshape = cos.shape[:2] + (1,) * (x.ndim - 3) + cos.shape[-1:]
    cos, sin = cos.reshape(bshape), sin.reshape(bshape)
    x1, x2 = jnp.split(x.astype(jnp.float32), 2, axis=-1)
    return jnp.concatenate([x1 * cos - x2 * sin, x2 * cos + x1 * sin], -1).astype(x.dtype)


def masked_softmax(s, mask):
    p = jax.nn.softmax(jnp.where(mask, s, NEG_INF), axis=-1)
    return jnp.where(mask, p, 0.0)


def adaln(c, w, b):
    m = (jax.nn.silu(c) @ w + b)[:, None, :]
    return jnp.split(m, 3, axis=-1)


def mla_mixer(h, cos, sin, w_in, g_q, w_uq, g_kv, w_ukv, w_o):
    B, S, _ = h.shape
    H, dn, dr, dv = MLA_HEADS, MLA_D_NOPE, MLA_D_ROPE, MLA_D_V
    c_q, c_kv, k_rope = jnp.split(h @ w_in, [MLA_Q_RANK, MLA_Q_RANK + MLA_KV_RANK], axis=-1)
    q = (rms_norm(c_q, g_q) @ w_uq).reshape(B, S, H, dn + dr)
    q_nope, q_rope = q[..., :dn], apply_rope(q[..., dn:], cos, sin)
    kv = (rms_norm(c_kv, g_kv) @ w_ukv).reshape(B, S, H, dn + dv)
    k_nope, v = kv[..., :dn], kv[..., dn:]
    k_rope = apply_rope(k_rope, cos, sin)
    scale = (dn + dr) ** -0.5
    k_pos = jnp.arange(S)

    def q_block(i):
        start = i * Q_BLOCK
        qn = lax.dynamic_slice_in_dim(q_nope, start, Q_BLOCK, axis=1)
        qr = lax.dynamic_slice_in_dim(q_rope, start, Q_BLOCK, axis=1)
        s = (jnp.einsum('bqhd,bkhd->bhqk', qn, k_nope)
             + jnp.einsum('bqhd,bkd->bhqk', qr, k_rope)).astype(jnp.float32) * scale
        causal = k_pos[None, :] <= (start + jnp.arange(Q_BLOCK))[:, None]
        p = masked_softmax(s, causal).astype(v.dtype)
        return jnp.einsum('bhqk,bkhd->bqhd', p, v)

    o = lax.map(q_block, jnp.arange(S // Q_BLOCK))
    o = jnp.moveaxis(o, 0, 1).reshape(B, S, H * dv)
    return o @ w_o


def nsa_mixer(h, cos, sin, w_in, pe_k, pe_v, w_ck1, w_ck2, w_cv1, w_cv2, w_o):
    B, S, _ = h.shape
    H, KH, Dh = NSA_HEADS, NSA_KV_HEADS, NSA_HEAD_DIM
    G = H // KH
    kvw = KH * Dh
    cuts = [int(v) for v in np.cumsum([H * Dh] + [kvw] * 6)]
    q, kc, vc, ks, vs, kw, vw, gl = jnp.split(h @ w_in, cuts, axis=-1)
    q = apply_rope(q.reshape(B, S, KH, G, Dh), cos, sin)
    kv_shape = (B, S, KH, Dh)
    kc, ks, kw = [apply_rope(t.reshape(kv_shape), cos, sin) for t in (kc, ks, kw)]
    vc, vs, vw = [t.reshape(kv_shape) for t in (vc, vs, vw)]
    gates = jax.nn.sigmoid(gl.astype(jnp.float32)).astype(h.dtype).reshape(B, S, KH, G, 3)
    scale = Dh ** -0.5
    pos = jnp.arange(S)

    n_cmp = (S - NSA_CMP_BLOCK) // NSA_CMP_STRIDE + 1
    cmp_start = np.arange(n_cmp, dtype=np.int32) * NSA_CMP_STRIDE
    cidx = cmp_start[:, None] + np.arange(NSA_CMP_BLOCK, dtype=np.int32)[None, :]

    def compress(t, pe, w1, w2):
        blk = t[:, cidx] + pe[:, None, :]
        return jax.nn.silu(jnp.einsum('bnlkd,lde->bnke', blk, w1)) @ w2

    k_cmp = compress(kc, pe_k, w_ck1, w_ck2)
    v_cmp = compress(vc, pe_v, w_cv1, w_cv2)
    s_cmp = jnp.einsum('bskgd,bnkd->bkgsn', q, k_cmp).astype(jnp.float32) * scale
    cmp_mask = (cmp_start + NSA_CMP_BLOCK - 1)[None, :] <= pos[:, None]
    p_cmp = masked_softmax(s_cmp, cmp_mask)
    o_cmp = jnp.einsum('bkgsn,bnkd->bskgd', p_cmp.astype(v_cmp.dtype), v_cmp)

    n_slc = S // NSA_SLC_BLOCK
    top_n = min(NSA_SLC_TOPK, n_slc)
    slc_start = np.arange(n_slc, dtype=np.int32) * NSA_SLC_BLOCK
    overlap = np.clip(np.minimum(cmp_start[:, None] + NSA_CMP_BLOCK, slc_start[None, :] + NSA_SLC_BLOCK)
                      - np.maximum(cmp_start[:, None], slc_start[None, :]), 0, None).astype(np.float32) / NSA_CMP_BLOCK
    imp = jnp.einsum('bkgsn,nj->bksj', p_cmp, jnp.asarray(overlap))
    blk_id = jnp.arange(n_slc)[None, :]
    cur = (pos // NSA_SLC_BLOCK)[:, None]
    forced = (blk_id == 0) | (blk_id == cur) | (blk_id == cur - 1)
    valid = jnp.asarray(slc_start)[None, :] <= pos[:, None]
    imp = jnp.where(valid, imp + jnp.where(forced, NSA_FORCE_BONUS, 0.0), -jnp.inf)
    _, sel = lax.top_k(imp, top_n)
    ks_blk = jnp.moveaxis(ks.reshape(B, n_slc, NSA_SLC_BLOCK, KH, Dh), 3, 1)
    vs_blk = jnp.moveaxis(vs.reshape(B, n_slc, NSA_SLC_BLOCK, KH, Dh), 3, 1)
    b_ix = jnp.arange(B)[:, None, None, None]
    k_ix = jnp.arange(KH)[None, :, None, None]
    C = NSA_SLC_Q_CHUNK
    n_tok = top_n * NSA_SLC_BLOCK

    def slc_chunk(i):
        start = i * C
        qc = lax.dynamic_slice_in_dim(q, start, C, axis=1)
        selc = lax.dynamic_slice_in_dim(sel, start, C, axis=2)
        kg = ks_blk[b_ix, k_ix, selc].reshape(B, KH, C, n_tok, Dh)
        vg = vs_blk[b_ix, k_ix, selc].reshape(B, KH, C, n_tok, Dh)
        tok_pos = (selc[..., None] * NSA_SLC_BLOCK + jnp.arange(NSA_SLC_BLOCK)).reshape(B, KH, C, n_tok)
        m = tok_pos <= (start + jnp.arange(C))[None, None, :, None]
        s = jnp.einsum('bckgd,bkcnd->bkgcn', qc, kg).astype(jnp.float32) * scale
        p = masked_softmax(s, m[:, :, None])
        return jnp.einsum('bkgcn,bkcnd->bckgd', p.astype(vg.dtype), vg)

    o_slc = jnp.moveaxis(lax.map(slc_chunk, jnp.arange(S // C)), 0, 1).reshape(B, S, KH, G, Dh)

    QB = Q_BLOCK
    nb = S // QB
    span = NSA_WINDOW + QB
    widx = np.arange(nb, dtype=np.int32)[:, None] * QB + np.arange(span, dtype=np.int32)[None, :]
    pad = ((0, 0), (NSA_WINDOW, 0), (0, 0), (0, 0))
    k_win = jnp.pad(kw, pad)[:, widx]
    v_win = jnp.pad(vw, pad)[:, widx]
    k_pos = widx - NSA_WINDOW
    q_pos = np.arange(S, dtype=np.int32).reshape(nb, QB)
    diff = q_pos[:, :, None] - k_pos[:, None, :]
    band = (diff >= 0) & (diff < NSA_WINDOW) & (k_pos[:, None, :] >= 0)
    s_win = jnp.einsum('bnqkgd,bnskd->bnkgqs', q.reshape(B, nb, QB, KH, G, Dh), k_win).astype(jnp.float32) * scale
    p_win = masked_softmax(s_win, band[None, :, None, None])
    o_win = jnp.einsum('bnkgqs,bnskd->bnqkgd', p_win.astype(v_win.dtype), v_win).reshape(B, S, KH, G, Dh)

    o = gates[..., 0:1] * o_cmp + gates[..., 1:2] * o_slc + gates[..., 2:3] * o_win
    return o.reshape(B, S, H * Dh) @ w_o


def sb_mixer(h, w_qkv, w_o):
    B, S, _ = h.shape
    H, d = SB_HEADS, SB_HEAD_DIM
    qkv = (h @ w_qkv).reshape(B, S, 3, H, d)
    q, k, v = qkv[:, :, 0], qkv[:, :, 1], qkv[:, :, 2]
    scale = d ** -0.5
    k_pos = jnp.arange(S)

    def q_block(i):
        start = i * Q_BLOCK
        qb = lax.dynamic_slice_in_dim(q, start, Q_BLOCK, axis=1)
        z = jnp.einsum('bqhd,bkhd->bhqk', qb, k).astype(jnp.float32) * scale
        strict = k_pos[None, :] < (start + jnp.arange(Q_BLOCK))[:, None]
        log_keep = jnp.where(strict, jax.nn.log_sigmoid(-z), 0.0)
        between = lax.cumsum(log_keep, axis=3, reverse=True) - log_keep
        a = jnp.where(strict, jnp.exp(jax.nn.log_sigmoid(z) + between), 0.0)
        return jnp.einsum('bhqk,bkhd->bqhd', a.astype(v.dtype), v)

    o = lax.map(q_block, jnp.arange(S // Q_BLOCK))
    o = jnp.moveaxis(o, 0, 1).reshape(B, S, H * d)
    return o @ w_o


def grouped_swiglu(xt, experts, weights, w_gate, w_up, w_down):
    T, D = xt.shape
    E, R = w_gate.shape[0], MOE_ROW_BLOCK
    K = experts.shape[1]
    N = T * K
    e_flat = experts.reshape(N)
    order = jnp.argsort(e_flat)
    e_sorted = e_flat[order]
    tok_sorted = (order // K).astype(jnp.int32)
    w_sorted = weights.reshape(N)[order].astype(xt.dtype)
    counts = jnp.bincount(e_flat, length=E)
    padded = (counts + R - 1) // R * R
    ends = jnp.cumsum(padded)
    dest = (ends - padded)[e_sorted] + jnp.arange(N) - (jnp.cumsum(counts) - counts)[e_sorted]
    P = ((N + R - 1) // R + E) * R
    row_tok = jnp.full((P,), T, jnp.int32).at[dest].set(tok_sorted)
    row_w = jnp.zeros((P,), xt.dtype).at[dest].set(w_sorted)
    n_blk = P // R
    blk_exp = jnp.minimum(jnp.sum(jnp.arange(n_blk)[:, None] * R >= ends[None, :], axis=1), E - 1)
    x_rows = jnp.concatenate([xt, jnp.zeros((1, D), xt.dtype)], axis=0)[row_tok].reshape(n_blk, R, D)

    def expert_block(args):
        xb, e = args
        return (jax.nn.silu(xb @ w_gate[e]) * (xb @ w_up[e])) @ w_down[e]

    y = lax.map(expert_block, (x_rows, blk_exp)).reshape(P, D) * row_w[:, None]
    return jnp.zeros((T + 1, D), y.dtype).at[row_tok].add(y)[:T]


def hier_moe(h, w_grp, b_grp, w_rt, b_rt, w_gate, w_up, w_down):
    B, S, D = h.shape
    xt = h.reshape(B * S, D)
    T = xt.shape[0]
    tok = jnp.arange(T)
    g_logit = (xt @ w_grp + b_grp).astype(jnp.float32)
    g_idx = jnp.argmax(g_logit, axis=-1)
    g_w = jax.nn.softmax(g_logit, axis=-1)[tok, g_idx]
    e_logit = (xt @ w_rt + b_rt).astype(jnp.float32).reshape(T, MOE_GROUPS, MOE_EXPERTS_PER_GROUP)[tok, g_idx]
    e_p, e_local = lax.top_k(jax.nn.softmax(e_logit, axis=-1), MOE_TOPK)
    weights = g_w[:, None] * e_p / jnp.sum(e_p, -1, keepdims=True)
    experts = g_idx[:, None] * MOE_EXPERTS_PER_GROUP + e_local
    return grouped_swiglu(xt, experts, weights, w_gate, w_up, w_down).reshape(B, S, D)


def setup_inputs(seed: int = 0) -> dict:
    key = jax.random.key(seed)
    keys = iter(jax.random.split(key, 40))
    D = D_MODEL

    def normal(shape, std):
        return jax.random.normal(next(keys), shape, jnp.float32) * std

    nA, nB, nC = N_MLA_LAYERS, N_NSA_LAYERS, N_SB_LAYERS
    mla_in = MLA_Q_RANK + MLA_KV_RANK + MLA_D_ROPE
    nsa_in = NSA_HEADS * NSA_HEAD_DIM + 6 * NSA_KV_HEADS * NSA_HEAD_DIM + 3 * NSA_HEADS
    E, F = MOE_EXPERTS, MOE_D_FF
    return {
        'x': normal((BATCH, SEQ, D), 1.0),
        'c': normal((BATCH, D), 1.0),
        'positions': jnp.arange(SEQ, dtype=jnp.int32)[None, :]
                     + jax.random.randint(next(keys), (BATCH, 1), 0, 4096, dtype=jnp.int32),
        'ada_w': normal((DEPTH, 2, D, 3 * D), 0.5 * D ** -0.5),
        'ada_b': normal((DEPTH, 2, 3 * D), 0.02),
        'ln_g': 1.0 + normal((DEPTH, 2, D), 0.05),
        'ln_b': normal((DEPTH, 2, D), 0.02),
        'mla_w_in': normal((nA, D, mla_in), D ** -0.5),
        'mla_g_q': 1.0 + normal((nA, MLA_Q_RANK), 0.05),
        'mla_w_uq': normal((nA, MLA_Q_RANK, MLA_HEADS * (MLA_D_NOPE + MLA_D_ROPE)), MLA_Q_RANK ** -0.5),
        'mla_g_kv': 1.0 + normal((nA, MLA_KV_RANK), 0.05),
        'mla_w_ukv': normal((nA, MLA_KV_RANK, MLA_HEADS * (MLA_D_NOPE + MLA_D_V)), MLA_KV_RANK ** -0.5),
        'mla_w_o': normal((nA, MLA_HEADS * MLA_D_V, D), DEEPNORM_BETA * (MLA_HEADS * MLA_D_V) ** -0.5),
        'nsa_w_in': normal((nB, D, nsa_in), D ** -0.5),
        'nsa_pe_k': normal((nB, NSA_CMP_BLOCK, NSA_HEAD_DIM), 0.1),
        'nsa_pe_v': normal((nB, NSA_CMP_BLOCK, NSA_HEAD_DIM), 0.1),
        'nsa_w_ck1': normal((nB, NSA_CMP_BLOCK, NSA_HEAD_DIM, NSA_CMP_HIDDEN), (NSA_CMP_BLOCK * NSA_HEAD_DIM) ** -0.5),
        'nsa_w_ck2': normal((nB, NSA_CMP_HIDDEN, NSA_HEAD_DIM), NSA_CMP_HIDDEN ** -0.5),
        'nsa_w_cv1': normal((nB, NSA_CMP_BLOCK, NSA_HEAD_DIM, NSA_CMP_HIDDEN), (NSA_CMP_BLOCK * NSA_HEAD_DIM) ** -0.5),
        'nsa_w_cv2': normal((nB, NSA_CMP_HIDDEN, NSA_HEAD_DIM), NSA_CMP_HIDDEN ** -0.5),
        'nsa_w_o': normal((nB, NSA_HEADS * NSA_HEAD_DIM, D), DEEPNORM_BETA * (NSA_HEADS * NSA_HEAD_DIM) ** -0.5),
        'sb_w_qkv': normal((nC, D, 3 * SB_HEADS * SB_HEAD_DIM), D ** -0.5),
        'sb_w_o': normal((nC, SB_HEADS * SB_HEAD_DIM, D), DEEPNORM_BETA * (SB_HEADS * SB_HEAD_DIM) ** -0.5),
        'moe_w_grp': normal((DEPTH, D, MOE_GROUPS), D ** -0.5),
        'moe_b_grp': normal((DEPTH, MOE_GROUPS), 0.01),
        'moe_w_rt': normal((DEPTH, D, E), D ** -0.5),
        'moe_b_rt': normal((DEPTH, E), 0.01),
        'moe_w_gate': normal((DEPTH, E, D, F), D ** -0.5),
        'moe_w_up': normal((DEPTH, E, D, F), D ** -0.5),
        'moe_w_down': normal((DEPTH, E, F, D), DEEPNORM_BETA * F ** -0.5),
    }


def reference(x, c, positions, ada_w, ada_b, ln_g, ln_b,
              mla_w_in, mla_g_q, mla_w_uq, mla_g_kv, mla_w_ukv, mla_w_o,
              nsa_w_in, nsa_pe_k, nsa_pe_v, nsa_w_ck1, nsa_w_ck2, nsa_w_cv1, nsa_w_cv2, nsa_w_o,
              sb_w_qkv, sb_w_o,
              moe_w_grp, moe_b_grp, moe_w_rt, moe_b_rt, moe_w_gate, moe_w_up, moe_w_down):
    cos_mla, sin_mla = rope_tables(positions, MLA_D_ROPE)
    cos_nsa, sin_nsa = rope_tables(positions, NSA_HEAD_DIM)
    for i in range(DEPTH):
        kind, j = i % N_MIXERS, i // N_MIXERS
        shift, scale, gate = adaln(c, ada_w[i, 0], ada_b[i, 0])
        h = x * (1.0 + scale) + shift
        if kind == 0:
            y = mla_mixer(h, cos_mla, sin_mla, mla_w_in[j], mla_g_q[j], mla_w_uq[j],
                          mla_g_kv[j], mla_w_ukv[j], mla_w_o[j])
        elif kind == 1:
            y = nsa_mixer(h, cos_nsa, sin_nsa, nsa_w_in[j], nsa_pe_k[j], nsa_pe_v[j],
                          nsa_w_ck1[j], nsa_w_ck2[j], nsa_w_cv1[j], nsa_w_cv2[j], nsa_w_o[j])
        else:
            y = sb_mixer(h, sb_w_qkv[j], sb_w_o[j])
        x = layer_norm(DEEPNORM_ALPHA * x + gate * y, ln_g[i, 0], ln_b[i, 0])
        shift, scale, gate = adaln(c, ada_w[i, 1], ada_b[i, 1])
        h = x * (1.0 + scale) + shift
        y = hier_moe(h, moe_w_grp[i], moe_b_grp[i], moe_w_rt[i], moe_b_rt[i],
                     moe_w_gate[i], moe_w_up[i], moe_w_down[i])
        x = layer_norm(DEEPNORM_ALPHA * x + gate * y, ln_g[i, 1], ln_b[i, 1])
    return x
```

```cpp
#include <hip/hip_runtime.h>
#include <stdint.h>
#include <stdio.h>

#ifndef MULTI_LAUNCH
#define MULTI_LAUNCH 0
#endif

typedef unsigned short bf16_t;
typedef short bf16x8 __attribute__((ext_vector_type(8)));
typedef float f32x16 __attribute__((ext_vector_type(16)));
typedef float f32x4 __attribute__((ext_vector_type(4)));
typedef _Float16 f16_t;
typedef _Float16 f16x4 __attribute__((ext_vector_type(4)));
typedef _Float16 f16x8 __attribute__((ext_vector_type(8)));
typedef float f32x8 __attribute__((ext_vector_type(8)));
__device__ __forceinline__ f32x4 ld4h(const f16_t* p) { return __builtin_convertvector(*reinterpret_cast<const f16x4*>(p), f32x4); }
__device__ __forceinline__ void st4h(f16_t* p, f32x4 v) { *reinterpret_cast<f16x4*>(p) = __builtin_convertvector(v, f16x4); }

constexpr int T_TOK = 16384, DM = 1024, NBATCH = 8, SEQ = 2048, DEPTH = 4;
constexpr float LN_EPS = 1e-5f, RMS_EPS = 1e-6f;
constexpr float DN_ALPHA = 1.6817928305074290f;
constexpr int NTHR = 256;
constexpr int LDS_WORK = 256;
constexpr int HALF_LDS = 80640;
constexpr int LDS_BYTES = LDS_WORK + 2 * HALF_LDS;
#define VHALF ((int)__builtin_amdgcn_readfirstlane((int)(threadIdx.x >> 8)))
#define VT ((int)(threadIdx.x & 255u))
#define VB ((int)(blockIdx.x * 2u) + VHALF)
#define NVB ((int)(gridDim.x * 2u))
#define VLDS (smem + LDS_WORK + VHALF * HALF_LDS)

#define XB_TMO      128
#define XB_XCNT(j)  (256  + 64 * (j))
#define XB_XSUB(j)  (1280 + 64 * (j))
#define XB_XGEN(j)  (2304 + 64 * (j))
#define XB_TOP      3328
#define XB_TOPGEN   3392
#define XCD_BAR_WORDS 3456
#define XB_SPIN_CAP (1u << 22)
#define LAS __attribute__((address_space(3)))

__device__ __forceinline__ unsigned xb_ld(unsigned* p)              { return __hip_atomic_load(p, __ATOMIC_RELAXED, __HIP_MEMORY_SCOPE_AGENT); }
__device__ __forceinline__ unsigned xb_add(unsigned* p, unsigned v) { return __hip_atomic_fetch_add(p, v, __ATOMIC_RELAXED, __HIP_MEMORY_SCOPE_AGENT); }
__device__ __forceinline__ unsigned xb_xcc_id() { return (unsigned)__builtin_amdgcn_s_getreg((3 << 11) | 20) & 0xFu; }
#define XB_SPIN(cond, bar) do { unsigned _sp = 0; while (cond) { __builtin_amdgcn_s_sleep(1); \
    if ((++_sp & 255u) == 0u) { if (xb_ld(&(bar)[XB_TMO])) break; if (_sp > XB_SPIN_CAP) { atomicAdd(&(bar)[XB_TMO], 1u); break; } } } } while (0)

struct XcdBarrier { unsigned* bar; unsigned x; volatile LAS unsigned* st; };

__device__ __forceinline__ XcdBarrier xcd_barrier_post(unsigned* bar, volatile LAS unsigned* st) {
    XcdBarrier b; b.bar = bar; b.x = xb_xcc_id(); b.st = st;
    if (threadIdx.x == 0) (void)xb_add(&bar[XB_XCNT(b.x)], 1u);
    return b;
}
__device__ __forceinline__ void xcd_barrier_complete(unsigned* bar, unsigned x, unsigned& nloc, unsigned& nx) {
    const unsigned G = gridDim.x * gridDim.y * gridDim.z;
    unsigned sum, cnt, mine, sp = 0u;
    for (;;) {
        sum = 0u; cnt = 0u; mine = 0u;
#pragma unroll
        for (unsigned j = 0; j < 16; ++j) { const unsigned c = xb_ld(&bar[XB_XCNT(j)]); sum += c; cnt += (c > 0u) ? 1u : 0u; mine = (j == x) ? c : mine; }
        if (sum == G) break;
        __builtin_amdgcn_s_sleep(1);
        if ((++sp & 255u) == 0u) { if (xb_ld(&bar[XB_TMO])) break; if (sp > XB_SPIN_CAP) { atomicAdd(&bar[XB_TMO], 1u); break; } }
    }
    nloc = mine > 0u ? mine : 1u; nx = cnt > 0u ? cnt : 1u;
}
__device__ __forceinline__ void xcd_barrier(const XcdBarrier& b) {
    asm volatile("s_waitcnt vmcnt(0)" ::: "memory");
    __syncthreads();
    if (threadIdx.x == 0) {
        unsigned* bar = b.bar;
        __builtin_amdgcn_s_waitcnt(0);
        unsigned nloc = b.st[0], nx = b.st[1];
        if (nloc == 0u) { xcd_barrier_complete(bar, b.x, nloc, nx); b.st[0] = nloc; b.st[1] = nx; }
        const unsigned old = xb_add(&bar[XB_XSUB(b.x)], 1u);
        const unsigned gen = old / nloc;
        if (old + 1u == (gen + 1u) * nloc) {
            __builtin_amdgcn_fence(__ATOMIC_RELEASE, "agent");
            asm volatile("s_waitcnt vmcnt(0)" ::: "memory");
            const unsigned og = xb_add(&bar[XB_TOP], 1u);
            const unsigned tg = og / nx;
            if (og + 1u == (tg + 1u) * nx) xb_add(&bar[XB_TOPGEN], 1u);
            else XB_SPIN(xb_ld(&bar[XB_TOPGEN]) == tg, bar);
            __builtin_amdgcn_fence(__ATOMIC_ACQUIRE, "agent");
            xb_add(&bar[XB_XGEN(b.x)], 1u);
            asm volatile("s_waitcnt vmcnt(0)" ::: "memory");
        } else {
            XB_SPIN(xb_ld(&bar[XB_XGEN(b.x)]) == gen, bar);
            __builtin_amdgcn_fence(__ATOMIC_ACQUIRE, "agent");
            asm volatile("s_waitcnt vmcnt(0)" ::: "memory");
        }
    }
    __syncthreads();
}

struct Params;
typedef const __attribute__((address_space(4))) Params& PRef;
struct Params {
    const float* x; const float* c; const int* pos; const float* ada_w; const float* ada_b; const float* ln_g; const float* ln_b;
    const float* mla_w_in; const float* mla_g_q; const float* mla_w_uq; const float* mla_g_kv; const float* mla_w_ukv; const float* mla_w_o;
    const float* nsa_w_in; const float* nsa_pe_k; const float* nsa_pe_v; const float* nsa_w_ck1; const float* nsa_w_ck2; const float* nsa_w_cv1; const float* nsa_w_cv2; const float* nsa_w_o;
    const float* sb_w_qkv; const float* sb_w_o;
    const float* moe_w_grp; const float* moe_b_grp; const float* moe_w_rt; const float* moe_b_rt; const float* moe_w_gate; const float* moe_w_up; const float* moe_w_down;
    float* out;
    unsigned* bar; int* cnt; float* mod; float* cosm; float* sinm; float* cosn; float* sinn; float* bias1; float* wr;
    f16_t* xbuf; f16_t* zbuf; bf16_t* hbuf;
    bf16_t* wt_mla_in; bf16_t* wt_uq; bf16_t* wt_ukv; bf16_t* wt_mla_o; bf16_t* wt_nsa_in; bf16_t* wt_ck1; bf16_t* wt_cv1; bf16_t* wt_ck2; bf16_t* wt_cv2;
    bf16_t* wt_nsa_o; bf16_t* wt_sb_qkv; bf16_t* wt_sb_o; bf16_t* wt_gu; bf16_t* wt_dn;
    bf16_t* cbuf; float* rss; bf16_t* krope; bf16_t* qm; bf16_t* kn; bf16_t* vt;
    bf16_t* qn; bf16_t* kc; bf16_t* vc; bf16_t* ks; bf16_t* kw; bf16_t* vst; bf16_t* vwt; float* gates; float* cpart; bf16_t* hid; bf16_t* kcmp; bf16_t* vcmpt;
    bf16_t* qs; bf16_t* ksb;
    bf16_t* obuf;
    int* wq;
    int* list; float* listw; bf16_t* hmoe; bf16_t* ybuf;
};

extern __shared__ __attribute__((aligned(16))) unsigned char smem[];

__device__ __forceinline__ unsigned cvtpk(float lo, float hi) { unsigned r; asm("s_nop 0\n\tv_cvt_pk_bf16_f32 %0, %1, %2\n\ts_nop 1" : "=v"(r) : "v"(lo), "v"(hi)); return r; }
__device__ __forceinline__ uint4 cvtpk8(float a0, float a1, float a2, float a3, float a4, float a5, float a6, float a7) {
    uint4 r;
    asm("s_nop 0\n\tv_cvt_pk_bf16_f32 %0, %4, %5\n\tv_cvt_pk_bf16_f32 %1, %6, %7\n\tv_cvt_pk_bf16_f32 %2, %8, %9\n\tv_cvt_pk_bf16_f32 %3, %10, %11\n\ts_nop 1"
        : "=&v"(r.x), "=&v"(r.y), "=&v"(r.z), "=&v"(r.w) : "v"(a0), "v"(a1), "v"(a2), "v"(a3), "v"(a4), "v"(a5), "v"(a6), "v"(a7));
    return r;
}
__device__ __forceinline__ float bf2f(unsigned v16) { return __uint_as_float(v16 << 16); }
__device__ __forceinline__ uint4 pack8(const float* v) { return cvtpk8(v[0], v[1], v[2], v[3], v[4], v[5], v[6], v[7]); }
__device__ __forceinline__ float wave_sum(float v) {
#pragma unroll
    for (int o = 32; o > 0; o >>= 1) v += __shfl_xor(v, o, 64);
    return v;
}
__device__ __forceinline__ float xh_max(float v) { auto rr = __builtin_amdgcn_permlane32_swap(__float_as_uint(v), __float_as_uint(v), false, false); return fmaxf(__uint_as_float(rr[0]), __uint_as_float(rr[1])); }
__device__ __forceinline__ float xh_sum(float v) { auto rr = __builtin_amdgcn_permlane32_swap(__float_as_uint(v), __float_as_uint(v), false, false); return __uint_as_float(rr[0]) + __uint_as_float(rr[1]); }
__device__ __forceinline__ float xh_other(float v, int h) { auto rr = __builtin_amdgcn_permlane32_swap(__float_as_uint(v), __float_as_uint(v), false, false); return h ? __uint_as_float(rr[0]) : __uint_as_float(rr[1]); }
__device__ __forceinline__ float silu_f(float v) { return v / (1.f + __expf(-v)); }
__device__ __forceinline__ float sigmoid_f(float v) { return 1.f / (1.f + __expf(-v)); }
#define MFMA32(a, b, c) __builtin_amdgcn_mfma_f32_32x32x16_bf16((a), (b), (c), 0, 0, 0)
__device__ __forceinline__ int crow(int reg, int h) { return (reg & 3) + 8 * (reg >> 2) + 4 * h; }
__device__ __forceinline__ bf16x8 lds_frag(const unsigned char* base, int off) { return *reinterpret_cast<const bf16x8*>(base + off); }

constexpr int CS_LD = 132;
constexpr int GEMM_RSTD_OFF = 128 * CS_LD * 4;
template <class RowPtr>
__device__ __forceinline__ void gemm_main(int tid, unsigned char* lds, const RowPtr& rowptr, const bf16_t* __restrict__ Bt, int ldb, int n0, int K, f32x16 (&acc)[2][2]) {
    const int lane = tid & 63, wid = tid >> 6, wr = wid >> 1, wc = wid & 1, r = lane & 31, h = lane >> 5;
    const bf16_t* pa[4]; const bf16_t* pb[4];
#pragma unroll
    for (int i = 0; i < 4; ++i) {
        const int pi = wid + 4 * i, row = 8 * pi + (lane >> 3), c = (lane & 7) ^ ((row >> 1) & 7);
        pa[i] = rowptr(row) + c * 8; pb[i] = Bt + (size_t)(n0 + row) * ldb + c * 8;
    }
    const int swz = (r >> 1) & 7;
    const int aoff = (wr * 64 + r) * 128, boff = 32768 + (wc * 64 + r) * 128;
#pragma unroll
    for (int i = 0; i < 2; ++i)
#pragma unroll
        for (int j = 0; j < 2; ++j)
#pragma unroll
            for (int q = 0; q < 16; ++q) acc[i][j][q] = 0.f;
    const int nk = K >> 6;
    auto dma = [&](int buf, int k0) {
#pragma unroll
        for (int i = 0; i < 4; ++i) {
            const int pi = wid + 4 * i;
            __builtin_amdgcn_global_load_lds((const unsigned*)(pa[i] + k0), (LAS unsigned*)(lds + buf * 16384 + pi * 1024), 16, 0, 0);
            __builtin_amdgcn_global_load_lds((const unsigned*)(pb[i] + k0), (LAS unsigned*)(lds + 32768 + buf * 16384 + pi * 1024), 16, 0, 0);
        }
    };
    dma(0, 0);
    asm volatile("s_waitcnt vmcnt(0)" ::: "memory"); __syncthreads();
    for (int kt = 0; kt < nk; ++kt) {
        if (kt + 1 < nk) dma((kt + 1) & 1, (kt + 1) << 6);
        const unsigned char* sa = lds + (kt & 1) * 16384;
#pragma unroll
        for (int kk = 0; kk < 4; ++kk) {
            const int co = ((2 * kk + h) ^ swz) << 4;
            const bf16x8 a0 = lds_frag(sa, aoff + co), a1 = lds_frag(sa, aoff + 4096 + co);
            const bf16x8 b0 = lds_frag(sa, boff + co), b1 = lds_frag(sa, boff + 4096 + co);
            acc[0][0] = MFMA32(a0, b0, acc[0][0]); acc[0][1] = MFMA32(a0, b1, acc[0][1]);
            acc[1][0] = MFMA32(a1, b0, acc[1][0]); acc[1][1] = MFMA32(a1, b1, acc[1][1]);
        }
        asm volatile("s_waitcnt vmcnt(0)" ::: "memory"); __syncthreads();
    }
    float* Cs = reinterpret_cast<float*>(lds);
#pragma unroll
    for (int i = 0; i < 2; ++i)
#pragma unroll
        for (int j = 0; j < 2; ++j)
#pragma unroll
            for (int q = 0; q < 16; ++q) Cs[(wr * 64 + i * 32 + crow(q, h)) * CS_LD + wc * 64 + j * 32 + r] = acc[i][j][q];
    __syncthreads();
}
#define ITEM_END_SYNC() do { asm volatile("s_waitcnt lgkmcnt(0)" ::: "memory"); __builtin_amdgcn_s_barrier(); asm volatile("" ::: "memory"); } while (0)
__device__ __forceinline__ void cs_load8(const float* Cs, int row, int c0, float* v) {
    const f32x4 a = *reinterpret_cast<const f32x4*>(Cs + row * CS_LD + c0), b = *reinterpret_cast<const f32x4*>(Cs + row * CS_LD + c0 + 4);
    v[0] = a[0]; v[1] = a[1]; v[2] = a[2]; v[3] = a[3]; v[4] = b[0]; v[5] = b[1]; v[6] = b[2]; v[7] = b[3];
}
__device__ __forceinline__ void epi_plain(const float* __restrict__ Cs, bf16_t* __restrict__ dst, size_t ld, const float* __restrict__ rowscale) {
    const int tid = VT, c0 = (tid & 15) * 8;
#pragma unroll
    for (int ps = 0; ps < 8; ++ps) {
        const int row = (tid >> 4) + 16 * ps; float v[8]; cs_load8(Cs, row, c0, v);
        if (rowscale) { const float s = rowscale[row];
#pragma unroll
            for (int q = 0; q < 8; ++q) v[q] *= s; }
        *reinterpret_cast<uint4*>(dst + (size_t)row * ld + c0) = pack8(v);
    }
}
__device__ __forceinline__ void epi_rope128(const float* __restrict__ Cs, bf16_t* __restrict__ dst, size_t ld, const float* __restrict__ cs, const float* __restrict__ sn, int tok0) {
    const int tid = VT, c0 = (tid & 15) * 8;
    if (c0 >= 64) return;
#pragma unroll
    for (int ps = 0; ps < 8; ++ps) {
        const int row = (tid >> 4) + 16 * ps; float a[8], b[8], o1[8], o2[8]; cs_load8(Cs, row, c0, a); cs_load8(Cs, row, c0 + 64, b);
        const float* cp = cs + (size_t)(tok0 + row) * 64 + c0; const float* sp = sn + (size_t)(tok0 + row) * 64 + c0;
#pragma unroll
        for (int q = 0; q < 8; ++q) { const float c = cp[q], s = sp[q]; o1[q] = a[q] * c - b[q] * s; o2[q] = b[q] * c + a[q] * s; }
        *reinterpret_cast<uint4*>(dst + (size_t)row * ld + c0) = pack8(o1);
        *reinterpret_cast<uint4*>(dst + (size_t)row * ld + c0 + 64) = pack8(o2);
    }
}
__device__ __forceinline__ void epi_transpose(const float* __restrict__ Cs, bf16_t* __restrict__ dst  , size_t ld, const float* __restrict__ rowscale) {
    const int tid = VT, dv = tid & 127, sh = tid >> 7;
#pragma unroll
    for (int j = 0; j < 8; ++j) {
        float v[8];
#pragma unroll
        for (int q = 0; q < 8; ++q) { const int row = sh * 64 + j * 8 + q; v[q] = Cs[row * CS_LD + dv] * (rowscale ? rowscale[row] : 1.f); }
        *reinterpret_cast<uint4*>(dst + (size_t)dv * ld + sh * 64 + j * 8) = pack8(v);
    }
}

struct RowPlain { const bf16_t* base; size_t ld; __device__ __forceinline__ const bf16_t* operator()(int r) const { return base + (size_t)r * ld; } };


namespace g8 {
typedef float f32x4_t __attribute__((ext_vector_type(4)));
constexpr int BK = 64, HALFR = 128, HTB = HALFR * BK * 2, STAGE_BYTES = 8 * HTB;
__device__ __forceinline__ int lds_byte(int r, int c) { const int st = (r >> 4) * 2 + (c >> 5), rr = r & 15, cc = c & 31, ob = rr * 64 + cc * 2; return st * 1024 + (ob ^ (((ob >> 9) & 1) << 5)); }
__device__ __forceinline__ void stage_rc(int b, int& R, int& C) { const int st = b / 1024, sb = b % 1024, swz = sb ^ (((sb >> 9) & 1) << 5); R = (st >> 1) * 16 + swz / 64; C = (st & 1) * 32 + (swz % 64) / 2; }
struct Unit { int pm, pn, par; };
template <class Sched, class Epi>
__device__ __forceinline__ void gemm8(LAS unsigned char* lds, const char* __restrict__ Abase, int ldb, int K, const Sched& S, const Epi& E) {
    const int tid = threadIdx.x;
    const int wid = __builtin_amdgcn_readfirstlane(tid >> 6), lane = tid & 63, wr = wid >> 2, wc = wid & 3, fr = lane & 15, fq = lane >> 4;
    const int nt = K / BK;
    unsigned voffB0; { int R, C; stage_rc(tid * 16, R, C); voffB0 = (unsigned)(R * ldb + C) * 2u; }
    const unsigned voffBd = (unsigned)(64 * ldb) * 2u;
    const size_t kstep = (size_t)(BK * 2), hstepB = (size_t)HALFR * ldb * 2;
    const unsigned ldsw = (unsigned)wid * 1024u;
    const int lpart = lds_byte(fr, fq * 8);
    const int aoff = lpart + wr * 8192, boff = lpart + wc * 4096;
#define G8_SA(b, h) (((b) * 2 + (h)) * HTB)
#define G8_SB(b, h) ((4 + (b) * 2 + (h)) * HTB)
#define G8_STAGE_B(bufoff, gbase) do { \
        __builtin_amdgcn_global_load_lds((const unsigned*)((const char*)(gbase) + voffB0), (LAS unsigned*)(lds + (bufoff) + ldsw), 16, 0, 0); \
        __builtin_amdgcn_global_load_lds((const unsigned*)((const char*)(gbase) + voffBd + voffB0), (LAS unsigned*)(lds + (bufoff) + ldsw + 8192), 16, 0, 0); } while (0)
#define G8_STAGE_A(bufoff, hnd, kbytes) do { \
        __builtin_amdgcn_global_load_lds((const unsigned*)(Abase + (size_t)S.a_off(hnd, 0, tid) + (kbytes)), (LAS unsigned*)(lds + (bufoff) + ldsw), 16, 0, 0); \
        __builtin_amdgcn_global_load_lds((const unsigned*)(Abase + (size_t)S.a_off(hnd, 1, tid) + (kbytes)), (LAS unsigned*)(lds + (bufoff) + ldsw + 8192), 16, 0, 0); } while (0)
#define G8_LDA(dst, b, h) do { _Pragma("unroll") for (int m = 0; m < 4; ++m) _Pragma("unroll") for (int k = 0; k < 2; ++k) dst[m][k] = *(const LAS bf16x8*)(lds + G8_SA(b, h) + aoff + m * 2048 + k * 1024); } while (0)
#define G8_LDB(dst, b, h) do { _Pragma("unroll") for (int n = 0; n < 2; ++n) _Pragma("unroll") for (int k = 0; k < 2; ++k) dst[n][k] = *(const LAS bf16x8*)(lds + G8_SB(b, h) + boff + n * 2048 + k * 1024); } while (0)
#define G8_MMA(ai, bj, At, Bt) do { __builtin_amdgcn_s_setprio(1); _Pragma("unroll") for (int m = 0; m < 4; ++m) _Pragma("unroll") for (int n = 0; n < 2; ++n) _Pragma("unroll") for (int k = 0; k < 2; ++k) \
        acc[ai][bj][m][n] = __builtin_amdgcn_mfma_f32_16x16x32_bf16(Bt[n][k], At[m][k], acc[ai][bj][m][n], 0, 0, 0); __builtin_amdgcn_s_setprio(0); } while (0)
#define G8_WAIT_V(n) asm volatile("s_waitcnt vmcnt(" #n ")" ::: "memory")
#define G8_WAIT_L(n) asm volatile("s_waitcnt lgkmcnt(" #n ")" ::: "memory")
#define G8_BAR __builtin_amdgcn_s_barrier()
#define G8_SCHED __builtin_amdgcn_sched_barrier(0)
    Unit cur, nxt; int ui = 0;
    if (!S.next(0, cur)) return;
    f32x4_t acc[2][2][4][2];
#pragma unroll
    for (int a = 0; a < 2; ++a)
#pragma unroll
        for (int b = 0; b < 2; ++b)
#pragma unroll
            for (int m = 0; m < 4; ++m)
#pragma unroll
                for (int n = 0; n < 2; ++n) acc[a][b][m][n] = (f32x4_t){0.f, 0.f, 0.f, 0.f};
    bf16x8 At[4][2], B0[2][2], B1[2][2];
    unsigned c0, c1;
    cur.par = 0; S.stash(cur, tid); S.stash_wait(); S.a_handles(cur, tid, c0, c1);
    const char* cB = S.b_base(cur);
    G8_STAGE_B(G8_SB(0, 0), cB); G8_STAGE_A(G8_SA(0, 0), c0, 0); G8_STAGE_B(G8_SB(0, 1), cB + hstepB); G8_STAGE_A(G8_SA(0, 1), c1, 0);
    if (wr == 1) G8_BAR;
    G8_WAIT_V(4); G8_BAR;
    G8_STAGE_B(G8_SB(1, 0), cB + kstep); G8_STAGE_A(G8_SA(1, 0), c0, kstep); G8_STAGE_B(G8_SB(1, 1), cB + hstepB + kstep);
    G8_WAIT_V(6); G8_BAR;
    for (;;) {
        const bool has_next = S.next(ui + 1, nxt); nxt.par = (ui + 1) % 3;
        const char* nB = cB;
        if (has_next) { S.stash(nxt, tid); nB = S.b_base(nxt); }
#pragma unroll 1
        for (int t = 0; t < nt; t += 2) {
            const bool last = (t == nt - 2);
            const size_t k1 = (size_t)(t + 1) * kstep;
            const size_t k2 = last ? 0 : (size_t)(t + 2) * kstep, k3 = k2 + kstep;
            const char* b2 = last ? nB : cB + k2; const char* b3 = b2 + kstep;
            G8_LDB(B0, 0, 0); G8_SCHED; G8_LDA(At, 0, 0); G8_STAGE_A(G8_SA(1, 1), c1, k1);
            if (last && has_next) S.a_handles(nxt, tid, c0, c1);
            G8_WAIT_L(8); G8_BAR; G8_WAIT_L(0); G8_MMA(0, 0, At, B0); G8_BAR; G8_SCHED;
            G8_LDB(B1, 0, 1); G8_STAGE_B(G8_SB(0, 0), b2);
            G8_BAR; G8_WAIT_L(0); G8_MMA(0, 1, At, B1); G8_BAR;
            G8_LDA(At, 0, 1); G8_STAGE_A(G8_SA(0, 0), c0, k2);
            G8_BAR; G8_WAIT_L(0); G8_MMA(1, 0, At, B0); G8_BAR; G8_SCHED;
            G8_STAGE_B(G8_SB(0, 1), b2 + hstepB);
            G8_WAIT_V(6); G8_BAR; G8_MMA(1, 1, At, B1); G8_BAR;
            G8_LDB(B0, 1, 0); G8_SCHED; G8_LDA(At, 1, 0); G8_STAGE_A(G8_SA(0, 1), c1, k2);
            G8_WAIT_L(8); G8_BAR; G8_WAIT_L(0); G8_MMA(0, 0, At, B0); G8_BAR; G8_SCHED;
            G8_LDB(B1, 1, 1); G8_STAGE_B(G8_SB(1, 0), b3);
            G8_BAR; G8_WAIT_L(0); G8_MMA(0, 1, At, B1); G8_BAR;
            G8_LDA(At, 1, 1); G8_STAGE_A(G8_SA(1, 0), c0, k3);
            G8_BAR; G8_WAIT_L(0); G8_MMA(1, 0, At, B0); G8_BAR; G8_SCHED;
            G8_STAGE_B(G8_SB(1, 1), b3 + hstepB);
            G8_WAIT_V(6); G8_BAR; G8_MMA(1, 1, At, B1); G8_BAR;
        }
        E(acc, cur, wr, wc, fr, fq);
        if (!has_next) break;
#pragma unroll
        for (int a = 0; a < 2; ++a)
#pragma unroll
            for (int b = 0; b < 2; ++b)
#pragma unroll
                for (int m = 0; m < 4; ++m)
#pragma unroll
                    for (int n = 0; n < 2; ++n) acc[a][b][m][n] = (f32x4_t){0.f, 0.f, 0.f, 0.f};
        cur = nxt; cB = nB; ++ui;
    }
    G8_WAIT_V(0);
    if (wr == 0) G8_BAR;
    G8_BAR;
#undef G8_SA
#undef G8_SB
#undef G8_STAGE_A
#undef G8_STAGE_B
#undef G8_LDA
#undef G8_LDB
#undef G8_MMA
#undef G8_WAIT_V
#undef G8_WAIT_L
#undef G8_BAR
#undef G8_SCHED
}
struct SchedPlain {
    int nM, nN, nwg, G, c, lda; const char* Bt; size_t ldb_bytes;
    __device__ __forceinline__ void init(int M, int N, int lda_, const void* Bt_, int ldb) { nM = M / 256; nN = N / 256; nwg = nM * nN; G = gridDim.x; c = blockIdx.x; lda = lda_; Bt = (const char*)Bt_; ldb_bytes = (size_t)ldb * 2; }
    __device__ __forceinline__ bool next(int i, Unit& u) const {
        const long L = (long)i * G + c; if (L >= nwg) return false;
        int wgid = (int)L; { const int q = nwg / 8, r = nwg % 8, xcd = wgid % 8, off = wgid / 8; wgid = (xcd < r ? xcd * (q + 1) : r * (q + 1) + (xcd - r) * q) + off; }
        const int nig = 8 * nN, gid = wgid / nig, fm = gid * 8, gsz = (nM - fm) < 8 ? (nM - fm) : 8;
        u.pm = fm + ((wgid % nig) % gsz); u.pn = (wgid % nig) / gsz; return true;
    }
    __device__ __forceinline__ void a_handles(const Unit& u, int tid, unsigned& h0, unsigned& h1) const {
        int R, C; stage_rc(tid * 16, R, C);
        h0 = ((unsigned)(u.pm * 256 + R) * (unsigned)lda + (unsigned)C) * 2u; h1 = h0 + (unsigned)(128 * lda) * 2u;
    }
    __device__ __forceinline__ unsigned a_off(unsigned h, int piece, int) const { return h + (unsigned)(piece * 64 * lda) * 2u; }
    __device__ __forceinline__ const char* b_base(const Unit& u) const { return Bt + (size_t)u.pn * 256 * ldb_bytes; }
    __device__ __forceinline__ void stash(const Unit&, int) const {}
    __device__ __forceinline__ void stash_wait() const {}
};
struct SchedMoe {
    const int* pre; const int* list; const float* listw; const char* Bt; size_t estride, ustride; int nunits, G, c, gather; int* tab;
    __device__ __forceinline__ int expert(int panel) const { int e = 0; for (int q = 1; q < 32; ++q) e = (pre[q] <= panel) ? q : e; return e; }
    __device__ __forceinline__ bool next(int i, Unit& u) const {
        const int per = (nunits + 7) >> 3, x = c & 7, Lx = i * (G >> 3) + (c >> 3), L = x * per + Lx;
        if (Lx >= per || L >= nunits) return false;
        u.pn = L & 3; u.pm = L >> 2; return true;
    }
    __device__ __forceinline__ void stash(const Unit& u, int tid) const {
        const int e = expert(u.pm), b0 = (u.pm - pre[e]) * 256; const int* l = list + (size_t)e * T_TOK + b0;
        const int wv = __builtin_amdgcn_readfirstlane(tid >> 6);
        if (gather) {
            int R, C; stage_rc(tid * 16, R, C);
#pragma unroll
            for (int k = 0; k < 4; ++k)
                __builtin_amdgcn_global_load_lds((const unsigned*)(l + R + 64 * (k & 1) + 128 * (k >> 1)), (LAS unsigned*)((LAS unsigned char*)(LAS int*)tab + k * 2048 + wv * 256), 4, 0, 0);
        } else {
            const int r = tid & 255; const int* src = (tid < 256) ? (l + r) : reinterpret_cast<const int*>(listw + (size_t)e * T_TOK + b0 + r);
            __builtin_amdgcn_global_load_lds((const unsigned*)src, (LAS unsigned*)((LAS unsigned char*)(LAS int*)tab + u.par * 2048 + wv * 256), 4, 0, 0);
        }
    }
    __device__ __forceinline__ void stash_wait() const { asm volatile("s_waitcnt vmcnt(0)" ::: "memory"); }
    __device__ __forceinline__ void a_handles(const Unit& u, int tid, unsigned& h0, unsigned& h1) const {
        if (gather) {
            asm volatile("" ::: "memory");
            const unsigned t0 = ((unsigned)tab[tid] >> 1) & 16383u, t1 = ((unsigned)tab[512 + tid] >> 1) & 16383u, t2 = ((unsigned)tab[1024 + tid] >> 1) & 16383u, t3 = ((unsigned)tab[1536 + tid] >> 1) & 16383u;
            h0 = t0 | (t1 << 16); h1 = t2 | (t3 << 16);
        }
        else { int R, C; stage_rc(tid * 16, R, C); h0 = ((unsigned)(u.pm * 256 + R) * 512u + (unsigned)C) * 2u; h1 = h0 + 128u * 512u * 2u; }
    }
    __device__ __forceinline__ unsigned a_off(unsigned h, int piece, int tid) const {
        if (gather) { int R, C; stage_rc(tid * 16, R, C); return (((h >> (16 * piece)) & 0xffffu) * 1024u + (unsigned)C) * 2u; }
        return h + (unsigned)(piece * 64 * 512) * 2u;
    }
    __device__ __forceinline__ const char* b_base(const Unit& u) const { return Bt + (size_t)expert(u.pm) * estride + (size_t)u.pn * ustride; }
};
}

__device__ __forceinline__ void convert_T(unsigned char* lds, const float* __restrict__ src, int nb, int K, int N, bf16_t* __restrict__ dst, size_t dst_bstride,
                                       const float* __restrict__ rowscale, int grp, int grp_stride, int off, int b0 = 0, int perm = 0) {
    (void)lds;
    int tid = VT; asm volatile("" : "+v"(tid));
    const int lane = tid & 63, wid = tid >> 6;
    const int nkt = K >> 7, nnt = (N + 63) >> 6, per = nkt * nnt, total = nb * per;
    for (int it = VB; it < total; it += NVB) {
        const int bl = it / per, b = b0 + bl, rem = it - bl * per, ktile = rem / nnt, ntile = rem - ktile * nnt;
        const int k0 = (ktile << 7) + (wid * 4 + (lane >> 4)) * 8, n = (ntile << 6) + (lane & 15) * 4;
        if (n < N) {
            const float* s = src + (size_t)b * K * N + (size_t)k0 * N + n;
            f32x4 v[8];
#pragma unroll
            for (int j = 0; j < 8; ++j) v[j] = *reinterpret_cast<const f32x4*>(s + (size_t)j * N);
            if (rowscale) {
#pragma unroll
                for (int j = 0; j < 8; ++j) { const float sc = rowscale[(size_t)b * K + k0 + j]; v[j] *= sc; }
            }
#pragma unroll
            for (int q = 0; q < 4; ++q) {
                const int nn = n + q; int drow = (nn / grp) * grp_stride + off + (nn % grp);
                if (perm == 1) { const int l = drow & 127; drow = (drow & ~127) | (32 * ((l >> 4) & 3) + 16 * (l >> 6) + (l & 15)); }
                if (perm == 3) { const int l = drow & 31; drow = (drow & ~31) | (16 * ((l >> 2) & 1) + 4 * (l >> 3) + (l & 3)); }
                else if (perm == 2) { const int l = drow & 63; drow = (drow & ~63) | (32 * ((l >> 4) & 1) + 16 * (l >> 5) + (l & 15)); }
                *reinterpret_cast<uint4*>(dst + (size_t)b * dst_bstride + (size_t)drow * K + k0) = cvtpk8(v[0][q], v[1][q], v[2][q], v[3][q], v[4][q], v[5][q], v[6][q], v[7][q]);
            }
        }
    }
}

__device__ __forceinline__ void job_mod(PRef p, unsigned char* lds) {
    int tid = VT; asm volatile("" : "+v"(tid));
    const int lane = tid & 63, wid = tid >> 6;
    float* sc = reinterpret_cast<float*>(lds);
    float* part = reinterpret_cast<float*>(lds + 32768);
    for (int i = tid; i < 8192; i += NTHR) { const int b = i >> 10, k = i & 1023; const float v = p.c[b * 1024 + k]; sc[k * 8 + b] = v / (1.f + expf(-v)); }
    __syncthreads();
    for (int it = VB; it < 384; it += NVB) {
        const int sl = it / 48, n0 = (it % 48) * 64;
        const float* W = p.ada_w + (size_t)sl * 1024 * 3072 + n0 + lane;
        float acc[8] = {0.f, 0.f, 0.f, 0.f, 0.f, 0.f, 0.f, 0.f};
        const int kb = wid * 256;
#pragma unroll 16
        for (int k = 0; k < 256; ++k) {
            const float w = W[(size_t)(kb + k) * 3072];
            const f32x4 s0 = *reinterpret_cast<const f32x4*>(sc + (kb + k) * 8), s1 = *reinterpret_cast<const f32x4*>(sc + (kb + k) * 8 + 4);
            acc[0] += s0[0] * w; acc[1] += s0[1] * w; acc[2] += s0[2] * w; acc[3] += s0[3] * w;
            acc[4] += s1[0] * w; acc[5] += s1[1] * w; acc[6] += s1[2] * w; acc[7] += s1[3] * w;
        }
#pragma unroll
        for (int b = 0; b < 8; ++b) part[(wid * 8 + b) * 64 + lane] = acc[b];
        __syncthreads();
        for (int o = tid; o < 512; o += NTHR) {
            const int b = o >> 6, l = o & 63;
            const float s = part[(0 * 8 + b) * 64 + l] + part[(1 * 8 + b) * 64 + l] + part[(2 * 8 + b) * 64 + l] + part[(3 * 8 + b) * 64 + l] + p.ada_b[sl * 3072 + n0 + l];
            p.mod[(size_t)(sl * 8 + b) * 3072 + n0 + l] = s;
        }
        __syncthreads();
    }
}

__device__ __forceinline__ void job_misc(PRef p, unsigned char* lds) {
    const int tid = VT;
    const size_t gtid = (size_t)VB * NTHR + tid, gsz = (size_t)NVB * NTHR;
    for (size_t i = gtid; i < (size_t)T_TOK * 32; i += gsz) {
        const int t = (int)(i >> 5), f = (int)(i & 31);
        const float inv = 1.0f / powf(10000.f, (float)(2 * f) / 64.f);
        const float ang = (float)p.pos[t] * inv;
        p.cosm[i] = cosf(ang); p.sinm[i] = sinf(ang);
    }
    for (size_t i = gtid; i < (size_t)T_TOK * 64; i += gsz) {
        const int t = (int)(i >> 6), f = (int)(i & 63);
        const float inv = 1.0f / powf(10000.f, (float)(2 * f) / 128.f);
        const float ang = (float)p.pos[t] * inv;
        p.cosn[i] = cosf(ang); p.sinn[i] = sinf(ang);
    }
    for (size_t i = gtid; i < (size_t)DEPTH * 1024 * 48; i += gsz) {
        const int e = (int)(i % 48); const size_t lk = i / 48;
        float v = 0.f;
        if (e < 4) v = p.moe_w_grp[lk * 4 + e]; else if (e < 36) v = p.moe_w_rt[lk * 32 + (e - 4)];
        p.wr[i] = v;
    }
    if (gtid < DEPTH * 32) p.cnt[gtid * 64] = 0;
    {
        const int lane = tid & 63, wid = tid >> 6;
        for (int o = VB * 4 + wid; o < 256; o += NVB * 4) {
            const int which = o >> 7, e = o & 127;
            const float* pe = which ? p.nsa_pe_v : p.nsa_pe_k; const float* w1 = which ? p.nsa_w_cv1 : p.nsa_w_ck1;
            float a = 0.f;
#pragma unroll 16
            for (int j = 0; j < 64; ++j) { const int k = lane + 64 * j; a += pe[k] * w1[(size_t)k * 128 + e]; }
            a = wave_sum(a);
            if (lane == 0) p.bias1[o] = a;
        }
    }
}

struct CvtJob { const float* src; int nb, K, N; bf16_t* dst; size_t bstride; const float* rowscale; int grp, gstride, off, perm; };
__device__ __forceinline__ CvtJob cvt_job(PRef p, int j) {
    const int BIG = 1 << 30;
    CvtJob c;
    switch (j) {
    case 0:  c = CvtJob{p.moe_w_gate, DEPTH * 32, 1024, 512, p.wt_gu, (size_t)1024 * 1024, nullptr, 64, 128, 0, 0}; break;
    case 1:  c = CvtJob{p.moe_w_up, DEPTH * 32, 1024, 512, p.wt_gu, (size_t)1024 * 1024, nullptr, 64, 128, 64, 0}; break;
    case 2:  c = CvtJob{p.moe_w_down, DEPTH * 32, 512, 1024, p.wt_dn, (size_t)1024 * 512, nullptr, BIG, 0, 0, 0}; break;
    case 3:  c = CvtJob{p.mla_w_in, 2, 1024, 576, p.wt_mla_in, (size_t)768 * 1024, nullptr, BIG, 0, 0, 2}; break;
    case 4:  c = CvtJob{p.mla_w_uq, 2, 256, 1536, p.wt_uq, (size_t)1536 * 256, p.mla_g_q, BIG, 0, 0, 2}; break;
    case 5:  c = CvtJob{p.mla_w_ukv, 2, 256, 2048, p.wt_ukv, (size_t)2048 * 256, p.mla_g_kv, BIG, 0, 0, 0}; break;
    case 6:  c = CvtJob{p.mla_w_o, 2, 1024, 1024, p.wt_mla_o, (size_t)1024 * 1024, nullptr, BIG, 0, 0, 3}; break;
    case 7:  c = CvtJob{p.nsa_w_in, 1, 1024, 2584, p.wt_nsa_in, 0, nullptr, BIG, 0, 0, 1}; break;
    case 8:  c = CvtJob{p.nsa_w_ck1, 1, 4096, 128, p.wt_ck1, 0, nullptr, BIG, 0, 0, 0}; break;
    case 9:  c = CvtJob{p.nsa_w_cv1, 1, 4096, 128, p.wt_cv1, 0, nullptr, BIG, 0, 0, 0}; break;
    case 10: c = CvtJob{p.nsa_w_ck2, 1, 128, 128, p.wt_ck2, 0, nullptr, BIG, 0, 0, 0}; break;
    case 11: c = CvtJob{p.nsa_w_cv2, 1, 128, 128, p.wt_cv2, 0, nullptr, BIG, 0, 0, 0}; break;
    case 12: c = CvtJob{p.nsa_w_o, 1, 1024, 1024, p.wt_nsa_o, 0, nullptr, BIG, 0, 0, 3}; break;
    case 13: c = CvtJob{p.sb_w_qkv, 1, 1024, 3072, p.wt_sb_qkv, 0, nullptr, BIG, 0, 0, 3}; break;
    default: c = CvtJob{p.sb_w_o, 1, 1024, 1024, p.wt_sb_o, 0, nullptr, BIG, 0, 0, 3}; break;
    }
    return c;
}
template <int K, int N, int grp, int grp_stride, int perm>
__device__ __forceinline__ void convert_T_steal(int* ctr, const float* __restrict__ src, bf16_t* __restrict__ dst, int off, int b0) {
    constexpr int nb = 32; constexpr size_t dst_bstride = (size_t)K * N * (grp_stride ? 2 : 1);
    int tid = threadIdx.x; asm volatile("" : "+v"(tid));
    const int lane = tid & 63;
    constexpr int nkt = K >> 7, nnt = N >> 6, per = nkt * nnt, total = nb * per * 4;
    for (;;) {
        int w0 = 0;
        if (lane == 0) w0 = __hip_atomic_fetch_add(ctr, 16, __ATOMIC_RELAXED, __HIP_MEMORY_SCOPE_AGENT);
        w0 = __builtin_amdgcn_readfirstlane(w0);
        if (w0 >= total) break;
#pragma unroll 1
        for (int w = w0; w < w0 + 16; ++w) {
            const int it = w >> 2, wq = w & 3;
            const int bl = it / per, b = b0 + bl, rem = it - bl * per, ktile = rem / nnt, ntile = rem - ktile * nnt;
            const int k0 = (ktile << 7) + (wq * 4 + (lane >> 4)) * 8, n = (ntile << 6) + (lane & 15) * 4;
            const float* sp = src + (size_t)b * K * N + (size_t)k0 * N + n;
            f32x4 v[8];
#pragma unroll
            for (int j = 0; j < 8; ++j) v[j] = *reinterpret_cast<const f32x4*>(sp + (size_t)j * N);
#pragma unroll
            for (int q = 0; q < 4; ++q) {
                const int nn = n + q; int drow = (nn / grp) * grp_stride + off + (nn % grp);
                if (perm == 1) { const int l = drow & 127; drow = (drow & ~127) | (32 * ((l >> 4) & 3) + 16 * (l >> 6) + (l & 15)); }
                if (perm == 3) { const int l = drow & 31; drow = (drow & ~31) | (16 * ((l >> 2) & 1) + 4 * (l >> 3) + (l & 3)); }
                *reinterpret_cast<uint4*>(dst + (size_t)b * dst_bstride + (size_t)drow * K + k0) = cvtpk8(v[0][q], v[1][q], v[2][q], v[3][q], v[4][q], v[5][q], v[6][q], v[7][q]);
            }
        }
    }
}
__device__ __forceinline__ void convert_moe_steal(PRef p, int layer, int which) {
    int* ctr = p.wq + (layer * 3 + which) * 64;
    if (which == 0) convert_T_steal<1024, 512, 128, 256, 3>(ctr, p.moe_w_gate, p.wt_gu, 0, layer * 32);
    else if (which == 1) convert_T_steal<1024, 512, 128, 256, 3>(ctr, p.moe_w_up, p.wt_gu, 128, layer * 32);
    else convert_T_steal<512, 1024, 1 << 30, 0, 3>(ctr, p.moe_w_down, p.wt_dn, 0, layer * 32);
}
__device__ __forceinline__ void convert_moe(PRef p, int layer, int which) {
    if (which == 0) convert_T(nullptr, p.moe_w_gate, 32, 1024, 512, p.wt_gu, (size_t)1024 * 1024, nullptr, 128, 256, 0, layer * 32, 3);
    else if (which == 1) convert_T(nullptr, p.moe_w_up, 32, 1024, 512, p.wt_gu, (size_t)1024 * 1024, nullptr, 128, 256, 128, layer * 32, 3);
    else convert_T(nullptr, p.moe_w_down, 32, 512, 1024, p.wt_dn, (size_t)1024 * 512, nullptr, 1 << 30, 0, 0, layer * 32, 3);
}
__device__ __forceinline__ void ph_prologue(PRef p) {
    unsigned char* lds = VLDS;
    job_mod(p, lds);
    job_misc(p, lds);
    for (int j = 3; j < 15; ++j) {
        const CvtJob c = cvt_job(p, j);
        convert_T(lds, c.src, c.nb, c.K, c.N, c.dst, c.bstride, c.rowscale, c.grp, c.gstride, c.off, 0, c.perm);
    }
    for (int w = 0; w < 2; ++w) convert_moe(p, 0, w);
}

__device__ __forceinline__ void ph_h0(PRef p) {
    const size_t gtid = (size_t)VB * NTHR + VT, gsz = (size_t)NVB * NTHR;
    for (size_t i = gtid; i < (size_t)T_TOK * 128; i += gsz) {
        const int row = (int)(i >> 7), c0 = (int)(i & 127) * 8, b = row >> 11;
        const float* xs = p.x + (size_t)row * 1024 + c0; const float* sh = p.mod + (size_t)b * 3072 + c0; const float* scp = sh + 1024;
        float v[8];
#pragma unroll
        for (int q = 0; q < 8; ++q) v[q] = xs[q] * (1.f + scp[q]) + sh[q];
        *reinterpret_cast<uint4*>(p.hbuf + (size_t)row * 1024 + c0) = pack8(v);
    }
}

__device__ __forceinline__ void st4bf(bf16_t* p, float a, float b, float c, float d) { uint2 pk; pk.x = cvtpk(a, b); pk.y = cvtpk(c, d); *reinterpret_cast<uint2*>(p) = pk; }
__device__ __forceinline__ void st_vt4(bf16_t* vt_feat0  , const g8::f32x4_t& a, float sc) {
#pragma unroll
    for (int q = 0; q < 4; ++q) vt_feat0[(size_t)q * SEQ] = (bf16_t)(cvtpk(a[q] * sc, 0.f) & 0xffffu);
}
struct EpiMlaIn {
    bf16_t* cbuf; float* rss; bf16_t* krope; const float* cosm; const float* sinm;
    __device__ __forceinline__ void operator()(const g8::f32x4_t (&acc)[2][2][4][2], const g8::Unit& u, int wr, int wc, int fr, int fq) const {
        const int lc = 64 * (wc >> 1) + 16 * (wc & 1) + 4 * fq;
#pragma unroll
        for (int ai = 0; ai < 2; ++ai) {
            f32x4 csb[4], snb[4];
            if (u.pn >= 2 && wc < 2) {
#pragma unroll
                for (int m = 0; m < 4; ++m) {
                    const int row = u.pm * 256 + ai * 128 + wr * 64 + m * 16 + fr, i0 = 16 * wc + 4 * fq;
                    csb[m] = *reinterpret_cast<const f32x4*>(cosm + (size_t)row * 32 + i0); snb[m] = *reinterpret_cast<const f32x4*>(sinm + (size_t)row * 32 + i0);
                }
            }
#pragma unroll
            for (int m = 0; m < 4; ++m) {
                const int row = u.pm * 256 + ai * 128 + wr * 64 + m * 16 + fr;
                if (u.pn < 2) {
                    float sq = 0.f;
#pragma unroll
                    for (int bj = 0; bj < 2; ++bj)
#pragma unroll
                        for (int n = 0; n < 2; ++n) {
                            const g8::f32x4_t a = acc[ai][bj][m][n];
                            st4bf(cbuf + (size_t)row * 512 + u.pn * 256 + bj * 128 + lc + 32 * n, a[0], a[1], a[2], a[3]);
                            sq += a[0] * a[0] + a[1] * a[1] + a[2] * a[2] + a[3] * a[3];
                        }
                    sq += __shfl_xor(sq, 16, 64); sq += __shfl_xor(sq, 32, 64);
                    if (fq == 0) rss[(size_t)row * 8 + u.pn * 4 + wc] = sq;
                } else if (wc < 2) {
                    const int i0 = 16 * wc + 4 * fq;
                    const f32x4 cs = csb[m], sn = snb[m];
                    const g8::f32x4_t x1 = acc[ai][0][m][0], x2 = acc[ai][0][m][1];
                    st4bf(krope + (size_t)row * 64 + i0, x1[0] * cs[0] - x2[0] * sn[0], x1[1] * cs[1] - x2[1] * sn[1], x1[2] * cs[2] - x2[2] * sn[2], x1[3] * cs[3] - x2[3] * sn[3]);
                    st4bf(krope + (size_t)row * 64 + 32 + i0, x2[0] * cs[0] + x1[0] * sn[0], x2[1] * cs[1] + x1[1] * sn[1], x2[2] * cs[2] + x1[2] * sn[2], x2[3] * cs[3] + x1[3] * sn[3]);
                }
            }
        }
    }
};
__device__ __forceinline__ void ph_mla_in(PRef p, int j) {
    g8::SchedPlain S; S.init(T_TOK, 768, 1024, p.wt_mla_in + (size_t)j * 768 * 1024, 1024);
    g8::gemm8((LAS unsigned char*)(smem + LDS_WORK), (const char*)p.hbuf, 1024, 1024, S, EpiMlaIn{p.cbuf, p.rss, p.krope, p.cosm, p.sinm});
    __syncthreads();
}
__device__ __forceinline__ float mla_rstd(const float* rss, int row, int which) {
    const f32x4 q = *reinterpret_cast<const f32x4*>(rss + (size_t)row * 8 + which * 4);
    return rsqrtf((q[0] + q[1] + q[2] + q[3]) * (1.f / 256.f) + RMS_EPS);
}
struct EpiMlaQ {
    bf16_t* qm; const float* rss; const float* cosm; const float* sinm;
    __device__ __forceinline__ void operator()(const g8::f32x4_t (&acc)[2][2][4][2], const g8::Unit& u, int wr, int wc, int fr, int fq) const {
        const int i0 = 16 * (wc & 1) + 4 * fq;
#pragma unroll
        for (int ai = 0; ai < 2; ++ai) {
            f32x4 qs[4], csb[4], snb[4];
#pragma unroll
            for (int m = 0; m < 4; ++m) {
                const int row = u.pm * 256 + ai * 128 + wr * 64 + m * 16 + fr;
                qs[m] = *reinterpret_cast<const f32x4*>(rss + (size_t)row * 8);
                csb[m] = *reinterpret_cast<const f32x4*>(cosm + (size_t)row * 32 + i0); snb[m] = *reinterpret_cast<const f32x4*>(sinm + (size_t)row * 32 + i0);
            }
#pragma unroll
            for (int m = 0; m < 4; ++m) {
                const int row = u.pm * 256 + ai * 128 + wr * 64 + m * 16 + fr;
                const float sc = rsqrtf((qs[m][0] + qs[m][1] + qs[m][2] + qs[m][3]) * (1.f / 256.f) + RMS_EPS);
                const f32x4 cs = csb[m], sn = snb[m];
#pragma unroll
                for (int bj = 0; bj < 2; ++bj) {
                    const int c64 = u.pn * 256 + bj * 128 + 64 * (wc >> 1);
                    bf16_t* dst = qm + (size_t)row * 1536 + c64 + i0;
                    const g8::f32x4_t x1 = acc[ai][bj][m][0], x2 = acc[ai][bj][m][1];
                    if ((c64 % 192) == 128) {
                        st4bf(dst, (x1[0] * cs[0] - x2[0] * sn[0]) * sc, (x1[1] * cs[1] - x2[1] * sn[1]) * sc, (x1[2] * cs[2] - x2[2] * sn[2]) * sc, (x1[3] * cs[3] - x2[3] * sn[3]) * sc);
                        st4bf(dst + 32, (x2[0] * cs[0] + x1[0] * sn[0]) * sc, (x2[1] * cs[1] + x1[1] * sn[1]) * sc, (x2[2] * cs[2] + x1[2] * sn[2]) * sc, (x2[3] * cs[3] + x1[3] * sn[3]) * sc);
                    } else {
                        st4bf(dst, x1[0] * sc, x1[1] * sc, x1[2] * sc, x1[3] * sc);
                        st4bf(dst + 32, x2[0] * sc, x2[1] * sc, x2[2] * sc, x2[3] * sc);
                    }
                }
            }
        }
    }
};
struct EpiMlaKv {
    bf16_t* kn; bf16_t* vt; const float* rss;
    __device__ __forceinline__ void operator()(const g8::f32x4_t (&acc)[2][2][4][2], const g8::Unit& u, int wr, int wc, int fr, int fq) const {
        const int hd = u.pn;
#pragma unroll
        for (int ai = 0; ai < 2; ++ai) {
            f32x4 qs[4];
#pragma unroll
            for (int m = 0; m < 4; ++m) qs[m] = *reinterpret_cast<const f32x4*>(rss + (size_t)(u.pm * 256 + ai * 128 + wr * 64 + m * 16 + fr) * 8 + 4);
#pragma unroll
            for (int m = 0; m < 4; ++m) {
                const int row = u.pm * 256 + ai * 128 + wr * 64 + m * 16 + fr, b = row >> 11, sq = row & 2047;
                const float sc = rsqrtf((qs[m][0] + qs[m][1] + qs[m][2] + qs[m][3]) * (1.f / 256.f) + RMS_EPS);
#pragma unroll
                for (int n = 0; n < 2; ++n) {
                    const int c = 32 * wc + 16 * n + 4 * fq;
                    const g8::f32x4_t k = acc[ai][0][m][n];
                    st4bf(kn + (size_t)row * 1024 + hd * 128 + c, k[0] * sc, k[1] * sc, k[2] * sc, k[3] * sc);
                    st_vt4(vt + ((size_t)(b * 8 + hd) * 128 + c) * SEQ + sq, acc[ai][1][m][n], sc);
                }
            }
        }
    }
};
__device__ __forceinline__ void ph_mla_up(PRef p, int j) {
    { g8::SchedPlain S; S.init(T_TOK, 1536, 512, p.wt_uq + (size_t)j * 1536 * 256, 256);
      g8::gemm8((LAS unsigned char*)(smem + LDS_WORK), (const char*)p.cbuf, 256, 256, S, EpiMlaQ{p.qm, p.rss, p.cosm, p.sinm}); }
    { g8::SchedPlain S; S.init(T_TOK, 2048, 512, p.wt_ukv + (size_t)j * 2048 * 256, 256);
      g8::gemm8((LAS unsigned char*)(smem + LDS_WORK), (const char*)(p.cbuf + 256), 256, 256, S, EpiMlaKv{p.kn, p.vt, p.rss}); }
    __syncthreads();
}
struct EpiNsaIn {
    PRef p;
    __device__ __forceinline__ void operator()(const g8::f32x4_t (&acc)[2][2][4][2], const g8::Unit& u, int wr, int wc, int fr, int fq) const {
        const int i0 = 16 * wc + 4 * fq;
        const bool rot = (u.pn < 5) || u.pn == 6 || u.pn == 8;
#pragma unroll
        for (int ai = 0; ai < 2; ++ai) {
            f32x4 cs[4], sn[4];
            if (rot) {
#pragma unroll
                for (int m = 0; m < 4; ++m) {
                    const int row = u.pm * 256 + ai * 128 + wr * 64 + m * 16 + fr;
                    cs[m] = *reinterpret_cast<const f32x4*>(p.cosn + (size_t)row * 64 + i0); sn[m] = *reinterpret_cast<const f32x4*>(p.sinn + (size_t)row * 64 + i0);
                }
            }
#pragma unroll
            for (int bj = 0; bj < 2; ++bj) {
                const int tn = 2 * u.pn + bj;
                if (tn >= 21) continue;
#pragma unroll
                for (int m = 0; m < 4; ++m) {
                    const int row = u.pm * 256 + ai * 128 + wr * 64 + m * 16 + fr, b = row >> 11, sq = row & 2047;
                    const g8::f32x4_t x1 = acc[ai][bj][m][0], x2 = acc[ai][bj][m][1];
                    if (tn == 20) {
                        if (i0 < 24) {
#pragma unroll
                            for (int q = 0; q < 4; ++q) { const int c = i0 + q; p.gates[(size_t)row * 32 + (c / 3) * 4 + (c % 3)] = sigmoid_f(x1[q]); }
                        }
                        continue;
                    }
                    const int g = (tn - 8) >> 1, kh = (tn - 8) & 1;
                    const size_t slab = (size_t)(b * 2 + kh) * SEQ * 128;
                    if (tn >= 8 && (g == 3 || g == 5)) {
                        bf16_t* vt = (g == 3 ? p.vst : p.vwt) + slab + sq;
                        st_vt4(vt + (size_t)i0 * SEQ, x1, 1.f); st_vt4(vt + (size_t)(i0 + 64) * SEQ, x2, 1.f);
                    } else if (tn >= 8 && g == 1) {
                        bf16_t* dst = p.vc + slab + (size_t)sq * 128 + i0;
                        st4bf(dst, x1[0], x1[1], x1[2], x1[3]); st4bf(dst + 64, x2[0], x2[1], x2[2], x2[3]);
                    } else {
                        bf16_t* dst = (tn < 8) ? p.qn + (size_t)row * 1024 + tn * 128 + i0 : (g == 0 ? p.kc : (g == 2 ? p.ks : p.kw)) + slab + (size_t)sq * 128 + i0;
                        const f32x4 c_ = cs[m], s_ = sn[m];
                        st4bf(dst, x1[0] * c_[0] - x2[0] * s_[0], x1[1] * c_[1] - x2[1] * s_[1], x1[2] * c_[2] - x2[2] * s_[2], x1[3] * c_[3] - x2[3] * s_[3]);
                        st4bf(dst + 64, x2[0] * c_[0] + x1[0] * s_[0], x2[1] * c_[1] + x1[1] * s_[1], x2[2] * c_[2] + x1[2] * s_[2], x2[3] * c_[3] + x1[3] * s_[3]);
                    }
                }
            }
        }
    }
};
__device__ __forceinline__ void ph_nsa_in(PRef p) {
    g8::SchedPlain S; S.init(T_TOK, 2816, 1024, p.wt_nsa_in, 1024);
    g8::gemm8((LAS unsigned char*)(smem + LDS_WORK), (const char*)p.hbuf, 1024, 1024, S, EpiNsaIn{p});
    __syncthreads();
}
struct RowWin { const bf16_t* base; __device__ __forceinline__ const bf16_t* operator()(int r) const { return base + (size_t)r * 2048; } };
__device__ __forceinline__ void ph_nsa_cmp1(PRef p) {
    unsigned char* lds = VLDS; const float* Cs = reinterpret_cast<const float*>(lds);
    for (int it = VB; it < 256; it += NVB) {
        const int item = it >> 3, sp = it & 7, which = item & 1, bkh = item >> 1;
        const bf16_t* src = (which ? p.vc : p.kc) + (size_t)bkh * SEQ * 128 + sp * 512;
        int tid = VT; asm volatile("" : "+v"(tid));
        f32x16 acc[2][2];
        gemm_main(tid, lds, RowWin{src}, (which ? p.wt_cv1 : p.wt_ck1) + sp * 512, 4096, 0, 512, acc);
        float* dst = p.cpart + (size_t)(item * 8 + sp) * 128 * 128;
        const int c0 = (tid & 15) * 8;
#pragma unroll
        for (int ps = 0; ps < 8; ++ps) {
            const int row = (tid >> 4) + 16 * ps;
            *reinterpret_cast<f32x4*>(dst + row * 128 + c0) = *reinterpret_cast<const f32x4*>(Cs + row * CS_LD + c0);
            *reinterpret_cast<f32x4*>(dst + row * 128 + c0 + 4) = *reinterpret_cast<const f32x4*>(Cs + row * CS_LD + c0 + 4);
        }
        ITEM_END_SYNC();
    }
}
__device__ __forceinline__ void ph_nsa_cmp2(PRef p) {
    unsigned char* lds = VLDS; const float* Cs = reinterpret_cast<const float*>(lds);
    for (int item = VB; item < 32; item += NVB) {
        const int which = item & 1, bkh = item >> 1;
        int tid = VT; asm volatile("" : "+v"(tid));
        bf16_t* hid = p.hid + (size_t)item * 128 * 128;
        for (int o = tid; o < 128 * 16; o += NTHR) {
            const int row = o >> 4, c0 = (o & 15) * 8; float v[8];
#pragma unroll
            for (int q = 0; q < 8; ++q) v[q] = p.bias1[which * 128 + c0 + q];
            for (int sp = 0; sp < 8; ++sp) {
                const float* src = p.cpart + (size_t)(item * 8 + sp) * 128 * 128 + row * 128 + c0;
#pragma unroll
                for (int q = 0; q < 8; ++q) v[q] += src[q];
            }
#pragma unroll
            for (int q = 0; q < 8; ++q) v[q] = silu_f(v[q]);
            *reinterpret_cast<uint4*>(hid + row * 128 + c0) = pack8(v);
        }
        __threadfence();
        __syncthreads();
        f32x16 acc[2][2];
        gemm_main(tid, lds, RowPlain{hid, 128}, which ? p.wt_cv2 : p.wt_ck2, 128, 0, 128, acc);
        if (!which) {
            const int c0 = (tid & 15) * 8;
#pragma unroll
            for (int ps = 0; ps < 8; ++ps) {
                const int row = (tid >> 4) + 16 * ps; float v[8]; cs_load8(Cs, row, c0, v);
                if (row == 127) {
#pragma unroll
                    for (int q = 0; q < 8; ++q) v[q] = 0.f; }
                *reinterpret_cast<uint4*>(p.kcmp + (size_t)bkh * 128 * 128 + row * 128 + c0) = pack8(v);
            }
        } else {
            const int dv = tid & 127, sh = tid >> 7;
#pragma unroll
            for (int jj = 0; jj < 8; ++jj) {
                float v[8];
#pragma unroll
                for (int q = 0; q < 8; ++q) { const int row = sh * 64 + jj * 8 + q; v[q] = (row == 127) ? 0.f : Cs[row * CS_LD + dv]; }
                *reinterpret_cast<uint4*>(p.vcmpt + (size_t)bkh * 128 * 128 + dv * 128 + sh * 64 + jj * 8) = pack8(v);
            }
        }
        ITEM_END_SYNC();
    }
}
struct EpiSbIn {
    bf16_t* qs; bf16_t* ksb; bf16_t* vt;
    __device__ __forceinline__ void operator()(const g8::f32x4_t (&acc)[2][2][4][2], const g8::Unit& u, int wr, int wc, int fr, int fq) const {
#pragma unroll
        for (int ai = 0; ai < 2; ++ai)
#pragma unroll
            for (int m = 0; m < 4; ++m) {
                const int row = u.pm * 256 + ai * 128 + wr * 64 + m * 16 + fr, b = row >> 11, sq = row & 2047;
#pragma unroll
                for (int bj = 0; bj < 2; ++bj) {
                    const int c = (u.pn & 3) * 256 + bj * 128 + 32 * wc + 8 * fq;
                    const g8::f32x4_t a = acc[ai][bj][m][0], d = acc[ai][bj][m][1];
                    if (u.pn < 8) *reinterpret_cast<uint4*>((u.pn < 4 ? qs : ksb) + (size_t)row * 1024 + c) = cvtpk8(a[0], a[1], a[2], a[3], d[0], d[1], d[2], d[3]);
                    else { st_vt4(vt + ((size_t)b * 1024 + c) * SEQ + sq, a, 1.f); st_vt4(vt + ((size_t)b * 1024 + c + 4) * SEQ + sq, d, 1.f); }
                }
            }
    }
};
__device__ __forceinline__ void ph_sb_in(PRef p) {
    g8::SchedPlain S; S.init(T_TOK, 3072, 1024, p.wt_sb_qkv, 1024);
    g8::gemm8((LAS unsigned char*)(smem + LDS_WORK), (const char*)p.hbuf, 1024, 1024, S, EpiSbIn{p.qs, p.ksb, p.vt});
    __syncthreads();
}
template <bool XF32> struct EpiWo {
    const float* xs; const f16_t* xh; f16_t* z; const float* mod; int L;
    __device__ __forceinline__ void operator()(const g8::f32x4_t (&acc)[2][2][4][2], const g8::Unit& u, int wr, int wc, int fr, int fq) const {
        const int row0 = u.pm * 256 + wr * 64 + fr, col0 = u.pn * 256 + wc * 32 + 8 * fq, b = (u.pm * 256) >> 11;
        const float* gate = mod + (size_t)((L * 2 + 0) * 8 + b) * 3072 + 2048 + col0;
        f32x4 gv[2][2];
#pragma unroll
        for (int bj = 0; bj < 2; ++bj)
#pragma unroll
            for (int n = 0; n < 2; ++n) gv[bj][n] = *reinterpret_cast<const f32x4*>(gate + bj * 128 + n * 4);
#pragma unroll
        for (int ai = 0; ai < 2; ++ai) {
            f32x4 xv[4][2][2];
#pragma unroll
            for (int m = 0; m < 4; ++m)
#pragma unroll
                for (int bj = 0; bj < 2; ++bj) {
                    const size_t o = (size_t)(row0 + ai * 128 + m * 16) * 1024 + col0 + bj * 128;
                    if (XF32) { xv[m][bj][0] = *reinterpret_cast<const f32x4*>(xs + o); xv[m][bj][1] = *reinterpret_cast<const f32x4*>(xs + o + 4); }
                    else { const f16x8 hx = *reinterpret_cast<const f16x8*>(xh + o); const f32x8 fx = __builtin_convertvector(hx, f32x8); xv[m][bj][0] = (f32x4){fx[0], fx[1], fx[2], fx[3]}; xv[m][bj][1] = (f32x4){fx[4], fx[5], fx[6], fx[7]}; }
                }
#pragma unroll
            for (int m = 0; m < 4; ++m)
#pragma unroll
                for (int bj = 0; bj < 2; ++bj) {
                    f32x8 zv;
#pragma unroll
                    for (int n = 0; n < 2; ++n)
#pragma unroll
                        for (int q = 0; q < 4; ++q) zv[n * 4 + q] = DN_ALPHA * xv[m][bj][n][q] + gv[bj][n][q] * acc[ai][bj][m][n][q];
                    *reinterpret_cast<f16x8*>(z + (size_t)(row0 + ai * 128 + m * 16) * 1024 + col0 + bj * 128) = __builtin_convertvector(zv, f16x8);
                }
        }
    }
};
__device__ __forceinline__ void ph_wo(PRef p, int L) {
    const int kind = L % 3, j = L / 3;
    const bf16_t* Bt = kind == 0 ? p.wt_mla_o + (size_t)j * 1024 * 1024 : (kind == 1 ? p.wt_nsa_o : p.wt_sb_o);
    g8::SchedPlain S; S.init(T_TOK, 1024, 1024, Bt, 1024);
    if (L == 0) g8::gemm8((LAS unsigned char*)(smem + LDS_WORK), (const char*)p.obuf, 1024, 1024, S, EpiWo<true>{p.x, p.xbuf, p.zbuf, p.mod, L});
    else g8::gemm8((LAS unsigned char*)(smem + LDS_WORK), (const char*)p.obuf, 1024, 1024, S, EpiWo<false>{p.x, p.xbuf, p.zbuf, p.mod, L});
}

#define LNC(i) (lane * 8 + 512 * ((i) >> 1) + 4 * ((i) & 1))
__device__ __forceinline__ void ln_row(float (&v)[16], const f32x4 (&gg)[4], const f32x4 (&bb)[4]) {
    float s = 0.f;
#pragma unroll
    for (int q = 0; q < 16; ++q) s += v[q];
    const float mu = wave_sum(s) * (1.f / 1024.f);
    float s2 = 0.f;
#pragma unroll
    for (int q = 0; q < 16; ++q) { const float d = v[q] - mu; s2 += d * d; }
    const float rstd = rsqrtf(wave_sum(s2) * (1.f / 1024.f) + LN_EPS);
#pragma unroll
    for (int i = 0; i < 4; ++i)
#pragma unroll
        for (int q = 0; q < 4; ++q) v[i * 4 + q] = (v[i * 4 + q] - mu) * rstd * gg[i][q] + bb[i][q];
}
__device__ __forceinline__ void ld8h_f(const uint4& w, float* v) { const f32x8 f = __builtin_convertvector(*reinterpret_cast<const f16x8*>(&w), f32x8);
#pragma unroll
    for (int q = 0; q < 8; ++q) v[q] = f[q]; }
__device__ __forceinline__ uint4 pk8h(const float* v) { f32x8 f;
#pragma unroll
    for (int q = 0; q < 8; ++q) f[q] = v[q];
    const f16x8 hh = __builtin_convertvector(f, f16x8); return *reinterpret_cast<const uint4*>(&hh); }
__device__ __forceinline__ void ph_lna(PRef p, int L, bool dry = false) {
    unsigned char* lds = VLDS;
    float* hs = reinterpret_cast<float*>(lds);
    float* part = reinterpret_cast<float*>(lds + 16 * 1028 * 4);
    int* lcnt = reinterpret_cast<int*>(lds + 78080); int* lbase = lcnt + 32; int* rexp = lcnt + 64; int* rslot = lcnt + 96; float* rwt = reinterpret_cast<float*>(lcnt + 128);
    if (VT < 32) lcnt[VT] = 0;
    __syncthreads();
    int tid = VT; asm volatile("" : "+v"(tid));
    const int lane = tid & 63, wid = tid >> 6;
    const float* g = p.ln_g + (size_t)(L * 2 + 0) * 1024; const float* bt = p.ln_b + (size_t)(L * 2 + 0) * 1024;
    const float* wr = p.wr + (size_t)L * 1024 * 48;
    int* cnt = p.cnt + L * 32 * 64;
    f32x4 lg[4], lb[4];
#pragma unroll
    for (int i = 0; i < 4; ++i) { lg[i] = *reinterpret_cast<const f32x4*>(g + LNC(i)); lb[i] = *reinterpret_cast<const f32x4*>(bt + LNC(i)); }
    for (int it = VB; it < T_TOK / 16; it += NVB) {
        const int R0 = it * 16, b = R0 >> 11;
        const float* md = p.mod + (size_t)((L * 2 + 1) * 8 + b) * 3072;
        f32x4 shv[4], scv[4];
#pragma unroll
        for (int i = 0; i < 4; ++i) { shv[i] = *reinterpret_cast<const f32x4*>(md + LNC(i)); scv[i] = *reinterpret_cast<const f32x4*>(md + 1024 + LNC(i)); }
        uint4 zr[2];
#pragma unroll
        for (int k = 0; k < 2; ++k) zr[k] = *reinterpret_cast<const uint4*>(p.zbuf + (size_t)(R0 + wid * 4) * 1024 + LNC(2 * k));
#pragma unroll 1
        for (int rr = 0; rr < 4; ++rr) {
            const int lrow = wid * 4 + rr, row = R0 + lrow;
            float v[16];
            ld8h_f(zr[0], v); ld8h_f(zr[1], v + 8);
            if (rr < 3) {
#pragma unroll
                for (int k = 0; k < 2; ++k) zr[k] = *reinterpret_cast<const uint4*>(p.zbuf + (size_t)(row + 1) * 1024 + LNC(2 * k));
            }
            ln_row(v, lg, lb);
#pragma unroll
            for (int k = 0; k < 2; ++k) {
                *reinterpret_cast<uint4*>((dry ? reinterpret_cast<f16_t*>(p.ybuf) : p.xbuf) + (size_t)row * 1024 + LNC(2 * k)) = pk8h(v + 8 * k);
                float hv[8];
#pragma unroll
                for (int q = 0; q < 8; ++q) hv[q] = v[8 * k + q] * (1.f + scv[2 * k + (q >> 2)][q & 3]) + shv[2 * k + (q >> 2)][q & 3];
                *reinterpret_cast<f32x4*>(hs + lrow * 1028 + LNC(2 * k)) = (f32x4){hv[0], hv[1], hv[2], hv[3]};
                *reinterpret_cast<f32x4*>(hs + lrow * 1028 + LNC(2 * k + 1)) = (f32x4){hv[4], hv[5], hv[6], hv[7]};
                *reinterpret_cast<uint4*>((dry ? p.hmoe : p.hbuf) + (size_t)row * 1024 + LNC(2 * k)) = cvtpk8(hv[0], hv[1], hv[2], hv[3], hv[4], hv[5], hv[6], hv[7]);
            }
        }
        __syncthreads();
        {
            f32x4 a0 = {0.f, 0.f, 0.f, 0.f}, a1 = a0, a2 = a0;
            const int rl = lane & 15, kq = lane >> 4;
#pragma unroll 32
            for (int kk = 0; kk < 64; ++kk) {
                const int k = wid * 256 + kk * 4 + kq;
                const float a = hs[rl * 1028 + k];
                const float* wp = wr + (size_t)k * 48 + rl;
                a0 = __builtin_amdgcn_mfma_f32_16x16x4f32(a, wp[0], a0, 0, 0, 0);
                a1 = __builtin_amdgcn_mfma_f32_16x16x4f32(a, wp[16], a1, 0, 0, 0);
                a2 = __builtin_amdgcn_mfma_f32_16x16x4f32(a, wp[32], a2, 0, 0, 0);
            }
#pragma unroll
            for (int q = 0; q < 4; ++q) {
                const int row = kq * 4 + q;
                part[(wid * 16 + row) * 48 + rl] = a0[q]; part[(wid * 16 + row) * 48 + 16 + rl] = a1[q]; part[(wid * 16 + row) * 48 + 32 + rl] = a2[q];
            }
        }
        __syncthreads();
        if (tid < 16) {
            const int row = R0 + tid;
            auto LG = [&](int e) { return part[(0 * 16 + tid) * 48 + e] + part[(1 * 16 + tid) * 48 + e] + part[(2 * 16 + tid) * 48 + e] + part[(3 * 16 + tid) * 48 + e]; };
            const float g0 = LG(0) + p.moe_b_grp[L * 4 + 0], g1 = LG(1) + p.moe_b_grp[L * 4 + 1], g2 = LG(2) + p.moe_b_grp[L * 4 + 2], g3 = LG(3) + p.moe_b_grp[L * 4 + 3];
            int gi = 0; float gm = g0;
            if (g1 > gm) { gm = g1; gi = 1; }
            if (g2 > gm) { gm = g2; gi = 2; }
            if (g3 > gm) { gm = g3; gi = 3; }
            const float gw = 1.f / (expf(g0 - gm) + expf(g1 - gm) + expf(g2 - gm) + expf(g3 - gm));
            int i1 = 0, i2 = 0; float m1 = -3.0e38f, m2 = -3.0e38f;
            for (int e = 0; e < 8; ++e) {
                const float v = LG(4 + gi * 8 + e) + p.moe_b_rt[L * 32 + gi * 8 + e];
                if (v > m1) { m2 = m1; i2 = i1; m1 = v; i1 = e; }
                else if (v > m2) { m2 = v; i2 = e; }
            }
            const float r = expf(m2 - m1);
            const float w1 = gw / (1.f + r), w2 = gw * r / (1.f + r);
            const int e1 = gi * 8 + i1, e2 = gi * 8 + i2;
            rwt[tid * 2] = w1; rwt[tid * 2 + 1] = w2;
            rexp[tid * 2] = e1; rexp[tid * 2 + 1] = e2;
            rslot[tid * 2] = atomicAdd(&lcnt[e1], 1); rslot[tid * 2 + 1] = atomicAdd(&lcnt[e2], 1);
        }
        __syncthreads();
        if (tid < 32) { const int c = lcnt[tid]; lbase[tid] = (c && !dry) ? atomicAdd(&cnt[tid * 64], c) : 0; lcnt[tid] = 0; }
        __syncthreads();
        if (tid < 32 && !dry) { const int e = rexp[tid]; const size_t o = (size_t)e * T_TOK + lbase[e] + rslot[tid]; p.list[o] = (R0 + (tid >> 1)) * 2 + (tid & 1); p.listw[o] = rwt[tid]; }
        __syncthreads();
    }
}
__device__ __forceinline__ void ph_lnb(PRef p, int L, bool dry = false) {
    int tid = VT; asm volatile("" : "+v"(tid));
    const int lane = tid & 63, wid = tid >> 6;
    const float* g = p.ln_g + (size_t)(L * 2 + 1) * 1024; const float* bt = p.ln_b + (size_t)(L * 2 + 1) * 1024;
    const bool last = (L == DEPTH - 1);
    f32x4 lg[4], lb[4];
#pragma unroll
    for (int i = 0; i < 4; ++i) { lg[i] = *reinterpret_cast<const f32x4*>(g + LNC(i)); lb[i] = *reinterpret_cast<const f32x4*>(bt + LNC(i)); }
    constexpr int RW = T_TOK / 2048;
    static_assert(2048 % RW == 0, "a wave's rows stay inside one batch element");
    for (int w0 = VB * 4 + wid; w0 * RW < T_TOK; w0 += NVB * 4) {
        const int row0 = w0 * RW, b = row0 >> 11;
        const float* gate = p.mod + (size_t)((L * 2 + 1) * 8 + b) * 3072 + 2048;
        const float* md = p.mod + (size_t)(((last ? L : L + 1) * 2 + 0) * 8 + b) * 3072;
        f32x4 gv[4], sh[4], sc[4];
#pragma unroll
        for (int i = 0; i < 4; ++i) { const int c = LNC(i); gv[i] = *reinterpret_cast<const f32x4*>(gate + c); if (!last) { sh[i] = *reinterpret_cast<const f32x4*>(md + c); sc[i] = *reinterpret_cast<const f32x4*>(md + 1024 + c); } }
        uint4 xr[2], y0[2], y1[2];
        auto issue = [&](int row) {
#pragma unroll
            for (int k = 0; k < 2; ++k) {
                const int c = LNC(2 * k);
                xr[k] = *reinterpret_cast<const uint4*>(p.xbuf + (size_t)row * 1024 + c);
                y0[k] = *reinterpret_cast<const uint4*>(p.ybuf + (size_t)(row * 2) * 1024 + c); y1[k] = *reinterpret_cast<const uint4*>(p.ybuf + (size_t)(row * 2 + 1) * 1024 + c);
            }
        };
        issue(row0);
#pragma unroll 1
        for (int ri = 0; ri < RW; ++ri) {
            const int row = row0 + ri;
            float v[16];
#pragma unroll
            for (int k = 0; k < 2; ++k) {
                float xv[8]; ld8h_f(xr[k], xv);
                const unsigned a0[4] = {y0[k].x, y0[k].y, y0[k].z, y0[k].w}, a1[4] = {y1[k].x, y1[k].y, y1[k].z, y1[k].w};
#pragma unroll
                for (int q = 0; q < 8; ++q) {
                    const unsigned w0 = a0[q >> 1], w1 = a1[q >> 1];
                    const float ys = (q & 1) ? (bf2f(w0 >> 16) + bf2f(w1 >> 16)) : (bf2f(w0 & 0xffffu) + bf2f(w1 & 0xffffu));
                    v[8 * k + q] = DN_ALPHA * xv[q] + gv[2 * k + (q >> 2)][q & 3] * ys;
                }
            }
            if (ri + 1 < RW) issue(row + 1);
            ln_row(v, lg, lb);
            if (last) {
#pragma unroll
                for (int i = 0; i < 4; ++i) *reinterpret_cast<f32x4*>((dry ? reinterpret_cast<float*>(p.zbuf) : p.out) + (size_t)row * 1024 + LNC(i)) = (f32x4){v[i * 4], v[i * 4 + 1], v[i * 4 + 2], v[i * 4 + 3]};
            } else {
#pragma unroll
                for (int k = 0; k < 2; ++k) {
                    const int c = LNC(2 * k);
                    *reinterpret_cast<uint4*>((dry ? p.zbuf : p.xbuf) + (size_t)row * 1024 + c) = pk8h(v + 8 * k);
                    float hv[8];
#pragma unroll
                    for (int q = 0; q < 8; ++q) hv[q] = v[8 * k + q] * (1.f + sc[2 * k + (q >> 2)][q & 3]) + sh[2 * k + (q >> 2)][q & 3];
                    *reinterpret_cast<uint4*>((dry ? p.obuf : p.hbuf) + (size_t)row * 1024 + c) = cvtpk8(hv[0], hv[1], hv[2], hv[3], hv[4], hv[5], hv[6], hv[7]);
                }
            }
        }
    }
}
#undef LNC

struct RowGather { const bf16_t* hb; const int* lst; int base, n; __device__ __forceinline__ const bf16_t* operator()(int r) const { const int idx = base + r; const int tok = (idx < n) ? (lst[idx] >> 1) : 0; return hb + (size_t)tok * 1024; } };
constexpr int G8_PRE_OFF = LDS_WORK + 131072;
__device__ __forceinline__ const int* moe_prefix256(const int* cnt) {
    int* pre = reinterpret_cast<int*>(smem + G8_PRE_OFF);
    int t_ = threadIdx.x; asm volatile("" : "+v"(t_));
    if (t_ == 0) { int s = 0; for (int e = 0; e < 32; ++e) { pre[e] = s; s += (cnt[e * 64] + 255) >> 8; } pre[32] = s; }
    if (t_ >= 64 && t_ < 96) pre[48 + t_ - 64] = cnt[(t_ - 64) * 64];
    __syncthreads();
    return pre;
}
struct EpiMoeA {
    bf16_t* hmoe;
    __device__ __forceinline__ void operator()(const g8::f32x4_t (&acc)[2][2][4][2], const g8::Unit& u, int wr, int wc, int fr, int fq) const {
#pragma unroll
        for (int ai = 0; ai < 2; ++ai)
#pragma unroll
            for (int m = 0; m < 4; ++m) {
                bf16_t* rowp = hmoe + (size_t)(u.pm * 256 + ai * 128 + wr * 64 + m * 16 + fr) * 512 + u.pn * 128 + wc * 32 + fq * 8;
                float hv[8];
#pragma unroll
                for (int n = 0; n < 2; ++n) {
                    const g8::f32x4_t g = acc[ai][0][m][n], up = acc[ai][1][m][n];
#pragma unroll
                    for (int q = 0; q < 4; ++q) hv[n * 4 + q] = silu_f(g[q]) * up[q];
                }
                *reinterpret_cast<uint4*>(rowp) = cvtpk8(hv[0], hv[1], hv[2], hv[3], hv[4], hv[5], hv[6], hv[7]);
            }
    }
};
__device__ __forceinline__ void ph_moe_a(PRef p, int L) {
    const int* cnt = p.cnt + L * 32 * 64;
    const int* pre = moe_prefix256(cnt);
    g8::SchedMoe S{pre, p.list, p.listw, (const char*)(p.wt_gu + (size_t)L * 32 * 1024 * 1024), (size_t)1024 * 1024 * 2, (size_t)256 * 1024 * 2, pre[32] * 4, (int)gridDim.x, (int)blockIdx.x, 1, reinterpret_cast<int*>(smem + G8_PRE_OFF + 512)};
    g8::gemm8((LAS unsigned char*)(smem + LDS_WORK), (const char*)p.hbuf, 1024, 1024, S, EpiMoeA{p.hmoe});
    __syncthreads();
}
struct EpiMoeB {
    const int* pre; const int* tab; bf16_t* ybuf;
    __device__ __forceinline__ void operator()(const g8::f32x4_t (&acc)[2][2][4][2], const g8::Unit& u, int wr, int wc, int fr, int fq) const {
        int e = 0; for (int q = 1; q < 32; ++q) e = (pre[q] <= u.pm) ? q : e;
        const int n = pre[48 + e] - (u.pm - pre[e]) * 256, r0 = wr * 64 + fr;
        const int col0 = u.pn * 256 + wc * 32 + fq * 8;
        const int* tb = tab + u.par * 512;
        asm volatile("" ::: "memory");
#pragma unroll
        for (int ai = 0; ai < 2; ++ai) {
#pragma unroll
            for (int m = 0; m < 4; ++m) {
                const int r = r0 + ai * 128 + m * 16;
                if (r < n) {
                    const int ent = tb[r]; const float ww = __int_as_float(tb[256 + r]);
                    bf16_t* rowp = ybuf + (size_t)ent * 1024 + col0;
#pragma unroll
                    for (int bj = 0; bj < 2; ++bj) {
                        const g8::f32x4_t a = acc[ai][bj][m][0], c = acc[ai][bj][m][1];
                        *reinterpret_cast<uint4*>(rowp + bj * 128) = cvtpk8(a[0] * ww, a[1] * ww, a[2] * ww, a[3] * ww, c[0] * ww, c[1] * ww, c[2] * ww, c[3] * ww);
                    }
                }
            }
        }
    }
};
__device__ __forceinline__ void ph_moe_b(PRef p, int L) {
    const int* cnt = p.cnt + L * 32 * 64;
    const int* pre = moe_prefix256(cnt);
    g8::SchedMoe S{pre, p.list, p.listw, (const char*)(p.wt_dn + (size_t)L * 32 * 1024 * 512), (size_t)1024 * 512 * 2, (size_t)256 * 512 * 2, pre[32] * 4, (int)gridDim.x, (int)blockIdx.x, 0, reinterpret_cast<int*>(smem + G8_PRE_OFF + 512)};
    g8::gemm8((LAS unsigned char*)(smem + LDS_WORK), (const char*)p.hmoe, 512, 512, S, EpiMoeB{pre, reinterpret_cast<const int*>(smem + G8_PRE_OFF + 512), p.ybuf});
    __syncthreads();
}

__device__ __forceinline__ void dma16_asm(const void* g, const unsigned char* lds_wave_base) {
    const unsigned m = __builtin_amdgcn_readfirstlane((unsigned)(size_t)(LAS const unsigned char*)lds_wave_base);
    asm volatile("s_mov_b32 m0, %1\n\ts_nop 0\n\tglobal_load_lds_dwordx4 %0, off" :: "v"(g), "s"(m) : "memory", "m0");
}
__device__ __forceinline__ unsigned lds_addr(const unsigned char* p) { return (unsigned)(size_t)(LAS const unsigned char*)p; }
__device__ __forceinline__ bf16x8 lds_ld128(unsigned a) { return *(const LAS bf16x8*)(size_t)a; }
__device__ __forceinline__ void dma16_asm_s(const void* ubase, unsigned voff, const unsigned char* lds_wave_base) {
    const unsigned m = __builtin_amdgcn_readfirstlane((unsigned)(size_t)(LAS const unsigned char*)lds_wave_base);
    asm volatile("s_mov_b32 m0, %2\n\ts_nop 0\n\tglobal_load_lds_dwordx4 %0, %1" :: "v"(voff), "s"(ubase), "s"(m) : "memory", "m0");
}
template <int DQK, int KT> struct AT {
    static constexpr int KB = KT / 32, NKK = DQK / 16;
    static constexpr bool ROPE = (DQK == 192);
    static constexpr int K_BYTES = KT * 256, KR_BYTES = ROPE ? KT * 128 : 0, V_BYTES = 256 * KT, STAGE = K_BYTES + KR_BYTES + V_BYTES;
    static constexpr int VRB = KT * 2;
    static __device__ __forceinline__ void dma(int tid, unsigned char* st, const bf16_t* kp  , size_t ldk, const bf16_t* krp  , const bf16_t* vp  , size_t ldv) {
        const int wid = tid >> 6, l = tid & 63;
#pragma unroll
        for (int i = 0; i < KT / 16; ++i) {
            const int pi = wid + 4 * i, row = 4 * pi + (l >> 4), c = (l & 15) ^ (row & 15);
            dma16_asm_s(kp, (unsigned)(row * (int)ldk + c * 8) * 2u, st + pi * 1024);
        }
        if (ROPE) {
            const int pi = wid, row = 8 * pi + (l >> 3), c = (l & 7) ^ ((row >> 1) & 7);
            dma16_asm_s(krp, (unsigned)(row * 64 + c * 8) * 2u, st + K_BYTES + pi * 1024);
        }
#pragma unroll
        for (int i = 0; i < KT / 16; ++i) {
            const int pi = wid + 4 * i;
            int row, c;
            if (KT == 64) { row = 8 * pi + (l >> 3); c = (l & 7) ^ ((row >> 1) & 7); }
            else          { row = 16 * pi + (l >> 2); c = (l & 3) ^ ((row >> 2) & 3); }
            dma16_asm_s(vp, (unsigned)(row * (int)ldv + c * 8) * 2u, st + K_BYTES + KR_BYTES + pi * 1024);
        }
    }
    static __device__ __forceinline__ void kload(const unsigned char* st, int kb, bf16x8 (&kf)[NKK], int r, int h) {
        const int row = kb * 32 + r, m = r & 15, m2 = (r >> 1) & 7;
        const unsigned a0 = lds_addr(st) + row * 256 + ((((m & ~1) | (h ^ (m & 1)))) << 4);
#pragma unroll
        for (int kk = 0; kk < 8; ++kk) kf[kk] = lds_ld128(a0 ^ (kk << 5));
        if (ROPE) {
            const unsigned a1 = lds_addr(st) + K_BYTES + row * 128 + ((((m2 & ~1) | (h ^ (m2 & 1)))) << 4);
#pragma unroll
            for (int kk = 0; kk < 4; ++kk) kf[8 + kk] = lds_ld128(a1 ^ (kk << 5));
        }
    }
    static __device__ __forceinline__ f32x16 qk_mma(const bf16x8 (&kf)[NKK], const bf16x8* qf) {
        f32x16 s;
#pragma unroll
        for (int q = 0; q < 16; ++q) s[q] = 0.f;
#pragma unroll
        for (int kk = 0; kk < NKK; ++kk) s = MFMA32(kf[kk], qf[kk], s);
        return s;
    }
    static __device__ __forceinline__ f32x16 qk(const unsigned char* st, int kb, const bf16x8* qf, int r, int h) {
        f32x16 s;
#pragma unroll
        for (int q = 0; q < 16; ++q) s[q] = 0.f;
        const int row = kb * 32 + r;
#pragma unroll
        for (int kk = 0; kk < 8; ++kk) s = MFMA32(lds_frag(st, row * 256 + (((2 * kk + h) ^ (r & 15)) << 4)), qf[kk], s);
        return s;
    }
    static __device__ __forceinline__ void vload(const unsigned char* st, int ks, bf16x8 (&vf)[4], int r, int h) {
        const int swz = (KT == 64) ? ((r >> 1) & 7) : ((r >> 2) & 3);
        const unsigned v0 = lds_addr(st) + K_BYTES + KR_BYTES + r * VRB + 8 * h + (swz << 4);
#pragma unroll
        for (int dvb = 0; dvb < 4; ++dvb) {
            typedef unsigned long long u64x2 __attribute__((ext_vector_type(2)));
            u64x2 w;
            w[0] = *(const volatile LAS unsigned long long*)(size_t)((v0 ^ ((2 * ks) << 4)) + dvb * 32 * VRB);
            w[1] = *(const volatile LAS unsigned long long*)(size_t)((v0 ^ ((2 * ks + 1) << 4)) + dvb * 32 * VRB);
            vf[dvb] = *reinterpret_cast<bf16x8*>(&w);
        }
    }
    static __device__ __forceinline__ void pv_mma(f32x16 (&o)[4], const bf16x8 (&vf)[4], bf16x8 pf) {
#pragma unroll
        for (int dvb = 0; dvb < 4; ++dvb) o[dvb] = MFMA32(vf[dvb], pf, o[dvb]);
    }
    static __device__ __forceinline__ void pv(const unsigned char* st, f32x16 (&o)[4], int ks, bf16x8 pf, int r, int h) {
        bf16x8 vf[4];
        vload(st, ks, vf, r, h);
        pv_mma(o, vf, pf);
    }
};
struct HalfBar { volatile LAS unsigned* ctr; unsigned target; };
__device__ __forceinline__ void half_bar(HalfBar& hb, int lane) {
    asm volatile("s_waitcnt lgkmcnt(0)" ::: "memory");
    hb.target += 4u;
    if (lane == 0) __hip_atomic_fetch_add((LAS unsigned*)hb.ctr, 1u, __ATOMIC_RELAXED, __HIP_MEMORY_SCOPE_WORKGROUP);
    while ((unsigned)__builtin_amdgcn_readfirstlane((int)*hb.ctr) < hb.target) __builtin_amdgcn_s_sleep(1);
    asm volatile("" ::: "memory");
}
#define DMA_WAIT_SYNC() do { asm volatile("s_waitcnt vmcnt(0)" ::: "memory"); __syncthreads(); } while (0)
__device__ __forceinline__ bf16x8 pfrag(const f32x16& s, int half) {
    const int b = half * 8;
    uint4 w = cvtpk8(s[b + 0], s[b + 1], s[b + 2], s[b + 3], s[b + 4], s[b + 5], s[b + 6], s[b + 7]);
    return *reinterpret_cast<bf16x8*>(&w);
}
template <int NKK> __device__ __forceinline__ void load_q(bf16x8 (&qf)[NKK], const bf16_t* qrow, int h) {
#pragma unroll
    for (int kk = 0; kk < NKK; ++kk) qf[kk] = *reinterpret_cast<const bf16x8*>(qrow + kk * 16 + h * 8);
}
__device__ __forceinline__ void store_pk16(bf16_t* orow, int dvb, int gp, uint2 X  , uint2 Y  , int h) {
    auto r0 = __builtin_amdgcn_permlane32_swap(X.x, Y.x, false, false), r1 = __builtin_amdgcn_permlane32_swap(X.y, Y.y, false, false);
    uint4 w; w.x = r0[0]; w.y = r1[0]; w.z = r0[1]; w.w = r1[1];
    *reinterpret_cast<uint4*>(orow + dvb * 32 + 8 * (2 * gp + h)) = w;
}
__device__ __forceinline__ void store_o(const f32x16 (&o)[4], bf16_t* orow, int h, float scale) {
#pragma unroll
    for (int dvb = 0; dvb < 4; ++dvb)
#pragma unroll
        for (int gp = 0; gp < 2; ++gp) {
            const int a = 8 * gp, c = 8 * gp + 4;
            uint2 X, Y;
            X.x = cvtpk(o[dvb][a] * scale, o[dvb][a + 1] * scale); X.y = cvtpk(o[dvb][a + 2] * scale, o[dvb][a + 3] * scale);
            Y.x = cvtpk(o[dvb][c] * scale, o[dvb][c + 1] * scale); Y.y = cvtpk(o[dvb][c + 2] * scale, o[dvb][c + 3] * scale);
            store_pk16(orow, dvb, gp, X, Y, h);
        }
}

template <int DQK, int KT, int MODE>
__device__ __forceinline__ void flash_loop(int tid, unsigned char* lds, const bf16x8* qf, f32x16 (&o)[4], float& m_run, float& l_half,
                                           const bf16_t* kbase, size_t ldk, const bf16_t* krbase, const bf16_t* vtbase, size_t ldv,
                                           int kt_lo, int kt_hi, int t  , int tw_min, int tw_max  , unsigned selmask, float C, int key_off = 0, HalfBar* hbp = nullptr) {
    typedef AT<DQK, KT> A;
    constexpr bool RING3 = (KT == 32);
    constexpr int NDMA = KT / 16 + KT / 16 + (DQK == 192 ? 1 : 0);
    auto tile_dma = [&](int stage, int kt) { A::dma(tid, lds + stage * A::STAGE, kbase + (size_t)kt * KT * ldk, ldk, krbase ? krbase + (size_t)kt * KT * 64 : nullptr, vtbase + (size_t)kt * KT, ldv); };
    if (RING3) { __builtin_amdgcn_s_waitcnt(0x0F70); tile_dma(0, kt_lo); if (kt_lo + 1 <= kt_hi) tile_dma(1, kt_lo + 1); }
    else { tile_dma(0, kt_lo); __builtin_amdgcn_s_waitcnt(0x0F70); __syncthreads(); }
    int stc = 0, stn = 2;
    for (int kt = kt_lo; kt <= kt_hi; ++kt) {
        asm volatile("" : "+v"(tid));
        const int lane = tid & 63, r = lane & 31, h = lane >> 5;
        const bool more = kt < kt_hi;
        const unsigned char* st;
        if (RING3) {
            if (more) { static_assert(!RING3 || NDMA == 5, "counted wait below is written for 5 DMA instructions per tile"); asm volatile("s_waitcnt vmcnt(5)" ::: "memory"); }
            else asm volatile("s_waitcnt vmcnt(0)" ::: "memory");
            if (hbp) half_bar(*hbp, lane); else __builtin_amdgcn_s_barrier();
            asm volatile("" ::: "memory");
            if (kt + 2 <= kt_hi) tile_dma(stn, kt + 2);
            st = lds + stc * A::STAGE;
            stc = (stc == 2) ? 0 : stc + 1; stn = (stn == 2) ? 0 : stn + 1;
        } else {
            const int cur = (kt - kt_lo) & 1;
            if (more) tile_dma(cur ^ 1, kt + 1);
            st = lds + cur * A::STAGE;
        }
        const int key0 = key_off + kt * KT;
        bool active = (key0 <= tw_max);
        if (MODE == 2) active = active && (key0 + KT - 1 > tw_min - 512);
        if (active) {
            f32x16 s[A::KB];
            bf16x8 vf[2][4];
            if constexpr (KT == 32) {
                bf16x8 kf[A::NKK];
                A::kload(st, 0, kf, r, h);
                __builtin_amdgcn_sched_barrier(0);
                s[0] = A::qk_mma(kf, qf);
                __builtin_amdgcn_sched_barrier(0);
                A::vload(st, 0, vf[0], r, h); A::vload(st, 1, vf[1], r, h);
            } else {
#pragma unroll
                for (int kb = 0; kb < A::KB; ++kb) s[kb] = A::qk(st, kb, qf, r, h);
            }
            const bool need_mask = (MODE == 1) || (key0 + KT - 1 > tw_min) || (MODE == 2 && key0 <= tw_max - 512);
            if (MODE == 1 && !(key0 + KT - 1 > tw_min)) {
                static_assert(MODE != 1 || KT == 64, "selected branch: tile = selection block");
                asm volatile("" ::: "memory");
                const float drop = ((selmask >> (key0 >> 6)) & 1u) ? 0.f : -__builtin_inff();
#pragma unroll
                for (int kb = 0; kb < A::KB; ++kb)
#pragma unroll
                    for (int q = 0; q < 16; ++q) s[kb][q] += drop;
            } else if (need_mask) {
                asm volatile("" ::: "memory");
#pragma unroll
                for (int kb = 0; kb < A::KB; ++kb)
#pragma unroll
                    for (int q = 0; q < 16; ++q) {
                        const int key = key0 + kb * 32 + crow(q, h);
                        bool ok = key <= t;
                        if (MODE == 1) ok = ok && ((selmask >> (key >> 6)) & 1u);
                        if (MODE == 2) ok = ok && (t - key < 512);
                        s[kb][q] = ok ? s[kb][q] : -__builtin_inff();
                    }
            }
            float mx = -__builtin_inff();
#pragma unroll
            for (int kb = 0; kb < A::KB; ++kb)
#pragma unroll
                for (int q = 0; q < 16; ++q) mx = fmaxf(mx, s[kb][q]);
            mx = xh_max(mx) * C;
            if (__any(mx > m_run + 8.f)) {
                const float mn = fmaxf(m_run, mx);
                const float alpha = __builtin_amdgcn_exp2f(m_run - mn);
                m_run = mn;
                l_half *= alpha;
#pragma unroll
                for (int dvb = 0; dvb < 4; ++dvb)
#pragma unroll
                    for (int q = 0; q < 16; ++q) o[dvb][q] *= alpha;
            }
            const float nm = -m_run;
            float ps = 0.f;
#pragma unroll
            for (int kb = 0; kb < A::KB; ++kb)
#pragma unroll
                for (int q = 0; q < 16; ++q) { const float e = __builtin_amdgcn_exp2f(__builtin_fmaf(s[kb][q], C, nm)); s[kb][q] = e; ps += e; }
            l_half += ps;
            if constexpr (KT == 32) { A::pv_mma(o, vf[0], pfrag(s[0], 0)); A::pv_mma(o, vf[1], pfrag(s[0], 1)); }
            else {
#pragma unroll
                for (int kb = 0; kb < A::KB; ++kb) { A::pv(st, o, kb * 2, pfrag(s[kb], 0), r, h); A::pv(st, o, kb * 2 + 1, pfrag(s[kb], 1), r, h); }
            }
        }
        if (!RING3) DMA_WAIT_SYNC();
    }
    if (RING3) { if (hbp) half_bar(*hbp, tid & 63); else __syncthreads(); }
}

__device__ __forceinline__ void mla_flash(int tid0, unsigned char* lds, const bf16x8* qf, f32x16 (&o)[4], float& m_run, float& l_half,
                                          const bf16_t* kbase, const bf16_t* krbase, const bf16_t* vtbase, int kt_hi, int t, int tw_min, float C) {
    typedef AT<192, 32> A;
    constexpr int KST = A::K_BYTES + A::KR_BYTES, VST = A::V_BYTES;
    static_assert(3 * KST + 4 * VST <= HALF_LDS, "rings");
    unsigned char* kring = lds; unsigned char* vring = lds + 3 * KST;
    auto tile_dma = [&](int tid, int kt) {
        unsigned char* ks = kring + (kt % 3) * KST; unsigned char* vs = vring + (kt & 3) * VST;
        const bf16_t* kp = kbase + (size_t)kt * 32 * 1024; const bf16_t* krp = krbase + (size_t)kt * 32 * 64; const bf16_t* vp = vtbase + (size_t)kt * 32;
        const int wid = tid >> 6, l = tid & 63;
#pragma unroll
        for (int i = 0; i < 2; ++i) { const int pi = wid + 4 * i, row = 4 * pi + (l >> 4), c = (l & 15) ^ (row & 15); dma16_asm_s(kp, (unsigned)(row * 1024 + c * 8) * 2u, ks + pi * 1024); }
        { const int pi = wid, row = 8 * pi + (l >> 3), c = (l & 7) ^ ((row >> 1) & 7); dma16_asm_s(krp, (unsigned)(row * 64 + c * 8) * 2u, ks + A::K_BYTES + pi * 1024); }
#pragma unroll
        for (int i = 0; i < 2; ++i) { const int pi = wid + 4 * i, row = 16 * pi + (l >> 2), c = (l & 3) ^ ((row >> 2) & 3); dma16_asm_s(vp, (unsigned)(row * SEQ + c * 8) * 2u, vs + pi * 1024); }
    };
    auto finish = [&](f32x16& sv, float mxraw, int kt, int h) {
        const int key0 = kt * 32;
        if (key0 + 31 > tw_min) {
            asm volatile("" ::: "memory");
            mxraw = -__builtin_inff();
#pragma unroll
            for (int q = 0; q < 16; ++q) { sv[q] = (key0 + crow(q, h) <= t) ? sv[q] : -__builtin_inff(); mxraw = fmaxf(mxraw, sv[q]); }
        }
        const float mx = xh_max(mxraw) * C;
        if (__any(mx > m_run + 8.f)) {
            const float mn = fmaxf(m_run, mx);
            const float alpha = __builtin_amdgcn_exp2f(m_run - mn);
            m_run = mn; l_half *= alpha;
#pragma unroll
            for (int dvb = 0; dvb < 4; ++dvb)
#pragma unroll
                for (int q = 0; q < 16; ++q) o[dvb][q] *= alpha;
        }
    };
    f32x16 sc;
    {
        int tid = tid0; asm volatile("" : "+v"(tid));
        tile_dma(tid, 0); if (kt_hi >= 1) tile_dma(tid, 1); if (kt_hi >= 2) tile_dma(tid, 2);
        __builtin_amdgcn_s_waitcnt(0x0F70);
        __builtin_amdgcn_s_barrier();
        asm volatile("" ::: "memory");
        const int lane = tid & 63, r = lane & 31, h = lane >> 5;
        bf16x8 kf[12];
        A::kload(kring, 0, kf, r, h);
        sc = A::qk_mma(kf, qf);
        float mxr = -__builtin_inff();
#pragma unroll
        for (int q = 0; q < 16; ++q) mxr = fmaxf(mxr, sc[q]);
        finish(sc, mxr, 0, h);
    }
    for (int kt = 0; kt <= kt_hi; ++kt) {
        const int tid = tid0, lane = tid & 63, r = lane & 31, h = lane >> 5;
        if (kt + 1 <= kt_hi) { if (kt + 2 <= kt_hi) asm volatile("s_waitcnt vmcnt(5)" ::: "memory"); else asm volatile("s_waitcnt vmcnt(0)" ::: "memory"); }
        __builtin_amdgcn_s_barrier();
        asm volatile("" ::: "memory");
        if (kt + 3 <= kt_hi) tile_dma(tid, kt + 3);
        const int kn = (kt + 1) % 3;
        bf16x8 kf[12];
        A::kload(kring + kn * KST, 0, kf, r, h);
        __builtin_amdgcn_sched_barrier(0);
        f32x16 sn = A::qk_mma(kf, qf);
        const float nm = -m_run;
        float ps = 0.f;
#pragma unroll
        for (int q = 0; q < 16; ++q) { const float e = __builtin_amdgcn_exp2f(__builtin_fmaf(sc[q], C, nm)); sc[q] = e; ps += e; }
        l_half += ps;
        const bf16x8 pf0 = pfrag(sc, 0), pf1 = pfrag(sc, 1);
        bf16x8 vf[2][4];
        const unsigned char* vadj = vring + (kt & 3) * VST - (A::K_BYTES + A::KR_BYTES);
        A::vload(vadj, 0, vf[0], r, h); A::vload(vadj, 1, vf[1], r, h);
        float mxr = -__builtin_inff();
#pragma unroll
        for (int q = 0; q < 16; ++q) mxr = fmaxf(mxr, sn[q]);
        A::pv_mma(o, vf[0], pf0); A::pv_mma(o, vf[1], pf1);
        if (kt + 1 <= kt_hi) finish(sn, mxr, kt + 1, h);
        sc = sn;
    }
    __syncthreads();
}

__device__ __forceinline__ void ph_mla_attn(PRef p) {
    unsigned char* lds = VLDS;
    const float C = 0.07216878364870322f * 1.4426950408889634f;
    for (int it = VB; it < 1024; it += NVB) {
        int tid = VT; asm volatile("" : "+v"(tid));
        const int lane = tid & 63, wid = tid >> 6, r = lane & 31, h = lane >> 5;
        const int vb_ = it & 511, xw_ = vb_ >> 4, pp = ((vb_ >> 1) & 7) * 64 + (((xw_ >> 3) * 2 + (vb_ & 1)) << 3) + (xw_ & 7), second = it >> 9, bh = pp >> 3, qt = second ? (pp & 7) : (15 - (pp & 7)), b = bh >> 3, hd = bh & 7;
        const int tw0 = qt * 128 + wid * 32, t = tw0 + r;
        const size_t tok = (size_t)b * SEQ + t;
        bf16x8 qf[12];
        load_q<12>(qf, p.qm + tok * 1536 + hd * 192, h);
        f32x16 o[4];
#pragma unroll
        for (int dvb = 0; dvb < 4; ++dvb)
#pragma unroll
            for (int q = 0; q < 16; ++q) o[dvb][q] = 0.f;
        float m_run = -1.0e30f, l_half = 0.f;
        mla_flash(tid, lds, qf, o, m_run, l_half, p.kn + (size_t)b * SEQ * 1024 + hd * 128, p.krope + (size_t)b * SEQ * 64,
                  p.vt + (size_t)(b * 8 + hd) * 128 * SEQ, (qt * 128 + 127) >> 5, t, tw0, C);
        const float l = xh_sum(l_half);
        store_o(o, p.obuf + tok * 1024 + hd * 128, h, l > 0.f ? 1.f / l : 0.f);
    }
}

__device__ __forceinline__ void acc_branch(uint2 (&ot)[16], const f32x16 (&o)[4], float sc, bool first) {
#pragma unroll
    for (int dvb = 0; dvb < 4; ++dvb)
#pragma unroll
        for (int g = 0; g < 4; ++g) {
            float a0 = o[dvb][4 * g] * sc, a1 = o[dvb][4 * g + 1] * sc, a2 = o[dvb][4 * g + 2] * sc, a3 = o[dvb][4 * g + 3] * sc;
            if (!first) { const uint2 pv = ot[dvb * 4 + g]; a0 += bf2f(pv.x & 0xffffu); a1 += bf2f(pv.x >> 16); a2 += bf2f(pv.y & 0xffffu); a3 += bf2f(pv.y >> 16); }
            ot[dvb * 4 + g] = make_uint2(cvtpk(a0, a1), cvtpk(a2, a3));
        }
}
__device__ __forceinline__ void ph_nsa_attn(PRef p) {
    unsigned char* lds = VLDS;
    typedef AT<128, 64> A;
    float* imp = reinterpret_cast<float*>(lds);
    unsigned* selm = reinterpret_cast<unsigned*>(lds + 2 * A::STAGE);
    const float C = 0.08838834764831845f * 1.4426950408889634f;
    for (int it = VB; it < 1024; it += NVB) {
        int tid = VT; asm volatile("" : "+v"(tid));
        const int lane = tid & 63, wid = tid >> 6, r = lane & 31, h = lane >> 5;
        const int vb_ = it & 511, pp = ((vb_ >> 1) & 7) * 64 + ((vb_ & 1) << 5) + (vb_ >> 4), second = it >> 9, bkh = pp >> 5, qc = second ? (pp & 31) : (63 - (pp & 31)), b = bkh >> 1, kh = bkh & 1;
        const int hd = kh * 4 + wid, t0 = qc * 32, t = t0 + r;
        const size_t tok = (size_t)b * SEQ + t;
        bf16x8 qf[8];
        load_q<8>(qf, p.qn + tok * 1024 + hd * 128, h);
        const f32x4 gate4 = *reinterpret_cast<const f32x4*>(p.gates + tok * 32 + hd * 4);
        uint2 ot[16];
        f32x16 o[4];
        {
            const bf16_t* kb_ = p.kcmp + (size_t)bkh * 128 * 128; const bf16_t* vb_ = p.vcmpt + (size_t)bkh * 128 * 128;
            A::dma(tid, lds, kb_, 128, nullptr, vb_, 128);
            A::dma(tid, lds + A::STAGE, kb_ + 64 * 128, 128, nullptr, vb_ + 64, 128);
            DMA_WAIT_SYNC();
            f32x16 s[4];
            s[0] = A::qk(lds, 0, qf, r, h); s[1] = A::qk(lds, 1, qf, r, h); s[2] = A::qk(lds + A::STAGE, 0, qf, r, h); s[3] = A::qk(lds + A::STAGE, 1, qf, r, h);
            float mx = -3.0e38f;
#pragma unroll
            for (int kb = 0; kb < 4; ++kb)
#pragma unroll
                for (int q = 0; q < 16; ++q) {
                    const int n = kb * 32 + crow(q, h);
                    const float v = (16 * n + 31 <= t) ? s[kb][q] * C : -__builtin_inff();
                    s[kb][q] = v; mx = fmaxf(mx, v);
                }
            mx = fmaxf(xh_max(mx), -1.0e30f);
            float ps = 0.f;
#pragma unroll
            for (int kb = 0; kb < 4; ++kb)
#pragma unroll
                for (int q = 0; q < 16; ++q) { const float e = __builtin_amdgcn_exp2f(s[kb][q] - mx); s[kb][q] = e; ps += e; }
            const float l = xh_sum(ps), inv = l > 0.f ? 1.f / l : 0.f;
#pragma unroll
            for (int kb = 0; kb < 4; ++kb)
#pragma unroll
                for (int q = 0; q < 16; ++q) s[kb][q] *= inv;
            float impv[16];
            {
                float prev = 0.f;
#pragma unroll
                for (int gi = 0; gi < 16; ++gi) {
                    const int kb = gi >> 2, rg = gi & 3;
                    const float p3 = 0.5f * s[kb][4 * rg + 3];
                    const float av = s[kb][4 * rg] + s[kb][4 * rg + 1] + s[kb][4 * rg + 2] + p3;
                    const float co = xh_other(p3, h);
                    impv[gi] = av + (h ? co : prev);
                    prev = co;
                }
            }
            bf16x8 pf[8];
#pragma unroll
            for (int kb = 0; kb < 4; ++kb) { pf[2 * kb] = pfrag(s[kb], 0); pf[2 * kb + 1] = pfrag(s[kb], 1); }
#pragma unroll
            for (int dvb = 0; dvb < 4; ++dvb)
#pragma unroll
                for (int q = 0; q < 16; ++q) o[dvb][q] = 0.f;
#pragma unroll
            for (int ks = 0; ks < 4; ++ks) A::pv(lds, o, ks, pf[ks], r, h);
#pragma unroll
            for (int ks = 0; ks < 4; ++ks) A::pv(lds + A::STAGE, o, ks, pf[4 + ks], r, h);
            acc_branch(ot, o, gate4[0], true);
            __syncthreads();
#pragma unroll
            for (int gi = 0; gi < 16; ++gi) imp[(wid * 32 + r) * 33 + (2 * gi + h)] = impv[gi];
            __syncthreads();
            if (tid < 32) {
                const int tq = t0 + tid, cur = tq >> 6;
                float val[32];
#pragma unroll
                for (int j = 0; j < 32; ++j) {
                    float v = imp[(0 * 32 + tid) * 33 + j] + imp[(1 * 32 + tid) * 33 + j] + imp[(2 * 32 + tid) * 33 + j] + imp[(3 * 32 + tid) * 33 + j];
                    if (j == 0 || j == cur || j == cur - 1) v += 1000.f;
                    val[j] = (64 * j <= tq) ? v : -__builtin_inff();
                }
                unsigned m = 0u;
                for (int k = 0; k < 8; ++k) {
                    float best = -__builtin_inff(); int bi = -1;
#pragma unroll
                    for (int j = 0; j < 32; ++j) { const bool free_ = !((m >> j) & 1u); if (free_ && (bi < 0 || val[j] > best)) { best = val[j]; bi = j; } }
                    m |= 1u << bi;
                }
                selm[tid] = m;
            }
            __syncthreads();
        }
        const unsigned sel = selm[r];
        load_q<8>(qf, p.qn + tok * 1024 + hd * 128, h);
        {
#pragma unroll
            for (int dvb = 0; dvb < 4; ++dvb)
#pragma unroll
                for (int q = 0; q < 16; ++q) o[dvb][q] = 0.f;
            float m_run = -1.0e30f, l_half = 0.f;
            flash_loop<128, 64, 1>(tid, lds, qf, o, m_run, l_half, p.ks + (size_t)bkh * SEQ * 128, 128, nullptr, p.vst + (size_t)bkh * 128 * SEQ, SEQ,
                                   0, (t0 + 31) >> 6, t, t0, t0 + 31, sel, C);
            const float l = xh_sum(l_half);
            acc_branch(ot, o, l > 0.f ? gate4[1] / l : 0.f, false);
        }
        {
#pragma unroll
            for (int dvb = 0; dvb < 4; ++dvb)
#pragma unroll
                for (int q = 0; q < 16; ++q) o[dvb][q] = 0.f;
            float m_run = -1.0e30f, l_half = 0.f;
            const int lo = (t0 - 511) > 0 ? ((t0 - 511) >> 6) : 0;
            flash_loop<128, 64, 2>(tid, lds, qf, o, m_run, l_half, p.kw + (size_t)bkh * SEQ * 128, 128, nullptr, p.vwt + (size_t)bkh * 128 * SEQ, SEQ,
                                   lo, (t0 + 31) >> 6, t, t0, t0 + 31, 0u, C);
            const float l = xh_sum(l_half);
            acc_branch(ot, o, l > 0.f ? gate4[2] / l : 0.f, false);
        }
        bf16_t* orow = p.obuf + tok * 1024 + hd * 128;
#pragma unroll
        for (int dvb = 0; dvb < 4; ++dvb)
#pragma unroll
            for (int gp = 0; gp < 2; ++gp) store_pk16(orow, dvb, gp, ot[dvb * 4 + 2 * gp], ot[dvb * 4 + 2 * gp + 1], h);
    }
}

__device__ __forceinline__ void ph_sb_attn(PRef p) {
    unsigned char* lds = VLDS;
    typedef AT<128, 64> A;
    const float SC = 0.08838834764831845f, L2E = 1.4426950408889634f, LN2 = 0.6931471805599453f;
    for (int it = VB; it < 1024; it += NVB) {
        int tid = VT; asm volatile("" : "+v"(tid));
        const int lane = tid & 63, wid = tid >> 6, r = lane & 31, h = lane >> 5;
        const int vb_ = it & 511, xw_ = vb_ >> 4, pp = ((vb_ >> 1) & 7) * 64 + (((xw_ >> 3) * 2 + (vb_ & 1)) << 3) + (xw_ & 7), second = it >> 9, bh = pp >> 3, qt = second ? (pp & 7) : (15 - (pp & 7)), b = bh >> 3, hd = bh & 7;
        const int tw0 = qt * 128 + wid * 32, t = tw0 + r;
        const size_t tok = (size_t)b * SEQ + t;
        bf16x8 qf[8];
        load_q<8>(qf, p.qs + tok * 1024 + hd * 128, h);
        f32x16 o[4];
#pragma unroll
        for (int dvb = 0; dvb < 4; ++dvb)
#pragma unroll
            for (int q = 0; q < 16; ++q) o[dvb][q] = 0.f;
        float R = 0.f;
        const bf16_t* kbase = p.ksb + (size_t)b * SEQ * 1024 + hd * 128; const bf16_t* vtbase = p.vt + (size_t)(b * 8 + hd) * 128 * SEQ;
        const int kt_hi = (qt * 128 + 127) >> 6;
        A::dma(tid, lds, kbase + (size_t)kt_hi * 64 * 1024, 1024, nullptr, vtbase + kt_hi * 64, SEQ);
        __builtin_amdgcn_s_waitcnt(0x0F70); __syncthreads();
        volatile int* done_f = reinterpret_cast<volatile int*>(smem + LDS_WORK + 2 * A::STAGE);
        const int rwave = VHALF * 4 + wid;
        bool wdone = false;
        for (int kt = kt_hi; kt >= 0; --kt) {
            const int cur = (kt_hi - kt) & 1;
            if (kt < kt_hi && (done_f[0] & done_f[1] & done_f[2] & done_f[3] & done_f[4] & done_f[5] & done_f[6] & done_f[7])) break;
            const bool more = kt > 0;
            if (more) A::dma(tid, lds + (cur ^ 1) * A::STAGE, kbase + (size_t)(kt - 1) * 64 * 1024, 1024, nullptr, vtbase + (kt - 1) * 64, SEQ);
            const unsigned char* st = lds + cur * A::STAGE;
            const int key0 = kt * 64;
            if (key0 < tw0 + 31 && !wdone) {
                f32x16 z[2];
                z[0] = A::qk(st, 0, qf, r, h); z[1] = A::qk(st, 1, qf, r, h);
                float T[8];
#pragma unroll
                for (int kb = 0; kb < 2; ++kb)
#pragma unroll
                    for (int rg = 0; rg < 4; ++rg) {
                        float suf = 0.f;
#pragma unroll
                        for (int i = 3; i >= 0; --i) {
                            const float zz = z[kb][4 * rg + i] * SC;
                            const float sp = fmaxf(zz, 0.f) + LN2 * __builtin_amdgcn_logf(1.f + __builtin_amdgcn_exp2f(-fabsf(zz) * L2E));
                            const bool ok = (key0 + kb * 32 + 8 * rg + 4 * h + i) < t;
                            suf += ok ? -sp : 0.f;
                            z[kb][4 * rg + i] = zz + suf;
                        }
                        T[kb * 4 + rg] = suf;
                    }
                float run = 0.f;
#pragma unroll
                for (int gq = 7; gq >= 0; --gq) {
                    const float U = xh_other(T[gq], h);
                    const float after = run + (h ? 0.f : U) + R;
                    const int kb = gq >> 2, rg = gq & 3;
#pragma unroll
                    for (int i = 0; i < 4; ++i) {
                        const bool ok = (key0 + kb * 32 + 8 * rg + 4 * h + i) < t;
                        const float a = __builtin_amdgcn_exp2f((z[kb][4 * rg + i] + after) * L2E);
                        z[kb][4 * rg + i] = ok ? a : 0.f;
                    }
                    run += T[gq] + U;
                }
                R += run;
                A::pv(st, o, 0, pfrag(z[0], 0), r, h); A::pv(st, o, 1, pfrag(z[0], 1), r, h); A::pv(st, o, 2, pfrag(z[1], 0), r, h); A::pv(st, o, 3, pfrag(z[1], 1), r, h);
                wdone = __all(R < -105.f);
            }
            if (lane == 0) done_f[rwave] = wdone ? 1 : 0;
            DMA_WAIT_SYNC();
        }
        store_o(o, p.obuf + tok * 1024 + hd * 128, h, 1.f);
        __syncthreads();
    }
}


#define KARGP ((const __attribute__((address_space(4))) Params*)__builtin_amdgcn_kernarg_segment_ptr())
#define PH(call) do { if (pc >= lo && pc < hi) { { const __attribute__((address_space(4))) Params* q_ = KARGP; asm volatile("" : "+s"(q_)); PRef p = *q_; call; } if (pc + 1 < hi) xcd_barrier(bar); } ++pc; } while (0)
template <int L> __device__ __forceinline__ void ph_attn_conv(PRef p) {
    constexpr int kind = L % 3;
    const bool conv_first = false;
    (void)conv_first;
    if (kind == 0) ph_mla_attn(p); else if (kind == 1) ph_nsa_attn(p); else ph_sb_attn(p);
}
template <int L> __device__ __forceinline__ void ph_moe_a_conv(PRef p) {
    const bool conv_first = false;
    (void)conv_first;
    ph_moe_a(p, L);
    if (L == 0) convert_moe_steal(p, 0, 2);
    if (L + 1 < DEPTH) { convert_moe_steal(p, L + 1, 0); convert_moe_steal(p, L + 1, 1); }
}
template <int L> __device__ __forceinline__ void ph_moe_b_conv(PRef p) {
    const bool conv_first = false;
    (void)conv_first;
    ph_moe_b(p, L);
    if (L + 1 < DEPTH) convert_moe_steal(p, L + 1, 2);
}
template <int L> __device__ __forceinline__ void run_layer(PRef p, const XcdBarrier& bar, int lo, int hi, int& pc) {
    constexpr int kind = L % 3, j = L / 3;
    if (kind == 0) { PH(ph_mla_in(p, j)); PH(ph_mla_up(p, j)); }
    else if (kind == 1) { PH(ph_nsa_in(p)); PH(ph_nsa_cmp1(p)); PH(ph_nsa_cmp2(p)); }
    else { PH(ph_sb_in(p)); }
    PH(ph_attn_conv<L>(p));
    PH(ph_wo(p, L)); PH(ph_lna(p, L)); PH(ph_moe_a_conv<L>(p)); PH(ph_moe_b_conv<L>(p)); PH(ph_lnb(p, L));
}
__global__ void __launch_bounds__(512, 2) mega(Params pv, int lo, int hi) {
    (void)pv; PRef p = *KARGP;
    volatile LAS unsigned* stw = (volatile LAS unsigned*)smem;
    if (threadIdx.x == 0) { stw[0] = 0u; stw[1] = 0u; stw[2] = 0u; stw[3] = 0u; }
    __syncthreads();
    XcdBarrier bar; bar.bar = p.bar; bar.x = 0; bar.st = stw;
    if (hi - lo > 1) bar = xcd_barrier_post(p.bar, stw);
    int pc = 0;
    PH(ph_prologue(p));
    PH(ph_h0(p));
    run_layer<0>(p, bar, lo, hi, pc);
    run_layer<1>(p, bar, lo, hi, pc);
    run_layer<2>(p, bar, lo, hi, pc);
    run_layer<3>(p, bar, lo, hi, pc);
}
#undef PH
constexpr int N_PHASES = 2 + (3 + 5) + (4 + 5) + (2 + 5) + (3 + 5);

extern "C" void kernel_launch(void* const* d_in, const int* in_sizes, int n_in, void* d_out, int out_size, void* d_ws, size_t ws_size, hipStream_t stream) {
    (void)in_sizes; (void)n_in; (void)out_size;
    static int grid = 0;
    if (grid == 0) {
        int dev = 0, cus = 0, per_cu = 0;
        hipGetDevice(&dev);
        hipDeviceGetAttribute(&cus, hipDeviceAttributeMultiprocessorCount, dev);
        if (hipFuncSetAttribute((const void*)mega, hipFuncAttributeMaxDynamicSharedMemorySize, LDS_BYTES) != hipSuccess) { fprintf(stderr, "kernel_launch: hipFuncSetAttribute failed\n"); }
        if (hipOccupancyMaxActiveBlocksPerMultiprocessor(&per_cu, (const void*)mega, 2 * NTHR, LDS_BYTES) != hipSuccess) per_cu = 1;
        (void)hipGetLastError();
        if (per_cu < 1) per_cu = 1;
        if (per_cu > 1) per_cu = 1;
        if (cus <= 0) cus = 256;
        grid = cus * per_cu;
        if (grid >= 8) grid &= ~7;
    }
    Params p{};
    const float* const* in = (const float* const*)d_in;
    p.x = in[0]; p.c = in[1]; p.pos = (const int*)d_in[2]; p.ada_w = in[3]; p.ada_b = in[4]; p.ln_g = in[5]; p.ln_b = in[6];
    p.mla_w_in = in[7]; p.mla_g_q = in[8]; p.mla_w_uq = in[9]; p.mla_g_kv = in[10]; p.mla_w_ukv = in[11]; p.mla_w_o = in[12];
    p.nsa_w_in = in[13]; p.nsa_pe_k = in[14]; p.nsa_pe_v = in[15]; p.nsa_w_ck1 = in[16]; p.nsa_w_ck2 = in[17]; p.nsa_w_cv1 = in[18]; p.nsa_w_cv2 = in[19]; p.nsa_w_o = in[20];
    p.sb_w_qkv = in[21]; p.sb_w_o = in[22];
    p.moe_w_grp = in[23]; p.moe_b_grp = in[24]; p.moe_w_rt = in[25]; p.moe_b_rt = in[26]; p.moe_w_gate = in[27]; p.moe_w_up = in[28]; p.moe_w_down = in[29];
    p.out = (float*)d_out;
    unsigned char* ws = (unsigned char*)d_ws; size_t off = 0;
    auto take = [&](size_t bytes) { unsigned char* r = ws + off; off += (bytes + 255) & ~(size_t)255; return r; };
    p.bar = (unsigned*)take(XCD_BAR_WORDS * 4 + 16 * 256); p.wq = (int*)(p.bar + XCD_BAR_WORDS); p.cnt = (int*)take(DEPTH * 32 * 64 * 4);
    p.mod = (float*)take((size_t)8 * 8 * 3072 * 4);
    p.cosm = (float*)take((size_t)T_TOK * 32 * 4); p.sinm = (float*)take((size_t)T_TOK * 32 * 4); p.cosn = (float*)take((size_t)T_TOK * 64 * 4); p.sinn = (float*)take((size_t)T_TOK * 64 * 4);
    p.bias1 = (float*)take(2 * 128 * 4); p.wr = (float*)take((size_t)DEPTH * 1024 * 48 * 4);
    p.xbuf = (f16_t*)take((size_t)T_TOK * 1024 * 4); p.zbuf = (f16_t*)take((size_t)T_TOK * 1024 * 4); p.hbuf = (bf16_t*)take((size_t)T_TOK * 1024 * 2);
    p.wt_mla_in = (bf16_t*)take((size_t)2 * 768 * 1024 * 2); p.wt_uq = (bf16_t*)take((size_t)2 * 1536 * 256 * 2); p.wt_ukv = (bf16_t*)take((size_t)2 * 2048 * 256 * 2);
    p.wt_mla_o = (bf16_t*)take((size_t)2 * 1024 * 1024 * 2); p.wt_nsa_in = (bf16_t*)take((size_t)2816 * 1024 * 2);
    p.wt_ck1 = (bf16_t*)take((size_t)128 * 4096 * 2); p.wt_cv1 = (bf16_t*)take((size_t)128 * 4096 * 2); p.wt_ck2 = (bf16_t*)take(128 * 128 * 2); p.wt_cv2 = (bf16_t*)take(128 * 128 * 2);
    p.wt_nsa_o = (bf16_t*)take((size_t)1024 * 1024 * 2); p.wt_sb_qkv = (bf16_t*)take((size_t)3072 * 1024 * 2); p.wt_sb_o = (bf16_t*)take((size_t)1024 * 1024 * 2);
    p.wt_gu = (bf16_t*)take((size_t)DEPTH * 32 * 1024 * 1024 * 2); p.wt_dn = (bf16_t*)take((size_t)DEPTH * 32 * 1024 * 512 * 2);
    p.obuf = (bf16_t*)take((size_t)T_TOK * 1024 * 2);
    p.list = (int*)take((size_t)32 * T_TOK * 4); p.listw = (float*)take((size_t)32 * T_TOK * 4);
    p.hmoe = (bf16_t*)take((size_t)(T_TOK * 2 + 32 * 256) * 512 * 2); p.ybuf = (bf16_t*)take((size_t)T_TOK * 2 * 1024 * 2);
    const size_t arena0 = off;
    p.cbuf = (bf16_t*)take((size_t)T_TOK * 512 * 2); p.rss = (float*)take((size_t)T_TOK * 8 * 4); p.krope = (bf16_t*)take((size_t)T_TOK * 64 * 2); p.qm = (bf16_t*)take((size_t)T_TOK * 1536 * 2);
    p.kn = (bf16_t*)take((size_t)T_TOK * 1024 * 2); p.vt = (bf16_t*)take((size_t)T_TOK * 1024 * 2);
    const size_t arena_mla = off; off = arena0;
    p.qn = (bf16_t*)take((size_t)T_TOK * 1024 * 2);
    p.kc = (bf16_t*)take((size_t)(16 * SEQ + 64) * 128 * 2); p.vc = (bf16_t*)take((size_t)(16 * SEQ + 64) * 128 * 2);
    p.ks = (bf16_t*)take((size_t)16 * SEQ * 128 * 2); p.kw = (bf16_t*)take((size_t)16 * SEQ * 128 * 2);
    p.vst = (bf16_t*)take((size_t)16 * SEQ * 128 * 2); p.vwt = (bf16_t*)take((size_t)16 * SEQ * 128 * 2);
    p.gates = (float*)take((size_t)T_TOK * 32 * 4); p.cpart = (float*)take((size_t)32 * 8 * 128 * 128 * 4); p.hid = (bf16_t*)take((size_t)32 * 128 * 128 * 2);
    p.kcmp = (bf16_t*)take((size_t)16 * 128 * 128 * 2); p.vcmpt = (bf16_t*)take((size_t)16 * 128 * 128 * 2);
    const size_t arena_nsa = off; off = arena0;
    p.qs = (bf16_t*)take((size_t)T_TOK * 1024 * 2); p.ksb = (bf16_t*)take((size_t)T_TOK * 1024 * 2);
    const size_t arena_sb = off; (void)arena_sb;
    off = arena_mla > arena_nsa ? arena_mla : arena_nsa;
    if (off > ws_size) { fprintf(stderr, "kernel_launch: workspace too small (%zu > %zu)\n", off, ws_size); }
    hipMemsetAsync(p.bar, 0, XCD_BAR_WORDS * 4 + 16 * 256, stream);
#if MULTI_LAUNCH
    for (int ph = 0; ph < N_PHASES; ++ph) hipLaunchKernelGGL(mega, dim3(grid), dim3(2 * NTHR), LDS_BYTES, stream, p, ph, ph + 1);
#else
    hipLaunchKernelGGL(mega, dim3(grid), dim3(2 * NTHR), LDS_BYTES, stream, p, 0, N_PHASES);
#endif
}
```

```cpp
#include <hip/hip_runtime.h>
#include <stdint.h>
#include <stdio.h>

#ifndef MULTI_LAUNCH
#define MULTI_LAUNCH 0
#endif

typedef unsigned short bf16_t;
typedef short bf16x8 __attribute__((ext_vector_type(8)));
typedef float f32x16 __attribute__((ext_vector_type(16)));
typedef float f32x4 __attribute__((ext_vector_type(4)));
typedef _Float16 f16_t;
typedef _Float16 f16x4 __attribute__((ext_vector_type(4)));
typedef _Float16 f16x8 __attribute__((ext_vector_type(8)));
typedef float f32x8 __attribute__((ext_vector_type(8)));
__device__ __forceinline__ f32x4 ld4h(const f16_t* p) { return __builtin_convertvector(*reinterpret_cast<const f16x4*>(p), f32x4); }
__device__ __forceinline__ void st4h(f16_t* p, f32x4 v) { *reinterpret_cast<f16x4*>(p) = __builtin_convertvector(v, f16x4); }

constexpr int T_TOK = 16384, DM = 1024, NBATCH = 8, SEQ = 2048, DEPTH = 4;
constexpr float LN_EPS = 1e-5f, RMS_EPS = 1e-6f;
constexpr float DN_ALPHA = 1.6817928305074290f;
constexpr int NTHR = 256;
constexpr int LDS_WORK = 256;
constexpr int HALF_LDS = 80640;
constexpr int LDS_BYTES = LDS_WORK + 2 * HALF_LDS;
#define VHALF ((int)__builtin_amdgcn_readfirstlane((int)(threadIdx.x >> 8)))
#define VT ((int)(threadIdx.x & 255u))
#define VB ((int)(blockIdx.x * 2u) + VHALF)
#define NVB ((int)(gridDim.x * 2u))
#define VLDS (smem + LDS_WORK + VHALF * HALF_LDS)

#define XB_TMO      128
#define XB_XCNT(j)  (256  + 64 * (j))
#define XB_XSUB(j)  (1280 + 64 * (j))
#define XB_XGEN(j)  (2304 + 64 * (j))
#define XB_TOP      3328
#define XB_TOPGEN   3392
#define XCD_BAR_WORDS 3456
#define XB_SPIN_CAP (1u << 22)
#define LAS __attribute__((address_space(3)))

__device__ __forceinline__ unsigned xb_ld(unsigned* p)              { return __hip_atomic_load(p, __ATOMIC_RELAXED, __HIP_MEMORY_SCOPE_AGENT); }
__device__ __forceinline__ unsigned xb_add(unsigned* p, unsigned v) { return __hip_atomic_fetch_add(p, v, __ATOMIC_RELAXED, __HIP_MEMORY_SCOPE_AGENT); }
__device__ __forceinline__ unsigned xb_xcc_id() { return (unsigned)__builtin_amdgcn_s_getreg((3 << 11) | 20) & 0xFu; }
#define XB_SPIN(cond, bar) do { unsigned _sp = 0; while (cond) { __builtin_amdgcn_s_sleep(1); \
    if ((++_sp & 255u) == 0u) { if (xb_ld(&(bar)[XB_TMO])) break; if (_sp > XB_SPIN_CAP) { atomicAdd(&(bar)[XB_TMO], 1u); break; } } } } while (0)

struct XcdBarrier { unsigned* bar; unsigned x; volatile LAS unsigned* st; };

__device__ __forceinline__ XcdBarrier xcd_barrier_post(unsigned* bar, volatile LAS unsigned* st) {
    XcdBarrier b; b.bar = bar; b.x = xb_xcc_id(); b.st = st;
    if (threadIdx.x == 0) (void)xb_add(&bar[XB_XCNT(b.x)], 1u);
    return b;
}
__device__ __forceinline__ void xcd_barrier_complete(unsigned* bar, unsigned x, unsigned& nloc, unsigned& nx) {
    const unsigned G = gridDim.x * gridDim.y * gridDim.z;
    unsigned sum, cnt, mine, sp = 0u;
    for (;;) {
        sum = 0u; cnt = 0u; mine = 0u;
#pragma unroll
        for (unsigned j = 0; j < 16; ++j) { const unsigned c = xb_ld(&bar[XB_XCNT(j)]); sum += c; cnt += (c > 0u) ? 1u : 0u; mine = (j == x) ? c : mine; }
        if (sum == G) break;
        __builtin_amdgcn_s_sleep(1);
        if ((++sp & 255u) == 0u) { if (xb_ld(&bar[XB_TMO])) break; if (sp > XB_SPIN_CAP) { atomicAdd(&bar[XB_TMO], 1u); break; } }
    }
    nloc = mine > 0u ? mine : 1u; nx = cnt > 0u ? cnt : 1u;
}
__device__ __forceinline__ void xcd_barrier(const XcdBarrier& b) {
    asm volatile("s_waitcnt vmcnt(0)" ::: "memory");
    __syncthreads();
    if (threadIdx.x == 0) {
        unsigned* bar = b.bar;
        __builtin_amdgcn_s_waitcnt(0);
        unsigned nloc = b.st[0], nx = b.st[1];
        if (nloc == 0u) { xcd_barrier_complete(bar, b.x, nloc, nx); b.st[0] = nloc; b.st[1] = nx; }
        const unsigned old = xb_add(&bar[XB_XSUB(b.x)], 1u);
        const unsigned gen = old / nloc;
        if (old + 1u == (gen + 1u) * nloc) {
            __builtin_amdgcn_fence(__ATOMIC_RELEASE, "agent");
            asm volatile("s_waitcnt vmcnt(0)" ::: "memory");
            const unsigned og = xb_add(&bar[XB_TOP], 1u);
            const unsigned tg = og / nx;
            if (og + 1u == (tg + 1u) * nx) xb_add(&bar[XB_TOPGEN], 1u);
            else XB_SPIN(xb_ld(&bar[XB_TOPGEN]) == tg, bar);
            __builtin_amdgcn_fence(__ATOMIC_ACQUIRE, "agent");
            xb_add(&bar[XB_XGEN(b.x)], 1u);
            asm volatile("s_waitcnt vmcnt(0)" ::: "memory");
        } else {
            XB_SPIN(xb_ld(&bar[XB_XGEN(b.x)]) == gen, bar);
            __builtin_amdgcn_fence(__ATOMIC_ACQUIRE, "agent");
            asm volatile("s_waitcnt vmcnt(0)" ::: "memory");
        }
    }
    __syncthreads();
}

struct Params;
typedef const __attribute__((address_space(4))) Params& PRef;
struct Params {
    const float* x; const float* c; const int* pos; const float* ada_w; const float* ada_b; const float* ln_g; const float* ln_b;
    const float* mla_w_in; const float* mla_g_q; const float* mla_w_uq; const float* mla_g_kv; const float* mla_w_ukv; const float* mla_w_o;
    const float* nsa_w_in; const float* nsa_pe_k; const float* nsa_pe_v; const float* nsa_w_ck1; const float* nsa_w_ck2; const float* nsa_w_cv1; const float* nsa_w_cv2; const float* nsa_w_o;
    const float* sb_w_qkv; const float* sb_w_o;
    const float* moe_w_grp; const float* moe_b_grp; const float* moe_w_rt; const float* moe_b_rt; const float* moe_w_gate; const float* moe_w_up; const float* moe_w_down;
    float* out;
    unsigned* bar; int* cnt; float* mod; float* cosm; float* sinm; float* cosn; float* sinn; float* bias1; float* wr;
    f16_t* xbuf; f16_t* zbuf; bf16_t* hbuf;
    bf16_t* wt_mla_in; bf16_t* wt_uq; bf16_t* wt_ukv; bf16_t* wt_mla_o; bf16_t* wt_nsa_in; bf16_t* wt_ck1; bf16_t* wt_cv1; bf16_t* wt_ck2; bf16_t* wt_cv2;
    bf16_t* wt_nsa_o; bf16_t* wt_sb_qkv; bf16_t* wt_sb_o; bf16_t* wt_gu; bf16_t* wt_dn;
    bf16_t* cbuf; float* rss; bf16_t* krope; bf16_t* qm; bf16_t* kn; bf16_t* vt;
    bf16_t* qn; bf16_t* kc; bf16_t* vc; bf16_t* ks; bf16_t* kw; bf16_t* vst; bf16_t* vwt; float* gates; float* cpart; bf16_t* hid; bf16_t* kcmp; bf16_t* vcmpt;
    bf16_t* qs; bf16_t* ksb;
    bf16_t* obuf;
    int* wq;
    int* list; float* listw; bf16_t* hmoe; bf16_t* ybuf;
};

extern __shared__ __attribute__((aligned(16))) unsigned char smem[];

__device__ __forceinline__ unsigned cvtpk(float lo, float hi) { unsigned r; asm("s_nop 0\n\tv_cvt_pk_bf16_f32 %0, %1, %2\n\ts_nop 1" : "=v"(r) : "v"(lo), "v"(hi)); return r; }
__device__ __forceinline__ uint4 cvtpk8(float a0, float a1, float a2, float a3, float a4, float a5, float a6, float a7) {
    uint4 r;
    asm("s_nop 0\n\tv_cvt_pk_bf16_f32 %0, %4, %5\n\tv_cvt_pk_bf16_f32 %1, %6, %7\n\tv_cvt_pk_bf16_f32 %2, %8, %9\n\tv_cvt_pk_bf16_f32 %3, %10, %11\n\ts_nop 1"
        : "=&v"(r.x), "=&v"(r.y), "=&v"(r.z), "=&v"(r.w) : "v"(a0), "v"(a1), "v"(a2), "v"(a3), "v"(a4), "v"(a5), "v"(a6), "v"(a7));
    return r;
}
__device__ __forceinline__ float bf2f(unsigned v16) { return __uint_as_float(v16 << 16); }
__device__ __forceinline__ uint4 pack8(const float* v) { return cvtpk8(v[0], v[1], v[2], v[3], v[4], v[5], v[6], v[7]); }
__device__ __forceinline__ float wave_sum(float v) {
#pragma unroll
    for (int o = 32; o > 0; o >>= 1) v += __shfl_xor(v, o, 64);
    return v;
}
__device__ __forceinline__ float xh_max(float v) { auto rr = __builtin_amdgcn_permlane32_swap(__float_as_uint(v), __float_as_uint(v), false, false); return fmaxf(__uint_as_float(rr[0]), __uint_as_float(rr[1])); }
__device__ __forceinline__ float xh_sum(float v) { auto rr = __builtin_amdgcn_permlane32_swap(__float_as_uint(v), __float_as_uint(v), false, false); return __uint_as_float(rr[0]) + __uint_as_float(rr[1]); }
__device__ __forceinline__ float xh_other(float v, int h) { auto rr = __builtin_amdgcn_permlane32_swap(__float_as_uint(v), __float_as_uint(v), false, false); return h ? __uint_as_float(rr[0]) : __uint_as_float(rr[1]); }
__device__ __forceinline__ float silu_f(float v) { return v / (1.f + __expf(-v)); }
__device__ __forceinline__ float sigmoid_f(float v) { return 1.f / (1.f + __expf(-v)); }
#define MFMA32(a, b, c) __builtin_amdgcn_mfma_f32_32x32x16_bf16((a), (b), (c), 0, 0, 0)
__device__ __forceinline__ int crow(int reg, int h) { return (reg & 3) + 8 * (reg >> 2) + 4 * h; }
__device__ __forceinline__ bf16x8 lds_frag(const unsigned char* base, int off) { return *reinterpret_cast<const bf16x8*>(base + off); }

constexpr int CS_LD = 132;
constexpr int GEMM_RSTD_OFF = 128 * CS_LD * 4;
template <class RowPtr>
__device__ __forceinline__ void gemm_main(int tid, unsigned char* lds, const RowPtr& rowptr, const bf16_t* __restrict__ Bt, int ldb, int n0, int K, f32x16 (&acc)[2][2]) {
    const int lane = tid & 63, wid = tid >> 6, wr = wid >> 1, wc = wid & 1, r = lane & 31, h = lane >> 5;
    const bf16_t* pa[4]; const bf16_t* pb[4];
#pragma unroll
    for (int i = 0; i < 4; ++i) {
        const int pi = wid + 4 * i, row = 8 * pi + (lane >> 3), c = (lane & 7) ^ ((row >> 1) & 7);
        pa[i] = rowptr(row) + c * 8; pb[i] = Bt + (size_t)(n0 + row) * ldb + c * 8;
    }
    const int swz = (r >> 1) & 7;
    const int aoff = (wr * 64 + r) * 128, boff = 32768 + (wc * 64 + r) * 128;
#pragma unroll
    for (int i = 0; i < 2; ++i)
#pragma unroll
        for (int j = 0; j < 2; ++j)
#pragma unroll
            for (int q = 0; q < 16; ++q) acc[i][j][q] = 0.f;
    const int nk = K >> 6;
    auto dma = [&](int buf, int k0) {
#pragma unroll
        for (int i = 0; i < 4; ++i) {
            const int pi = wid + 4 * i;
            __builtin_amdgcn_global_load_lds((const unsigned*)(pa[i] + k0), (LAS unsigned*)(lds + buf * 16384 + pi * 1024), 16, 0, 0);
            __builtin_amdgcn_global_load_lds((const unsigned*)(pb[i] + k0), (LAS unsigned*)(lds + 32768 + buf * 16384 + pi * 1024), 16, 0, 0);
        }
    };
    dma(0, 0);
    asm volatile("s_waitcnt vmcnt(0)" ::: "memory"); __syncthreads();
    for (int kt = 0; kt < nk; ++kt) {
        if (kt + 1 < nk) dma((kt + 1) & 1, (kt + 1) << 6);
        const unsigned char* sa = lds + (kt & 1) * 16384;
#pragma unroll
        for (int kk = 0; kk < 4; ++kk) {
            const int co = ((2 * kk + h) ^ swz) << 4;
            const bf16x8 a0 = lds_frag(sa, aoff + co), a1 = lds_frag(sa, aoff + 4096 + co);
            const bf16x8 b0 = lds_frag(sa, boff + co), b1 = lds_frag(sa, boff + 4096 + co);
            acc[0][0] = MFMA32(a0, b0, acc[0][0]); acc[0][1] = MFMA32(a0, b1, acc[0][1]);
            acc[1][0] = MFMA32(a1, b0, acc[1][0]); acc[1][1] = MFMA32(a1, b1, acc[1][1]);
        }
        asm volatile("s_waitcnt vmcnt(0)" ::: "memory"); __syncthreads();
    }
    float* Cs = reinterpret_cast<float*>(lds);
#pragma unroll
    for (int i = 0; i < 2; ++i)
#pragma unroll
        for (int j = 0; j < 2; ++j)
#pragma unroll
            for (int q = 0; q < 16; ++q) Cs[(wr * 64 + i * 32 + crow(q, h)) * CS_LD + wc * 64 + j * 32 + r] = acc[i][j][q];
    __syncthreads();
}
#define ITEM_END_SYNC() do { asm volatile("s_waitcnt lgkmcnt(0)" ::: "memory"); __builtin_amdgcn_s_barrier(); asm volatile("" ::: "memory"); } while (0)
__device__ __forceinline__ void cs_load8(const float* Cs, int row, int c0, float* v) {
    const f32x4 a = *reinterpret_cast<const f32x4*>(Cs + row * CS_LD + c0), b = *reinterpret_cast<const f32x4*>(Cs + row * CS_LD + c0 + 4);
    v[0] = a[0]; v[1] = a[1]; v[2] = a[2]; v[3] = a[3]; v[4] = b[0]; v[5] = b[1]; v[6] = b[2]; v[7] = b[3];
}
__device__ __forceinline__ void epi_plain(const float* __restrict__ Cs, bf16_t* __restrict__ dst, size_t ld, const float* __restrict__ rowscale) {
    const int tid = VT, c0 = (tid & 15) * 8;
#pragma unroll
    for (int ps = 0; ps < 8; ++ps) {
        const int row = (tid >> 4) + 16 * ps; float v[8]; cs_load8(Cs, row, c0, v);
        if (rowscale) { const float s = rowscale[row];
#pragma unroll
            for (int q = 0; q < 8; ++q) v[q] *= s; }
        *reinterpret_cast<uint4*>(dst + (size_t)row * ld + c0) = pack8(v);
    }
}
__device__ __forceinline__ void epi_rope128(const float* __restrict__ Cs, bf16_t* __restrict__ dst, size_t ld, const float* __restrict__ cs, const float* __restrict__ sn, int tok0) {
    const int tid = VT, c0 = (tid & 15) * 8;
    if (c0 >= 64) return;
#pragma unroll
    for (int ps = 0; ps < 8; ++ps) {
        const int row = (tid >> 4) + 16 * ps; float a[8], b[8], o1[8], o2[8]; cs_load8(Cs, row, c0, a); cs_load8(Cs, row, c0 + 64, b);
        const float* cp = cs + (size_t)(tok0 + row) * 64 + c0; const float* sp = sn + (size_t)(tok0 + row) * 64 + c0;
#pragma unroll
        for (int q = 0; q < 8; ++q) { const float c = cp[q], s = sp[q]; o1[q] = a[q] * c - b[q] * s; o2[q] = b[q] * c + a[q] * s; }
        *reinterpret_cast<uint4*>(dst + (size_t)row * ld + c0) = pack8(o1);
        *reinterpret_cast<uint4*>(dst + (size_t)row * ld + c0 + 64) = pack8(o2);
    }
}
__device__ __forceinline__ void epi_transpose(const float* __restrict__ Cs, bf16_t* __restrict__ dst  , size_t ld, const float* __restrict__ rowscale) {
    const int tid = VT, dv = tid & 127, sh = tid >> 7;
#pragma unroll
    for (int j = 0; j < 8; ++j) {
        float v[8];
#pragma unroll
        for (int q = 0; q < 8; ++q) { const int row = sh * 64 + j * 8 + q; v[q] = Cs[row * CS_LD + dv] * (rowscale ? rowscale[row] : 1.f); }
        *reinterpret_cast<uint4*>(dst + (size_t)dv * ld + sh * 64 + j * 8) = pack8(v);
    }
}

struct RowPlain { const bf16_t* base; size_t ld; __device__ __forceinline__ const bf16_t* operator()(int r) const { return base + (size_t)r * ld; } };


namespace g8 {
typedef float f32x4_t __attribute__((ext_vector_type(4)));
constexpr int BK = 64, HALFR = 128, HTB = HALFR * BK * 2, STAGE_BYTES = 8 * HTB;
__device__ __forceinline__ int lds_byte(int r, int c) { const int st = (r >> 4) * 2 + (c >> 5), rr = r & 15, cc = c & 31, ob = rr * 64 + cc * 2; return st * 1024 + (ob ^ (((ob >> 9) & 1) << 5)); }
__device__ __forceinline__ void stage_rc(int b, int& R, int& C) { const int st = b / 1024, sb = b % 1024, swz = sb ^ (((sb >> 9) & 1) << 5); R = (st >> 1) * 16 + swz / 64; C = (st & 1) * 32 + (swz % 64) / 2; }
struct Unit { int pm, pn, par; };
template <class Sched, class Epi>
__device__ __forceinline__ void gemm8(LAS unsigned char* lds, const char* __restrict__ Abase, int ldb, int K, const Sched& S, const Epi& E) {
    const int tid = threadIdx.x;
    const int wid = __builtin_amdgcn_readfirstlane(tid >> 6), lane = tid & 63, wr = wid >> 2, wc = wid & 3, fr = lane & 15, fq = lane >> 4;
    const int nt = K / BK;
    unsigned voffB0; { int R, C; stage_rc(tid * 16, R, C); voffB0 = (unsigned)(R * ldb + C) * 2u; }
    const unsigned voffBd = (unsigned)(64 * ldb) * 2u;
    const size_t kstep = (size_t)(BK * 2), hstepB = (size_t)HALFR * ldb * 2;
    const unsigned ldsw = (unsigned)wid * 1024u;
    const int lpart = lds_byte(fr, fq * 8);
    const int aoff = lpart + wr * 8192, boff = lpart + wc * 4096;
#define G8_SA(b, h) (((b) * 2 + (h)) * HTB)
#define G8_SB(b, h) ((4 + (b) * 2 + (h)) * HTB)
#define G8_STAGE_B(bufoff, gbase) do { \
        __builtin_amdgcn_global_load_lds((const unsigned*)((const char*)(gbase) + voffB0), (LAS unsigned*)(lds + (bufoff) + ldsw), 16, 0, 0); \
        __builtin_amdgcn_global_load_lds((const unsigned*)((const char*)(gbase) + voffBd + voffB0), (LAS unsigned*)(lds + (bufoff) + ldsw + 8192), 16, 0, 0); } while (0)
#define G8_STAGE_A(bufoff, hnd, kbytes) do { \
        __builtin_amdgcn_global_load_lds((const unsigned*)(Abase + (size_t)S.a_off(hnd, 0, tid) + (kbytes)), (LAS unsigned*)(lds + (bufoff) + ldsw), 16, 0, 0); \
        __builtin_amdgcn_global_load_lds((const unsigned*)(Abase + (size_t)S.a_off(hnd, 1, tid) + (kbytes)), (LAS unsigned*)(lds + (bufoff) + ldsw + 8192), 16, 0, 0); } while (0)
#define G8_LDA(dst, b, h) do { _Pragma("unroll") for (int m = 0; m < 4; ++m) _Pragma("unroll") for (int k = 0; k < 2; ++k) dst[m][k] = *(const LAS bf16x8*)(lds + G8_SA(b, h) + aoff + m * 2048 + k * 1024); } while (0)
#define G8_LDB(dst, b, h) do { _Pragma("unroll") for (int n = 0; n < 2; ++n) _Pragma("unroll") for (int k = 0; k < 2; ++k) dst[n][k] = *(const LAS bf16x8*)(lds + G8_SB(b, h) + boff + n * 2048 + k * 1024); } while (0)
#define G8_MMA(ai, bj, At, Bt) do { __builtin_amdgcn_s_setprio(1); _Pragma("unroll") for (int m = 0; m < 4; ++m) _Pragma("unroll") for (int n = 0; n < 2; ++n) _Pragma("unroll") for (int k = 0; k < 2; ++k) \
        acc[ai][bj][m][n] = __builtin_amdgcn_mfma_f32_16x16x32_bf16(Bt[n][k], At[m][k], acc[ai][bj][m][n], 0, 0, 0); __builtin_amdgcn_s_setprio(0); } while (0)
#define G8_WAIT_V(n) asm volatile("s_waitcnt vmcnt(" #n ")" ::: "memory")
#define G8_WAIT_L(n) asm volatile("s_waitcnt lgkmcnt(" #n ")" ::: "memory")
#define G8_BAR __builtin_amdgcn_s_barrier()
#define G8_SCHED __builtin_amdgcn_sched_barrier(0)
    Unit cur, nxt; int ui = 0;
    if (!S.next(0, cur)) return;
    f32x4_t acc[2][2][4][2];
#pragma unroll
    for (int a = 0; a < 2; ++a)
#pragma unroll
        for (int b = 0; b < 2; ++b)
#pragma unroll
            for (int m = 0; m < 4; ++m)
#pragma unroll
                for (int n = 0; n < 2; ++n) acc[a][b][m][n] = (f32x4_t){0.f, 0.f, 0.f, 0.f};
    bf16x8 At[4][2], B0[2][2], B1[2][2];
    unsigned c0, c1;
    cur.par = 0; S.stash(cur, tid); S.stash_wait(); S.a_handles(cur, tid, c0, c1);
    const char* cB = S.b_base(cur);
    G8_STAGE_B(G8_SB(0, 0), cB); G8_STAGE_A(G8_SA(0, 0), c0, 0); G8_STAGE_B(G8_SB(0, 1), cB + hstepB); G8_STAGE_A(G8_SA(0, 1), c1, 0);
    if (wr == 1) G8_BAR;
    G8_WAIT_V(4); G8_BAR;
    G8_STAGE_B(G8_SB(1, 0), cB + kstep); G8_STAGE_A(G8_SA(1, 0), c0, kstep); G8_STAGE_B(G8_SB(1, 1), cB + hstepB + kstep);
    G8_WAIT_V(6); G8_BAR;
    for (;;) {
        const bool has_next = S.next(ui + 1, nxt); nxt.par = (ui + 1) % 3;
        const char* nB = cB;
        if (has_next) { S.stash(nxt, tid); nB = S.b_base(nxt); }
#pragma unroll 1
        for (int t = 0; t < nt; t += 2) {
            const bool last = (t == nt - 2);
            const size_t k1 = (size_t)(t + 1) * kstep;
            const size_t k2 = last ? 0 : (size_t)(t + 2) * kstep, k3 = k2 + kstep;
            const char* b2 = last ? nB : cB + k2; const char* b3 = b2 + kstep;
            G8_LDB(B0, 0, 0); G8_SCHED; G8_LDA(At, 0, 0); G8_STAGE_A(G8_SA(1, 1), c1, k1);
            if (last && has_next) S.a_handles(nxt, tid, c0, c1);
            G8_WAIT_L(8); G8_BAR; G8_WAIT_L(0); G8_MMA(0, 0, At, B0); G8_BAR; G8_SCHED;
            G8_LDB(B1, 0, 1); G8_STAGE_B(G8_SB(0, 0), b2);
            G8_BAR; G8_WAIT_L(0); G8_MMA(0, 1, At, B1); G8_BAR;
            G8_LDA(At, 0, 1); G8_STAGE_A(G8_SA(0, 0), c0, k2);
            G8_BAR; G8_WAIT_L(0); G8_MMA(1, 0, At, B0); G8_BAR; G8_SCHED;
            G8_STAGE_B(G8_SB(0, 1), b2 + hstepB);
            G8_WAIT_V(6); G8_BAR; G8_MMA(1, 1, At, B1); G8_BAR;
            G8_LDB(B0, 1, 0); G8_SCHED; G8_LDA(At, 1, 0); G8_STAGE_A(G8_SA(0, 1), c1, k2);
            G8_WAIT_L(8); G8_BAR; G8_WAIT_L(0); G8_MMA(0, 0, At, B0); G8_BAR; G8_SCHED;
            G8_LDB(B1, 1, 1); G8_STAGE_B(G8_SB(1, 0), b3);
            G8_BAR; G8_WAIT_L(0); G8_MMA(0, 1, At, B1); G8_BAR;
            G8_LDA(At, 1, 1); G8_STAGE_A(G8_SA(1, 0), c0, k3);
            G8_BAR; G8_WAIT_L(0); G8_MMA(1, 0, At, B0); G8_BAR; G8_SCHED;
            G8_STAGE_B(G8_SB(1, 1), b3 + hstepB);
            G8_WAIT_V(6); G8_BAR; G8_MMA(1, 1, At, B1); G8_BAR;
        }
        E(acc, cur, wr, wc, fr, fq);
        if (!has_next) break;
#pragma unroll
        for (int a = 0; a < 2; ++a)
#pragma unroll
            for (int b = 0; b < 2; ++b)
#pragma unroll
                for (int m = 0; m < 4; ++m)
#pragma unroll
                    for (int n = 0; n < 2; ++n) acc[a][b][m][n] = (f32x4_t){0.f, 0.f, 0.f, 0.f};
        cur = nxt; cB = nB; ++ui;
    }
    G8_WAIT_V(0);
    if (wr == 0) G8_BAR;
    G8_BAR;
#undef G8_SA
#undef G8_SB
#undef G8_STAGE_A
#undef G8_STAGE_B
#undef G8_LDA
#undef G8_LDB
#undef G8_MMA
#undef G8_WAIT_V
#undef G8_WAIT_L
#undef G8_BAR
#undef G8_SCHED
}
struct SchedPlain {
    int nM, nN, nwg, G, c, lda; const char* Bt; size_t ldb_bytes;
    __device__ __forceinline__ void init(int M, int N, int lda_, const void* Bt_, int ldb) { nM = M / 256; nN = N / 256; nwg = nM * nN; G = gridDim.x; c = blockIdx.x; lda = lda_; Bt = (const char*)Bt_; ldb_bytes = (size_t)ldb * 2; }
    __device__ __forceinline__ bool next(int i, Unit& u) const {
        const long L = (long)i * G + c; if (L >= nwg) return false;
        int wgid = (int)L; { const int q = nwg / 8, r = nwg % 8, xcd = wgid % 8, off = wgid / 8; wgid = (xcd < r ? xcd * (q + 1) : r * (q + 1) + (xcd - r) * q) + off; }
        const int nig = 8 * nN, gid = wgid / nig, fm = gid * 8, gsz = (nM - fm) < 8 ? (nM - fm) : 8;
        u.pm = fm + ((wgid % nig) % gsz); u.pn = (wgid % nig) / gsz; return true;
    }
    __device__ __forceinline__ void a_handles(const Unit& u, int tid, unsigned& h0, unsigned& h1) const {
        int R, C; stage_rc(tid * 16, R, C);
        h0 = ((unsigned)(u.pm * 256 + R) * (unsigned)lda + (unsigned)C) * 2u; h1 = h0 + (unsigned)(128 * lda) * 2u;
    }
    __device__ __forceinline__ unsigned a_off(unsigned h, int piece, int) const { return h + (unsigned)(piece * 64 * lda) * 2u; }
    __device__ __forceinline__ const char* b_base(const Unit& u) const { return Bt + (size_t)u.pn * 256 * ldb_bytes; }
    __device__ __forceinline__ void stash(const Unit&, int) const {}
    __device__ __forceinline__ void stash_wait() const {}
};
struct SchedMoe {
    const int* pre; const int* list; const float* listw; const char* Bt; size_t estride, ustride; int nunits, G, c, gather; int* tab;
    __device__ __forceinline__ int expert(int panel) const { int e = 0; for (int q = 1; q < 32; ++q) e = (pre[q] <= panel) ? q : e; return e; }
    __device__ __forceinline__ bool next(int i, Unit& u) const {
        const int per = (nunits + 7) >> 3, x = c & 7, Lx = i * (G >> 3) + (c >> 3), L = x * per + Lx;
        if (Lx >= per || L >= nunits) return false;
        u.pn = L & 3; u.pm = L >> 2; return true;
    }
    __device__ __forceinline__ void stash(const Unit& u, int tid) const {
        const int e = expert(u.pm), b0 = (u.pm - pre[e]) * 256; const int* l = list + (size_t)e * T_TOK + b0;
        const int wv = __builtin_amdgcn_readfirstlane(tid >> 6);
        if (gather) {
            int R, C; stage_rc(tid * 16, R, C);
#pragma unroll
            for (int k = 0; k < 4; ++k)
                __builtin_amdgcn_global_load_lds((const unsigned*)(l + R + 64 * (k & 1) + 128 * (k >> 1)), (LAS unsigned*)((LAS unsigned char*)(LAS int*)tab + k * 2048 + wv * 256), 4, 0, 0);
        } else {
            const int r = tid & 255; const int* src = (tid < 256) ? (l + r) : reinterpret_cast<const int*>(listw + (size_t)e * T_TOK + b0 + r);
            __builtin_amdgcn_global_load_lds((const unsigned*)src, (LAS unsigned*)((LAS unsigned char*)(LAS int*)tab + u.par * 2048 + wv * 256), 4, 0, 0);
        }
    }
    __device__ __forceinline__ void stash_wait() const { asm volatile("s_waitcnt vmcnt(0)" ::: "memory"); }
    __device__ __forceinline__ void a_handles(const Unit& u, int tid, unsigned& h0, unsigned& h1) const {
        if (gather) {
            asm volatile("" ::: "memory");
            const unsigned t0 = ((unsigned)tab[tid] >> 1) & 16383u, t1 = ((unsigned)tab[512 + tid] >> 1) & 16383u, t2 = ((unsigned)tab[1024 + tid] >> 1) & 16383u, t3 = ((unsigned)tab[1536 + tid] >> 1) & 16383u;
            h0 = t0 | (t1 << 16); h1 = t2 | (t3 << 16);
        }
        else { int R, C; stage_rc(tid * 16, R, C); h0 = ((unsigned)(u.pm * 256 + R) * 512u + (unsigned)C) * 2u; h1 = h0 + 128u * 512u * 2u; }
    }
    __device__ __forceinline__ unsigned a_off(unsigned h, int piece, int tid) const {
        if (gather) { int R, C; stage_rc(tid * 16, R, C); return (((h >> (16 * piece)) & 0xffffu) * 1024u + (unsigned)C) * 2u; }
        return h + (unsigned)(piece * 64 * 512) * 2u;
    }
    __device__ __forceinline__ const char* b_base(const Unit& u) const { return Bt + (size_t)expert(u.pm) * estride + (size_t)u.pn * ustride; }
};
}

__device__ __forceinline__ void convert_T(unsigned char* lds, const float* __restrict__ src, int nb, int K, int N, bf16_t* __restrict__ dst, size_t dst_bstride,
                                       const float* __restrict__ rowscale, int grp, int grp_stride, int off, int b0 = 0, int perm = 0) {
    (void)lds;
    int tid = VT; asm volatile("" : "+v"(tid));
    const int lane = tid & 63, wid = tid >> 6;
    const int nkt = K >> 7, nnt = (N + 63) >> 6, per = nkt * nnt, total = nb * per;
    for (int it = VB; it < total; it += NVB) {
        const int bl = it / per, b = b0 + bl, rem = it - bl * per, ktile = rem / nnt, ntile = rem - ktile * nnt;
        const int k0 = (ktile << 7) + (wid * 4 + (lane >> 4)) * 8, n = (ntile << 6) + (lane & 15) * 4;
        if (n < N) {
            const float* s = src + (size_t)b * K * N + (size_t)k0 * N + n;
            f32x4 v[8];
#pragma unroll
            for (int j = 0; j < 8; ++j) v[j] = *reinterpret_cast<const f32x4*>(s + (size_t)j * N);
            if (rowscale) {
#pragma unroll
                for (int j = 0; j < 8; ++j) { const float sc = rowscale[(size_t)b * K + k0 + j]; v[j] *= sc; }
            }
#pragma unroll
            for (int q = 0; q < 4; ++q) {
                const int nn = n + q; int drow = (nn / grp) * grp_stride + off + (nn % grp);
                if (perm == 1) { const int l = drow & 127; drow = (drow & ~127) | (32 * ((l >> 4) & 3) + 16 * (l >> 6) + (l & 15)); }
                if (perm == 3) { const int l = drow & 31; drow = (drow & ~31) | (16 * ((l >> 2) & 1) + 4 * (l >> 3) + (l & 3)); }
                else if (perm == 2) { const int l = drow & 63; drow = (drow & ~63) | (32 * ((l >> 4) & 1) + 16 * (l >> 5) + (l & 15)); }
                *reinterpret_cast<uint4*>(dst + (size_t)b * dst_bstride + (size_t)drow * K + k0) = cvtpk8(v[0][q], v[1][q], v[2][q], v[3][q], v[4][q], v[5][q], v[6][q], v[7][q]);
            }
        }
    }
}

__device__ __forceinline__ void job_mod(PRef p, unsigned char* lds) {
    int tid = VT; asm volatile("" : "+v"(tid));
    const int lane = tid & 63, wid = tid >> 6;
    float* sc = reinterpret_cast<float*>(lds);
    float* part = reinterpret_cast<float*>(lds + 32768);
    for (int i = tid; i < 8192; i += NTHR) { const int b = i >> 10, k = i & 1023; const float v = p.c[b * 1024 + k]; sc[k * 8 + b] = v / (1.f + expf(-v)); }
    __syncthreads();
    for (int it = VB; it < 384; it += NVB) {
        const int sl = it / 48, n0 = (it % 48) * 64;
        const float* W = p.ada_w + (size_t)sl * 1024 * 3072 + n0 + lane;
        float acc[8] = {0.f, 0.f, 0.f, 0.f, 0.f, 0.f, 0.f, 0.f};
        const int kb = wid * 256;
#pragma unroll 16
        for (int k = 0; k < 256; ++k) {
            const float w = W[(size_t)(kb + k) * 3072];
            const f32x4 s0 = *reinterpret_cast<const f32x4*>(sc + (kb + k) * 8), s1 = *reinterpret_cast<const f32x4*>(sc + (kb + k) * 8 + 4);
            acc[0] += s0[0] * w; acc[1] += s0[1] * w; acc[2] += s0[2] * w; acc[3] += s0[3] * w;
            acc[4] += s1[0] * w; acc[5] += s1[1] * w; acc[6] += s1[2] * w; acc[7] += s1[3] * w;
        }
#pragma unroll
        for (int b = 0; b < 8; ++b) part[(wid * 8 + b) * 64 + lane] = acc[b];
        __syncthreads();
        for (int o = tid; o < 512; o += NTHR) {
            const int b = o >> 6, l = o & 63;
            const float s = part[(0 * 8 + b) * 64 + l] + part[(1 * 8 + b) * 64 + l] + part[(2 * 8 + b) * 64 + l] + part[(3 * 8 + b) * 64 + l] + p.ada_b[sl * 3072 + n0 + l];
            p.mod[(size_t)(sl * 8 + b) * 3072 + n0 + l] = s;
        }
        __syncthreads();
    }
}

__device__ __forceinline__ void job_misc(PRef p, unsigned char* lds) {
    const int tid = VT;
    const size_t gtid = (size_t)VB * NTHR + tid, gsz = (size_t)NVB * NTHR;
    for (size_t i = gtid; i < (size_t)T_TOK * 32; i += gsz) {
        const int t = (int)(i >> 5), f = (int)(i & 31);
        const float inv = 1.0f / powf(10000.f, (float)(2 * f) / 64.f);
        const float ang = (float)p.pos[t] * inv;
        p.cosm[i] = cosf(ang); p.sinm[i] = sinf(ang);
    }
    for (size_t i = gtid; i < (size_t)T_TOK * 64; i += gsz) {
        const int t = (int)(i >> 6), f = (int)(i & 63);
        const float inv = 1.0f / powf(10000.f, (float)(2 * f) / 128.f);
        const float ang = (float)p.pos[t] * inv;
        p.cosn[i] = cosf(ang); p.sinn[i] = sinf(ang);
    }
    for (size_t i = gtid; i < (size_t)DEPTH * 1024 * 48; i += gsz) {
        const int e = (int)(i % 48); const size_t lk = i / 48;
        float v = 0.f;
        if (e < 4) v = p.moe_w_grp[lk * 4 + e]; else if (e < 36) v = p.moe_w_rt[lk * 32 + (e - 4)];
        p.wr[i] = v;
    }
    if (gtid < DEPTH * 32) p.cnt[gtid * 64] = 0;
    {
        const int lane = tid & 63, wid = tid >> 6;
        for (int o = VB * 4 + wid; o < 256; o += NVB * 4) {
            const int which = o >> 7, e = o & 127;
            const float* pe = which ? p.nsa_pe_v : p.nsa_pe_k; const float* w1 = which ? p.nsa_w_cv1 : p.nsa_w_ck1;
            float a = 0.f;
#pragma unroll 16
            for (int j = 0; j < 64; ++j) { const int k = lane + 64 * j; a += pe[k] * w1[(size_t)k * 128 + e]; }
            a = wave_sum(a);
            if (lane == 0) p.bias1[o] = a;
        }
    }
}

struct CvtJob { const float* src; int nb, K, N; bf16_t* dst; size_t bstride; const float* rowscale; int grp, gstride, off, perm; };
__device__ __forceinline__ CvtJob cvt_job(PRef p, int j) {
    const int BIG = 1 << 30;
    CvtJob c;
    switch (j) {
    case 0:  c = CvtJob{p.moe_w_gate, DEPTH * 32, 1024, 512, p.wt_gu, (size_t)1024 * 1024, nullptr, 64, 128, 0, 0}; break;
    case 1:  c = CvtJob{p.moe_w_up, DEPTH * 32, 1024, 512, p.wt_gu, (size_t)1024 * 1024, nullptr, 64, 128, 64, 0}; break;
    case 2:  c = CvtJob{p.moe_w_down, DEPTH * 32, 512, 1024, p.wt_dn, (size_t)1024 * 512, nullptr, BIG, 0, 0, 0}; break;
    case 3:  c = CvtJob{p.mla_w_in, 2, 1024, 576, p.wt_mla_in, (size_t)768 * 1024, nullptr, BIG, 0, 0, 2}; break;
    case 4:  c = CvtJob{p.mla_w_uq, 2, 256, 1536, p.wt_uq, (size_t)1536 * 256, p.mla_g_q, BIG, 0, 0, 2}; break;
    case 5:  c = CvtJob{p.mla_w_ukv, 2, 256, 2048, p.wt_ukv, (size_t)2048 * 256, p.mla_g_kv, BIG, 0, 0, 0}; break;
    case 6:  c = CvtJob{p.mla_w_o, 2, 1024, 1024, p.wt_mla_o, (size_t)1024 * 1024, nullptr, BIG, 0, 0, 3}; break;
    case 7:  c = CvtJob{p.nsa_w_in, 1, 1024, 2584, p.wt_nsa_in, 0, nullptr, BIG, 0, 0, 1}; break;
    case 8:  c = CvtJob{p.nsa_w_ck1, 1, 4096, 128, p.wt_ck1, 0, nullptr, BIG, 0, 0, 0}; break;
    case 9:  c = CvtJob{p.nsa_w_cv1, 1, 4096, 128, p.wt_cv1, 0, nullptr, BIG, 0, 0, 0}; break;
    case 10: c = CvtJob{p.nsa_w_ck2, 1, 128, 128, p.wt_ck2, 0, nullptr, BIG, 0, 0, 0}; break;
    case 11: c = CvtJob{p.nsa_w_cv2, 1, 128, 128, p.wt_cv2, 0, nullptr, BIG, 0, 0, 0}; break;
    case 12: c = CvtJob{p.nsa_w_o, 1, 1024, 1024, p.wt_nsa_o, 0, nullptr, BIG, 0, 0, 3}; break;
    case 13: c = CvtJob{p.sb_w_qkv, 1, 1024, 3072, p.wt_sb_qkv, 0, nullptr, BIG, 0, 0, 3}; break;
    default: c = CvtJob{p.sb_w_o, 1, 1024, 1024, p.wt_sb_o, 0, nullptr, BIG, 0, 0, 3}; break;
    }
    return c;
}
template <int K, int N, int grp, int grp_stride, int perm>
__device__ __forceinline__ void convert_T_steal(int* ctr, const float* __restrict__ src, bf16_t* __restrict__ dst, int off, int b0) {
    constexpr int nb = 32; constexpr size_t dst_bstride = (size_t)K * N * (grp_stride ? 2 : 1);
    int tid = threadIdx.x; asm volatile("" : "+v"(tid));
    const int lane = tid & 63;
    constexpr int nkt = K >> 7, nnt = N >> 6, per = nkt * nnt, total = nb * per * 4;
    for (;;) {
        int w0 = 0;
        if (lane == 0) w0 = __hip_atomic_fetch_add(ctr, 16, __ATOMIC_RELAXED, __HIP_MEMORY_SCOPE_AGENT);
        w0 = __builtin_amdgcn_readfirstlane(w0);
        if (w0 >= total) break;
#pragma unroll 1
        for (int w = w0; w < w0 + 16; ++w) {
            const int it = w >> 2, wq = w & 3;
            const int bl = it / per, b = b0 + bl, rem = it - bl * per, ktile = rem / nnt, ntile = rem - ktile * nnt;
            const int k0 = (ktile << 7) + (wq * 4 + (lane >> 4)) * 8, n = (ntile << 6) + (lane & 15) * 4;
            const float* sp = src + (size_t)b * K * N + (size_t)k0 * N + n;
            f32x4 v[8];
#pragma unroll
            for (int j = 0; j < 8; ++j) v[j] = *reinterpret_cast<const f32x4*>(sp + (size_t)j * N);
#pragma unroll
            for (int q = 0; q < 4; ++q) {
                const int nn = n + q; int drow = (nn / grp) * grp_stride + off + (nn % grp);
                if (perm == 1) { const int l = drow & 127; drow = (drow & ~127) | (32 * ((l >> 4) & 3) + 16 * (l >> 6) + (l & 15)); }
                if (perm == 3) { const int l = drow & 31; drow = (drow & ~31) | (16 * ((l >> 2) & 1) + 4 * (l >> 3) + (l & 3)); }
                *reinterpret_cast<uint4*>(dst + (size_t)b * dst_bstride + (size_t)drow * K + k0) = cvtpk8(v[0][q], v[1][q], v[2][q], v[3][q], v[4][q], v[5][q], v[6][q], v[7][q]);
            }
        }
    }
}
__device__ __forceinline__ void convert_moe_steal(PRef p, int layer, int which) {
    int* ctr = p.wq + (layer * 3 + which) * 64;
    if (which == 0) convert_T_steal<1024, 512, 128, 256, 3>(ctr, p.moe_w_gate, p.wt_gu, 0, layer * 32);
    else if (which == 1) convert_T_steal<1024, 512, 128, 256, 3>(ctr, p.moe_w_up, p.wt_gu, 128, layer * 32);
    else convert_T_steal<512, 1024, 1 << 30, 0, 3>(ctr, p.moe_w_down, p.wt_dn, 0, layer * 32);
}
__device__ __forceinline__ void convert_moe(PRef p, int layer, int which) {
    if (which == 0) convert_T(nullptr, p.moe_w_gate, 32, 1024, 512, p.wt_gu, (size_t)1024 * 1024, nullptr, 128, 256, 0, layer * 32, 3);
    else if (which == 1) convert_T(nullptr, p.moe_w_up, 32, 1024, 512, p.wt_gu, (size_t)1024 * 1024, nullptr, 128, 256, 128, layer * 32, 3);
    else convert_T(nullptr, p.moe_w_down, 32, 512, 1024, p.wt_dn, (size_t)1024 * 512, nullptr, 1 << 30, 0, 0, layer * 32, 3);
}
__device__ __forceinline__ void ph_prologue(PRef p) {
    unsigned char* lds = VLDS;
    job_mod(p, lds);
    job_misc(p, lds);
    for (int j = 3; j < 15; ++j) {
        const CvtJob c = cvt_job(p, j);
        convert_T(lds, c.src, c.nb, c.K, c.N, c.dst, c.bstride, c.rowscale, c.grp, c.gstride, c.off, 0, c.perm);
    }
    for (int w = 0; w < 2; ++w) convert_moe(p, 0, w);
}

__device__ __forceinline__ void ph_h0(PRef p) {
    const size_t gtid = (size_t)VB * NTHR + VT, gsz = (size_t)NVB * NTHR;
    for (size_t i = gtid; i < (size_t)T_TOK * 128; i += gsz) {
        const int row = (int)(i >> 7), c0 = (int)(i & 127) * 8, b = row >> 11;
        const float* xs = p.x + (size_t)row * 1024 + c0; const float* sh = p.mod + (size_t)b * 3072 + c0; const float* scp = sh + 1024;
        float v[8];
#pragma unroll
        for (int q = 0; q < 8; ++q) v[q] = xs[q] * (1.f + scp[q]) + sh[q];
        *reinterpret_cast<uint4*>(p.hbuf + (size_t)row * 1024 + c0) = pack8(v);
    }
}

__device__ __forceinline__ void st4bf(bf16_t* p, float a, float b, float c, float d) { uint2 pk; pk.x = cvtpk(a, b); pk.y = cvtpk(c, d); *reinterpret_cast<uint2*>(p) = pk; }
__device__ __forceinline__ int vt_pos(int s) { return (s & ~12) | ((s & 4) << 1) | ((s & 8) >> 1); }
__device__ __forceinline__ void st_vt4(bf16_t* vt_feat0  , const g8::f32x4_t& a, float sc) {
#pragma unroll
    for (int q = 0; q < 4; ++q) vt_feat0[(size_t)q * SEQ] = (bf16_t)(cvtpk(a[q] * sc, 0.f) & 0xffffu);
}
struct EpiMlaIn {
    bf16_t* cbuf; float* rss; bf16_t* krope; const float* cosm; const float* sinm;
    __device__ __forceinline__ void operator()(const g8::f32x4_t (&acc)[2][2][4][2], const g8::Unit& u, int wr, int wc, int fr, int fq) const {
        const int lc = 64 * (wc >> 1) + 16 * (wc & 1) + 4 * fq;
#pragma unroll
        for (int ai = 0; ai < 2; ++ai) {
            f32x4 csb[4], snb[4];
            if (u.pn >= 2 && wc < 2) {
#pragma unroll
                for (int m = 0; m < 4; ++m) {
                    const int row = u.pm * 256 + ai * 128 + wr * 64 + m * 16 + fr, i0 = 16 * wc + 4 * fq;
                    csb[m] = *reinterpret_cast<const f32x4*>(cosm + (size_t)row * 32 + i0); snb[m] = *reinterpret_cast<const f32x4*>(sinm + (size_t)row * 32 + i0);
                }
            }
#pragma unroll
            for (int m = 0; m < 4; ++m) {
                const int row = u.pm * 256 + ai * 128 + wr * 64 + m * 16 + fr;
                if (u.pn < 2) {
                    float sq = 0.f;
#pragma unroll
                    for (int bj = 0; bj < 2; ++bj)
#pragma unroll
                        for (int n = 0; n < 2; ++n) {
                            const g8::f32x4_t a = acc[ai][bj][m][n];
                            st4bf(cbuf + (size_t)row * 512 + u.pn * 256 + bj * 128 + lc + 32 * n, a[0], a[1], a[2], a[3]);
                            sq += a[0] * a[0] + a[1] * a[1] + a[2] * a[2] + a[3] * a[3];
                        }
                    sq += __shfl_xor(sq, 16, 64); sq += __shfl_xor(sq, 32, 64);
                    if (fq == 0) rss[(size_t)row * 8 + u.pn * 4 + wc] = sq;
                } else if (wc < 2) {
                    const int i0 = 16 * wc + 4 * fq;
                    const f32x4 cs = csb[m], sn = snb[m];
                    const g8::f32x4_t x1 = acc[ai][0][m][0], x2 = acc[ai][0][m][1];
                    st4bf(krope + (size_t)row * 64 + i0, x1[0] * cs[0] - x2[0] * sn[0], x1[1] * cs[1] - x2[1] * sn[1], x1[2] * cs[2] - x2[2] * sn[2], x1[3] * cs[3] - x2[3] * sn[3]);
                    st4bf(krope + (size_t)row * 64 + 32 + i0, x2[0] * cs[0] + x1[0] * sn[0], x2[1] * cs[1] + x1[1] * sn[1], x2[2] * cs[2] + x1[2] * sn[2], x2[3] * cs[3] + x1[3] * sn[3]);
                }
            }
        }
    }
};
__device__ __forceinline__ void ph_mla_in(PRef p, int j) {
    g8::SchedPlain S; S.init(T_TOK, 768, 1024, p.wt_mla_in + (size_t)j * 768 * 1024, 1024);
    g8::gemm8((LAS unsigned char*)(smem + LDS_WORK), (const char*)p.hbuf, 1024, 1024, S, EpiMlaIn{p.cbuf, p.rss, p.krope, p.cosm, p.sinm});
    __syncthreads();
}
__device__ __forceinline__ float mla_rstd(const float* rss, int row, int which) {
    const f32x4 q = *reinterpret_cast<const f32x4*>(rss + (size_t)row * 8 + which * 4);
    return rsqrtf((q[0] + q[1] + q[2] + q[3]) * (1.f / 256.f) + RMS_EPS);
}
struct EpiMlaQ {
    bf16_t* qm; const float* rss; const float* cosm; const float* sinm;
    __device__ __forceinline__ void operator()(const g8::f32x4_t (&acc)[2][2][4][2], const g8::Unit& u, int wr, int wc, int fr, int fq) const {
        const int i0 = 16 * (wc & 1) + 4 * fq;
#pragma unroll
        for (int ai = 0; ai < 2; ++ai) {
            f32x4 qs[4], csb[4], snb[4];
#pragma unroll
            for (int m = 0; m < 4; ++m) {
                const int row = u.pm * 256 + ai * 128 + wr * 64 + m * 16 + fr;
                qs[m] = *reinterpret_cast<const f32x4*>(rss + (size_t)row * 8);
                csb[m] = *reinterpret_cast<const f32x4*>(cosm + (size_t)row * 32 + i0); snb[m] = *reinterpret_cast<const f32x4*>(sinm + (size_t)row * 32 + i0);
            }
#pragma unroll
            for (int m = 0; m < 4; ++m) {
                const int row = u.pm * 256 + ai * 128 + wr * 64 + m * 16 + fr;
                const float sc = rsqrtf((qs[m][0] + qs[m][1] + qs[m][2] + qs[m][3]) * (1.f / 256.f) + RMS_EPS);
                const f32x4 cs = csb[m], sn = snb[m];
#pragma unroll
                for (int bj = 0; bj < 2; ++bj) {
                    const int c64 = u.pn * 256 + bj * 128 + 64 * (wc >> 1);
                    bf16_t* dst = qm + (size_t)row * 1536 + c64 + i0;
                    const g8::f32x4_t x1 = acc[ai][bj][m][0], x2 = acc[ai][bj][m][1];
                    if ((c64 % 192) == 128) {
                        st4bf(dst, (x1[0] * cs[0] - x2[0] * sn[0]) * sc, (x1[1] * cs[1] - x2[1] * sn[1]) * sc, (x1[2] * cs[2] - x2[2] * sn[2]) * sc, (x1[3] * cs[3] - x2[3] * sn[3]) * sc);
                        st4bf(dst + 32, (x2[0] * cs[0] + x1[0] * sn[0]) * sc, (x2[1] * cs[1] + x1[1] * sn[1]) * sc, (x2[2] * cs[2] + x1[2] * sn[2]) * sc, (x2[3] * cs[3] + x1[3] * sn[3]) * sc);
                    } else {
                        st4bf(dst, x1[0] * sc, x1[1] * sc, x1[2] * sc, x1[3] * sc);
                        st4bf(dst + 32, x2[0] * sc, x2[1] * sc, x2[2] * sc, x2[3] * sc);
                    }
                }
            }
        }
    }
};
struct EpiMlaKv {
    bf16_t* kn; bf16_t* vt; const float* rss;
    __device__ __forceinline__ void operator()(const g8::f32x4_t (&acc)[2][2][4][2], const g8::Unit& u, int wr, int wc, int fr, int fq) const {
        const int hd = u.pn;
#pragma unroll
        for (int ai = 0; ai < 2; ++ai) {
            f32x4 qs[4];
#pragma unroll
            for (int m = 0; m < 4; ++m) qs[m] = *reinterpret_cast<const f32x4*>(rss + (size_t)(u.pm * 256 + ai * 128 + wr * 64 + m * 16 + fr) * 8 + 4);
#pragma unroll
            for (int m = 0; m < 4; ++m) {
                const int row = u.pm * 256 + ai * 128 + wr * 64 + m * 16 + fr, b = row >> 11, sq = row & 2047;
                const float sc = rsqrtf((qs[m][0] + qs[m][1] + qs[m][2] + qs[m][3]) * (1.f / 256.f) + RMS_EPS);
#pragma unroll
                for (int n = 0; n < 2; ++n) {
                    const int c = 32 * wc + 16 * n + 4 * fq;
                    const g8::f32x4_t k = acc[ai][0][m][n];
                    st4bf(kn + (size_t)row * 1024 + hd * 128 + c, k[0] * sc, k[1] * sc, k[2] * sc, k[3] * sc);
                    st_vt4(vt + ((size_t)(b * 8 + hd) * 128 + c) * SEQ + vt_pos(sq), acc[ai][1][m][n], sc);
                }
            }
        }
    }
};
__device__ __forceinline__ void ph_mla_up(PRef p, int j) {
    { g8::SchedPlain S; S.init(T_TOK, 1536, 512, p.wt_uq + (size_t)j * 1536 * 256, 256);
      g8::gemm8((LAS unsigned char*)(smem + LDS_WORK), (const char*)p.cbuf, 256, 256, S, EpiMlaQ{p.qm, p.rss, p.cosm, p.sinm}); }
    { g8::SchedPlain S; S.init(T_TOK, 2048, 512, p.wt_ukv + (size_t)j * 2048 * 256, 256);
      g8::gemm8((LAS unsigned char*)(smem + LDS_WORK), (const char*)(p.cbuf + 256), 256, 256, S, EpiMlaKv{p.kn, p.vt, p.rss}); }
    __syncthreads();
}
struct EpiNsaIn {
    PRef p;
    __device__ __forceinline__ void operator()(const g8::f32x4_t (&acc)[2][2][4][2], const g8::Unit& u, int wr, int wc, int fr, int fq) const {
        const int i0 = 16 * wc + 4 * fq;
        const bool rot = (u.pn < 5) || u.pn == 6 || u.pn == 8;
#pragma unroll
        for (int ai = 0; ai < 2; ++ai) {
            f32x4 cs[4], sn[4];
            if (rot) {
#pragma unroll
                for (int m = 0; m < 4; ++m) {
                    const int row = u.pm * 256 + ai * 128 + wr * 64 + m * 16 + fr;
                    cs[m] = *reinterpret_cast<const f32x4*>(p.cosn + (size_t)row * 64 + i0); sn[m] = *reinterpret_cast<const f32x4*>(p.sinn + (size_t)row * 64 + i0);
                }
            }
#pragma unroll
            for (int bj = 0; bj < 2; ++bj) {
                const int tn = 2 * u.pn + bj;
                if (tn >= 21) continue;
#pragma unroll
                for (int m = 0; m < 4; ++m) {
                    const int row = u.pm * 256 + ai * 128 + wr * 64 + m * 16 + fr, b = row >> 11, sq = row & 2047;
                    const g8::f32x4_t x1 = acc[ai][bj][m][0], x2 = acc[ai][bj][m][1];
                    if (tn == 20) {
                        if (i0 < 24) {
#pragma unroll
                            for (int q = 0; q < 4; ++q) { const int c = i0 + q; p.gates[(size_t)row * 32 + (c / 3) * 4 + (c % 3)] = sigmoid_f(x1[q]); }
                        }
                        continue;
                    }
                    const int g = (tn - 8) >> 1, kh = (tn - 8) & 1;
                    const size_t slab = (size_t)(b * 2 + kh) * SEQ * 128;
                    if (tn >= 8 && (g == 3 || g == 5)) {
                        bf16_t* vt = (g == 3 ? p.vst : p.vwt) + slab + vt_pos(sq);
                        st_vt4(vt + (size_t)i0 * SEQ, x1, 1.f); st_vt4(vt + (size_t)(i0 + 64) * SEQ, x2, 1.f);
                    } else if (tn >= 8 && g == 1) {
                        bf16_t* dst = p.vc + slab + (size_t)sq * 128 + i0;
                        st4bf(dst, x1[0], x1[1], x1[2], x1[3]); st4bf(dst + 64, x2[0], x2[1], x2[2], x2[3]);
                    } else {
                        bf16_t* dst = (tn < 8) ? p.qn + (size_t)row * 1024 + tn * 128 + i0 : (g == 0 ? p.kc : (g == 2 ? p.ks : p.kw)) + slab + (size_t)sq * 128 + i0;
                        const f32x4 c_ = cs[m], s_ = sn[m];
                        st4bf(dst, x1[0] * c_[0] - x2[0] * s_[0], x1[1] * c_[1] - x2[1] * s_[1], x1[2] * c_[2] - x2[2] * s_[2], x1[3] * c_[3] - x2[3] * s_[3]);
                        st4bf(dst + 64, x2[0] * c_[0] + x1[0] * s_[0], x2[1] * c_[1] + x1[1] * s_[1], x2[2] * c_[2] + x1[2] * s_[2], x2[3] * c_[3] + x1[3] * s_[3]);
                    }
                }
            }
        }
    }
};
__device__ __forceinline__ void ph_nsa_in(PRef p) {
    g8::SchedPlain S; S.init(T_TOK, 2816, 1024, p.wt_nsa_in, 1024);
    g8::gemm8((LAS unsigned char*)(smem + LDS_WORK), (const char*)p.hbuf, 1024, 1024, S, EpiNsaIn{p});
    __syncthreads();
}
struct RowWin { const bf16_t* base; __device__ __forceinline__ const bf16_t* operator()(int r) const { return base + (size_t)r * 2048; } };
__device__ __forceinline__ void ph_nsa_cmp1(PRef p) {
    unsigned char* lds = VLDS; const float* Cs = reinterpret_cast<const float*>(lds);
    for (int it = VB; it < 256; it += NVB) {
        const int item = it >> 3, sp = it & 7, which = item & 1, bkh = item >> 1;
        const bf16_t* src = (which ? p.vc : p.kc) + (size_t)bkh * SEQ * 128 + sp * 512;
        int tid = VT; asm volatile("" : "+v"(tid));
        f32x16 acc[2][2];
        gemm_main(tid, lds, RowWin{src}, (which ? p.wt_cv1 : p.wt_ck1) + sp * 512, 4096, 0, 512, acc);
        float* dst = p.cpart + (size_t)(item * 8 + sp) * 128 * 128;
        const int c0 = (tid & 15) * 8;
#pragma unroll
        for (int ps = 0; ps < 8; ++ps) {
            const int row = (tid >> 4) + 16 * ps;
            *reinterpret_cast<f32x4*>(dst + row * 128 + c0) = *reinterpret_cast<const f32x4*>(Cs + row * CS_LD + c0);
            *reinterpret_cast<f32x4*>(dst + row * 128 + c0 + 4) = *reinterpret_cast<const f32x4*>(Cs + row * CS_LD + c0 + 4);
        }
        ITEM_END_SYNC();
    }
}
__device__ __forceinline__ void ph_nsa_cmp2(PRef p) {
    unsigned char* lds = VLDS; const float* Cs = reinterpret_cast<const float*>(lds);
    for (int item = VB; item < 32; item += NVB) {
        const int which = item & 1, bkh = item >> 1;
        int tid = VT; asm volatile("" : "+v"(tid));
        bf16_t* hid = p.hid + (size_t)item * 128 * 128;
        for (int o = tid; o < 128 * 16; o += NTHR) {
            const int row = o >> 4, c0 = (o & 15) * 8; float v[8];
#pragma unroll
            for (int q = 0; q < 8; ++q) v[q] = p.bias1[which * 128 + c0 + q];
            for (int sp = 0; sp < 8; ++sp) {
                const float* src = p.cpart + (size_t)(item * 8 + sp) * 128 * 128 + row * 128 + c0;
#pragma unroll
                for (int q = 0; q < 8; ++q) v[q] += src[q];
            }
#pragma unroll
            for (int q = 0; q < 8; ++q) v[q] = silu_f(v[q]);
            *reinterpret_cast<uint4*>(hid + row * 128 + c0) = pack8(v);
        }
        __threadfence();
        __syncthreads();
        f32x16 acc[2][2];
        gemm_main(tid, lds, RowPlain{hid, 128}, which ? p.wt_cv2 : p.wt_ck2, 128, 0, 128, acc);
        if (!which) {
            const int c0 = (tid & 15) * 8;
#pragma unroll
            for (int ps = 0; ps < 8; ++ps) {
                const int row = (tid >> 4) + 16 * ps; float v[8]; cs_load8(Cs, row, c0, v);
                if (row == 127) {
#pragma unroll
                    for (int q = 0; q < 8; ++q) v[q] = 0.f; }
                *reinterpret_cast<uint4*>(p.kcmp + (size_t)bkh * 128 * 128 + row * 128 + c0) = pack8(v);
            }
        } else {
            const int dv = tid & 127, sh = tid >> 7;
#pragma unroll
            for (int jj = 0; jj < 8; ++jj) {
                float v[8];
#pragma unroll
                for (int q = 0; q < 8; ++q) { const int row = vt_pos(sh * 64 + jj * 8 + q); v[q] = (row == 127) ? 0.f : Cs[row * CS_LD + dv]; }
                *reinterpret_cast<uint4*>(p.vcmpt + (size_t)bkh * 128 * 128 + dv * 128 + sh * 64 + jj * 8) = pack8(v);
            }
        }
        ITEM_END_SYNC();
    }
}
struct EpiSbIn {
    bf16_t* qs; bf16_t* ksb; bf16_t* vt;
    __device__ __forceinline__ void operator()(const g8::f32x4_t (&acc)[2][2][4][2], const g8::Unit& u, int wr, int wc, int fr, int fq) const {
#pragma unroll
        for (int ai = 0; ai < 2; ++ai)
#pragma unroll
            for (int m = 0; m < 4; ++m) {
                const int row = u.pm * 256 + ai * 128 + wr * 64 + m * 16 + fr, b = row >> 11, sq = row & 2047;
#pragma unroll
                for (int bj = 0; bj < 2; ++bj) {
                    const int c = (u.pn & 3) * 256 + bj * 128 + 32 * wc + 8 * fq;
                    const g8::f32x4_t a = acc[ai][bj][m][0], d = acc[ai][bj][m][1];
                    if (u.pn < 8) *reinterpret_cast<uint4*>((u.pn < 4 ? qs : ksb) + (size_t)row * 1024 + c) = cvtpk8(a[0], a[1], a[2], a[3], d[0], d[1], d[2], d[3]);
                    else { st_vt4(vt + ((size_t)b * 1024 + c) * SEQ + vt_pos(sq), a, 1.f); st_vt4(vt + ((size_t)b * 1024 + c + 4) * SEQ + vt_pos(sq), d, 1.f); }
                }
            }
    }
};
__device__ __forceinline__ void ph_sb_in(PRef p) {
    g8::SchedPlain S; S.init(T_TOK, 3072, 1024, p.wt_sb_qkv, 1024);
    g8::gemm8((LAS unsigned char*)(smem + LDS_WORK), (const char*)p.hbuf, 1024, 1024, S, EpiSbIn{p.qs, p.ksb, p.vt});
    __syncthreads();
}
template <bool XF32> struct EpiWo {
    const float* xs; const f16_t* xh; f16_t* z; const float* mod; int L;
    __device__ __forceinline__ void operator()(const g8::f32x4_t (&acc)[2][2][4][2], const g8::Unit& u, int wr, int wc, int fr, int fq) const {
        const int row0 = u.pm * 256 + wr * 64 + fr, col0 = u.pn * 256 + wc * 32 + 8 * fq, b = (u.pm * 256) >> 11;
        const float* gate = mod + (size_t)((L * 2 + 0) * 8 + b) * 3072 + 2048 + col0;
        f32x4 gv[2][2];
#pragma unroll
        for (int bj = 0; bj < 2; ++bj)
#pragma unroll
            for (int n = 0; n < 2; ++n) gv[bj][n] = *reinterpret_cast<const f32x4*>(gate + bj * 128 + n * 4);
#pragma unroll
        for (int ai = 0; ai < 2; ++ai) {
            f32x4 xv[4][2][2];
#pragma unroll
            for (int m = 0; m < 4; ++m)
#pragma unroll
                for (int bj = 0; bj < 2; ++bj) {
                    const size_t o = (size_t)(row0 + ai * 128 + m * 16) * 1024 + col0 + bj * 128;
                    if (XF32) { xv[m][bj][0] = *reinterpret_cast<const f32x4*>(xs + o); xv[m][bj][1] = *reinterpret_cast<const f32x4*>(xs + o + 4); }
                    else { const f16x8 hx = *reinterpret_cast<const f16x8*>(xh + o); const f32x8 fx = __builtin_convertvector(hx, f32x8); xv[m][bj][0] = (f32x4){fx[0], fx[1], fx[2], fx[3]}; xv[m][bj][1] = (f32x4){fx[4], fx[5], fx[6], fx[7]}; }
                }
#pragma unroll
            for (int m = 0; m < 4; ++m)
#pragma unroll
                for (int bj = 0; bj < 2; ++bj) {
                    f32x8 zv;
#pragma unroll
                    for (int n = 0; n < 2; ++n)
#pragma unroll
                        for (int q = 0; q < 4; ++q) zv[n * 4 + q] = DN_ALPHA * xv[m][bj][n][q] + gv[bj][n][q] * acc[ai][bj][m][n][q];
                    *reinterpret_cast<f16x8*>(z + (size_t)(row0 + ai * 128 + m * 16) * 1024 + col0 + bj * 128) = __builtin_convertvector(zv, f16x8);
                }
        }
    }
};
__device__ __forceinline__ void ph_wo(PRef p, int L) {
    const int kind = L % 3, j = L / 3;
    const bf16_t* Bt = kind == 0 ? p.wt_mla_o + (size_t)j * 1024 * 1024 : (kind == 1 ? p.wt_nsa_o : p.wt_sb_o);
    g8::SchedPlain S; S.init(T_TOK, 1024, 1024, Bt, 1024);
    if (L == 0) g8::gemm8((LAS unsigned char*)(smem + LDS_WORK), (const char*)p.obuf, 1024, 1024, S, EpiWo<true>{p.x, p.xbuf, p.zbuf, p.mod, L});
    else g8::gemm8((LAS unsigned char*)(smem + LDS_WORK), (const char*)p.obuf, 1024, 1024, S, EpiWo<false>{p.x, p.xbuf, p.zbuf, p.mod, L});
}

#define LNC(i) (lane * 8 + 512 * ((i) >> 1) + 4 * ((i) & 1))
__device__ __forceinline__ void ln_row(float (&v)[16], const f32x4 (&gg)[4], const f32x4 (&bb)[4]) {
    float s = 0.f;
#pragma unroll
    for (int q = 0; q < 16; ++q) s += v[q];
    const float mu = wave_sum(s) * (1.f / 1024.f);
    float s2 = 0.f;
#pragma unroll
    for (int q = 0; q < 16; ++q) { const float d = v[q] - mu; s2 += d * d; }
    const float rstd = rsqrtf(wave_sum(s2) * (1.f / 1024.f) + LN_EPS);
#pragma unroll
    for (int i = 0; i < 4; ++i)
#pragma unroll
        for (int q = 0; q < 4; ++q) v[i * 4 + q] = (v[i * 4 + q] - mu) * rstd * gg[i][q] + bb[i][q];
}
__device__ __forceinline__ void ld8h_f(const uint4& w, float* v) { const f32x8 f = __builtin_convertvector(*reinterpret_cast<const f16x8*>(&w), f32x8);
#pragma unroll
    for (int q = 0; q < 8; ++q) v[q] = f[q]; }
__device__ __forceinline__ uint4 pk8h(const float* v) { f32x8 f;
#pragma unroll
    for (int q = 0; q < 8; ++q) f[q] = v[q];
    const f16x8 hh = __builtin_convertvector(f, f16x8); return *reinterpret_cast<const uint4*>(&hh); }
__device__ __forceinline__ void ph_lna(PRef p, int L, bool dry = false) {
    unsigned char* lds = VLDS;
    float* hs = reinterpret_cast<float*>(lds);
    float* part = reinterpret_cast<float*>(lds + 16 * 1028 * 4);
    int* lcnt = reinterpret_cast<int*>(lds + 78080); int* lbase = lcnt + 32; int* rexp = lcnt + 64; int* rslot = lcnt + 96; float* rwt = reinterpret_cast<float*>(lcnt + 128);
    if (VT < 32) lcnt[VT] = 0;
    __syncthreads();
    int tid = VT; asm volatile("" : "+v"(tid));
    const int lane = tid & 63, wid = tid >> 6;
    const float* g = p.ln_g + (size_t)(L * 2 + 0) * 1024; const float* bt = p.ln_b + (size_t)(L * 2 + 0) * 1024;
    const float* wr = p.wr + (size_t)L * 1024 * 48;
    int* cnt = p.cnt + L * 32 * 64;
    f32x4 lg[4], lb[4];
#pragma unroll
    for (int i = 0; i < 4; ++i) { lg[i] = *reinterpret_cast<const f32x4*>(g + LNC(i)); lb[i] = *reinterpret_cast<const f32x4*>(bt + LNC(i)); }
    for (int it = VB; it < T_TOK / 16; it += NVB) {
        const int R0 = it * 16, b = R0 >> 11;
        const float* md = p.mod + (size_t)((L * 2 + 1) * 8 + b) * 3072;
        f32x4 shv[4], scv[4];
#pragma unroll
        for (int i = 0; i < 4; ++i) { shv[i] = *reinterpret_cast<const f32x4*>(md + LNC(i)); scv[i] = *reinterpret_cast<const f32x4*>(md + 1024 + LNC(i)); }
        uint4 zr[2];
#pragma unroll
        for (int k = 0; k < 2; ++k) zr[k] = *reinterpret_cast<const uint4*>(p.zbuf + (size_t)(R0 + wid * 4) * 1024 + LNC(2 * k));
#pragma unroll 1
        for (int rr = 0; rr < 4; ++rr) {
            const int lrow = wid * 4 + rr, row = R0 + lrow;
            float v[16];
            ld8h_f(zr[0], v); ld8h_f(zr[1], v + 8);
            if (rr < 3) {
#pragma unroll
                for (int k = 0; k < 2; ++k) zr[k] = *reinterpret_cast<const uint4*>(p.zbuf + (size_t)(row + 1) * 1024 + LNC(2 * k));
            }
            ln_row(v, lg, lb);
#pragma unroll
            for (int k = 0; k < 2; ++k) {
                *reinterpret_cast<uint4*>((dry ? reinterpret_cast<f16_t*>(p.ybuf) : p.xbuf) + (size_t)row * 1024 + LNC(2 * k)) = pk8h(v + 8 * k);
                float hv[8];
#pragma unroll
                for (int q = 0; q < 8; ++q) hv[q] = v[8 * k + q] * (1.f + scv[2 * k + (q >> 2)][q & 3]) + shv[2 * k + (q >> 2)][q & 3];
                *reinterpret_cast<f32x4*>(hs + lrow * 1028 + LNC(2 * k)) = (f32x4){hv[0], hv[1], hv[2], hv[3]};
                *reinterpret_cast<f32x4*>(hs + lrow * 1028 + LNC(2 * k + 1)) = (f32x4){hv[4], hv[5], hv[6], hv[7]};
                *reinterpret_cast<uint4*>((dry ? p.hmoe : p.hbuf) + (size_t)row * 1024 + LNC(2 * k)) = cvtpk8(hv[0], hv[1], hv[2], hv[3], hv[4], hv[5], hv[6], hv[7]);
            }
        }
        __syncthreads();
        {
            f32x4 a0 = {0.f, 0.f, 0.f, 0.f}, a1 = a0, a2 = a0;
            const int rl = lane & 15, kq = lane >> 4;
#pragma unroll 32
            for (int kk = 0; kk < 64; ++kk) {
                const int k = wid * 256 + kk * 4 + kq;
                const float a = hs[rl * 1028 + k];
                const float* wp = wr + (size_t)k * 48 + rl;
                a0 = __builtin_amdgcn_mfma_f32_16x16x4f32(a, wp[0], a0, 0, 0, 0);
                a1 = __builtin_amdgcn_mfma_f32_16x16x4f32(a, wp[16], a1, 0, 0, 0);
                a2 = __builtin_amdgcn_mfma_f32_16x16x4f32(a, wp[32], a2, 0, 0, 0);
            }
#pragma unroll
            for (int q = 0; q < 4; ++q) {
                const int row = kq * 4 + q;
                part[(wid * 16 + row) * 48 + rl] = a0[q]; part[(wid * 16 + row) * 48 + 16 + rl] = a1[q]; part[(wid * 16 + row) * 48 + 32 + rl] = a2[q];
            }
        }
        __syncthreads();
        if (tid < 16) {
            const int row = R0 + tid;
            auto LG = [&](int e) { return part[(0 * 16 + tid) * 48 + e] + part[(1 * 16 + tid) * 48 + e] + part[(2 * 16 + tid) * 48 + e] + part[(3 * 16 + tid) * 48 + e]; };
            const float g0 = LG(0) + p.moe_b_grp[L * 4 + 0], g1 = LG(1) + p.moe_b_grp[L * 4 + 1], g2 = LG(2) + p.moe_b_grp[L * 4 + 2], g3 = LG(3) + p.moe_b_grp[L * 4 + 3];
            int gi = 0; float gm = g0;
            if (g1 > gm) { gm = g1; gi = 1; }
            if (g2 > gm) { gm = g2; gi = 2; }
            if (g3 > gm) { gm = g3; gi = 3; }
            const float gw = 1.f / (expf(g0 - gm) + expf(g1 - gm) + expf(g2 - gm) + expf(g3 - gm));
            int i1 = 0, i2 = 0; float m1 = -3.0e38f, m2 = -3.0e38f;
            for (int e = 0; e < 8; ++e) {
                const float v = LG(4 + gi * 8 + e) + p.moe_b_rt[L * 32 + gi * 8 + e];
                if (v > m1) { m2 = m1; i2 = i1; m1 = v; i1 = e; }
                else if (v > m2) { m2 = v; i2 = e; }
            }
            const float r = expf(m2 - m1);
            const float w1 = gw / (1.f + r), w2 = gw * r / (1.f + r);
            const int e1 = gi * 8 + i1, e2 = gi * 8 + i2;
            rwt[tid * 2] = w1; rwt[tid * 2 + 1] = w2;
            rexp[tid * 2] = e1; rexp[tid * 2 + 1] = e2;
            rslot[tid * 2] = atomicAdd(&lcnt[e1], 1); rslot[tid * 2 + 1] = atomicAdd(&lcnt[e2], 1);
        }
        __syncthreads();
        if (tid < 32) { const int c = lcnt[tid]; lbase[tid] = (c && !dry) ? atomicAdd(&cnt[tid * 64], c) : 0; lcnt[tid] = 0; }
        __syncthreads();
        if (tid < 32 && !dry) { const int e = rexp[tid]; const size_t o = (size_t)e * T_TOK + lbase[e] + rslot[tid]; p.list[o] = (R0 + (tid >> 1)) * 2 + (tid & 1); p.listw[o] = rwt[tid]; }
        __syncthreads();
    }
}
__device__ __forceinline__ void ph_lnb(PRef p, int L, bool dry = false) {
    int tid = VT; asm volatile("" : "+v"(tid));
    const int lane = tid & 63, wid = tid >> 6;
    const float* g = p.ln_g + (size_t)(L * 2 + 1) * 1024; const float* bt = p.ln_b + (size_t)(L * 2 + 1) * 1024;
    const bool last = (L == DEPTH - 1);
    f32x4 lg[4], lb[4];
#pragma unroll
    for (int i = 0; i < 4; ++i) { lg[i] = *reinterpret_cast<const f32x4*>(g + LNC(i)); lb[i] = *reinterpret_cast<const f32x4*>(bt + LNC(i)); }
    constexpr int RW = T_TOK / 2048;
    static_assert(2048 % RW == 0, "a wave's rows stay inside one batch element");
    for (int w0 = VB * 4 + wid; w0 * RW < T_TOK; w0 += NVB * 4) {
        const int row0 = w0 * RW, b = row0 >> 11;
        const float* gate = p.mod + (size_t)((L * 2 + 1) * 8 + b) * 3072 + 2048;
        const float* md = p.mod + (size_t)(((last ? L : L + 1) * 2 + 0) * 8 + b) * 3072;
        f32x4 gv[4], sh[4], sc[4];
#pragma unroll
        for (int i = 0; i < 4; ++i) { const int c = LNC(i); gv[i] = *reinterpret_cast<const f32x4*>(gate + c); if (!last) { sh[i] = *reinterpret_cast<const f32x4*>(md + c); sc[i] = *reinterpret_cast<const f32x4*>(md + 1024 + c); } }
        uint4 xr[2], y0[2], y1[2];
        auto issue = [&](int row) {
#pragma unroll
            for (int k = 0; k < 2; ++k) {
                const int c = LNC(2 * k);
                xr[k] = *reinterpret_cast<const uint4*>(p.xbuf + (size_t)row * 1024 + c);
                y0[k] = *reinterpret_cast<const uint4*>(p.ybuf + (size_t)(row * 2) * 1024 + c); y1[k] = *reinterpret_cast<const uint4*>(p.ybuf + (size_t)(row * 2 + 1) * 1024 + c);
            }
        };
        issue(row0);
#pragma unroll 1
        for (int ri = 0; ri < RW; ++ri) {
            const int row = row0 + ri;
            float v[16];
#pragma unroll
            for (int k = 0; k < 2; ++k) {
                float xv[8]; ld8h_f(xr[k], xv);
                const unsigned a0[4] = {y0[k].x, y0[k].y, y0[k].z, y0[k].w}, a1[4] = {y1[k].x, y1[k].y, y1[k].z, y1[k].w};
#pragma unroll
                for (int q = 0; q < 8; ++q) {
                    const unsigned w0 = a0[q >> 1], w1 = a1[q >> 1];
                    const float ys = (q & 1) ? (bf2f(w0 >> 16) + bf2f(w1 >> 16)) : (bf2f(w0 & 0xffffu) + bf2f(w1 & 0xffffu));
                    v[8 * k + q] = DN_ALPHA * xv[q] + gv[2 * k + (q >> 2)][q & 3] * ys;
                }
            }
            if (ri + 1 < RW) issue(row + 1);
            ln_row(v, lg, lb);
            if (last) {
#pragma unroll
                for (int i = 0; i < 4; ++i) *reinterpret_cast<f32x4*>((dry ? reinterpret_cast<float*>(p.zbuf) : p.out) + (size_t)row * 1024 + LNC(i)) = (f32x4){v[i * 4], v[i * 4 + 1], v[i * 4 + 2], v[i * 4 + 3]};
            } else {
#pragma unroll
                for (int k = 0; k < 2; ++k) {
                    const int c = LNC(2 * k);
                    *reinterpret_cast<uint4*>((dry ? p.zbuf : p.xbuf) + (size_t)row * 1024 + c) = pk8h(v + 8 * k);
                    float hv[8];
#pragma unroll
                    for (int q = 0; q < 8; ++q) hv[q] = v[8 * k + q] * (1.f + sc[2 * k + (q >> 2)][q & 3]) + sh[2 * k + (q >> 2)][q & 3];
                    *reinterpret_cast<uint4*>((dry ? p.obuf : p.hbuf) + (size_t)row * 1024 + c) = cvtpk8(hv[0], hv[1], hv[2], hv[3], hv[4], hv[5], hv[6], hv[7]);
                }
            }
        }
    }
}
#undef LNC

struct RowGather { const bf16_t* hb; const int* lst; int base, n; __device__ __forceinline__ const bf16_t* operator()(int r) const { const int idx = base + r; const int tok = (idx < n) ? (lst[idx] >> 1) : 0; return hb + (size_t)tok * 1024; } };
constexpr int G8_PRE_OFF = LDS_WORK + 131072;
__device__ __forceinline__ const int* moe_prefix256(const int* cnt) {
    int* pre = reinterpret_cast<int*>(smem + G8_PRE_OFF);
    int t_ = threadIdx.x; asm volatile("" : "+v"(t_));
    if (t_ == 0) { int s = 0; for (int e = 0; e < 32; ++e) { pre[e] = s; s += (cnt[e * 64] + 255) >> 8; } pre[32] = s; }
    if (t_ >= 64 && t_ < 96) pre[48 + t_ - 64] = cnt[(t_ - 64) * 64];
    __syncthreads();
    return pre;
}
struct EpiMoeA {
    bf16_t* hmoe;
    __device__ __forceinline__ void operator()(const g8::f32x4_t (&acc)[2][2][4][2], const g8::Unit& u, int wr, int wc, int fr, int fq) const {
#pragma unroll
        for (int ai = 0; ai < 2; ++ai)
#pragma unroll
            for (int m = 0; m < 4; ++m) {
                bf16_t* rowp = hmoe + (size_t)(u.pm * 256 + ai * 128 + wr * 64 + m * 16 + fr) * 512 + u.pn * 128 + wc * 32 + fq * 8;
                float hv[8];
#pragma unroll
                for (int n = 0; n < 2; ++n) {
                    const g8::f32x4_t g = acc[ai][0][m][n], up = acc[ai][1][m][n];
#pragma unroll
                    for (int q = 0; q < 4; ++q) hv[n * 4 + q] = silu_f(g[q]) * up[q];
                }
                *reinterpret_cast<uint4*>(rowp) = cvtpk8(hv[0], hv[1], hv[2], hv[3], hv[4], hv[5], hv[6], hv[7]);
            }
    }
};
__device__ __forceinline__ void ph_moe_a(PRef p, int L) {
    const int* cnt = p.cnt + L * 32 * 64;
    const int* pre = moe_prefix256(cnt);
    g8::SchedMoe S{pre, p.list, p.listw, (const char*)(p.wt_gu + (size_t)L * 32 * 1024 * 1024), (size_t)1024 * 1024 * 2, (size_t)256 * 1024 * 2, pre[32] * 4, (int)gridDim.x, (int)blockIdx.x, 1, reinterpret_cast<int*>(smem + G8_PRE_OFF + 512)};
    g8::gemm8((LAS unsigned char*)(smem + LDS_WORK), (const char*)p.hbuf, 1024, 1024, S, EpiMoeA{p.hmoe});
    __syncthreads();
}
struct EpiMoeB {
    const int* pre; const int* tab; bf16_t* ybuf;
    __device__ __forceinline__ void operator()(const g8::f32x4_t (&acc)[2][2][4][2], const g8::Unit& u, int wr, int wc, int fr, int fq) const {
        int e = 0; for (int q = 1; q < 32; ++q) e = (pre[q] <= u.pm) ? q : e;
        const int n = pre[48 + e] - (u.pm - pre[e]) * 256, r0 = wr * 64 + fr;
        const int col0 = u.pn * 256 + wc * 32 + fq * 8;
        const int* tb = tab + u.par * 512;
        asm volatile("" ::: "memory");
#pragma unroll
        for (int ai = 0; ai < 2; ++ai) {
#pragma unroll
            for (int m = 0; m < 4; ++m) {
                const int r = r0 + ai * 128 + m * 16;
                if (r < n) {
                    const int ent = tb[r]; const float ww = __int_as_float(tb[256 + r]);
                    bf16_t* rowp = ybuf + (size_t)ent * 1024 + col0;
#pragma unroll
                    for (int bj = 0; bj < 2; ++bj) {
                        const g8::f32x4_t a = acc[ai][bj][m][0], c = acc[ai][bj][m][1];
                        *reinterpret_cast<uint4*>(rowp + bj * 128) = cvtpk8(a[0] * ww, a[1] * ww, a[2] * ww, a[3] * ww, c[0] * ww, c[1] * ww, c[2] * ww, c[3] * ww);
                    }
                }
            }
        }
    }
};
__device__ __forceinline__ void ph_moe_b(PRef p, int L) {
    const int* cnt = p.cnt + L * 32 * 64;
    const int* pre = moe_prefix256(cnt);
    g8::SchedMoe S{pre, p.list, p.listw, (const char*)(p.wt_dn + (size_t)L * 32 * 1024 * 512), (size_t)1024 * 512 * 2, (size_t)256 * 512 * 2, pre[32] * 4, (int)gridDim.x, (int)blockIdx.x, 0, reinterpret_cast<int*>(smem + G8_PRE_OFF + 512)};
    g8::gemm8((LAS unsigned char*)(smem + LDS_WORK), (const char*)p.hmoe, 512, 512, S, EpiMoeB{pre, reinterpret_cast<const int*>(smem + G8_PRE_OFF + 512), p.ybuf});
    __syncthreads();
}

__device__ __forceinline__ void dma16_asm(const void* g, const unsigned char* lds_wave_base) {
    const unsigned m = __builtin_amdgcn_readfirstlane((unsigned)(size_t)(LAS const unsigned char*)lds_wave_base);
    asm volatile("s_mov_b32 m0, %1\n\ts_nop 0\n\tglobal_load_lds_dwordx4 %0, off" :: "v"(g), "s"(m) : "memory", "m0");
}
__device__ __forceinline__ unsigned lds_addr(const unsigned char* p) { return (unsigned)(size_t)(LAS const unsigned char*)p; }
__device__ __forceinline__ bf16x8 lds_ld128(unsigned a) { return *(const LAS bf16x8*)(size_t)a; }
__device__ __forceinline__ void dma16_asm_s(const void* ubase, unsigned voff, const unsigned char* lds_wave_base) {
    const unsigned m = __builtin_amdgcn_readfirstlane((unsigned)(size_t)(LAS const unsigned char*)lds_wave_base);
    asm volatile("s_mov_b32 m0, %2\n\ts_nop 0\n\tglobal_load_lds_dwordx4 %0, %1" :: "v"(voff), "s"(ubase), "s"(m) : "memory", "m0");
}
template <int DQK, int KT> struct AT {
    static constexpr int KB = KT / 32, NKK = DQK / 16;
    static constexpr bool ROPE = (DQK == 192);
    static constexpr int K_BYTES = KT * 256, KR_BYTES = ROPE ? KT * 128 : 0, V_BYTES = 256 * KT, STAGE = K_BYTES + KR_BYTES + V_BYTES;
    static constexpr int VRB = KT * 2;
    static __device__ __forceinline__ void dma(int tid, unsigned char* st, const bf16_t* kp  , size_t ldk, const bf16_t* krp  , const bf16_t* vp  , size_t ldv) {
        const int wid = tid >> 6, l = tid & 63;
#pragma unroll
        for (int i = 0; i < KT / 16; ++i) {
            const int pi = wid + 4 * i, row = 4 * pi + (l >> 4), c = (l & 15) ^ (row & 15);
            dma16_asm_s(kp, (unsigned)(row * (int)ldk + c * 8) * 2u, st + pi * 1024);
        }
        if (ROPE) {
            const int pi = wid, row = 8 * pi + (l >> 3), c = (l & 7) ^ ((row >> 1) & 7);
            dma16_asm_s(krp, (unsigned)(row * 64 + c * 8) * 2u, st + K_BYTES + pi * 1024);
        }
#pragma unroll
        for (int i = 0; i < KT / 16; ++i) {
            const int pi = wid + 4 * i;
            int row, c;
            if (KT == 64) { row = 8 * pi + (l >> 3); c = (l & 7) ^ ((row >> 1) & 7); }
            else          { row = 16 * pi + (l >> 2); c = (l & 3) ^ ((row >> 2) & 3); }
            dma16_asm_s(vp, (unsigned)(row * (int)ldv + c * 8) * 2u, st + K_BYTES + KR_BYTES + pi * 1024);
        }
    }
    static __device__ __forceinline__ void kload(const unsigned char* st, int kb, bf16x8 (&kf)[NKK], int r, int h) {
        const int row = kb * 32 + r, m = r & 15, m2 = (r >> 1) & 7;
        const unsigned a0 = lds_addr(st) + row * 256 + ((((m & ~1) | (h ^ (m & 1)))) << 4);
#pragma unroll
        for (int kk = 0; kk < 8; ++kk) kf[kk] = lds_ld128(a0 ^ (kk << 5));
        if (ROPE) {
            const unsigned a1 = lds_addr(st) + K_BYTES + row * 128 + ((((m2 & ~1) | (h ^ (m2 & 1)))) << 4);
#pragma unroll
            for (int kk = 0; kk < 4; ++kk) kf[8 + kk] = lds_ld128(a1 ^ (kk << 5));
        }
    }
    static __device__ __forceinline__ f32x16 qk_mma(const bf16x8 (&kf)[NKK], const bf16x8* qf) {
        f32x16 s;
#pragma unroll
        for (int q = 0; q < 16; ++q) s[q] = 0.f;
#pragma unroll
        for (int kk = 0; kk < NKK; ++kk) s = MFMA32(kf[kk], qf[kk], s);
        return s;
    }
    static __device__ __forceinline__ f32x16 qk(const unsigned char* st, int kb, const bf16x8* qf, int r, int h) {
        f32x16 s;
#pragma unroll
        for (int q = 0; q < 16; ++q) s[q] = 0.f;
        const int row = kb * 32 + r;
#pragma unroll
        for (int kk = 0; kk < 8; ++kk) s = MFMA32(lds_frag(st, row * 256 + (((2 * kk + h) ^ (r & 15)) << 4)), qf[kk], s);
        return s;
    }
    static __device__ __forceinline__ void vload(const unsigned char* st, int ks, bf16x8 (&vf)[4], int r, int h) {
        const int swz = (KT == 64) ? ((r >> 1) & 7) : ((r >> 2) & 3);
        const unsigned v0 = lds_addr(st) + K_BYTES + KR_BYTES + r * VRB + ((swz ^ h) << 4);
#pragma unroll
        for (int dvb = 0; dvb < 4; ++dvb) vf[dvb] = lds_ld128((v0 ^ ((2 * ks) << 4)) + dvb * 32 * VRB);
    }
    static __device__ __forceinline__ void pv_mma(f32x16 (&o)[4], const bf16x8 (&vf)[4], bf16x8 pf) {
#pragma unroll
        for (int dvb = 0; dvb < 4; ++dvb) o[dvb] = MFMA32(vf[dvb], pf, o[dvb]);
    }
    static __device__ __forceinline__ void pv(const unsigned char* st, f32x16 (&o)[4], int ks, bf16x8 pf, int r, int h) {
        bf16x8 vf[4];
        vload(st, ks, vf, r, h);
        pv_mma(o, vf, pf);
    }
};
struct HalfBar { volatile LAS unsigned* ctr; unsigned target; };
__device__ __forceinline__ void half_bar(HalfBar& hb, int lane) {
    asm volatile("s_waitcnt lgkmcnt(0)" ::: "memory");
    hb.target += 4u;
    if (lane == 0) __hip_atomic_fetch_add((LAS unsigned*)hb.ctr, 1u, __ATOMIC_RELAXED, __HIP_MEMORY_SCOPE_WORKGROUP);
    while ((unsigned)__builtin_amdgcn_readfirstlane((int)*hb.ctr) < hb.target) __builtin_amdgcn_s_sleep(1);
    asm volatile("" ::: "memory");
}
#define DMA_WAIT_SYNC() do { asm volatile("s_waitcnt vmcnt(0)" ::: "memory"); __syncthreads(); } while (0)
__device__ __forceinline__ bf16x8 pfrag(const f32x16& s, int half) {
    const int b = half * 8;
    uint4 w = cvtpk8(s[b + 0], s[b + 1], s[b + 2], s[b + 3], s[b + 4], s[b + 5], s[b + 6], s[b + 7]);
    return *reinterpret_cast<bf16x8*>(&w);
}
template <int NKK> __device__ __forceinline__ void load_q(bf16x8 (&qf)[NKK], const bf16_t* qrow, int h) {
#pragma unroll
    for (int kk = 0; kk < NKK; ++kk) qf[kk] = *reinterpret_cast<const bf16x8*>(qrow + kk * 16 + h * 8);
}
__device__ __forceinline__ void store_pk16(bf16_t* orow, int dvb, int gp, uint2 X  , uint2 Y  , int h) {
    auto r0 = __builtin_amdgcn_permlane32_swap(X.x, Y.x, false, false), r1 = __builtin_amdgcn_permlane32_swap(X.y, Y.y, false, false);
    uint4 w; w.x = r0[0]; w.y = r1[0]; w.z = r0[1]; w.w = r1[1];
    *reinterpret_cast<uint4*>(orow + dvb * 32 + 8 * (2 * gp + h)) = w;
}
__device__ __forceinline__ void store_o(const f32x16 (&o)[4], bf16_t* orow, int h, float scale) {
#pragma unroll
    for (int dvb = 0; dvb < 4; ++dvb)
#pragma unroll
        for (int gp = 0; gp < 2; ++gp) {
            const int a = 8 * gp, c = 8 * gp + 4;
            uint2 X, Y;
            X.x = cvtpk(o[dvb][a] * scale, o[dvb][a + 1] * scale); X.y = cvtpk(o[dvb][a + 2] * scale, o[dvb][a + 3] * scale);
            Y.x = cvtpk(o[dvb][c] * scale, o[dvb][c + 1] * scale); Y.y = cvtpk(o[dvb][c + 2] * scale, o[dvb][c + 3] * scale);
            store_pk16(orow, dvb, gp, X, Y, h);
        }
}

template <int DQK, int KT, int MODE>
__device__ __forceinline__ void flash_loop(int tid, unsigned char* lds, const bf16x8* qf, f32x16 (&o)[4], float& m_run, float& l_half,
                                           const bf16_t* kbase, size_t ldk, const bf16_t* krbase, const bf16_t* vtbase, size_t ldv,
                                           int kt_lo, int kt_hi, int t  , int tw_min, int tw_max  , unsigned selmask, float C, int key_off = 0, HalfBar* hbp = nullptr) {
    typedef AT<DQK, KT> A;
    constexpr bool RING3 = (KT == 32);
    constexpr int NDMA = KT / 16 + KT / 16 + (DQK == 192 ? 1 : 0);
    auto tile_dma = [&](int stage, int kt) { A::dma(tid, lds + stage * A::STAGE, kbase + (size_t)kt * KT * ldk, ldk, krbase ? krbase + (size_t)kt * KT * 64 : nullptr, vtbase + (size_t)kt * KT, ldv); };
    if (RING3) { __builtin_amdgcn_s_waitcnt(0x0F70); tile_dma(0, kt_lo); if (kt_lo + 1 <= kt_hi) tile_dma(1, kt_lo + 1); }
    else { tile_dma(0, kt_lo); __builtin_amdgcn_s_waitcnt(0x0F70); __syncthreads(); }
    int stc = 0, stn = 2;
    for (int kt = kt_lo; kt <= kt_hi; ++kt) {
        asm volatile("" : "+v"(tid));
        const int lane = tid & 63, r = lane & 31, h = lane >> 5;
        const bool more = kt < kt_hi;
        const unsigned char* st;
        if (RING3) {
            if (more) { static_assert(!RING3 || NDMA == 5, "counted wait below is written for 5 DMA instructions per tile"); asm volatile("s_waitcnt vmcnt(5)" ::: "memory"); }
            else asm volatile("s_waitcnt vmcnt(0)" ::: "memory");
            if (hbp) half_bar(*hbp, lane); else __builtin_amdgcn_s_barrier();
            asm volatile("" ::: "memory");
            if (kt + 2 <= kt_hi) tile_dma(stn, kt + 2);
            st = lds + stc * A::STAGE;
            stc = (stc == 2) ? 0 : stc + 1; stn = (stn == 2) ? 0 : stn + 1;
        } else {
            const int cur = (kt - kt_lo) & 1;
            if (more) tile_dma(cur ^ 1, kt + 1);
            st = lds + cur * A::STAGE;
        }
        const int key0 = key_off + kt * KT;
        bool active = (key0 <= tw_max);
        if (MODE == 2) active = active && (key0 + KT - 1 > tw_min - 512);
        if (active) {
            f32x16 s[A::KB];
            bf16x8 vf[2][4];
            if constexpr (KT == 32) {
                bf16x8 kf[A::NKK];
                A::kload(st, 0, kf, r, h);
                __builtin_amdgcn_sched_barrier(0);
                s[0] = A::qk_mma(kf, qf);
                __builtin_amdgcn_sched_barrier(0);
                A::vload(st, 0, vf[0], r, h); A::vload(st, 1, vf[1], r, h);
            } else {
#pragma unroll
                for (int kb = 0; kb < A::KB; ++kb) s[kb] = A::qk(st, kb, qf, r, h);
            }
            const bool need_mask = (MODE == 1) || (key0 + KT - 1 > tw_min) || (MODE == 2 && key0 <= tw_max - 512);
            if (MODE == 1 && !(key0 + KT - 1 > tw_min)) {
                static_assert(MODE != 1 || KT == 64, "selected branch: tile = selection block");
                asm volatile("" ::: "memory");
                const float drop = ((selmask >> (key0 >> 6)) & 1u) ? 0.f : -__builtin_inff();
#pragma unroll
                for (int kb = 0; kb < A::KB; ++kb)
#pragma unroll
                    for (int q = 0; q < 16; ++q) s[kb][q] += drop;
            } else if (need_mask) {
                asm volatile("" ::: "memory");
#pragma unroll
                for (int kb = 0; kb < A::KB; ++kb)
#pragma unroll
                    for (int q = 0; q < 16; ++q) {
                        const int key = key0 + kb * 32 + crow(q, h);
                        bool ok = key <= t;
                        if (MODE == 1) ok = ok && ((selmask >> (key >> 6)) & 1u);
                        if (MODE == 2) ok = ok && (t - key < 512);
                        s[kb][q] = ok ? s[kb][q] : -__builtin_inff();
                    }
            }
            float mx = -__builtin_inff();
#pragma unroll
            for (int kb = 0; kb < A::KB; ++kb)
#pragma unroll
                for (int q = 0; q < 16; ++q) mx = fmaxf(mx, s[kb][q]);
            mx = xh_max(mx) * C;
            if (__any(mx > m_run + 8.f)) {
                const float mn = fmaxf(m_run, mx);
                const float alpha = __builtin_amdgcn_exp2f(m_run - mn);
                m_run = mn;
                l_half *= alpha;
#pragma unroll
                for (int dvb = 0; dvb < 4; ++dvb)
#pragma unroll
                    for (int q = 0; q < 16; ++q) o[dvb][q] *= alpha;
            }
            const float nm = -m_run;
            float ps = 0.f;
#pragma unroll
            for (int kb = 0; kb < A::KB; ++kb)
#pragma unroll
                for (int q = 0; q < 16; ++q) { const float e = __builtin_amdgcn_exp2f(__builtin_fmaf(s[kb][q], C, nm)); s[kb][q] = e; ps += e; }
            l_half += ps;
            if constexpr (KT == 32) { A::pv_mma(o, vf[0], pfrag(s[0], 0)); A::pv_mma(o, vf[1], pfrag(s[0], 1)); }
            else {
#pragma unroll
                for (int kb = 0; kb < A::KB; ++kb) { A::pv(st, o, kb * 2, pfrag(s[kb], 0), r, h); A::pv(st, o, kb * 2 + 1, pfrag(s[kb], 1), r, h); }
            }
        }
        if (!RING3) DMA_WAIT_SYNC();
    }
    if (RING3) { if (hbp) half_bar(*hbp, tid & 63); else __syncthreads(); }
}

__device__ __forceinline__ void mla_flash(int tid0, unsigned char* lds, const bf16x8* qf, f32x16 (&o)[4], float& m_run, float& l_half,
                                          const bf16_t* kbase, const bf16_t* krbase, const bf16_t* vtbase, int kt_hi, int t, int tw_min, float C) {
    typedef AT<192, 32> A;
    constexpr int KST = A::K_BYTES + A::KR_BYTES, VST = A::V_BYTES;
    static_assert(3 * KST + 4 * VST <= HALF_LDS, "rings");
    unsigned char* kring = lds; unsigned char* vring = lds + 3 * KST;
    auto tile_dma = [&](int tid, int kt) {
        unsigned char* ks = kring + (kt % 3) * KST; unsigned char* vs = vring + (kt & 3) * VST;
        const bf16_t* kp = kbase + (size_t)kt * 32 * 1024; const bf16_t* krp = krbase + (size_t)kt * 32 * 64; const bf16_t* vp = vtbase + (size_t)kt * 32;
        const int wid = tid >> 6, l = tid & 63;
#pragma unroll
        for (int i = 0; i < 2; ++i) { const int pi = wid + 4 * i, row = 4 * pi + (l >> 4), c = (l & 15) ^ (row & 15); dma16_asm_s(kp, (unsigned)(row * 1024 + c * 8) * 2u, ks + pi * 1024); }
        { const int pi = wid, row = 8 * pi + (l >> 3), c = (l & 7) ^ ((row >> 1) & 7); dma16_asm_s(krp, (unsigned)(row * 64 + c * 8) * 2u, ks + A::K_BYTES + pi * 1024); }
#pragma unroll
        for (int i = 0; i < 2; ++i) { const int pi = wid + 4 * i, row = 16 * pi + (l >> 2), c = (l & 3) ^ ((row >> 2) & 3); dma16_asm_s(vp, (unsigned)(row * SEQ + c * 8) * 2u, vs + pi * 1024); }
    };
    auto finish = [&](f32x16& sv, float mxraw, int kt, int h) {
        const int key0 = kt * 32;
        if (key0 + 31 > tw_min) {
            asm volatile("" ::: "memory");
            mxraw = -__builtin_inff();
#pragma unroll
            for (int q = 0; q < 16; ++q) { sv[q] = (key0 + crow(q, h) <= t) ? sv[q] : -__builtin_inff(); mxraw = fmaxf(mxraw, sv[q]); }
        }
        const float mx = xh_max(mxraw) * C;
        if (__any(mx > m_run + 8.f)) {
            const float mn = fmaxf(m_run, mx);
            const float alpha = __builtin_amdgcn_exp2f(m_run - mn);
            m_run = mn; l_half *= alpha;
#pragma unroll
            for (int dvb = 0; dvb < 4; ++dvb)
#pragma unroll
                for (int q = 0; q < 16; ++q) o[dvb][q] *= alpha;
        }
    };
    f32x16 sc;
    {
        int tid = tid0; asm volatile("" : "+v"(tid));
        tile_dma(tid, 0); if (kt_hi >= 1) tile_dma(tid, 1); if (kt_hi >= 2) tile_dma(tid, 2);
        __builtin_amdgcn_s_waitcnt(0x0F70);
        __builtin_amdgcn_s_barrier();
        asm volatile("" ::: "memory");
        const int lane = tid & 63, r = lane & 31, h = lane >> 5;
        bf16x8 kf[12];
        A::kload(kring, 0, kf, r, h);
        sc = A::qk_mma(kf, qf);
        float mxr = -__builtin_inff();
#pragma unroll
        for (int q = 0; q < 16; ++q) mxr = fmaxf(mxr, sc[q]);
        finish(sc, mxr, 0, h);
    }
    for (int kt = 0; kt <= kt_hi; ++kt) {
        const int tid = tid0, lane = tid & 63, r = lane & 31, h = lane >> 5;
        if (kt + 1 <= kt_hi) { if (kt + 2 <= kt_hi) asm volatile("s_waitcnt vmcnt(5)" ::: "memory"); else asm volatile("s_waitcnt vmcnt(0)" ::: "memory"); }
        __builtin_amdgcn_s_barrier();
        asm volatile("" ::: "memory");
        if (kt + 3 <= kt_hi) tile_dma(tid, kt + 3);
        const int kn = (kt + 1) % 3;
        bf16x8 kf[12];
        A::kload(kring + kn * KST, 0, kf, r, h);
        __builtin_amdgcn_sched_barrier(0);
        f32x16 sn = A::qk_mma(kf, qf);
        const float nm = -m_run;
        float ps = 0.f;
#pragma unroll
        for (int q = 0; q < 16; ++q) { const float e = __builtin_amdgcn_exp2f(__builtin_fmaf(sc[q], C, nm)); sc[q] = e; ps += e; }
        l_half += ps;
        const bf16x8 pf0 = pfrag(sc, 0), pf1 = pfrag(sc, 1);
        bf16x8 vf[2][4];
        const unsigned char* vadj = vring + (kt & 3) * VST - (A::K_BYTES + A::KR_BYTES);
        A::vload(vadj, 0, vf[0], r, h); A::vload(vadj, 1, vf[1], r, h);
        float mxr = -__builtin_inff();
#pragma unroll
        for (int q = 0; q < 16; ++q) mxr = fmaxf(mxr, sn[q]);
        A::pv_mma(o, vf[0], pf0); A::pv_mma(o, vf[1], pf1);
        if (kt + 1 <= kt_hi) finish(sn, mxr, kt + 1, h);
        sc = sn;
    }
    __syncthreads();
}

__device__ __forceinline__ void ph_mla_attn(PRef p) {
    unsigned char* lds = VLDS;
    const float C = 0.07216878364870322f * 1.4426950408889634f;
    for (int it = VB; it < 1024; it += NVB) {
        int tid = VT; asm volatile("" : "+v"(tid));
        const int lane = tid & 63, wid = tid >> 6, r = lane & 31, h = lane >> 5;
        const int vb_ = it & 511, xw_ = vb_ >> 4, pp = ((vb_ >> 1) & 7) * 64 + (((xw_ >> 3) * 2 + (vb_ & 1)) << 3) + (xw_ & 7), second = it >> 9, bh = pp >> 3, qt = second ? (pp & 7) : (15 - (pp & 7)), b = bh >> 3, hd = bh & 7;
        const int tw0 = qt * 128 + wid * 32, t = tw0 + r;
        const size_t tok = (size_t)b * SEQ + t;
        bf16x8 qf[12];
        load_q<12>(qf, p.qm + tok * 1536 + hd * 192, h);
        f32x16 o[4];
#pragma unroll
        for (int dvb = 0; dvb < 4; ++dvb)
#pragma unroll
            for (int q = 0; q < 16; ++q) o[dvb][q] = 0.f;
        float m_run = -1.0e30f, l_half = 0.f;
        mla_flash(tid, lds, qf, o, m_run, l_half, p.kn + (size_t)b * SEQ * 1024 + hd * 128, p.krope + (size_t)b * SEQ * 64,
                  p.vt + (size_t)(b * 8 + hd) * 128 * SEQ, (qt * 128 + 127) >> 5, t, tw0, C);
        const float l = xh_sum(l_half);
        store_o(o, p.obuf + tok * 1024 + hd * 128, h, l > 0.f ? 1.f / l : 0.f);
    }
}

__device__ __forceinline__ void acc_branch(uint2 (&ot)[16], const f32x16 (&o)[4], float sc, bool first) {
#pragma unroll
    for (int dvb = 0; dvb < 4; ++dvb)
#pragma unroll
        for (int g = 0; g < 4; ++g) {
            float a0 = o[dvb][4 * g] * sc, a1 = o[dvb][4 * g + 1] * sc, a2 = o[dvb][4 * g + 2] * sc, a3 = o[dvb][4 * g + 3] * sc;
            if (!first) { const uint2 pv = ot[dvb * 4 + g]; a0 += bf2f(pv.x & 0xffffu); a1 += bf2f(pv.x >> 16); a2 += bf2f(pv.y & 0xffffu); a3 += bf2f(pv.y >> 16); }
            ot[dvb * 4 + g] = make_uint2(cvtpk(a0, a1), cvtpk(a2, a3));
        }
}
__device__ __forceinline__ void ph_nsa_attn(PRef p) {
    unsigned char* lds = VLDS;
    typedef AT<128, 64> A;
    float* imp = reinterpret_cast<float*>(lds);
    unsigned* selm = reinterpret_cast<unsigned*>(lds + 2 * A::STAGE);
    const float C = 0.08838834764831845f * 1.4426950408889634f;
    for (int it = VB; it < 1024; it += NVB) {
        int tid = VT; asm volatile("" : "+v"(tid));
        const int lane = tid & 63, wid = tid >> 6, r = lane & 31, h = lane >> 5;
        const int vb_ = it & 511, pp = ((vb_ >> 1) & 7) * 64 + ((vb_ & 1) << 5) + (vb_ >> 4), second = it >> 9, bkh = pp >> 5, qc = second ? (pp & 31) : (63 - (pp & 31)), b = bkh >> 1, kh = bkh & 1;
        const int hd = kh * 4 + wid, t0 = qc * 32, t = t0 + r;
        const size_t tok = (size_t)b * SEQ + t;
        bf16x8 qf[8];
        load_q<8>(qf, p.qn + tok * 1024 + hd * 128, h);
        const f32x4 gate4 = *reinterpret_cast<const f32x4*>(p.gates + tok * 32 + hd * 4);
        uint2 ot[16];
        f32x16 o[4];
        {
            const bf16_t* kb_ = p.kcmp + (size_t)bkh * 128 * 128; const bf16_t* vb_ = p.vcmpt + (size_t)bkh * 128 * 128;
            A::dma(tid, lds, kb_, 128, nullptr, vb_, 128);
            A::dma(tid, lds + A::STAGE, kb_ + 64 * 128, 128, nullptr, vb_ + 64, 128);
            DMA_WAIT_SYNC();
            f32x16 s[4];
            s[0] = A::qk(lds, 0, qf, r, h); s[1] = A::qk(lds, 1, qf, r, h); s[2] = A::qk(lds + A::STAGE, 0, qf, r, h); s[3] = A::qk(lds + A::STAGE, 1, qf, r, h);
            float mx = -3.0e38f;
#pragma unroll
            for (int kb = 0; kb < 4; ++kb)
#pragma unroll
                for (int q = 0; q < 16; ++q) {
                    const int n = kb * 32 + crow(q, h);
                    const float v = (16 * n + 31 <= t) ? s[kb][q] * C : -__builtin_inff();
                    s[kb][q] = v; mx = fmaxf(mx, v);
                }
            mx = fmaxf(xh_max(mx), -1.0e30f);
            float ps = 0.f;
#pragma unroll
            for (int kb = 0; kb < 4; ++kb)
#pragma unroll
                for (int q = 0; q < 16; ++q) { const float e = __builtin_amdgcn_exp2f(s[kb][q] - mx); s[kb][q] = e; ps += e; }
            const float l = xh_sum(ps), inv = l > 0.f ? 1.f / l : 0.f;
#pragma unroll
            for (int kb = 0; kb < 4; ++kb)
#pragma unroll
                for (int q = 0; q < 16; ++q) s[kb][q] *= inv;
            float impv[16];
            {
                float prev = 0.f;
#pragma unroll
                for (int gi = 0; gi < 16; ++gi) {
                    const int kb = gi >> 2, rg = gi & 3;
                    const float p3 = 0.5f * s[kb][4 * rg + 3];
                    const float av = s[kb][4 * rg] + s[kb][4 * rg + 1] + s[kb][4 * rg + 2] + p3;
                    const float co = xh_other(p3, h);
                    impv[gi] = av + (h ? co : prev);
                    prev = co;
                }
            }
            bf16x8 pf[8];
#pragma unroll
            for (int kb = 0; kb < 4; ++kb) { pf[2 * kb] = pfrag(s[kb], 0); pf[2 * kb + 1] = pfrag(s[kb], 1); }
#pragma unroll
            for (int dvb = 0; dvb < 4; ++dvb)
#pragma unroll
                for (int q = 0; q < 16; ++q) o[dvb][q] = 0.f;
#pragma unroll
            for (int ks = 0; ks < 4; ++ks) A::pv(lds, o, ks, pf[ks], r, h);
#pragma unroll
            for (int ks = 0; ks < 4; ++ks) A::pv(lds + A::STAGE, o, ks, pf[4 + ks], r, h);
            acc_branch(ot, o, gate4[0], true);
            __syncthreads();
#pragma unroll
            for (int gi = 0; gi < 16; ++gi) imp[(wid * 32 + r) * 33 + (2 * gi + h)] = impv[gi];
            __syncthreads();
            if (tid < 32) {
                const int tq = t0 + tid, cur = tq >> 6;
                float val[32];
#pragma unroll
                for (int j = 0; j < 32; ++j) {
                    float v = imp[(0 * 32 + tid) * 33 + j] + imp[(1 * 32 + tid) * 33 + j] + imp[(2 * 32 + tid) * 33 + j] + imp[(3 * 32 + tid) * 33 + j];
                    if (j == 0 || j == cur || j == cur - 1) v += 1000.f;
                    val[j] = (64 * j <= tq) ? v : -__builtin_inff();
                }
                unsigned m = 0u;
                for (int k = 0; k < 8; ++k) {
                    float best = -__builtin_inff(); int bi = -1;
#pragma unroll
                    for (int j = 0; j < 32; ++j) { const bool free_ = !((m >> j) & 1u); if (free_ && (bi < 0 || val[j] > best)) { best = val[j]; bi = j; } }
                    m |= 1u << bi;
                }
                selm[tid] = m;
            }
            __syncthreads();
        }
        const unsigned sel = selm[r];
        load_q<8>(qf, p.qn + tok * 1024 + hd * 128, h);
        {
#pragma unroll
            for (int dvb = 0; dvb < 4; ++dvb)
#pragma unroll
                for (int q = 0; q < 16; ++q) o[dvb][q] = 0.f;
            float m_run = -1.0e30f, l_half = 0.f;
            flash_loop<128, 64, 1>(tid, lds, qf, o, m_run, l_half, p.ks + (size_t)bkh * SEQ * 128, 128, nullptr, p.vst + (size_t)bkh * 128 * SEQ, SEQ,
                                   0, (t0 + 31) >> 6, t, t0, t0 + 31, sel, C);
            const float l = xh_sum(l_half);
            acc_branch(ot, o, l > 0.f ? gate4[1] / l : 0.f, false);
        }
        {
#pragma unroll
            for (int dvb = 0; dvb < 4; ++dvb)
#pragma unroll
                for (int q = 0; q < 16; ++q) o[dvb][q] = 0.f;
            float m_run = -1.0e30f, l_half = 0.f;
            const int lo = (t0 - 511) > 0 ? ((t0 - 511) >> 6) : 0;
            flash_loop<128, 64, 2>(tid, lds, qf, o, m_run, l_half, p.kw + (size_t)bkh * SEQ * 128, 128, nullptr, p.vwt + (size_t)bkh * 128 * SEQ, SEQ,
                                   lo, (t0 + 31) >> 6, t, t0, t0 + 31, 0u, C);
            const float l = xh_sum(l_half);
            acc_branch(ot, o, l > 0.f ? gate4[2] / l : 0.f, false);
        }
        bf16_t* orow = p.obuf + tok * 1024 + hd * 128;
#pragma unroll
        for (int dvb = 0; dvb < 4; ++dvb)
#pragma unroll
            for (int gp = 0; gp < 2; ++gp) store_pk16(orow, dvb, gp, ot[dvb * 4 + 2 * gp], ot[dvb * 4 + 2 * gp + 1], h);
    }
}

__device__ __forceinline__ void ph_sb_attn(PRef p) {
    unsigned char* lds = VLDS;
    typedef AT<128, 64> A;
    const float SC = 0.08838834764831845f, L2E = 1.4426950408889634f, LN2 = 0.6931471805599453f;
    for (int it = VB; it < 1024; it += NVB) {
        int tid = VT; asm volatile("" : "+v"(tid));
        const int lane = tid & 63, wid = tid >> 6, r = lane & 31, h = lane >> 5;
        const int vb_ = it & 511, xw_ = vb_ >> 4, pp = ((vb_ >> 1) & 7) * 64 + (((xw_ >> 3) * 2 + (vb_ & 1)) << 3) + (xw_ & 7), second = it >> 9, bh = pp >> 3, qt = second ? (pp & 7) : (15 - (pp & 7)), b = bh >> 3, hd = bh & 7;
        const int tw0 = qt * 128 + wid * 32, t = tw0 + r;
        const size_t tok = (size_t)b * SEQ + t;
        bf16x8 qf[8];
        load_q<8>(qf, p.qs + tok * 1024 + hd * 128, h);
        f32x16 o[4];
#pragma unroll
        for (int dvb = 0; dvb < 4; ++dvb)
#pragma unroll
            for (int q = 0; q < 16; ++q) o[dvb][q] = 0.f;
        float R = 0.f;
        const bf16_t* kbase = p.ksb + (size_t)b * SEQ * 1024 + hd * 128; const bf16_t* vtbase = p.vt + (size_t)(b * 8 + hd) * 128 * SEQ;
        const int kt_hi = (qt * 128 + 127) >> 6;
        A::dma(tid, lds, kbase + (size_t)kt_hi * 64 * 1024, 1024, nullptr, vtbase + kt_hi * 64, SEQ);
        __builtin_amdgcn_s_waitcnt(0x0F70); __syncthreads();
        volatile int* done_f = reinterpret_cast<volatile int*>(smem + LDS_WORK + 2 * A::STAGE);
        const int rwave = VHALF * 4 + wid;
        bool wdone = false;
        for (int kt = kt_hi; kt >= 0; --kt) {
            const int cur = (kt_hi - kt) & 1;
            if (kt < kt_hi && (done_f[0] & done_f[1] & done_f[2] & done_f[3] & done_f[4] & done_f[5] & done_f[6] & done_f[7])) break;
            const bool more = kt > 0;
            if (more) A::dma(tid, lds + (cur ^ 1) * A::STAGE, kbase + (size_t)(kt - 1) * 64 * 1024, 1024, nullptr, vtbase + (kt - 1) * 64, SEQ);
            const unsigned char* st = lds + cur * A::STAGE;
            const int key0 = kt * 64;
            if (key0 < tw0 + 31 && !wdone) {
                f32x16 z[2];
                z[0] = A::qk(st, 0, qf, r, h); z[1] = A::qk(st, 1, qf, r, h);
                float T[8];
#pragma unroll
                for (int kb = 0; kb < 2; ++kb)
#pragma unroll
                    for (int rg = 0; rg < 4; ++rg) {
                        float suf = 0.f;
#pragma unroll
                        for (int i = 3; i >= 0; --i) {
                            const float zz = z[kb][4 * rg + i] * SC;
                            const float sp = fmaxf(zz, 0.f) + LN2 * __builtin_amdgcn_logf(1.f + __builtin_amdgcn_exp2f(-fabsf(zz) * L2E));
                            const bool ok = (key0 + kb * 32 + 8 * rg + 4 * h + i) < t;
                            suf += ok ? -sp : 0.f;
                            z[kb][4 * rg + i] = zz + suf;
                        }
                        T[kb * 4 + rg] = suf;
                    }
                float run = 0.f;
#pragma unroll
                for (int gq = 7; gq >= 0; --gq) {
                    const float U = xh_other(T[gq], h);
                    const float after = run + (h ? 0.f : U) + R;
                    const int kb = gq >> 2, rg = gq & 3;
#pragma unroll
                    for (int i = 0; i < 4; ++i) {
                        const bool ok = (key0 + kb * 32 + 8 * rg + 4 * h + i) < t;
                        const float a = __builtin_amdgcn_exp2f((z[kb][4 * rg + i] + after) * L2E);
                        z[kb][4 * rg + i] = ok ? a : 0.f;
                    }
                    run += T[gq] + U;
                }
                R += run;
                A::pv(st, o, 0, pfrag(z[0], 0), r, h); A::pv(st, o, 1, pfrag(z[0], 1), r, h); A::pv(st, o, 2, pfrag(z[1], 0), r, h); A::pv(st, o, 3, pfrag(z[1], 1), r, h);
                wdone = __all(R < -105.f);
            }
            if (lane == 0) done_f[rwave] = wdone ? 1 : 0;
            DMA_WAIT_SYNC();
        }
        store_o(o, p.obuf + tok * 1024 + hd * 128, h, 1.f);
        __syncthreads();
    }
}


#define KARGP ((const __attribute__((address_space(4))) Params*)__builtin_amdgcn_kernarg_segment_ptr())
#define PH(call) do { if (pc >= lo && pc < hi) { { const __attribute__((address_space(4))) Params* q_ = KARGP; asm volatile("" : "+s"(q_)); PRef p = *q_; call; } if (pc + 1 < hi) xcd_barrier(bar); } ++pc; } while (0)
template <int L> __device__ __forceinline__ void ph_attn_conv(PRef p) {
    constexpr int kind = L % 3;
    const bool conv_first = false;
    (void)conv_first;
    if (kind == 0) ph_mla_attn(p); else if (kind == 1) ph_nsa_attn(p); else ph_sb_attn(p);
}
template <int L> __device__ __forceinline__ void ph_moe_a_conv(PRef p) {
    const bool conv_first = false;
    (void)conv_first;
    ph_moe_a(p, L);
    if (L == 0) convert_moe_steal(p, 0, 2);
    if (L + 1 < DEPTH) { convert_moe_steal(p, L + 1, 0); convert_moe_steal(p, L + 1, 1); }
}
template <int L> __device__ __forceinline__ void ph_moe_b_conv(PRef p) {
    const bool conv_first = false;
    (void)conv_first;
    ph_moe_b(p, L);
    if (L + 1 < DEPTH) convert_moe_steal(p, L + 1, 2);
}
template <int L> __device__ __forceinline__ void run_layer(PRef p, const XcdBarrier& bar, int lo, int hi, int& pc) {
    constexpr int kind = L % 3, j = L / 3;
    if (kind == 0) { PH(ph_mla_in(p, j)); PH(ph_mla_up(p, j)); }
    else if (kind == 1) { PH(ph_nsa_in(p)); PH(ph_nsa_cmp1(p)); PH(ph_nsa_cmp2(p)); }
    else { PH(ph_sb_in(p)); }
    PH(ph_attn_conv<L>(p));
    PH(ph_wo(p, L)); PH(ph_lna(p, L)); PH(ph_moe_a_conv<L>(p)); PH(ph_moe_b_conv<L>(p)); PH(ph_lnb(p, L));
}
__global__ void __launch_bounds__(512, 2) mega(Params pv, int lo, int hi) {
    (void)pv; PRef p = *KARGP;
    volatile LAS unsigned* stw = (volatile LAS unsigned*)smem;
    if (threadIdx.x == 0) { stw[0] = 0u; stw[1] = 0u; stw[2] = 0u; stw[3] = 0u; }
    __syncthreads();
    XcdBarrier bar; bar.bar = p.bar; bar.x = 0; bar.st = stw;
    if (hi - lo > 1) bar = xcd_barrier_post(p.bar, stw);
    int pc = 0;
    PH(ph_prologue(p));
    PH(ph_h0(p));
    run_layer<0>(p, bar, lo, hi, pc);
    run_layer<1>(p, bar, lo, hi, pc);
    run_layer<2>(p, bar, lo, hi, pc);
    run_layer<3>(p, bar, lo, hi, pc);
}
#undef PH
constexpr int N_PHASES = 2 + (3 + 5) + (4 + 5) + (2 + 5) + (3 + 5);

extern "C" void kernel_launch(void* const* d_in, const int* in_sizes, int n_in, void* d_out, int out_size, void* d_ws, size_t ws_size, hipStream_t stream) {
    (void)in_sizes; (void)n_in; (void)out_size;
    static int grid = 0;
    if (grid == 0) {
        int dev = 0, cus = 0, per_cu = 0;
        hipGetDevice(&dev);
        hipDeviceGetAttribute(&cus, hipDeviceAttributeMultiprocessorCount, dev);
        if (hipFuncSetAttribute((const void*)mega, hipFuncAttributeMaxDynamicSharedMemorySize, LDS_BYTES) != hipSuccess) { fprintf(stderr, "kernel_launch: hipFuncSetAttribute failed\n"); }
        if (hipOccupancyMaxActiveBlocksPerMultiprocessor(&per_cu, (const void*)mega, 2 * NTHR, LDS_BYTES) != hipSuccess) per_cu = 1;
        (void)hipGetLastError();
        if (per_cu < 1) per_cu = 1;
        if (per_cu > 1) per_cu = 1;
        if (cus <= 0) cus = 256;
        grid = cus * per_cu;
        if (grid >= 8) grid &= ~7;
    }
    Params p{};
    const float* const* in = (const float* const*)d_in;
    p.x = in[0]; p.c = in[1]; p.pos = (const int*)d_in[2]; p.ada_w = in[3]; p.ada_b = in[4]; p.ln_g = in[5]; p.ln_b = in[6];
    p.mla_w_in = in[7]; p.mla_g_q = in[8]; p.mla_w_uq = in[9]; p.mla_g_kv = in[10]; p.mla_w_ukv = in[11]; p.mla_w_o = in[12];
    p.nsa_w_in = in[13]; p.nsa_pe_k = in[14]; p.nsa_pe_v = in[15]; p.nsa_w_ck1 = in[16]; p.nsa_w_ck2 = in[17]; p.nsa_w_cv1 = in[18]; p.nsa_w_cv2 = in[19]; p.nsa_w_o = in[20];
    p.sb_w_qkv = in[21]; p.sb_w_o = in[22];
    p.moe_w_grp = in[23]; p.moe_b_grp = in[24]; p.moe_w_rt = in[25]; p.moe_b_rt = in[26]; p.moe_w_gate = in[27]; p.moe_w_up = in[28]; p.moe_w_down = in[29];
    p.out = (float*)d_out;
    unsigned char* ws = (unsigned char*)d_ws; size_t off = 0;
    auto take = [&](size_t bytes) { unsigned char* r = ws + off; off += (bytes + 255) & ~(size_t)255; return r; };
    p.bar = (unsigned*)take(XCD_BAR_WORDS * 4 + 16 * 256); p.wq = (int*)(p.bar + XCD_BAR_WORDS); p.cnt = (int*)take(DEPTH * 32 * 64 * 4);
    p.mod = (float*)take((size_t)8 * 8 * 3072 * 4);
    p.cosm = (float*)take((size_t)T_TOK * 32 * 4); p.sinm = (float*)take((size_t)T_TOK * 32 * 4); p.cosn = (float*)take((size_t)T_TOK * 64 * 4); p.sinn = (float*)take((size_t)T_TOK * 64 * 4);
    p.bias1 = (float*)take(2 * 128 * 4); p.wr = (float*)take((size_t)DEPTH * 1024 * 48 * 4);
    p.xbuf = (f16_t*)take((size_t)T_TOK * 1024 * 4); p.zbuf = (f16_t*)take((size_t)T_TOK * 1024 * 4); p.hbuf = (bf16_t*)take((size_t)T_TOK * 1024 * 2);
    p.wt_mla_in = (bf16_t*)take((size_t)2 * 768 * 1024 * 2); p.wt_uq = (bf16_t*)take((size_t)2 * 1536 * 256 * 2); p.wt_ukv = (bf16_t*)take((size_t)2 * 2048 * 256 * 2);
    p.wt_mla_o = (bf16_t*)take((size_t)2 * 1024 * 1024 * 2); p.wt_nsa_in = (bf16_t*)take((size_t)2816 * 1024 * 2);
    p.wt_ck1 = (bf16_t*)take((size_t)128 * 4096 * 2); p.wt_cv1 = (bf16_t*)take((size_t)128 * 4096 * 2); p.wt_ck2 = (bf16_t*)take(128 * 128 * 2); p.wt_cv2 = (bf16_t*)take(128 * 128 * 2);
    p.wt_nsa_o = (bf16_t*)take((size_t)1024 * 1024 * 2); p.wt_sb_qkv = (bf16_t*)take((size_t)3072 * 1024 * 2); p.wt_sb_o = (bf16_t*)take((size_t)1024 * 1024 * 2);
    p.wt_gu = (bf16_t*)take((size_t)DEPTH * 32 * 1024 * 1024 * 2); p.wt_dn = (bf16_t*)take((size_t)DEPTH * 32 * 1024 * 512 * 2);
    p.obuf = (bf16_t*)take((size_t)T_TOK * 1024 * 2);
    p.list = (int*)take((size_t)32 * T_TOK * 4); p.listw = (float*)take((size_t)32 * T_TOK * 4);
    p.hmoe = (bf16_t*)take((size_t)(T_TOK * 2 + 32 * 256) * 512 * 2); p.ybuf = (bf16_t*)take((size_t)T_TOK * 2 * 1024 * 2);
    const size_t arena0 = off;
    p.cbuf = (bf16_t*)take((size_t)T_TOK * 512 * 2); p.rss = (float*)take((size_t)T_TOK * 8 * 4); p.krope = (bf16_t*)take((size_t)T_TOK * 64 * 2); p.qm = (bf16_t*)take((size_t)T_TOK * 1536 * 2);
    p.kn = (bf16_t*)take((size_t)T_TOK * 1024 * 2); p.vt = (bf16_t*)take((size_t)T_TOK * 1024 * 2);
    const size_t arena_mla = off; off = arena0;
    p.qn = (bf16_t*)take((size_t)T_TOK * 1024 * 2);
    p.kc = (bf16_t*)take((size_t)(16 * SEQ + 64) * 128 * 2); p.vc = (bf16_t*)take((size_t)(16 * SEQ + 64) * 128 * 2);
    p.ks = (bf16_t*)take((size_t)16 * SEQ * 128 * 2); p.kw = (bf16_t*)take((size_t)16 * SEQ * 128 * 2);
    p.vst = (bf16_t*)take((size_t)16 * SEQ * 128 * 2); p.vwt = (bf16_t*)take((size_t)16 * SEQ * 128 * 2);
    p.gates = (float*)take((size_t)T_TOK * 32 * 4); p.cpart = (float*)take((size_t)32 * 8 * 128 * 128 * 4); p.hid = (bf16_t*)take((size_t)32 * 128 * 128 * 2);
    p.kcmp = (bf16_t*)take((size_t)16 * 128 * 128 * 2); p.vcmpt = (bf16_t*)take((size_t)16 * 128 * 128 * 2);
    const size_t arena_nsa = off; off = arena0;
    p.qs = (bf16_t*)take((size_t)T_TOK * 1024 * 2); p.ksb = (bf16_t*)take((size_t)T_TOK * 1024 * 2);
    const size_t arena_sb = off; (void)arena_sb;
    off = arena_mla > arena_nsa ? arena_mla : arena_nsa;
    if (off > ws_size) { fprintf(stderr, "kernel_launch: workspace too small (%zu > %zu)\n", off, ws_size); }
    hipMemsetAsync(p.bar, 0, XCD_BAR_WORDS * 4 + 16 * 256, stream);
#if MULTI_LAUNCH
    for (int ph = 0; ph < N_PHASES; ++ph) hipLaunchKernelGGL(mega, dim3(grid), dim3(2 * NTHR), LDS_BYTES, stream, p, ph, ph + 1);
#else
    hipLaunchKernelGGL(mega, dim3(grid), dim3(2 * NTHR), LDS_BYTES, stream, p, 0, N_PHASES);
#endif
}
```

```cpp
#include <hip/hip_runtime.h>
#include <stdint.h>
#include <stdio.h>

#ifndef MULTI_LAUNCH
#define MULTI_LAUNCH 0
#endif

typedef unsigned short bf16_t;
typedef short bf16x8 __attribute__((ext_vector_type(8)));
typedef float f32x16 __attribute__((ext_vector_type(16)));
typedef float f32x4 __attribute__((ext_vector_type(4)));
typedef _Float16 f16_t;
typedef _Float16 f16x4 __attribute__((ext_vector_type(4)));
typedef _Float16 f16x8 __attribute__((ext_vector_type(8)));
typedef float f32x8 __attribute__((ext_vector_type(8)));
__device__ __forceinline__ f32x4 ld4h(const f16_t* p) { return __builtin_convertvector(*reinterpret_cast<const f16x4*>(p), f32x4); }
__device__ __forceinline__ void st4h(f16_t* p, f32x4 v) { *reinterpret_cast<f16x4*>(p) = __builtin_convertvector(v, f16x4); }

constexpr int T_TOK = 16384, DM = 1024, NBATCH = 8, SEQ = 2048, DEPTH = 4;
constexpr float LN_EPS = 1e-5f, RMS_EPS = 1e-6f;
constexpr float DN_ALPHA = 1.6817928305074290f;
constexpr int NTHR = 256;
constexpr int LDS_WORK = 256;
constexpr int HALF_LDS = 80640;
constexpr int LDS_BYTES = LDS_WORK + 2 * HALF_LDS;
#define VHALF ((int)__builtin_amdgcn_readfirstlane((int)(threadIdx.x >> 8)))
#define VT ((int)(threadIdx.x & 255u))
#define VB ((int)(blockIdx.x * 2u) + VHALF)
#define NVB ((int)(gridDim.x * 2u))
#define VLDS (smem + LDS_WORK + VHALF * HALF_LDS)

#define XB_TMO      128
#define XB_XCNT(j)  (256  + 64 * (j))
#define XB_XSUB(j)  (1280 + 64 * (j))
#define XB_XGEN(j)  (2304 + 64 * (j))
#define XB_TOP      3328
#define XB_TOPGEN   3392
#define XCD_BAR_WORDS 3456
#define XB_SPIN_CAP (1u << 22)
#define LAS __attribute__((address_space(3)))

__device__ __forceinline__ unsigned xb_ld(unsigned* p)              { return __hip_atomic_load(p, __ATOMIC_RELAXED, __HIP_MEMORY_SCOPE_AGENT); }
__device__ __forceinline__ unsigned xb_add(unsigned* p, unsigned v) { return __hip_atomic_fetch_add(p, v, __ATOMIC_RELAXED, __HIP_MEMORY_SCOPE_AGENT); }
__device__ __forceinline__ unsigned xb_xcc_id() { return (unsigned)__builtin_amdgcn_s_getreg((3 << 11) | 20) & 0xFu; }
#define XB_SPIN(cond, bar) do { unsigned _sp = 0; while (cond) { __builtin_amdgcn_s_sleep(1); \
    if ((++_sp & 255u) == 0u) { if (xb_ld(&(bar)[XB_TMO])) break; if (_sp > XB_SPIN_CAP) { atomicAdd(&(bar)[XB_TMO], 1u); break; } } } } while (0)

struct XcdBarrier { unsigned* bar; unsigned x; volatile LAS unsigned* st; };

__device__ __forceinline__ XcdBarrier xcd_barrier_post(unsigned* bar, volatile LAS unsigned* st) {
    XcdBarrier b; b.bar = bar; b.x = xb_xcc_id(); b.st = st;
    if (threadIdx.x == 0) (void)xb_add(&bar[XB_XCNT(b.x)], 1u);
    return b;
}
__device__ __forceinline__ void xcd_barrier_complete(unsigned* bar, unsigned x, unsigned& nloc, unsigned& nx) {
    const unsigned G = gridDim.x * gridDim.y * gridDim.z;
    unsigned sum, cnt, mine, sp = 0u;
    for (;;) {
        sum = 0u; cnt = 0u; mine = 0u;
#pragma unroll
        for (unsigned j = 0; j < 16; ++j) { const unsigned c = xb_ld(&bar[XB_XCNT(j)]); sum += c; cnt += (c > 0u) ? 1u : 0u; mine = (j == x) ? c : mine; }
        if (sum == G) break;
        __builtin_amdgcn_s_sleep(1);
        if ((++sp & 255u) == 0u) { if (xb_ld(&bar[XB_TMO])) break; if (sp > XB_SPIN_CAP) { atomicAdd(&bar[XB_TMO], 1u); break; } }
    }
    nloc = mine > 0u ? mine : 1u; nx = cnt > 0u ? cnt : 1u;
}
__device__ __forceinline__ void xcd_barrier(const XcdBarrier& b) {
    asm volatile("s_waitcnt vmcnt(0)" ::: "memory");
    __syncthreads();
    if (threadIdx.x == 0) {
        unsigned* bar = b.bar;
        __builtin_amdgcn_s_waitcnt(0);
        unsigned nloc = b.st[0], nx = b.st[1];
        if (nloc == 0u) { xcd_barrier_complete(bar, b.x, nloc, nx); b.st[0] = nloc; b.st[1] = nx; }
        const unsigned old = xb_add(&bar[XB_XSUB(b.x)], 1u);
        const unsigned gen = old / nloc;
        if (old + 1u == (gen + 1u) * nloc) {
            __builtin_amdgcn_fence(__ATOMIC_RELEASE, "agent");
            asm volatile("s_waitcnt vmcnt(0)" ::: "memory");
            const unsigned og = xb_add(&bar[XB_TOP], 1u);
            const unsigned tg = og / nx;
            if (og + 1u == (tg + 1u) * nx) xb_add(&bar[XB_TOPGEN], 1u);
            else XB_SPIN(xb_ld(&bar[XB_TOPGEN]) == tg, bar);
            __builtin_amdgcn_fence(__ATOMIC_ACQUIRE, "agent");
            xb_add(&bar[XB_XGEN(b.x)], 1u);
            asm volatile("s_waitcnt vmcnt(0)" ::: "memory");
        } else {
            XB_SPIN(xb_ld(&bar[XB_XGEN(b.x)]) == gen, bar);
            __builtin_amdgcn_fence(__ATOMIC_ACQUIRE, "agent");
            asm volatile("s_waitcnt vmcnt(0)" ::: "memory");
        }
    }
    __syncthreads();
}

struct Params;
typedef const __attribute__((address_space(4))) Params& PRef;
struct Params {
    const float* x; const float* c; const int* pos; const float* ada_w; const float* ada_b; const float* ln_g; const float* ln_b;
    const float* mla_w_in; const float* mla_g_q; const float* mla_w_uq; const float* mla_g_kv; const float* mla_w_ukv; const float* mla_w_o;
    const float* nsa_w_in; const float* nsa_pe_k; const float* nsa_pe_v; const float* nsa_w_ck1; const float* nsa_w_ck2; const float* nsa_w_cv1; const float* nsa_w_cv2; const float* nsa_w_o;
    const float* sb_w_qkv; const float* sb_w_o;
    const float* moe_w_grp; const float* moe_b_grp; const float* moe_w_rt; const float* moe_b_rt; const float* moe_w_gate; const float* moe_w_up; const float* moe_w_down;
    float* out;
    unsigned* bar; int* cnt; float* mod; float* cosm; float* sinm; float* cosn; float* sinn; float* bias1; float* wr;
    f16_t* xbuf; f16_t* zbuf; bf16_t* hbuf;
    bf16_t* wt_mla_in; bf16_t* wt_uq; bf16_t* wt_ukv; bf16_t* wt_mla_o; bf16_t* wt_nsa_in; bf16_t* wt_ck1; bf16_t* wt_cv1; bf16_t* wt_ck2; bf16_t* wt_cv2;
    bf16_t* wt_nsa_o; bf16_t* wt_sb_qkv; bf16_t* wt_sb_o; bf16_t* wt_gu; bf16_t* wt_dn;
    bf16_t* cbuf; float* rss; bf16_t* krope; bf16_t* qm; bf16_t* kn; bf16_t* vt;
    bf16_t* qn; bf16_t* kc; bf16_t* vc; bf16_t* ks; bf16_t* kw; bf16_t* vst; bf16_t* vwt; float* gates; float* cpart; bf16_t* hid; bf16_t* kcmp; bf16_t* vcmpt;
    bf16_t* qs; bf16_t* ksb;
    bf16_t* obuf;
    int* wq;
    int* list; float* listw; bf16_t* hmoe; bf16_t* ybuf;
};

extern __shared__ __attribute__((aligned(16))) unsigned char smem[];

__device__ __forceinline__ unsigned cvtpk(float lo, float hi) { unsigned r; asm("s_nop 0\n\tv_cvt_pk_bf16_f32 %0, %1, %2\n\ts_nop 1" : "=v"(r) : "v"(lo), "v"(hi)); return r; }
__device__ __forceinline__ uint4 cvtpk8(float a0, float a1, float a2, float a3, float a4, float a5, float a6, float a7) {
    uint4 r;
    asm("s_nop 0\n\tv_cvt_pk_bf16_f32 %0, %4, %5\n\tv_cvt_pk_bf16_f32 %1, %6, %7\n\tv_cvt_pk_bf16_f32 %2, %8, %9\n\tv_cvt_pk_bf16_f32 %3, %10, %11\n\ts_nop 1"
        : "=&v"(r.x), "=&v"(r.y), "=&v"(r.z), "=&v"(r.w) : "v"(a0), "v"(a1), "v"(a2), "v"(a3), "v"(a4), "v"(a5), "v"(a6), "v"(a7));
    return r;
}
__device__ __forceinline__ float bf2f(unsigned v16) { return __uint_as_float(v16 << 16); }
__device__ __forceinline__ uint4 pack8(const float* v) { return cvtpk8(v[0], v[1], v[2], v[3], v[4], v[5], v[6], v[7]); }
__device__ __forceinline__ float wave_sum(float v) {
#pragma unroll
    for (int o = 32; o > 0; o >>= 1) v += __shfl_xor(v, o, 64);
    return v;
}
__device__ __forceinline__ float xh_max(float v) { auto rr = __builtin_amdgcn_permlane32_swap(__float_as_uint(v), __float_as_uint(v), false, false); return fmaxf(__uint_as_float(rr[0]), __uint_as_float(rr[1])); }
__device__ __forceinline__ float xh_sum(float v) { auto rr = __builtin_amdgcn_permlane32_swap(__float_as_uint(v), __float_as_uint(v), false, false); return __uint_as_float(rr[0]) + __uint_as_float(rr[1]); }
__device__ __forceinline__ float xh_other(float v, int h) { auto rr = __builtin_amdgcn_permlane32_swap(__float_as_uint(v), __float_as_uint(v), false, false); return h ? __uint_as_float(rr[0]) : __uint_as_float(rr[1]); }
__device__ __forceinline__ float silu_f(float v) { return v / (1.f + __expf(-v)); }
__device__ __forceinline__ float sigmoid_f(float v) { return 1.f / (1.f + __expf(-v)); }
#define MFMA32(a, b, c) __builtin_amdgcn_mfma_f32_32x32x16_bf16((a), (b), (c), 0, 0, 0)
__device__ __forceinline__ int crow(int reg, int h) { return (reg & 3) + 8 * (reg >> 2) + 4 * h; }
__device__ __forceinline__ bf16x8 lds_frag(const unsigned char* base, int off) { return *reinterpret_cast<const bf16x8*>(base + off); }

constexpr int CS_LD = 132;
constexpr int GEMM_RSTD_OFF = 128 * CS_LD * 4;
template <class RowPtr>
__device__ __forceinline__ void gemm_main(int tid, unsigned char* lds, const RowPtr& rowptr, const bf16_t* __restrict__ Bt, int ldb, int n0, int K, f32x16 (&acc)[2][2]) {
    const int lane = tid & 63, wid = tid >> 6, wr = wid >> 1, wc = wid & 1, r = lane & 31, h = lane >> 5;
    const bf16_t* pa[4]; const bf16_t* pb[4];
#pragma unroll
    for (int i = 0; i < 4; ++i) {
        const int pi = wid + 4 * i, row = 8 * pi + (lane >> 3), c = (lane & 7) ^ ((row >> 1) & 7);
        pa[i] = rowptr(row) + c * 8; pb[i] = Bt + (size_t)(n0 + row) * ldb + c * 8;
    }
    const int swz = (r >> 1) & 7;
    const int aoff = (wr * 64 + r) * 128, boff = 32768 + (wc * 64 + r) * 128;
#pragma unroll
    for (int i = 0; i < 2; ++i)
#pragma unroll
        for (int j = 0; j < 2; ++j)
#pragma unroll
            for (int q = 0; q < 16; ++q) acc[i][j][q] = 0.f;
    const int nk = K >> 6;
    auto dma = [&](int buf, int k0) {
#pragma unroll
        for (int i = 0; i < 4; ++i) {
            const int pi = wid + 4 * i;
            __builtin_amdgcn_global_load_lds((const unsigned*)(pa[i] + k0), (LAS unsigned*)(lds + buf * 16384 + pi * 1024), 16, 0, 0);
            __builtin_amdgcn_global_load_lds((const unsigned*)(pb[i] + k0), (LAS unsigned*)(lds + 32768 + buf * 16384 + pi * 1024), 16, 0, 0);
        }
    };
    dma(0, 0);
    asm volatile("s_waitcnt vmcnt(0)" ::: "memory"); __syncthreads();
    for (int kt = 0; kt < nk; ++kt) {
        if (kt + 1 < nk) dma((kt + 1) & 1, (kt + 1) << 6);
        const unsigned char* sa = lds + (kt & 1) * 16384;
#pragma unroll
        for (int kk = 0; kk < 4; ++kk) {
            const int co = ((2 * kk + h) ^ swz) << 4;
            const bf16x8 a0 = lds_frag(sa, aoff + co), a1 = lds_frag(sa, aoff + 4096 + co);
            const bf16x8 b0 = lds_frag(sa, boff + co), b1 = lds_frag(sa, boff + 4096 + co);
            acc[0][0] = MFMA32(a0, b0, acc[0][0]); acc[0][1] = MFMA32(a0, b1, acc[0][1]);
            acc[1][0] = MFMA32(a1, b0, acc[1][0]); acc[1][1] = MFMA32(a1, b1, acc[1][1]);
        }
        asm volatile("s_waitcnt vmcnt(0)" ::: "memory"); __syncthreads();
    }
    float* Cs = reinterpret_cast<float*>(lds);
#pragma unroll
    for (int i = 0; i < 2; ++i)
#pragma unroll
        for (int j = 0; j < 2; ++j)
#pragma unroll
            for (int q = 0; q < 16; ++q) Cs[(wr * 64 + i * 32 + crow(q, h)) * CS_LD + wc * 64 + j * 32 + r] = acc[i][j][q];
    __syncthreads();
}
#define ITEM_END_SYNC() do { asm volatile("s_waitcnt lgkmcnt(0)" ::: "memory"); __builtin_amdgcn_s_barrier(); asm volatile("" ::: "memory"); } while (0)
__device__ __forceinline__ void cs_load8(const float* Cs, int row, int c0, float* v) {
    const f32x4 a = *reinterpret_cast<const f32x4*>(Cs + row * CS_LD + c0), b = *reinterpret_cast<const f32x4*>(Cs + row * CS_LD + c0 + 4);
    v[0] = a[0]; v[1] = a[1]; v[2] = a[2]; v[3] = a[3]; v[4] = b[0]; v[5] = b[1]; v[6] = b[2]; v[7] = b[3];
}
__device__ __forceinline__ void epi_plain(const float* __restrict__ Cs, bf16_t* __restrict__ dst, size_t ld, const float* __restrict__ rowscale) {
    const int tid = VT, c0 = (tid & 15) * 8;
#pragma unroll
    for (int ps = 0; ps < 8; ++ps) {
        const int row = (tid >> 4) + 16 * ps; float v[8]; cs_load8(Cs, row, c0, v);
        if (rowscale) { const float s = rowscale[row];
#pragma unroll
            for (int q = 0; q < 8; ++q) v[q] *= s; }
        *reinterpret_cast<uint4*>(dst + (size_t)row * ld + c0) = pack8(v);
    }
}
__device__ __forceinline__ void epi_rope128(const float* __restrict__ Cs, bf16_t* __restrict__ dst, size_t ld, const float* __restrict__ cs, const float* __restrict__ sn, int tok0) {
    const int tid = VT, c0 = (tid & 15) * 8;
    if (c0 >= 64) return;
#pragma unroll
    for (int ps = 0; ps < 8; ++ps) {
        const int row = (tid >> 4) + 16 * ps; float a[8], b[8], o1[8], o2[8]; cs_load8(Cs, row, c0, a); cs_load8(Cs, row, c0 + 64, b);
        const float* cp = cs + (size_t)(tok0 + row) * 64 + c0; const float* sp = sn + (size_t)(tok0 + row) * 64 + c0;
#pragma unroll
        for (int q = 0; q < 8; ++q) { const float c = cp[q], s = sp[q]; o1[q] = a[q] * c - b[q] * s; o2[q] = b[q] * c + a[q] * s; }
        *reinterpret_cast<uint4*>(dst + (size_t)row * ld + c0) = pack8(o1);
        *reinterpret_cast<uint4*>(dst + (size_t)row * ld + c0 + 64) = pack8(o2);
    }
}
__device__ __forceinline__ void epi_transpose(const float* __restrict__ Cs, bf16_t* __restrict__ dst  , size_t ld, const float* __restrict__ rowscale) {
    const int tid = VT, dv = tid & 127, sh = tid >> 7;
#pragma unroll
    for (int j = 0; j < 8; ++j) {
        float v[8];
#pragma unroll
        for (int q = 0; q < 8; ++q) { const int row = sh * 64 + j * 8 + q; v[q] = Cs[row * CS_LD + dv] * (rowscale ? rowscale[row] : 1.f); }
        *reinterpret_cast<uint4*>(dst + (size_t)dv * ld + sh * 64 + j * 8) = pack8(v);
    }
}

struct RowPlain { const bf16_t* base; size_t ld; __device__ __forceinline__ const bf16_t* operator()(int r) const { return base + (size_t)r * ld; } };


namespace g8 {
typedef float f32x4_t __attribute__((ext_vector_type(4)));
constexpr int BK = 64, HALFR = 128, HTB = HALFR * BK * 2, STAGE_BYTES = 8 * HTB;
__device__ __forceinline__ int lds_byte(int r, int c) { const int st = (r >> 4) * 2 + (c >> 5), rr = r & 15, cc = c & 31, ob = rr * 64 + cc * 2; return st * 1024 + (ob ^ (((ob >> 9) & 1) << 5)); }
__device__ __forceinline__ void stage_rc(int b, int& R, int& C) { const int st = b / 1024, sb = b % 1024, swz = sb ^ (((sb >> 9) & 1) << 5); R = (st >> 1) * 16 + swz / 64; C = (st & 1) * 32 + (swz % 64) / 2; }
struct Unit { int pm, pn, par; };
template <class Sched, class Epi>
__device__ __forceinline__ void gemm8(LAS unsigned char* lds, const char* __restrict__ Abase, int ldb, int K, const Sched& S, const Epi& E) {
    const int tid = threadIdx.x;
    const int wid = __builtin_amdgcn_readfirstlane(tid >> 6), lane = tid & 63, wr = wid >> 2, wc = wid & 3, fr = lane & 15, fq = lane >> 4;
    const int nt = K / BK;
    unsigned voffB0; { int R, C; stage_rc(tid * 16, R, C); voffB0 = (unsigned)(R * ldb + C) * 2u; }
    const unsigned voffBd = (unsigned)(64 * ldb) * 2u;
    const size_t kstep = (size_t)(BK * 2), hstepB = (size_t)HALFR * ldb * 2;
    const unsigned ldsw = (unsigned)wid * 1024u;
    const int lpart = lds_byte(fr, fq * 8);
    const int aoff = lpart + wr * 8192, boff = lpart + wc * 4096;
#define G8_SA(b, h) (((b) * 2 + (h)) * HTB)
#define G8_SB(b, h) ((4 + (b) * 2 + (h)) * HTB)
#define G8_STAGE_B(bufoff, gbase) do { \
        __builtin_amdgcn_global_load_lds((const unsigned*)((const char*)(gbase) + voffB0), (LAS unsigned*)(lds + (bufoff) + ldsw), 16, 0, 0); \
        __builtin_amdgcn_global_load_lds((const unsigned*)((const char*)(gbase) + voffBd + voffB0), (LAS unsigned*)(lds + (bufoff) + ldsw + 8192), 16, 0, 0); } while (0)
#define G8_STAGE_A(bufoff, hnd, kbytes) do { \
        __builtin_amdgcn_global_load_lds((const unsigned*)(Abase + (size_t)S.a_off(hnd, 0, tid) + (kbytes)), (LAS unsigned*)(lds + (bufoff) + ldsw), 16, 0, 0); \
        __builtin_amdgcn_global_load_lds((const unsigned*)(Abase + (size_t)S.a_off(hnd, 1, tid) + (kbytes)), (LAS unsigned*)(lds + (bufoff) + ldsw + 8192), 16, 0, 0); } while (0)
#define G8_LDA(dst, b, h) do { _Pragma("unroll") for (int m = 0; m < 4; ++m) _Pragma("unroll") for (int k = 0; k < 2; ++k) dst[m][k] = *(const LAS bf16x8*)(lds + G8_SA(b, h) + aoff + m * 2048 + k * 1024); } while (0)
#define G8_LDB(dst, b, h) do { _Pragma("unroll") for (int n = 0; n < 2; ++n) _Pragma("unroll") for (int k = 0; k < 2; ++k) dst[n][k] = *(const LAS bf16x8*)(lds + G8_SB(b, h) + boff + n * 2048 + k * 1024); } while (0)
#define G8_MMA(ai, bj, At, Bt) do { __builtin_amdgcn_s_setprio(1); _Pragma("unroll") for (int m = 0; m < 4; ++m) _Pragma("unroll") for (int n = 0; n < 2; ++n) _Pragma("unroll") for (int k = 0; k < 2; ++k) \
        acc[ai][bj][m][n] = __builtin_amdgcn_mfma_f32_16x16x32_bf16(Bt[n][k], At[m][k], acc[ai][bj][m][n], 0, 0, 0); __builtin_amdgcn_s_setprio(0); } while (0)
#define G8_WAIT_V(n) asm volatile("s_waitcnt vmcnt(" #n ")" ::: "memory")
#define G8_WAIT_L(n) asm volatile("s_waitcnt lgkmcnt(" #n ")" ::: "memory")
#define G8_BAR __builtin_amdgcn_s_barrier()
#define G8_SCHED __builtin_amdgcn_sched_barrier(0)
    Unit cur, nxt; int ui = 0;
    if (!S.next(0, cur)) return;
    f32x4_t acc[2][2][4][2];
#pragma unroll
    for (int a = 0; a < 2; ++a)
#pragma unroll
        for (int b = 0; b < 2; ++b)
#pragma unroll
            for (int m = 0; m < 4; ++m)
#pragma unroll
                for (int n = 0; n < 2; ++n) acc[a][b][m][n] = (f32x4_t){0.f, 0.f, 0.f, 0.f};
    bf16x8 At[4][2], B0[2][2], B1[2][2];
    unsigned c0, c1;
    cur.par = 0; S.stash(cur, tid); S.stash_wait(); S.a_handles(cur, tid, c0, c1);
    const char* cB = S.b_base(cur);
    G8_STAGE_B(G8_SB(0, 0), cB); G8_STAGE_A(G8_SA(0, 0), c0, 0); G8_STAGE_B(G8_SB(0, 1), cB + hstepB); G8_STAGE_A(G8_SA(0, 1), c1, 0);
    if (wr == 1) G8_BAR;
    G8_WAIT_V(4); G8_BAR;
    G8_STAGE_B(G8_SB(1, 0), cB + kstep); G8_STAGE_A(G8_SA(1, 0), c0, kstep); G8_STAGE_B(G8_SB(1, 1), cB + hstepB + kstep);
    G8_WAIT_V(6); G8_BAR;
    for (;;) {
        const bool has_next = S.next(ui + 1, nxt); nxt.par = (ui + 1) % 3;
        const char* nB = cB;
        if (has_next) { S.stash(nxt, tid); nB = S.b_base(nxt); }
#pragma unroll 1
        for (int t = 0; t < nt; t += 2) {
            const bool last = (t == nt - 2);
            const size_t k1 = (size_t)(t + 1) * kstep;
            const size_t k2 = last ? 0 : (size_t)(t + 2) * kstep, k3 = k2 + kstep;
            const char* b2 = last ? nB : cB + k2; const char* b3 = b2 + kstep;
            G8_LDB(B0, 0, 0); G8_SCHED; G8_LDA(At, 0, 0); G8_STAGE_A(G8_SA(1, 1), c1, k1);
            if (last && has_next) S.a_handles(nxt, tid, c0, c1);
            G8_WAIT_L(8); G8_BAR; G8_WAIT_L(0); G8_MMA(0, 0, At, B0); G8_BAR; G8_SCHED;
            G8_LDB(B1, 0, 1); G8_STAGE_B(G8_SB(0, 0), b2);
            G8_BAR; G8_WAIT_L(0); G8_MMA(0, 1, At, B1); G8_BAR;
            G8_LDA(At, 0, 1); G8_STAGE_A(G8_SA(0, 0), c0, k2);
            G8_BAR; G8_WAIT_L(0); G8_MMA(1, 0, At, B0); G8_BAR; G8_SCHED;
            G8_STAGE_B(G8_SB(0, 1), b2 + hstepB);
            G8_WAIT_V(6); G8_BAR; G8_MMA(1, 1, At, B1); G8_BAR;
            G8_LDB(B0, 1, 0); G8_SCHED; G8_LDA(At, 1, 0); G8_STAGE_A(G8_SA(0, 1), c1, k2);
            G8_WAIT_L(8); G8_BAR; G8_WAIT_L(0); G8_MMA(0, 0, At, B0); G8_BAR; G8_SCHED;
            G8_LDB(B1, 1, 1); G8_STAGE_B(G8_SB(1, 0), b3);
            G8_BAR; G8_WAIT_L(0); G8_MMA(0, 1, At, B1); G8_BAR;
            G8_LDA(At, 1, 1); G8_STAGE_A(G8_SA(1, 0), c0, k3);
            G8_BAR; G8_WAIT_L(0); G8_MMA(1, 0, At, B0); G8_BAR; G8_SCHED;
            G8_STAGE_B(G8_SB(1, 1), b3 + hstepB);
            G8_WAIT_V(6); G8_BAR; G8_MMA(1, 1, At, B1); G8_BAR;
        }
        E(acc, cur, wr, wc, fr, fq);
        if (!has_next) break;
#pragma unroll
        for (int a = 0; a < 2; ++a)
#pragma unroll
            for (int b = 0; b < 2; ++b)
#pragma unroll
                for (int m = 0; m < 4; ++m)
#pragma unroll
                    for (int n = 0; n < 2; ++n) acc[a][b][m][n] = (f32x4_t){0.f, 0.f, 0.f, 0.f};
        cur = nxt; cB = nB; ++ui;
    }
    G8_WAIT_V(0);
    if (wr == 0) G8_BAR;
    G8_BAR;
#undef G8_SA
#undef G8_SB
#undef G8_STAGE_A
#undef G8_STAGE_B
#undef G8_LDA
#undef G8_LDB
#undef G8_MMA
#undef G8_WAIT_V
#undef G8_WAIT_L
#undef G8_BAR
#undef G8_SCHED
}
struct SchedPlain {
    int nM, nN, nwg, G, c, lda; const char* Bt; size_t ldb_bytes;
    __device__ __forceinline__ void init(int M, int N, int lda_, const void* Bt_, int ldb) { nM = M / 256; nN = N / 256; nwg = nM * nN; G = gridDim.x; c = blockIdx.x; lda = lda_; Bt = (const char*)Bt_; ldb_bytes = (size_t)ldb * 2; }
    __device__ __forceinline__ bool next(int i, Unit& u) const {
        const long L = (long)i * G + c; if (L >= nwg) return false;
        int wgid = (int)L; { const int q = nwg / 8, r = nwg % 8, xcd = wgid % 8, off = wgid / 8; wgid = (xcd < r ? xcd * (q + 1) : r * (q + 1) + (xcd - r) * q) + off; }
        const int nig = 8 * nN, gid = wgid / nig, fm = gid * 8, gsz = (nM - fm) < 8 ? (nM - fm) : 8;
        u.pm = fm + ((wgid % nig) % gsz); u.pn = (wgid % nig) / gsz; return true;
    }
    __device__ __forceinline__ void a_handles(const Unit& u, int tid, unsigned& h0, unsigned& h1) const {
        int R, C; stage_rc(tid * 16, R, C);
        h0 = ((unsigned)(u.pm * 256 + R) * (unsigned)lda + (unsigned)C) * 2u; h1 = h0 + (unsigned)(128 * lda) * 2u;
    }
    __device__ __forceinline__ unsigned a_off(unsigned h, int piece, int) const { return h + (unsigned)(piece * 64 * lda) * 2u; }
    __device__ __forceinline__ const char* b_base(const Unit& u) const { return Bt + (size_t)u.pn * 256 * ldb_bytes; }
    __device__ __forceinline__ void stash(const Unit&, int) const {}
    __device__ __forceinline__ void stash_wait() const {}
};
struct SchedMoe {
    const int* pre; const int* list; const float* listw; const char* Bt; size_t estride, ustride; int nunits, G, c, gather; int* tab;
    __device__ __forceinline__ int expert(int panel) const { int e = 0; for (int q = 1; q < 32; ++q) e = (pre[q] <= panel) ? q : e; return e; }
    __device__ __forceinline__ bool next(int i, Unit& u) const {
        const int per = (nunits + 7) >> 3, x = c & 7, Lx = i * (G >> 3) + (c >> 3), L = x * per + Lx;
        if (Lx >= per || L >= nunits) return false;
        u.pn = L & 3; u.pm = L >> 2; return true;
    }
    __device__ __forceinline__ void stash(const Unit& u, int tid) const {
        const int e = expert(u.pm), b0 = (u.pm - pre[e]) * 256; const int* l = list + (size_t)e * T_TOK + b0;
        const int wv = __builtin_amdgcn_readfirstlane(tid >> 6);
        if (gather) {
            int R, C; stage_rc(tid * 16, R, C);
#pragma unroll
            for (int k = 0; k < 4; ++k)
                __builtin_amdgcn_global_load_lds((const unsigned*)(l + R + 64 * (k & 1) + 128 * (k >> 1)), (LAS unsigned*)((LAS unsigned char*)(LAS int*)tab + k * 2048 + wv * 256), 4, 0, 0);
        } else {
            const int r = tid & 255; const int* src = (tid < 256) ? (l + r) : reinterpret_cast<const int*>(listw + (size_t)e * T_TOK + b0 + r);
            __builtin_amdgcn_global_load_lds((const unsigned*)src, (LAS unsigned*)((LAS unsigned char*)(LAS int*)tab + u.par * 2048 + wv * 256), 4, 0, 0);
        }
    }
    __device__ __forceinline__ void stash_wait() const { asm volatile("s_waitcnt vmcnt(0)" ::: "memory"); }
    __device__ __forceinline__ void a_handles(const Unit& u, int tid, unsigned& h0, unsigned& h1) const {
        if (gather) {
            asm volatile("" ::: "memory");
            const unsigned t0 = ((unsigned)tab[tid] >> 1) & 16383u, t1 = ((unsigned)tab[512 + tid] >> 1) & 16383u, t2 = ((unsigned)tab[1024 + tid] >> 1) & 16383u, t3 = ((unsigned)tab[1536 + tid] >> 1) & 16383u;
            h0 = t0 | (t1 << 16); h1 = t2 | (t3 << 16);
        }
        else { int R, C; stage_rc(tid * 16, R, C); h0 = ((unsigned)(u.pm * 256 + R) * 512u + (unsigned)C) * 2u; h1 = h0 + 128u * 512u * 2u; }
    }
    __device__ __forceinline__ unsigned a_off(unsigned h, int piece, int tid) const {
        if (gather) { int R, C; stage_rc(tid * 16, R, C); return (((h >> (16 * piece)) & 0xffffu) * 1024u + (unsigned)C) * 2u; }
        return h + (unsigned)(piece * 64 * 512) * 2u;
    }
    __device__ __forceinline__ const char* b_base(const Unit& u) const { return Bt + (size_t)expert(u.pm) * estride + (size_t)u.pn * ustride; }
};
}

__device__ __forceinline__ void convert_T(unsigned char* lds, const float* __restrict__ src, int nb, int K, int N, bf16_t* __restrict__ dst, size_t dst_bstride,
                                       const float* __restrict__ rowscale, int grp, int grp_stride, int off, int b0 = 0, int perm = 0) {
    (void)lds;
    int tid = VT; asm volatile("" : "+v"(tid));
    const int lane = tid & 63, wid = tid >> 6;
    const int nkt = K >> 7, nnt = (N + 63) >> 6, per = nkt * nnt, total = nb * per;
    for (int it = VB; it < total; it += NVB) {
        const int bl = it / per, b = b0 + bl, rem = it - bl * per, ktile = rem / nnt, ntile = rem - ktile * nnt;
        const int k0 = (ktile << 7) + (wid * 4 + (lane >> 4)) * 8, n = (ntile << 6) + (lane & 15) * 4;
        if (n < N) {
            const float* s = src + (size_t)b * K * N + (size_t)k0 * N + n;
            f32x4 v[8];
#pragma unroll
            for (int j = 0; j < 8; ++j) v[j] = *reinterpret_cast<const f32x4*>(s + (size_t)j * N);
            if (rowscale) {
#pragma unroll
                for (int j = 0; j < 8; ++j) { const float sc = rowscale[(size_t)b * K + k0 + j]; v[j] *= sc; }
            }
#pragma unroll
            for (int q = 0; q < 4; ++q) {
                const int nn = n + q; int drow = (nn / grp) * grp_stride + off + (nn % grp);
                if (perm == 1) { const int l = drow & 127; drow = (drow & ~127) | (32 * ((l >> 4) & 3) + 16 * (l >> 6) + (l & 15)); }
                if (perm == 3) { const int l = drow & 31; drow = (drow & ~31) | (16 * ((l >> 2) & 1) + 4 * (l >> 3) + (l & 3)); }
                else if (perm == 2) { const int l = drow & 63; drow = (drow & ~63) | (32 * ((l >> 4) & 1) + 16 * (l >> 5) + (l & 15)); }
                *reinterpret_cast<uint4*>(dst + (size_t)b * dst_bstride + (size_t)drow * K + k0) = cvtpk8(v[0][q], v[1][q], v[2][q], v[3][q], v[4][q], v[5][q], v[6][q], v[7][q]);
            }
        }
    }
}

__device__ __forceinline__ void job_mod(PRef p, unsigned char* lds) {
    int tid = VT; asm volatile("" : "+v"(tid));
    const int lane = tid & 63, wid = tid >> 6;
    float* sc = reinterpret_cast<float*>(lds);
    float* part = reinterpret_cast<float*>(lds + 32768);
    for (int i = tid; i < 8192; i += NTHR) { const int b = i >> 10, k = i & 1023; const float v = p.c[b * 1024 + k]; sc[k * 8 + b] = v / (1.f + expf(-v)); }
    __syncthreads();
    for (int it = VB; it < 384; it += NVB) {
        const int sl = it / 48, n0 = (it % 48) * 64;
        const float* W = p.ada_w + (size_t)sl * 1024 * 3072 + n0 + lane;
        float acc[8] = {0.f, 0.f, 0.f, 0.f, 0.f, 0.f, 0.f, 0.f};
        const int kb = wid * 256;
#pragma unroll 16
        for (int k = 0; k < 256; ++k) {
            const float w = W[(size_t)(kb + k) * 3072];
            const f32x4 s0 = *reinterpret_cast<const f32x4*>(sc + (kb + k) * 8), s1 = *reinterpret_cast<const f32x4*>(sc + (kb + k) * 8 + 4);
            acc[0] += s0[0] * w; acc[1] += s0[1] * w; acc[2] += s0[2] * w; acc[3] += s0[3] * w;
            acc[4] += s1[0] * w; acc[5] += s1[1] * w; acc[6] += s1[2] * w; acc[7] += s1[3] * w;
        }
#pragma unroll
        for (int b = 0; b < 8; ++b) part[(wid * 8 + b) * 64 + lane] = acc[b];
        __syncthreads();
        for (int o = tid; o < 512; o += NTHR) {
            const int b = o >> 6, l = o & 63;
            const float s = part[(0 * 8 + b) * 64 + l] + part[(1 * 8 + b) * 64 + l] + part[(2 * 8 + b) * 64 + l] + part[(3 * 8 + b) * 64 + l] + p.ada_b[sl * 3072 + n0 + l];
            p.mod[(size_t)(sl * 8 + b) * 3072 + n0 + l] = s;
        }
        __syncthreads();
    }
}

__device__ __forceinline__ void job_misc(PRef p, unsigned char* lds) {
    const int tid = VT;
    const size_t gtid = (size_t)VB * NTHR + tid, gsz = (size_t)NVB * NTHR;
    for (size_t i = gtid; i < (size_t)T_TOK * 32; i += gsz) {
        const int t = (int)(i >> 5), f = (int)(i & 31);
        const float inv = 1.0f / powf(10000.f, (float)(2 * f) / 64.f);
        const float ang = (float)p.pos[t] * inv;
        p.cosm[i] = cosf(ang); p.sinm[i] = sinf(ang);
    }
    for (size_t i = gtid; i < (size_t)T_TOK * 64; i += gsz) {
        const int t = (int)(i >> 6), f = (int)(i & 63);
        const float inv = 1.0f / powf(10000.f, (float)(2 * f) / 128.f);
        const float ang = (float)p.pos[t] * inv;
        p.cosn[i] = cosf(ang); p.sinn[i] = sinf(ang);
    }
    for (size_t i = gtid; i < (size_t)DEPTH * 1024 * 48; i += gsz) {
        const int e = (int)(i % 48); const size_t lk = i / 48;
        float v = 0.f;
        if (e < 4) v = p.moe_w_grp[lk * 4 + e]; else if (e < 36) v = p.moe_w_rt[lk * 32 + (e - 4)];
        p.wr[i] = v;
    }
    if (gtid < DEPTH * 32) p.cnt[gtid * 64] = 0;
    {
        const int lane = tid & 63, wid = tid >> 6;
        for (int o = VB * 4 + wid; o < 256; o += NVB * 4) {
            const int which = o >> 7, e = o & 127;
            const float* pe = which ? p.nsa_pe_v : p.nsa_pe_k; const float* w1 = which ? p.nsa_w_cv1 : p.nsa_w_ck1;
            float a = 0.f;
#pragma unroll 16
            for (int j = 0; j < 64; ++j) { const int k = lane + 64 * j; a += pe[k] * w1[(size_t)k * 128 + e]; }
            a = wave_sum(a);
            if (lane == 0) p.bias1[o] = a;
        }
    }
}

struct CvtJob { const float* src; int nb, K, N; bf16_t* dst; size_t bstride; const float* rowscale; int grp, gstride, off, perm; };
__device__ __forceinline__ CvtJob cvt_job(PRef p, int j) {
    const int BIG = 1 << 30;
    CvtJob c;
    switch (j) {
    case 0:  c = CvtJob{p.moe_w_gate, DEPTH * 32, 1024, 512, p.wt_gu, (size_t)1024 * 1024, nullptr, 64, 128, 0, 0}; break;
    case 1:  c = CvtJob{p.moe_w_up, DEPTH * 32, 1024, 512, p.wt_gu, (size_t)1024 * 1024, nullptr, 64, 128, 64, 0}; break;
    case 2:  c = CvtJob{p.moe_w_down, DEPTH * 32, 512, 1024, p.wt_dn, (size_t)1024 * 512, nullptr, BIG, 0, 0, 0}; break;
    case 3:  c = CvtJob{p.mla_w_in, 2, 1024, 576, p.wt_mla_in, (size_t)768 * 1024, nullptr, BIG, 0, 0, 2}; break;
    case 4:  c = CvtJob{p.mla_w_uq, 2, 256, 1536, p.wt_uq, (size_t)1536 * 256, p.mla_g_q, BIG, 0, 0, 2}; break;
    case 5:  c = CvtJob{p.mla_w_ukv, 2, 256, 2048, p.wt_ukv, (size_t)2048 * 256, p.mla_g_kv, BIG, 0, 0, 3}; break;
    case 6:  c = CvtJob{p.mla_w_o, 2, 1024, 1024, p.wt_mla_o, (size_t)1024 * 1024, nullptr, BIG, 0, 0, 3}; break;
    case 7:  c = CvtJob{p.nsa_w_in, 1, 1024, 2584, p.wt_nsa_in, 0, nullptr, BIG, 0, 0, 1}; break;
    case 8:  c = CvtJob{p.nsa_w_ck1, 1, 4096, 128, p.wt_ck1, 0, nullptr, BIG, 0, 0, 0}; break;
    case 9:  c = CvtJob{p.nsa_w_cv1, 1, 4096, 128, p.wt_cv1, 0, nullptr, BIG, 0, 0, 0}; break;
    case 10: c = CvtJob{p.nsa_w_ck2, 1, 128, 128, p.wt_ck2, 0, nullptr, BIG, 0, 0, 0}; break;
    case 11: c = CvtJob{p.nsa_w_cv2, 1, 128, 128, p.wt_cv2, 0, nullptr, BIG, 0, 0, 0}; break;
    case 12: c = CvtJob{p.nsa_w_o, 1, 1024, 1024, p.wt_nsa_o, 0, nullptr, BIG, 0, 0, 3}; break;
    case 13: c = CvtJob{p.sb_w_qkv, 1, 1024, 3072, p.wt_sb_qkv, 0, nullptr, BIG, 0, 0, 3}; break;
    default: c = CvtJob{p.sb_w_o, 1, 1024, 1024, p.wt_sb_o, 0, nullptr, BIG, 0, 0, 3}; break;
    }
    return c;
}
template <int K, int N, int grp, int grp_stride, int perm>
__device__ __forceinline__ void convert_T_steal(int* ctr, const float* __restrict__ src, bf16_t* __restrict__ dst, int off, int b0) {
    constexpr int nb = 32; constexpr size_t dst_bstride = (size_t)K * N * (grp_stride ? 2 : 1);
    int tid = threadIdx.x; asm volatile("" : "+v"(tid));
    const int lane = tid & 63;
    constexpr int nkt = K >> 7, nnt = N >> 6, per = nkt * nnt, total = nb * per * 4;
    for (;;) {
        int w0 = 0;
        if (lane == 0) w0 = __hip_atomic_fetch_add(ctr, 16, __ATOMIC_RELAXED, __HIP_MEMORY_SCOPE_AGENT);
        w0 = __builtin_amdgcn_readfirstlane(w0);
        if (w0 >= total) break;
#pragma unroll 1
        for (int w = w0; w < w0 + 16; ++w) {
            const int it = w >> 2, wq = w & 3;
            const int bl = it / per, b = b0 + bl, rem = it - bl * per, ktile = rem / nnt, ntile = rem - ktile * nnt;
            const int k0 = (ktile << 7) + (wq * 4 + (lane >> 4)) * 8, n = (ntile << 6) + (lane & 15) * 4;
            const float* sp = src + (size_t)b * K * N + (size_t)k0 * N + n;
            f32x4 v[8];
#pragma unroll
            for (int j = 0; j < 8; ++j) v[j] = *reinterpret_cast<const f32x4*>(sp + (size_t)j * N);
#pragma unroll
            for (int q = 0; q < 4; ++q) {
                const int nn = n + q; int drow = (nn / grp) * grp_stride + off + (nn % grp);
                if (perm == 1) { const int l = drow & 127; drow = (drow & ~127) | (32 * ((l >> 4) & 3) + 16 * (l >> 6) + (l & 15)); }
                if (perm == 3) { const int l = drow & 31; drow = (drow & ~31) | (16 * ((l >> 2) & 1) + 4 * (l >> 3) + (l & 3)); }
                *reinterpret_cast<uint4*>(dst + (size_t)b * dst_bstride + (size_t)drow * K + k0) = cvtpk8(v[0][q], v[1][q], v[2][q], v[3][q], v[4][q], v[5][q], v[6][q], v[7][q]);
            }
        }
    }
}
__device__ __forceinline__ void convert_moe_steal(PRef p, int layer, int which) {
    int* ctr = p.wq + (layer * 3 + which) * 64;
    if (which == 0) convert_T_steal<1024, 512, 128, 256, 3>(ctr, p.moe_w_gate, p.wt_gu, 0, layer * 32);
    else if (which == 1) convert_T_steal<1024, 512, 128, 256, 3>(ctr, p.moe_w_up, p.wt_gu, 128, layer * 32);
    else convert_T_steal<512, 1024, 1 << 30, 0, 3>(ctr, p.moe_w_down, p.wt_dn, 0, layer * 32);
}
__device__ __forceinline__ void convert_moe(PRef p, int layer, int which) {
    if (which == 0) convert_T(nullptr, p.moe_w_gate, 32, 1024, 512, p.wt_gu, (size_t)1024 * 1024, nullptr, 128, 256, 0, layer * 32, 3);
    else if (which == 1) convert_T(nullptr, p.moe_w_up, 32, 1024, 512, p.wt_gu, (size_t)1024 * 1024, nullptr, 128, 256, 128, layer * 32, 3);
    else convert_T(nullptr, p.moe_w_down, 32, 512, 1024, p.wt_dn, (size_t)1024 * 512, nullptr, 1 << 30, 0, 0, layer * 32, 3);
}
__device__ __forceinline__ void ph_prologue(PRef p) {
    unsigned char* lds = VLDS;
    job_mod(p, lds);
    job_misc(p, lds);
    for (int j = 3; j < 15; ++j) {
        const CvtJob c = cvt_job(p, j);
        convert_T(lds, c.src, c.nb, c.K, c.N, c.dst, c.bstride, c.rowscale, c.grp, c.gstride, c.off, 0, c.perm);
    }
    for (int w = 0; w < 2; ++w) convert_moe(p, 0, w);
}

__device__ __forceinline__ void ph_h0(PRef p) {
    const size_t gtid = (size_t)VB * NTHR + VT, gsz = (size_t)NVB * NTHR;
    for (size_t i = gtid; i < (size_t)T_TOK * 128; i += gsz) {
        const int row = (int)(i >> 7), c0 = (int)(i & 127) * 8, b = row >> 11;
        const float* xs = p.x + (size_t)row * 1024 + c0; const float* sh = p.mod + (size_t)b * 3072 + c0; const float* scp = sh + 1024;
        float v[8];
#pragma unroll
        for (int q = 0; q < 8; ++q) v[q] = xs[q] * (1.f + scp[q]) + sh[q];
        *reinterpret_cast<uint4*>(p.hbuf + (size_t)row * 1024 + c0) = pack8(v);
    }
}

__device__ __forceinline__ void st4bf(bf16_t* p, float a, float b, float c, float d) { uint2 pk; pk.x = cvtpk(a, b); pk.y = cvtpk(c, d); *reinterpret_cast<uint2*>(p) = pk; }
__device__ __forceinline__ int vt_pos(int s) { return (s & ~12) | ((s & 4) << 1) | ((s & 8) >> 1); }
__device__ __forceinline__ void st_vt4(bf16_t* vt_feat0  , const g8::f32x4_t& a, float sc) {
#pragma unroll
    for (int q = 0; q < 4; ++q) vt_feat0[(size_t)q * SEQ] = (bf16_t)(cvtpk(a[q] * sc, 0.f) & 0xffffu);
}
struct EpiMlaIn {
    bf16_t* cbuf; float* rss; bf16_t* krope; const float* cosm; const float* sinm;
    __device__ __forceinline__ void operator()(const g8::f32x4_t (&acc)[2][2][4][2], const g8::Unit& u, int wr, int wc, int fr, int fq) const {
        const int lc = 64 * (wc >> 1) + 16 * (wc & 1) + 4 * fq;
#pragma unroll
        for (int ai = 0; ai < 2; ++ai) {
            f32x4 csb[4], snb[4];
            if (u.pn >= 2 && wc < 2) {
#pragma unroll
                for (int m = 0; m < 4; ++m) {
                    const int row = u.pm * 256 + ai * 128 + wr * 64 + m * 16 + fr, i0 = 16 * wc + 4 * fq;
                    csb[m] = *reinterpret_cast<const f32x4*>(cosm + (size_t)row * 32 + i0); snb[m] = *reinterpret_cast<const f32x4*>(sinm + (size_t)row * 32 + i0);
                }
            }
#pragma unroll
            for (int m = 0; m < 4; ++m) {
                const int row = u.pm * 256 + ai * 128 + wr * 64 + m * 16 + fr;
                if (u.pn < 2) {
                    float sq = 0.f;
#pragma unroll
                    for (int bj = 0; bj < 2; ++bj)
#pragma unroll
                        for (int n = 0; n < 2; ++n) {
                            const g8::f32x4_t a = acc[ai][bj][m][n];
                            st4bf(cbuf + (size_t)row * 512 + u.pn * 256 + bj * 128 + lc + 32 * n, a[0], a[1], a[2], a[3]);
                            sq += a[0] * a[0] + a[1] * a[1] + a[2] * a[2] + a[3] * a[3];
                        }
                    sq += __shfl_xor(sq, 16, 64); sq += __shfl_xor(sq, 32, 64);
                    if (fq == 0) rss[(size_t)row * 8 + u.pn * 4 + wc] = sq;
                } else if (wc < 2) {
                    const int i0 = 16 * wc + 4 * fq;
                    const f32x4 cs = csb[m], sn = snb[m];
                    const g8::f32x4_t x1 = acc[ai][0][m][0], x2 = acc[ai][0][m][1];
                    st4bf(krope + (size_t)row * 64 + i0, x1[0] * cs[0] - x2[0] * sn[0], x1[1] * cs[1] - x2[1] * sn[1], x1[2] * cs[2] - x2[2] * sn[2], x1[3] * cs[3] - x2[3] * sn[3]);
                    st4bf(krope + (size_t)row * 64 + 32 + i0, x2[0] * cs[0] + x1[0] * sn[0], x2[1] * cs[1] + x1[1] * sn[1], x2[2] * cs[2] + x1[2] * sn[2], x2[3] * cs[3] + x1[3] * sn[3]);
                }
            }
        }
    }
};
__device__ __forceinline__ void ph_mla_in(PRef p, int j) {
    g8::SchedPlain S; S.init(T_TOK, 768, 1024, p.wt_mla_in + (size_t)j * 768 * 1024, 1024);
    g8::gemm8((LAS unsigned char*)(smem + LDS_WORK), (const char*)p.hbuf, 1024, 1024, S, EpiMlaIn{p.cbuf, p.rss, p.krope, p.cosm, p.sinm});
    __syncthreads();
}
__device__ __forceinline__ float mla_rstd(const float* rss, int row, int which) {
    const f32x4 q = *reinterpret_cast<const f32x4*>(rss + (size_t)row * 8 + which * 4);
    return rsqrtf((q[0] + q[1] + q[2] + q[3]) * (1.f / 256.f) + RMS_EPS);
}
struct EpiMlaQ {
    bf16_t* qm; const float* rss; const float* cosm; const float* sinm;
    __device__ __forceinline__ void operator()(const g8::f32x4_t (&acc)[2][2][4][2], const g8::Unit& u, int wr, int wc, int fr, int fq) const {
        const int i0 = 16 * (wc & 1) + 4 * fq;
#pragma unroll
        for (int ai = 0; ai < 2; ++ai) {
            f32x4 qs[4], csb[4], snb[4];
#pragma unroll
            for (int m = 0; m < 4; ++m) {
                const int row = u.pm * 256 + ai * 128 + wr * 64 + m * 16 + fr;
                qs[m] = *reinterpret_cast<const f32x4*>(rss + (size_t)row * 8);
                csb[m] = *reinterpret_cast<const f32x4*>(cosm + (size_t)row * 32 + i0); snb[m] = *reinterpret_cast<const f32x4*>(sinm + (size_t)row * 32 + i0);
            }
#pragma unroll
            for (int m = 0; m < 4; ++m) {
                const int row = u.pm * 256 + ai * 128 + wr * 64 + m * 16 + fr;
                const float sc = rsqrtf((qs[m][0] + qs[m][1] + qs[m][2] + qs[m][3]) * (1.f / 256.f) + RMS_EPS);
                const f32x4 cs = csb[m], sn = snb[m];
#pragma unroll
                for (int bj = 0; bj < 2; ++bj) {
                    const int c64 = u.pn * 256 + bj * 128 + 64 * (wc >> 1);
                    bf16_t* dst = qm + (size_t)row * 1536 + c64 + i0;
                    const g8::f32x4_t x1 = acc[ai][bj][m][0], x2 = acc[ai][bj][m][1];
                    if ((c64 % 192) == 128) {
                        st4bf(dst, (x1[0] * cs[0] - x2[0] * sn[0]) * sc, (x1[1] * cs[1] - x2[1] * sn[1]) * sc, (x1[2] * cs[2] - x2[2] * sn[2]) * sc, (x1[3] * cs[3] - x2[3] * sn[3]) * sc);
                        st4bf(dst + 32, (x2[0] * cs[0] + x1[0] * sn[0]) * sc, (x2[1] * cs[1] + x1[1] * sn[1]) * sc, (x2[2] * cs[2] + x1[2] * sn[2]) * sc, (x2[3] * cs[3] + x1[3] * sn[3]) * sc);
                    } else {
                        st4bf(dst, x1[0] * sc, x1[1] * sc, x1[2] * sc, x1[3] * sc);
                        st4bf(dst + 32, x2[0] * sc, x2[1] * sc, x2[2] * sc, x2[3] * sc);
                    }
                }
            }
        }
    }
};
struct EpiMlaKv {
    bf16_t* kn; bf16_t* vt; const float* rss;
    __device__ __forceinline__ void operator()(const g8::f32x4_t (&acc)[2][2][4][2], const g8::Unit& u, int wr, int wc, int fr, int fq) const {
        const int hd = u.pn;
#pragma unroll
        for (int ai = 0; ai < 2; ++ai) {
            f32x4 qs[4];
#pragma unroll
            for (int m = 0; m < 4; ++m) qs[m] = *reinterpret_cast<const f32x4*>(rss + (size_t)(u.pm * 256 + ai * 128 + wr * 64 + m * 16 + fr) * 8 + 4);
#pragma unroll
            for (int m = 0; m < 4; ++m) {
                const int row = u.pm * 256 + ai * 128 + wr * 64 + m * 16 + fr, b = row >> 11, sq = row & 2047;
                const float sc = rsqrtf((qs[m][0] + qs[m][1] + qs[m][2] + qs[m][3]) * (1.f / 256.f) + RMS_EPS);
                const int c = 32 * wc + 8 * fq;
                const g8::f32x4_t k0 = acc[ai][0][m][0], k1 = acc[ai][0][m][1];
                *reinterpret_cast<uint4*>(kn + (size_t)row * 1024 + hd * 128 + c) = cvtpk8(k0[0] * sc, k0[1] * sc, k0[2] * sc, k0[3] * sc, k1[0] * sc, k1[1] * sc, k1[2] * sc, k1[3] * sc);
#pragma unroll
                for (int n = 0; n < 2; ++n) st_vt4(vt + ((size_t)(b * 8 + hd) * 128 + c + 4 * n) * SEQ + vt_pos(sq), acc[ai][1][m][n], sc);
            }
        }
    }
};
__device__ __forceinline__ void ph_mla_up(PRef p, int j) {
    { g8::SchedPlain S; S.init(T_TOK, 1536, 512, p.wt_uq + (size_t)j * 1536 * 256, 256);
      g8::gemm8((LAS unsigned char*)(smem + LDS_WORK), (const char*)p.cbuf, 256, 256, S, EpiMlaQ{p.qm, p.rss, p.cosm, p.sinm}); }
    { g8::SchedPlain S; S.init(T_TOK, 2048, 512, p.wt_ukv + (size_t)j * 2048 * 256, 256);
      g8::gemm8((LAS unsigned char*)(smem + LDS_WORK), (const char*)(p.cbuf + 256), 256, 256, S, EpiMlaKv{p.kn, p.vt, p.rss}); }
    __syncthreads();
}
struct EpiNsaIn {
    PRef p;
    __device__ __forceinline__ void operator()(const g8::f32x4_t (&acc)[2][2][4][2], const g8::Unit& u, int wr, int wc, int fr, int fq) const {
        const int i0 = 16 * wc + 4 * fq;
        const bool rot = (u.pn < 5) || u.pn == 6 || u.pn == 8;
#pragma unroll
        for (int ai = 0; ai < 2; ++ai) {
            f32x4 cs[4], sn[4];
            if (rot) {
#pragma unroll
                for (int m = 0; m < 4; ++m) {
                    const int row = u.pm * 256 + ai * 128 + wr * 64 + m * 16 + fr;
                    cs[m] = *reinterpret_cast<const f32x4*>(p.cosn + (size_t)row * 64 + i0); sn[m] = *reinterpret_cast<const f32x4*>(p.sinn + (size_t)row * 64 + i0);
                }
            }
#pragma unroll
            for (int bj = 0; bj < 2; ++bj) {
                const int tn = 2 * u.pn + bj;
                if (tn >= 21) continue;
#pragma unroll
                for (int m = 0; m < 4; ++m) {
                    const int row = u.pm * 256 + ai * 128 + wr * 64 + m * 16 + fr, b = row >> 11, sq = row & 2047;
                    const g8::f32x4_t x1 = acc[ai][bj][m][0], x2 = acc[ai][bj][m][1];
                    if (tn == 20) {
                        if (i0 < 24) {
#pragma unroll
                            for (int q = 0; q < 4; ++q) { const int c = i0 + q; p.gates[(size_t)row * 32 + (c / 3) * 4 + (c % 3)] = sigmoid_f(x1[q]); }
                        }
                        continue;
                    }
                    const int g = (tn - 8) >> 1, kh = (tn - 8) & 1;
                    const size_t slab = (size_t)(b * 2 + kh) * SEQ * 128;
                    if (tn >= 8 && (g == 3 || g == 5)) {
                        bf16_t* vt = (g == 3 ? p.vst : p.vwt) + slab + vt_pos(sq);
                        st_vt4(vt + (size_t)i0 * SEQ, x1, 1.f); st_vt4(vt + (size_t)(i0 + 64) * SEQ, x2, 1.f);
                    } else if (tn >= 8 && g == 1) {
                        bf16_t* dst = p.vc + slab + (size_t)sq * 128 + i0;
                        st4bf(dst, x1[0], x1[1], x1[2], x1[3]); st4bf(dst + 64, x2[0], x2[1], x2[2], x2[3]);
                    } else {
                        bf16_t* dst = (tn < 8) ? p.qn + (size_t)row * 1024 + tn * 128 + i0 : (g == 0 ? p.kc : (g == 2 ? p.ks : p.kw)) + slab + (size_t)sq * 128 + i0;
                        const f32x4 c_ = cs[m], s_ = sn[m];
                        st4bf(dst, x1[0] * c_[0] - x2[0] * s_[0], x1[1] * c_[1] - x2[1] * s_[1], x1[2] * c_[2] - x2[2] * s_[2], x1[3] * c_[3] - x2[3] * s_[3]);
                        st4bf(dst + 64, x2[0] * c_[0] + x1[0] * s_[0], x2[1] * c_[1] + x1[1] * s_[1], x2[2] * c_[2] + x1[2] * s_[2], x2[3] * c_[3] + x1[3] * s_[3]);
                    }
                }
            }
        }
    }
};
__device__ __forceinline__ void ph_nsa_in(PRef p) {
    g8::SchedPlain S; S.init(T_TOK, 2816, 1024, p.wt_nsa_in, 1024);
    g8::gemm8((LAS unsigned char*)(smem + LDS_WORK), (const char*)p.hbuf, 1024, 1024, S, EpiNsaIn{p});
    __syncthreads();
}
struct RowWin { const bf16_t* base; __device__ __forceinline__ const bf16_t* operator()(int r) const { return base + (size_t)r * 2048; } };
__device__ __forceinline__ void ph_nsa_cmp1(PRef p) {
    unsigned char* lds = VLDS; const float* Cs = reinterpret_cast<const float*>(lds);
    for (int it = VB; it < 256; it += NVB) {
        const int item = it >> 3, sp = it & 7, which = item & 1, bkh = item >> 1;
        const bf16_t* src = (which ? p.vc : p.kc) + (size_t)bkh * SEQ * 128 + sp * 512;
        int tid = VT; asm volatile("" : "+v"(tid));
        f32x16 acc[2][2];
        gemm_main(tid, lds, RowWin{src}, (which ? p.wt_cv1 : p.wt_ck1) + sp * 512, 4096, 0, 512, acc);
        float* dst = p.cpart + (size_t)(item * 8 + sp) * 128 * 128;
        const int c0 = (tid & 15) * 8;
#pragma unroll
        for (int ps = 0; ps < 8; ++ps) {
            const int row = (tid >> 4) + 16 * ps;
            *reinterpret_cast<f32x4*>(dst + row * 128 + c0) = *reinterpret_cast<const f32x4*>(Cs + row * CS_LD + c0);
            *reinterpret_cast<f32x4*>(dst + row * 128 + c0 + 4) = *reinterpret_cast<const f32x4*>(Cs + row * CS_LD + c0 + 4);
        }
        ITEM_END_SYNC();
    }
}
__device__ __forceinline__ void ph_nsa_cmp2(PRef p) {
    unsigned char* lds = VLDS; const float* Cs = reinterpret_cast<const float*>(lds);
    for (int item = VB; item < 32; item += NVB) {
        const int which = item & 1, bkh = item >> 1;
        int tid = VT; asm volatile("" : "+v"(tid));
        bf16_t* hid = p.hid + (size_t)item * 128 * 128;
        for (int o = tid; o < 128 * 16; o += NTHR) {
            const int row = o >> 4, c0 = (o & 15) * 8; float v[8];
#pragma unroll
            for (int q = 0; q < 8; ++q) v[q] = p.bias1[which * 128 + c0 + q];
            for (int sp = 0; sp < 8; ++sp) {
                const float* src = p.cpart + (size_t)(item * 8 + sp) * 128 * 128 + row * 128 + c0;
#pragma unroll
                for (int q = 0; q < 8; ++q) v[q] += src[q];
            }
#pragma unroll
            for (int q = 0; q < 8; ++q) v[q] = silu_f(v[q]);
            *reinterpret_cast<uint4*>(hid + row * 128 + c0) = pack8(v);
        }
        __threadfence();
        __syncthreads();
        f32x16 acc[2][2];
        gemm_main(tid, lds, RowPlain{hid, 128}, which ? p.wt_cv2 : p.wt_ck2, 128, 0, 128, acc);
        if (!which) {
            const int c0 = (tid & 15) * 8;
#pragma unroll
            for (int ps = 0; ps < 8; ++ps) {
                const int row = (tid >> 4) + 16 * ps; float v[8]; cs_load8(Cs, row, c0, v);
                if (row == 127) {
#pragma unroll
                    for (int q = 0; q < 8; ++q) v[q] = 0.f; }
                *reinterpret_cast<uint4*>(p.kcmp + (size_t)bkh * 128 * 128 + row * 128 + c0) = pack8(v);
            }
        } else {
            const int dv = tid & 127, sh = tid >> 7;
#pragma unroll
            for (int jj = 0; jj < 8; ++jj) {
                float v[8];
#pragma unroll
                for (int q = 0; q < 8; ++q) { const int row = vt_pos(sh * 64 + jj * 8 + q); v[q] = (row == 127) ? 0.f : Cs[row * CS_LD + dv]; }
                *reinterpret_cast<uint4*>(p.vcmpt + (size_t)bkh * 128 * 128 + dv * 128 + sh * 64 + jj * 8) = pack8(v);
            }
        }
        ITEM_END_SYNC();
    }
}
struct EpiSbIn {
    bf16_t* qs; bf16_t* ksb; bf16_t* vt;
    __device__ __forceinline__ void operator()(const g8::f32x4_t (&acc)[2][2][4][2], const g8::Unit& u, int wr, int wc, int fr, int fq) const {
#pragma unroll
        for (int ai = 0; ai < 2; ++ai)
#pragma unroll
            for (int m = 0; m < 4; ++m) {
                const int row = u.pm * 256 + ai * 128 + wr * 64 + m * 16 + fr, b = row >> 11, sq = row & 2047;
#pragma unroll
                for (int bj = 0; bj < 2; ++bj) {
                    const int c = (u.pn & 3) * 256 + bj * 128 + 32 * wc + 8 * fq;
                    const g8::f32x4_t a = acc[ai][bj][m][0], d = acc[ai][bj][m][1];
                    if (u.pn < 8) *reinterpret_cast<uint4*>((u.pn < 4 ? qs : ksb) + (size_t)row * 1024 + c) = cvtpk8(a[0], a[1], a[2], a[3], d[0], d[1], d[2], d[3]);
                    else { st_vt4(vt + ((size_t)b * 1024 + c) * SEQ + vt_pos(sq), a, 1.f); st_vt4(vt + ((size_t)b * 1024 + c + 4) * SEQ + vt_pos(sq), d, 1.f); }
                }
            }
    }
};
__device__ __forceinline__ void ph_sb_in(PRef p) {
    g8::SchedPlain S; S.init(T_TOK, 3072, 1024, p.wt_sb_qkv, 1024);
    g8::gemm8((LAS unsigned char*)(smem + LDS_WORK), (const char*)p.hbuf, 1024, 1024, S, EpiSbIn{p.qs, p.ksb, p.vt});
    __syncthreads();
}
template <bool XF32> struct EpiWo {
    const float* xs; const f16_t* xh; f16_t* z; const float* mod; int L;
    __device__ __forceinline__ void operator()(const g8::f32x4_t (&acc)[2][2][4][2], const g8::Unit& u, int wr, int wc, int fr, int fq) const {
        const int row0 = u.pm * 256 + wr * 64 + fr, col0 = u.pn * 256 + wc * 32 + 8 * fq, b = (u.pm * 256) >> 11;
        const float* gate = mod + (size_t)((L * 2 + 0) * 8 + b) * 3072 + 2048 + col0;
        f32x4 gv[2][2];
#pragma unroll
        for (int bj = 0; bj < 2; ++bj)
#pragma unroll
            for (int n = 0; n < 2; ++n) gv[bj][n] = *reinterpret_cast<const f32x4*>(gate + bj * 128 + n * 4);
#pragma unroll
        for (int ai = 0; ai < 2; ++ai) {
            f32x4 xv[4][2][2];
#pragma unroll
            for (int m = 0; m < 4; ++m)
#pragma unroll
                for (int bj = 0; bj < 2; ++bj) {
                    const size_t o = (size_t)(row0 + ai * 128 + m * 16) * 1024 + col0 + bj * 128;
                    if (XF32) { xv[m][bj][0] = *reinterpret_cast<const f32x4*>(xs + o); xv[m][bj][1] = *reinterpret_cast<const f32x4*>(xs + o + 4); }
                    else { const f16x8 hx = *reinterpret_cast<const f16x8*>(xh + o); const f32x8 fx = __builtin_convertvector(hx, f32x8); xv[m][bj][0] = (f32x4){fx[0], fx[1], fx[2], fx[3]}; xv[m][bj][1] = (f32x4){fx[4], fx[5], fx[6], fx[7]}; }
                }
#pragma unroll
            for (int m = 0; m < 4; ++m)
#pragma unroll
                for (int bj = 0; bj < 2; ++bj) {
                    f32x8 zv;
#pragma unroll
                    for (int n = 0; n < 2; ++n)
#pragma unroll
                        for (int q = 0; q < 4; ++q) zv[n * 4 + q] = DN_ALPHA * xv[m][bj][n][q] + gv[bj][n][q] * acc[ai][bj][m][n][q];
                    *reinterpret_cast<f16x8*>(z + (size_t)(row0 + ai * 128 + m * 16) * 1024 + col0 + bj * 128) = __builtin_convertvector(zv, f16x8);
                }
        }
    }
};
__device__ __forceinline__ void ph_wo(PRef p, int L) {
    const int kind = L % 3, j = L / 3;
    const bf16_t* Bt = kind == 0 ? p.wt_mla_o + (size_t)j * 1024 * 1024 : (kind == 1 ? p.wt_nsa_o : p.wt_sb_o);
    g8::SchedPlain S; S.init(T_TOK, 1024, 1024, Bt, 1024);
    if (L == 0) g8::gemm8((LAS unsigned char*)(smem + LDS_WORK), (const char*)p.obuf, 1024, 1024, S, EpiWo<true>{p.x, p.xbuf, p.zbuf, p.mod, L});
    else g8::gemm8((LAS unsigned char*)(smem + LDS_WORK), (const char*)p.obuf, 1024, 1024, S, EpiWo<false>{p.x, p.xbuf, p.zbuf, p.mod, L});
}

#define LNC(i) (lane * 8 + 512 * ((i) >> 1) + 4 * ((i) & 1))
__device__ __forceinline__ void ln_row(float (&v)[16], const f32x4 (&gg)[4], const f32x4 (&bb)[4]) {
    float s = 0.f;
#pragma unroll
    for (int q = 0; q < 16; ++q) s += v[q];
    const float mu = wave_sum(s) * (1.f / 1024.f);
    float s2 = 0.f;
#pragma unroll
    for (int q = 0; q < 16; ++q) { const float d = v[q] - mu; s2 += d * d; }
    const float rstd = rsqrtf(wave_sum(s2) * (1.f / 1024.f) + LN_EPS);
#pragma unroll
    for (int i = 0; i < 4; ++i)
#pragma unroll
        for (int q = 0; q < 4; ++q) v[i * 4 + q] = (v[i * 4 + q] - mu) * rstd * gg[i][q] + bb[i][q];
}
__device__ __forceinline__ void ld8h_f(const uint4& w, float* v) { const f32x8 f = __builtin_convertvector(*reinterpret_cast<const f16x8*>(&w), f32x8);
#pragma unroll
    for (int q = 0; q < 8; ++q) v[q] = f[q]; }
__device__ __forceinline__ uint4 pk8h(const float* v) { f32x8 f;
#pragma unroll
    for (int q = 0; q < 8; ++q) f[q] = v[q];
    const f16x8 hh = __builtin_convertvector(f, f16x8); return *reinterpret_cast<const uint4*>(&hh); }
__device__ __forceinline__ void ph_lna(PRef p, int L, bool dry = false) {
    unsigned char* lds = VLDS;
    float* hs = reinterpret_cast<float*>(lds);
    float* part = reinterpret_cast<float*>(lds + 16 * 1028 * 4);
    int* lcnt = reinterpret_cast<int*>(lds + 78080); int* lbase = lcnt + 32; int* rexp = lcnt + 64; int* rslot = lcnt + 96; float* rwt = reinterpret_cast<float*>(lcnt + 128);
    if (VT < 32) lcnt[VT] = 0;
    __syncthreads();
    int tid = VT; asm volatile("" : "+v"(tid));
    const int lane = tid & 63, wid = tid >> 6;
    const float* g = p.ln_g + (size_t)(L * 2 + 0) * 1024; const float* bt = p.ln_b + (size_t)(L * 2 + 0) * 1024;
    const float* wr = p.wr + (size_t)L * 1024 * 48;
    int* cnt = p.cnt + L * 32 * 64;
    f32x4 lg[4], lb[4];
#pragma unroll
    for (int i = 0; i < 4; ++i) { lg[i] = *reinterpret_cast<const f32x4*>(g + LNC(i)); lb[i] = *reinterpret_cast<const f32x4*>(bt + LNC(i)); }
    for (int it = VB; it < T_TOK / 16; it += NVB) {
        const int R0 = it * 16, b = R0 >> 11;
        const float* md = p.mod + (size_t)((L * 2 + 1) * 8 + b) * 3072;
        f32x4 shv[4], scv[4];
#pragma unroll
        for (int i = 0; i < 4; ++i) { shv[i] = *reinterpret_cast<const f32x4*>(md + LNC(i)); scv[i] = *reinterpret_cast<const f32x4*>(md + 1024 + LNC(i)); }
        uint4 zr[2];
#pragma unroll
        for (int k = 0; k < 2; ++k) zr[k] = *reinterpret_cast<const uint4*>(p.zbuf + (size_t)(R0 + wid * 4) * 1024 + LNC(2 * k));
#pragma unroll 1
        for (int rr = 0; rr < 4; ++rr) {
            const int lrow = wid * 4 + rr, row = R0 + lrow;
            float v[16];
            ld8h_f(zr[0], v); ld8h_f(zr[1], v + 8);
            if (rr < 3) {
#pragma unroll
                for (int k = 0; k < 2; ++k) zr[k] = *reinterpret_cast<const uint4*>(p.zbuf + (size_t)(row + 1) * 1024 + LNC(2 * k));
            }
            ln_row(v, lg, lb);
#pragma unroll
            for (int k = 0; k < 2; ++k) {
                *reinterpret_cast<uint4*>((dry ? reinterpret_cast<f16_t*>(p.ybuf) : p.xbuf) + (size_t)row * 1024 + LNC(2 * k)) = pk8h(v + 8 * k);
                float hv[8];
#pragma unroll
                for (int q = 0; q < 8; ++q) hv[q] = v[8 * k + q] * (1.f + scv[2 * k + (q >> 2)][q & 3]) + shv[2 * k + (q >> 2)][q & 3];
                *reinterpret_cast<f32x4*>(hs + lrow * 1028 + LNC(2 * k)) = (f32x4){hv[0], hv[1], hv[2], hv[3]};
                *reinterpret_cast<f32x4*>(hs + lrow * 1028 + LNC(2 * k + 1)) = (f32x4){hv[4], hv[5], hv[6], hv[7]};
                *reinterpret_cast<uint4*>((dry ? p.hmoe : p.hbuf) + (size_t)row * 1024 + LNC(2 * k)) = cvtpk8(hv[0], hv[1], hv[2], hv[3], hv[4], hv[5], hv[6], hv[7]);
            }
        }
        __syncthreads();
        {
            f32x4 a0 = {0.f, 0.f, 0.f, 0.f}, a1 = a0, a2 = a0;
            const int rl = lane & 15, kq = lane >> 4;
#pragma unroll 32
            for (int kk = 0; kk < 64; ++kk) {
                const int k = wid * 256 + kk * 4 + kq;
                const float a = hs[rl * 1028 + k];
                const float* wp = wr + (size_t)k * 48 + rl;
                a0 = __builtin_amdgcn_mfma_f32_16x16x4f32(a, wp[0], a0, 0, 0, 0);
                a1 = __builtin_amdgcn_mfma_f32_16x16x4f32(a, wp[16], a1, 0, 0, 0);
                a2 = __builtin_amdgcn_mfma_f32_16x16x4f32(a, wp[32], a2, 0, 0, 0);
            }
#pragma unroll
            for (int q = 0; q < 4; ++q) {
                const int row = kq * 4 + q;
                part[(wid * 16 + row) * 48 + rl] = a0[q]; part[(wid * 16 + row) * 48 + 16 + rl] = a1[q]; part[(wid * 16 + row) * 48 + 32 + rl] = a2[q];
            }
        }
        __syncthreads();
        if (tid < 16) {
            const int row = R0 + tid;
            auto LG = [&](int e) { return part[(0 * 16 + tid) * 48 + e] + part[(1 * 16 + tid) * 48 + e] + part[(2 * 16 + tid) * 48 + e] + part[(3 * 16 + tid) * 48 + e]; };
            const float g0 = LG(0) + p.moe_b_grp[L * 4 + 0], g1 = LG(1) + p.moe_b_grp[L * 4 + 1], g2 = LG(2) + p.moe_b_grp[L * 4 + 2], g3 = LG(3) + p.moe_b_grp[L * 4 + 3];
            int gi = 0; float gm = g0;
            if (g1 > gm) { gm = g1; gi = 1; }
            if (g2 > gm) { gm = g2; gi = 2; }
            if (g3 > gm) { gm = g3; gi = 3; }
            const float gw = 1.f / (expf(g0 - gm) + expf(g1 - gm) + expf(g2 - gm) + expf(g3 - gm));
            int i1 = 0, i2 = 0; float m1 = -3.0e38f, m2 = -3.0e38f;
            for (int e = 0; e < 8; ++e) {
                const float v = LG(4 + gi * 8 + e) + p.moe_b_rt[L * 32 + gi * 8 + e];
                if (v > m1) { m2 = m1; i2 = i1; m1 = v; i1 = e; }
                else if (v > m2) { m2 = v; i2 = e; }
            }
            const float r = expf(m2 - m1);
            const float w1 = gw / (1.f + r), w2 = gw * r / (1.f + r);
            const int e1 = gi * 8 + i1, e2 = gi * 8 + i2;
            rwt[tid * 2] = w1; rwt[tid * 2 + 1] = w2;
            rexp[tid * 2] = e1; rexp[tid * 2 + 1] = e2;
            rslot[tid * 2] = atomicAdd(&lcnt[e1], 1); rslot[tid * 2 + 1] = atomicAdd(&lcnt[e2], 1);
        }
        __syncthreads();
        if (tid < 32) { const int c = lcnt[tid]; lbase[tid] = (c && !dry) ? atomicAdd(&cnt[tid * 64], c) : 0; lcnt[tid] = 0; }
        __syncthreads();
        if (tid < 32 && !dry) { const int e = rexp[tid]; const size_t o = (size_t)e * T_TOK + lbase[e] + rslot[tid]; p.list[o] = (R0 + (tid >> 1)) * 2 + (tid & 1); p.listw[o] = rwt[tid]; }
        __syncthreads();
    }
}
__device__ __forceinline__ void ph_lnb(PRef p, int L, bool dry = false) {
    int tid = VT; asm volatile("" : "+v"(tid));
    const int lane = tid & 63, wid = tid >> 6;
    const float* g = p.ln_g + (size_t)(L * 2 + 1) * 1024; const float* bt = p.ln_b + (size_t)(L * 2 + 1) * 1024;
    const bool last = (L == DEPTH - 1);
    f32x4 lg[4], lb[4];
#pragma unroll
    for (int i = 0; i < 4; ++i) { lg[i] = *reinterpret_cast<const f32x4*>(g + LNC(i)); lb[i] = *reinterpret_cast<const f32x4*>(bt + LNC(i)); }
    constexpr int RW = T_TOK / 2048;
    static_assert(2048 % RW == 0, "a wave's rows stay inside one batch element");
    for (int w0 = VB * 4 + wid; w0 * RW < T_TOK; w0 += NVB * 4) {
        const int row0 = w0 * RW, b = row0 >> 11;
        const float* gate = p.mod + (size_t)((L * 2 + 1) * 8 + b) * 3072 + 2048;
        const float* md = p.mod + (size_t)(((last ? L : L + 1) * 2 + 0) * 8 + b) * 3072;
        f32x4 gv[4], sh[4], sc[4];
#pragma unroll
        for (int i = 0; i < 4; ++i) { const int c = LNC(i); gv[i] = *reinterpret_cast<const f32x4*>(gate + c); if (!last) { sh[i] = *reinterpret_cast<const f32x4*>(md + c); sc[i] = *reinterpret_cast<const f32x4*>(md + 1024 + c); } }
        uint4 xr[2], y0[2], y1[2];
        auto issue = [&](int row) {
#pragma unroll
            for (int k = 0; k < 2; ++k) {
                const int c = LNC(2 * k);
                xr[k] = *reinterpret_cast<const uint4*>(p.xbuf + (size_t)row * 1024 + c);
                y0[k] = *reinterpret_cast<const uint4*>(p.ybuf + (size_t)(row * 2) * 1024 + c); y1[k] = *reinterpret_cast<const uint4*>(p.ybuf + (size_t)(row * 2 + 1) * 1024 + c);
            }
        };
        issue(row0);
#pragma unroll 1
        for (int ri = 0; ri < RW; ++ri) {
            const int row = row0 + ri;
            float v[16];
#pragma unroll
            for (int k = 0; k < 2; ++k) {
                float xv[8]; ld8h_f(xr[k], xv);
                const unsigned a0[4] = {y0[k].x, y0[k].y, y0[k].z, y0[k].w}, a1[4] = {y1[k].x, y1[k].y, y1[k].z, y1[k].w};
#pragma unroll
                for (int q = 0; q < 8; ++q) {
                    const unsigned w0 = a0[q >> 1], w1 = a1[q >> 1];
                    const float ys = (q & 1) ? (bf2f(w0 >> 16) + bf2f(w1 >> 16)) : (bf2f(w0 & 0xffffu) + bf2f(w1 & 0xffffu));
                    v[8 * k + q] = DN_ALPHA * xv[q] + gv[2 * k + (q >> 2)][q & 3] * ys;
                }
            }
            if (ri + 1 < RW) issue(row + 1);
            ln_row(v, lg, lb);
            if (last) {
#pragma unroll
                for (int i = 0; i < 4; ++i) *reinterpret_cast<f32x4*>((dry ? reinterpret_cast<float*>(p.zbuf) : p.out) + (size_t)row * 1024 + LNC(i)) = (f32x4){v[i * 4], v[i * 4 + 1], v[i * 4 + 2], v[i * 4 + 3]};
            } else {
#pragma unroll
                for (int k = 0; k < 2; ++k) {
                    const int c = LNC(2 * k);
                    *reinterpret_cast<uint4*>((dry ? p.zbuf : p.xbuf) + (size_t)row * 1024 + c) = pk8h(v + 8 * k);
                    float hv[8];
#pragma unroll
                    for (int q = 0; q < 8; ++q) hv[q] = v[8 * k + q] * (1.f + sc[2 * k + (q >> 2)][q & 3]) + sh[2 * k + (q >> 2)][q & 3];
                    *reinterpret_cast<uint4*>((dry ? p.obuf : p.hbuf) + (size_t)row * 1024 + c) = cvtpk8(hv[0], hv[1], hv[2], hv[3], hv[4], hv[5], hv[6], hv[7]);
                }
            }
        }
    }
}
#undef LNC

struct RowGather { const bf16_t* hb; const int* lst; int base, n; __device__ __forceinline__ const bf16_t* operator()(int r) const { const int idx = base + r; const int tok = (idx < n) ? (lst[idx] >> 1) : 0; return hb + (size_t)tok * 1024; } };
constexpr int G8_PRE_OFF = LDS_WORK + 131072;
__device__ __forceinline__ const int* moe_prefix256(const int* cnt) {
    int* pre = reinterpret_cast<int*>(smem + G8_PRE_OFF);
    int t_ = threadIdx.x; asm volatile("" : "+v"(t_));
    if (t_ == 0) { int s = 0; for (int e = 0; e < 32; ++e) { pre[e] = s; s += (cnt[e * 64] + 255) >> 8; } pre[32] = s; }
    if (t_ >= 64 && t_ < 96) pre[48 + t_ - 64] = cnt[(t_ - 64) * 64];
    __syncthreads();
    return pre;
}
struct EpiMoeA {
    bf16_t* hmoe;
    __device__ __forceinline__ void operator()(const g8::f32x4_t (&acc)[2][2][4][2], const g8::Unit& u, int wr, int wc, int fr, int fq) const {
#pragma unroll
        for (int ai = 0; ai < 2; ++ai)
#pragma unroll
            for (int m = 0; m < 4; ++m) {
                bf16_t* rowp = hmoe + (size_t)(u.pm * 256 + ai * 128 + wr * 64 + m * 16 + fr) * 512 + u.pn * 128 + wc * 32 + fq * 8;
                float hv[8];
#pragma unroll
                for (int n = 0; n < 2; ++n) {
                    const g8::f32x4_t g = acc[ai][0][m][n], up = acc[ai][1][m][n];
#pragma unroll
                    for (int q = 0; q < 4; ++q) hv[n * 4 + q] = silu_f(g[q]) * up[q];
                }
                *reinterpret_cast<uint4*>(rowp) = cvtpk8(hv[0], hv[1], hv[2], hv[3], hv[4], hv[5], hv[6], hv[7]);
            }
    }
};
__device__ __forceinline__ void ph_moe_a(PRef p, int L) {
    const int* cnt = p.cnt + L * 32 * 64;
    const int* pre = moe_prefix256(cnt);
    g8::SchedMoe S{pre, p.list, p.listw, (const char*)(p.wt_gu + (size_t)L * 32 * 1024 * 1024), (size_t)1024 * 1024 * 2, (size_t)256 * 1024 * 2, pre[32] * 4, (int)gridDim.x, (int)blockIdx.x, 1, reinterpret_cast<int*>(smem + G8_PRE_OFF + 512)};
    g8::gemm8((LAS unsigned char*)(smem + LDS_WORK), (const char*)p.hbuf, 1024, 1024, S, EpiMoeA{p.hmoe});
    __syncthreads();
}
struct EpiMoeB {
    const int* pre; const int* tab; bf16_t* ybuf;
    __device__ __forceinline__ void operator()(const g8::f32x4_t (&acc)[2][2][4][2], const g8::Unit& u, int wr, int wc, int fr, int fq) const {
        int e = 0; for (int q = 1; q < 32; ++q) e = (pre[q] <= u.pm) ? q : e;
        const int n = pre[48 + e] - (u.pm - pre[e]) * 256, r0 = wr * 64 + fr;
        const int col0 = u.pn * 256 + wc * 32 + fq * 8;
        const int* tb = tab + u.par * 512;
        asm volatile("" ::: "memory");
#pragma unroll
        for (int ai = 0; ai < 2; ++ai) {
#pragma unroll
            for (int m = 0; m < 4; ++m) {
                const int r = r0 + ai * 128 + m * 16;
                if (r < n) {
                    const int ent = tb[r]; const float ww = __int_as_float(tb[256 + r]);
                    bf16_t* rowp = ybuf + (size_t)ent * 1024 + col0;
#pragma unroll
                    for (int bj = 0; bj < 2; ++bj) {
                        const g8::f32x4_t a = acc[ai][bj][m][0], c = acc[ai][bj][m][1];
                        *reinterpret_cast<uint4*>(rowp + bj * 128) = cvtpk8(a[0] * ww, a[1] * ww, a[2] * ww, a[3] * ww, c[0] * ww, c[1] * ww, c[2] * ww, c[3] * ww);
                    }
                }
            }
        }
    }
};
__device__ __forceinline__ void ph_moe_b(PRef p, int L) {
    const int* cnt = p.cnt + L * 32 * 64;
    const int* pre = moe_prefix256(cnt);
    g8::SchedMoe S{pre, p.list, p.listw, (const char*)(p.wt_dn + (size_t)L * 32 * 1024 * 512), (size_t)1024 * 512 * 2, (size_t)256 * 512 * 2, pre[32] * 4, (int)gridDim.x, (int)blockIdx.x, 0, reinterpret_cast<int*>(smem + G8_PRE_OFF + 512)};
    g8::gemm8((LAS unsigned char*)(smem + LDS_WORK), (const char*)p.hmoe, 512, 512, S, EpiMoeB{pre, reinterpret_cast<const int*>(smem + G8_PRE_OFF + 512), p.ybuf});
    __syncthreads();
}

__device__ __forceinline__ void dma16_asm(const void* g, const unsigned char* lds_wave_base) {
    const unsigned m = __builtin_amdgcn_readfirstlane((unsigned)(size_t)(LAS const unsigned char*)lds_wave_base);
    asm volatile("s_mov_b32 m0, %1\n\ts_nop 0\n\tglobal_load_lds_dwordx4 %0, off" :: "v"(g), "s"(m) : "memory", "m0");
}
__device__ __forceinline__ unsigned lds_addr(const unsigned char* p) { return (unsigned)(size_t)(LAS const unsigned char*)p; }
__device__ __forceinline__ bf16x8 lds_ld128(unsigned a) { return *(const LAS bf16x8*)(size_t)a; }
__device__ __forceinline__ void dma16_asm_s(const void* ubase, unsigned voff, const unsigned char* lds_wave_base) {
    const unsigned m = __builtin_amdgcn_readfirstlane((unsigned)(size_t)(LAS const unsigned char*)lds_wave_base);
    asm volatile("s_mov_b32 m0, %2\n\ts_nop 0\n\tglobal_load_lds_dwordx4 %0, %1" :: "v"(voff), "s"(ubase), "s"(m) : "memory", "m0");
}
template <int DQK, int KT> struct AT {
    static constexpr int KB = KT / 32, NKK = DQK / 16;
    static constexpr bool ROPE = (DQK == 192);
    static constexpr int K_BYTES = KT * 256, KR_BYTES = ROPE ? KT * 128 : 0, V_BYTES = 256 * KT, STAGE = K_BYTES + KR_BYTES + V_BYTES;
    static constexpr int VRB = KT * 2;
    static __device__ __forceinline__ void dma(int tid, unsigned char* st, const bf16_t* kp  , size_t ldk, const bf16_t* krp  , const bf16_t* vp  , size_t ldv) {
        const int wid = tid >> 6, l = tid & 63;
#pragma unroll
        for (int i = 0; i < KT / 16; ++i) {
            const int pi = wid + 4 * i, row = 4 * pi + (l >> 4), c = (l & 15) ^ (row & 15);
            dma16_asm_s(kp, (unsigned)(row * (int)ldk + c * 8) * 2u, st + pi * 1024);
        }
        if (ROPE) {
            const int pi = wid, row = 8 * pi + (l >> 3), c = (l & 7) ^ ((row >> 1) & 7);
            dma16_asm_s(krp, (unsigned)(row * 64 + c * 8) * 2u, st + K_BYTES + pi * 1024);
        }
#pragma unroll
        for (int i = 0; i < KT / 16; ++i) {
            const int pi = wid + 4 * i;
            int row, c;
            if (KT == 64) { row = 8 * pi + (l >> 3); c = (l & 7) ^ ((row >> 1) & 7); }
            else          { row = 16 * pi + (l >> 2); c = (l & 3) ^ ((row >> 2) & 3); }
            dma16_asm_s(vp, (unsigned)(row * (int)ldv + c * 8) * 2u, st + K_BYTES + KR_BYTES + pi * 1024);
        }
    }
    static __device__ __forceinline__ void kload(const unsigned char* st, int kb, bf16x8 (&kf)[NKK], int r, int h) {
        const int row = kb * 32 + r, m = r & 15, m2 = (r >> 1) & 7;
        const unsigned a0 = lds_addr(st) + row * 256 + ((((m & ~1) | (h ^ (m & 1)))) << 4);
#pragma unroll
        for (int kk = 0; kk < 8; ++kk) kf[kk] = lds_ld128(a0 ^ (kk << 5));
        if (ROPE) {
            const unsigned a1 = lds_addr(st) + K_BYTES + row * 128 + ((((m2 & ~1) | (h ^ (m2 & 1)))) << 4);
#pragma unroll
            for (int kk = 0; kk < 4; ++kk) kf[8 + kk] = lds_ld128(a1 ^ (kk << 5));
        }
    }
    static __device__ __forceinline__ f32x16 qk_mma(const bf16x8 (&kf)[NKK], const bf16x8* qf) {
        f32x16 s;
#pragma unroll
        for (int q = 0; q < 16; ++q) s[q] = 0.f;
#pragma unroll
        for (int kk = 0; kk < NKK; ++kk) s = MFMA32(kf[kk], qf[kk], s);
        return s;
    }
    static __device__ __forceinline__ f32x16 qk(const unsigned char* st, int kb, const bf16x8* qf, int r, int h) {
        f32x16 s;
#pragma unroll
        for (int q = 0; q < 16; ++q) s[q] = 0.f;
        const int row = kb * 32 + r;
#pragma unroll
        for (int kk = 0; kk < 8; ++kk) s = MFMA32(lds_frag(st, row * 256 + (((2 * kk + h) ^ (r & 15)) << 4)), qf[kk], s);
        return s;
    }
    static __device__ __forceinline__ void vload(const unsigned char* st, int ks, bf16x8 (&vf)[4], int r, int h) {
        const int swz = (KT == 64) ? ((r >> 1) & 7) : ((r >> 2) & 3);
        const unsigned v0 = lds_addr(st) + K_BYTES + KR_BYTES + r * VRB + ((swz ^ h) << 4);
#pragma unroll
        for (int dvb = 0; dvb < 4; ++dvb) vf[dvb] = lds_ld128((v0 ^ ((2 * ks) << 4)) + dvb * 32 * VRB);
    }
    static __device__ __forceinline__ void pv_mma(f32x16 (&o)[4], const bf16x8 (&vf)[4], bf16x8 pf) {
#pragma unroll
        for (int dvb = 0; dvb < 4; ++dvb) o[dvb] = MFMA32(vf[dvb], pf, o[dvb]);
    }
    static __device__ __forceinline__ void pv(const unsigned char* st, f32x16 (&o)[4], int ks, bf16x8 pf, int r, int h) {
        bf16x8 vf[4];
        vload(st, ks, vf, r, h);
        pv_mma(o, vf, pf);
    }
};
struct HalfBar { volatile LAS unsigned* ctr; unsigned target; };
__device__ __forceinline__ void half_bar(HalfBar& hb, int lane) {
    asm volatile("s_waitcnt lgkmcnt(0)" ::: "memory");
    hb.target += 4u;
    if (lane == 0) __hip_atomic_fetch_add((LAS unsigned*)hb.ctr, 1u, __ATOMIC_RELAXED, __HIP_MEMORY_SCOPE_WORKGROUP);
    while ((unsigned)__builtin_amdgcn_readfirstlane((int)*hb.ctr) < hb.target) __builtin_amdgcn_s_sleep(1);
    asm volatile("" ::: "memory");
}
#define DMA_WAIT_SYNC() do { asm volatile("s_waitcnt vmcnt(0)" ::: "memory"); __syncthreads(); } while (0)
__device__ __forceinline__ bf16x8 pfrag(const f32x16& s, int half) {
    const int b = half * 8;
    uint4 w = cvtpk8(s[b + 0], s[b + 1], s[b + 2], s[b + 3], s[b + 4], s[b + 5], s[b + 6], s[b + 7]);
    return *reinterpret_cast<bf16x8*>(&w);
}
template <int NKK> __device__ __forceinline__ void load_q(bf16x8 (&qf)[NKK], const bf16_t* qrow, int h) {
#pragma unroll
    for (int kk = 0; kk < NKK; ++kk) qf[kk] = *reinterpret_cast<const bf16x8*>(qrow + kk * 16 + h * 8);
}
__device__ __forceinline__ void store_pk16(bf16_t* orow, int dvb, int gp, uint2 X  , uint2 Y  , int h) {
    auto r0 = __builtin_amdgcn_permlane32_swap(X.x, Y.x, false, false), r1 = __builtin_amdgcn_permlane32_swap(X.y, Y.y, false, false);
    uint4 w; w.x = r0[0]; w.y = r1[0]; w.z = r0[1]; w.w = r1[1];
    *reinterpret_cast<uint4*>(orow + dvb * 32 + 8 * (2 * gp + h)) = w;
}
__device__ __forceinline__ void store_o(const f32x16 (&o)[4], bf16_t* orow, int h, float scale) {
#pragma unroll
    for (int dvb = 0; dvb < 4; ++dvb)
#pragma unroll
        for (int gp = 0; gp < 2; ++gp) {
            const int a = 8 * gp, c = 8 * gp + 4;
            uint2 X, Y;
            X.x = cvtpk(o[dvb][a] * scale, o[dvb][a + 1] * scale); X.y = cvtpk(o[dvb][a + 2] * scale, o[dvb][a + 3] * scale);
            Y.x = cvtpk(o[dvb][c] * scale, o[dvb][c + 1] * scale); Y.y = cvtpk(o[dvb][c + 2] * scale, o[dvb][c + 3] * scale);
            store_pk16(orow, dvb, gp, X, Y, h);
        }
}

template <int DQK, int KT, int MODE>
__device__ __forceinline__ void flash_loop(int tid, unsigned char* lds, const bf16x8* qf, f32x16 (&o)[4], float& m_run, float& l_half,
                                           const bf16_t* kbase, size_t ldk, const bf16_t* krbase, const bf16_t* vtbase, size_t ldv,
                                           int kt_lo, int kt_hi, int t  , int tw_min, int tw_max  , unsigned selmask, float C, int key_off = 0, HalfBar* hbp = nullptr) {
    typedef AT<DQK, KT> A;
    constexpr bool RING3 = (KT == 32);
    constexpr int NDMA = KT / 16 + KT / 16 + (DQK == 192 ? 1 : 0);
    auto tile_dma = [&](int stage, int kt) { A::dma(tid, lds + stage * A::STAGE, kbase + (size_t)kt * KT * ldk, ldk, krbase ? krbase + (size_t)kt * KT * 64 : nullptr, vtbase + (size_t)kt * KT, ldv); };
    if (RING3) { __builtin_amdgcn_s_waitcnt(0x0F70); tile_dma(0, kt_lo); if (kt_lo + 1 <= kt_hi) tile_dma(1, kt_lo + 1); }
    else { tile_dma(0, kt_lo); __builtin_amdgcn_s_waitcnt(0x0F70); __syncthreads(); }
    int stc = 0, stn = 2;
    for (int kt = kt_lo; kt <= kt_hi; ++kt) {
        asm volatile("" : "+v"(tid));
        const int lane = tid & 63, r = lane & 31, h = lane >> 5;
        const bool more = kt < kt_hi;
        const unsigned char* st;
        if (RING3) {
            if (more) { static_assert(!RING3 || NDMA == 5, "counted wait below is written for 5 DMA instructions per tile"); asm volatile("s_waitcnt vmcnt(5)" ::: "memory"); }
            else asm volatile("s_waitcnt vmcnt(0)" ::: "memory");
            if (hbp) half_bar(*hbp, lane); else __builtin_amdgcn_s_barrier();
            asm volatile("" ::: "memory");
            if (kt + 2 <= kt_hi) tile_dma(stn, kt + 2);
            st = lds + stc * A::STAGE;
            stc = (stc == 2) ? 0 : stc + 1; stn = (stn == 2) ? 0 : stn + 1;
        } else {
            const int cur = (kt - kt_lo) & 1;
            if (more) tile_dma(cur ^ 1, kt + 1);
            st = lds + cur * A::STAGE;
        }
        const int key0 = key_off + kt * KT;
        bool active = (key0 <= tw_max);
        if (MODE == 2) active = active && (key0 + KT - 1 > tw_min - 512);
        if (active) {
            f32x16 s[A::KB];
            bf16x8 vf[2][4];
            if constexpr (KT == 32) {
                bf16x8 kf[A::NKK];
                A::kload(st, 0, kf, r, h);
                __builtin_amdgcn_sched_barrier(0);
                s[0] = A::qk_mma(kf, qf);
                __builtin_amdgcn_sched_barrier(0);
                A::vload(st, 0, vf[0], r, h); A::vload(st, 1, vf[1], r, h);
            } else {
#pragma unroll
                for (int kb = 0; kb < A::KB; ++kb) s[kb] = A::qk(st, kb, qf, r, h);
            }
            const bool need_mask = (MODE == 1) || (key0 + KT - 1 > tw_min) || (MODE == 2 && key0 <= tw_max - 512);
            if (MODE == 1 && !(key0 + KT - 1 > tw_min)) {
                static_assert(MODE != 1 || KT == 64, "selected branch: tile = selection block");
                asm volatile("" ::: "memory");
                const float drop = ((selmask >> (key0 >> 6)) & 1u) ? 0.f : -__builtin_inff();
#pragma unroll
                for (int kb = 0; kb < A::KB; ++kb)
#pragma unroll
                    for (int q = 0; q < 16; ++q) s[kb][q] += drop;
            } else if (need_mask) {
                asm volatile("" ::: "memory");
#pragma unroll
                for (int kb = 0; kb < A::KB; ++kb)
#pragma unroll
                    for (int q = 0; q < 16; ++q) {
                        const int key = key0 + kb * 32 + crow(q, h);
                        bool ok = key <= t;
                        if (MODE == 1) ok = ok && ((selmask >> (key >> 6)) & 1u);
                        if (MODE == 2) ok = ok && (t - key < 512);
                        s[kb][q] = ok ? s[kb][q] : -__builtin_inff();
                    }
            }
            float mx = -__builtin_inff();
#pragma unroll
            for (int kb = 0; kb < A::KB; ++kb)
#pragma unroll
                for (int q = 0; q < 16; ++q) mx = fmaxf(mx, s[kb][q]);
            mx = xh_max(mx) * C;
            if (__any(mx > m_run + 8.f)) {
                const float mn = fmaxf(m_run, mx);
                const float alpha = __builtin_amdgcn_exp2f(m_run - mn);
                m_run = mn;
                l_half *= alpha;
#pragma unroll
                for (int dvb = 0; dvb < 4; ++dvb)
#pragma unroll
                    for (int q = 0; q < 16; ++q) o[dvb][q] *= alpha;
            }
            const float nm = -m_run;
            float ps = 0.f;
#pragma unroll
            for (int kb = 0; kb < A::KB; ++kb)
#pragma unroll
                for (int q = 0; q < 16; ++q) { const float e = __builtin_amdgcn_exp2f(__builtin_fmaf(s[kb][q], C, nm)); s[kb][q] = e; ps += e; }
            l_half += ps;
            if constexpr (KT == 32) { A::pv_mma(o, vf[0], pfrag(s[0], 0)); A::pv_mma(o, vf[1], pfrag(s[0], 1)); }
            else {
#pragma unroll
                for (int kb = 0; kb < A::KB; ++kb) { A::pv(st, o, kb * 2, pfrag(s[kb], 0), r, h); A::pv(st, o, kb * 2 + 1, pfrag(s[kb], 1), r, h); }
            }
        }
        if (!RING3) DMA_WAIT_SYNC();
    }
    if (RING3) { if (hbp) half_bar(*hbp, tid & 63); else __syncthreads(); }
}

__device__ __forceinline__ void mla_flash(int tid0, unsigned char* lds, const bf16x8* qf, f32x16 (&o)[4], float& m_run, float& l_half,
                                          const bf16_t* kbase, const bf16_t* krbase, const bf16_t* vtbase, int kt_hi, int t, int tw_min, float C) {
    typedef AT<192, 32> A;
    constexpr int KST = A::K_BYTES + A::KR_BYTES, VST = A::V_BYTES;
    static_assert(3 * KST + 4 * VST <= HALF_LDS, "rings");
    unsigned char* kring = lds; unsigned char* vring = lds + 3 * KST;
    auto tile_dma = [&](int tid, int kt) {
        unsigned char* ks = kring + (kt % 3) * KST; unsigned char* vs = vring + (kt & 3) * VST;
        const bf16_t* kp = kbase + (size_t)kt * 32 * 1024; const bf16_t* krp = krbase + (size_t)kt * 32 * 64; const bf16_t* vp = vtbase + (size_t)kt * 32;
        const int wid = tid >> 6, l = tid & 63;
#pragma unroll
        for (int i = 0; i < 2; ++i) { const int pi = wid + 4 * i, row = 4 * pi + (l >> 4), c = (l & 15) ^ (row & 15); dma16_asm_s(kp, (unsigned)(row * 1024 + c * 8) * 2u, ks + pi * 1024); }
        { const int pi = wid, row = 8 * pi + (l >> 3), c = (l & 7) ^ ((row >> 1) & 7); dma16_asm_s(krp, (unsigned)(row * 64 + c * 8) * 2u, ks + A::K_BYTES + pi * 1024); }
#pragma unroll
        for (int i = 0; i < 2; ++i) { const int pi = wid + 4 * i, row = 16 * pi + (l >> 2), c = (l & 3) ^ ((row >> 2) & 3); dma16_asm_s(vp, (unsigned)(row * SEQ + c * 8) * 2u, vs + pi * 1024); }
    };
    auto finish = [&](f32x16& sv, float mxraw, int kt, int h) {
        const int key0 = kt * 32;
        if (key0 + 31 > tw_min) {
            asm volatile("" ::: "memory");
            mxraw = -__builtin_inff();
#pragma unroll
            for (int q = 0; q < 16; ++q) { sv[q] = (key0 + crow(q, h) <= t) ? sv[q] : -__builtin_inff(); mxraw = fmaxf(mxraw, sv[q]); }
        }
        const float mx = xh_max(mxraw) * C;
        if (__any(mx > m_run + 8.f)) {
            const float mn = fmaxf(m_run, mx);
            const float alpha = __builtin_amdgcn_exp2f(m_run - mn);
            m_run = mn; l_half *= alpha;
#pragma unroll
            for (int dvb = 0; dvb < 4; ++dvb)
#pragma unroll
                for (int q = 0; q < 16; ++q) o[dvb][q] *= alpha;
        }
    };
    f32x16 sc;
    {
        int tid = tid0; asm volatile("" : "+v"(tid));
        tile_dma(tid, 0); if (kt_hi >= 1) tile_dma(tid, 1); if (kt_hi >= 2) tile_dma(tid, 2);
        __builtin_amdgcn_s_waitcnt(0x0F70);
        __builtin_amdgcn_s_barrier();
        asm volatile("" ::: "memory");
        const int lane = tid & 63, r = lane & 31, h = lane >> 5;
        bf16x8 kf[12];
        A::kload(kring, 0, kf, r, h);
        sc = A::qk_mma(kf, qf);
        float mxr = -__builtin_inff();
#pragma unroll
        for (int q = 0; q < 16; ++q) mxr = fmaxf(mxr, sc[q]);
        finish(sc, mxr, 0, h);
    }
    for (int kt = 0; kt <= kt_hi; ++kt) {
        const int tid = tid0, lane = tid & 63, r = lane & 31, h = lane >> 5;
        if (kt + 1 <= kt_hi) { if (kt + 2 <= kt_hi) asm volatile("s_waitcnt vmcnt(5)" ::: "memory"); else asm volatile("s_waitcnt vmcnt(0)" ::: "memory"); }
        __builtin_amdgcn_s_barrier();
        asm volatile("" ::: "memory");
        if (kt + 3 <= kt_hi) tile_dma(tid, kt + 3);
        const int kn = (kt + 1) % 3;
        bf16x8 kf[12];
        A::kload(kring + kn * KST, 0, kf, r, h);
        __builtin_amdgcn_sched_barrier(0);
        f32x16 sn = A::qk_mma(kf, qf);
        const float nm = -m_run;
        float ps = 0.f;
#pragma unroll
        for (int q = 0; q < 16; ++q) { const float e = __builtin_amdgcn_exp2f(__builtin_fmaf(sc[q], C, nm)); sc[q] = e; ps += e; }
        l_half += ps;
        const bf16x8 pf0 = pfrag(sc, 0), pf1 = pfrag(sc, 1);
        bf16x8 vf[2][4];
        const unsigned char* vadj = vring + (kt & 3) * VST - (A::K_BYTES + A::KR_BYTES);
        A::vload(vadj, 0, vf[0], r, h); A::vload(vadj, 1, vf[1], r, h);
        float mxr = -__builtin_inff();
#pragma unroll
        for (int q = 0; q < 16; ++q) mxr = fmaxf(mxr, sn[q]);
        A::pv_mma(o, vf[0], pf0); A::pv_mma(o, vf[1], pf1);
        if (kt + 1 <= kt_hi) finish(sn, mxr, kt + 1, h);
        sc = sn;
    }
    __syncthreads();
}

__device__ __forceinline__ void ph_mla_attn(PRef p) {
    unsigned char* lds = VLDS;
    const float C = 0.07216878364870322f * 1.4426950408889634f;
    for (int it = VB; it < 1024; it += NVB) {
        int tid = VT; asm volatile("" : "+v"(tid));
        const int lane = tid & 63, wid = tid >> 6, r = lane & 31, h = lane >> 5;
        const int vb_ = it & 511, xw_ = vb_ >> 4, pp = ((vb_ >> 1) & 7) * 64 + (((xw_ >> 3) * 2 + (vb_ & 1)) << 3) + (xw_ & 7), second = it >> 9, bh = pp >> 3, qt = second ? (pp & 7) : (15 - (pp & 7)), b = bh >> 3, hd = bh & 7;
        const int tw0 = qt * 128 + wid * 32, t = tw0 + r;
        const size_t tok = (size_t)b * SEQ + t;
        bf16x8 qf[12];
        load_q<12>(qf, p.qm + tok * 1536 + hd * 192, h);
        f32x16 o[4];
#pragma unroll
        for (int dvb = 0; dvb < 4; ++dvb)
#pragma unroll
            for (int q = 0; q < 16; ++q) o[dvb][q] = 0.f;
        float m_run = -1.0e30f, l_half = 0.f;
        mla_flash(tid, lds, qf, o, m_run, l_half, p.kn + (size_t)b * SEQ * 1024 + hd * 128, p.krope + (size_t)b * SEQ * 64,
                  p.vt + (size_t)(b * 8 + hd) * 128 * SEQ, (qt * 128 + 127) >> 5, t, tw0, C);
        const float l = xh_sum(l_half);
        store_o(o, p.obuf + tok * 1024 + hd * 128, h, l > 0.f ? 1.f / l : 0.f);
    }
}

__device__ __forceinline__ void acc_branch(uint2 (&ot)[16], const f32x16 (&o)[4], float sc, bool first) {
#pragma unroll
    for (int dvb = 0; dvb < 4; ++dvb)
#pragma unroll
        for (int g = 0; g < 4; ++g) {
            float a0 = o[dvb][4 * g] * sc, a1 = o[dvb][4 * g + 1] * sc, a2 = o[dvb][4 * g + 2] * sc, a3 = o[dvb][4 * g + 3] * sc;
            if (!first) { const uint2 pv = ot[dvb * 4 + g]; a0 += bf2f(pv.x & 0xffffu); a1 += bf2f(pv.x >> 16); a2 += bf2f(pv.y & 0xffffu); a3 += bf2f(pv.y >> 16); }
            ot[dvb * 4 + g] = make_uint2(cvtpk(a0, a1), cvtpk(a2, a3));
        }
}
__device__ __forceinline__ void ph_nsa_attn(PRef p) {
    unsigned char* lds = VLDS;
    typedef AT<128, 64> A;
    float* imp = reinterpret_cast<float*>(lds);
    unsigned* selm = reinterpret_cast<unsigned*>(lds + 2 * A::STAGE);
    const float C = 0.08838834764831845f * 1.4426950408889634f;
    for (int it = VB; it < 1024; it += NVB) {
        int tid = VT; asm volatile("" : "+v"(tid));
        const int lane = tid & 63, wid = tid >> 6, r = lane & 31, h = lane >> 5;
        const int vb_ = it & 511, pp = ((vb_ >> 1) & 7) * 64 + ((vb_ & 1) << 5) + (vb_ >> 4), second = it >> 9, bkh = pp >> 5, qc = second ? (pp & 31) : (63 - (pp & 31)), b = bkh >> 1, kh = bkh & 1;
        const int hd = kh * 4 + wid, t0 = qc * 32, t = t0 + r;
        const size_t tok = (size_t)b * SEQ + t;
        bf16x8 qf[8];
        load_q<8>(qf, p.qn + tok * 1024 + hd * 128, h);
        const f32x4 gate4 = *reinterpret_cast<const f32x4*>(p.gates + tok * 32 + hd * 4);
        uint2 ot[16];
        f32x16 o[4];
        {
            const bf16_t* kb_ = p.kcmp + (size_t)bkh * 128 * 128; const bf16_t* vb_ = p.vcmpt + (size_t)bkh * 128 * 128;
            A::dma(tid, lds, kb_, 128, nullptr, vb_, 128);
            A::dma(tid, lds + A::STAGE, kb_ + 64 * 128, 128, nullptr, vb_ + 64, 128);
            DMA_WAIT_SYNC();
            f32x16 s[4];
            s[0] = A::qk(lds, 0, qf, r, h); s[1] = A::qk(lds, 1, qf, r, h); s[2] = A::qk(lds + A::STAGE, 0, qf, r, h); s[3] = A::qk(lds + A::STAGE, 1, qf, r, h);
            float mx = -3.0e38f;
#pragma unroll
            for (int kb = 0; kb < 4; ++kb)
#pragma unroll
                for (int q = 0; q < 16; ++q) {
                    const int n = kb * 32 + crow(q, h);
                    const float v = (16 * n + 31 <= t) ? s[kb][q] * C : -__builtin_inff();
                    s[kb][q] = v; mx = fmaxf(mx, v);
                }
            mx = fmaxf(xh_max(mx), -1.0e30f);
            float ps = 0.f;
#pragma unroll
            for (int kb = 0; kb < 4; ++kb)
#pragma unroll
                for (int q = 0; q < 16; ++q) { const float e = __builtin_amdgcn_exp2f(s[kb][q] - mx); s[kb][q] = e; ps += e; }
            const float l = xh_sum(ps), inv = l > 0.f ? 1.f / l : 0.f;
#pragma unroll
            for (int kb = 0; kb < 4; ++kb)
#pragma unroll
                for (int q = 0; q < 16; ++q) s[kb][q] *= inv;
            float impv[16];
            {
                float prev = 0.f;
#pragma unroll
                for (int gi = 0; gi < 16; ++gi) {
                    const int kb = gi >> 2, rg = gi & 3;
                    const float p3 = 0.5f * s[kb][4 * rg + 3];
                    const float av = s[kb][4 * rg] + s[kb][4 * rg + 1] + s[kb][4 * rg + 2] + p3;
                    const float co = xh_other(p3, h);
                    impv[gi] = av + (h ? co : prev);
                    prev = co;
                }
            }
            bf16x8 pf[8];
#pragma unroll
            for (int kb = 0; kb < 4; ++kb) { pf[2 * kb] = pfrag(s[kb], 0); pf[2 * kb + 1] = pfrag(s[kb], 1); }
#pragma unroll
            for (int dvb = 0; dvb < 4; ++dvb)
#pragma unroll
                for (int q = 0; q < 16; ++q) o[dvb][q] = 0.f;
#pragma unroll
            for (int ks = 0; ks < 4; ++ks) A::pv(lds, o, ks, pf[ks], r, h);
#pragma unroll
            for (int ks = 0; ks < 4; ++ks) A::pv(lds + A::STAGE, o, ks, pf[4 + ks], r, h);
            acc_branch(ot, o, gate4[0], true);
            __syncthreads();
#pragma unroll
            for (int gi = 0; gi < 16; ++gi) imp[(wid * 32 + r) * 33 + (2 * gi + h)] = impv[gi];
            __syncthreads();
            if (tid < 32) {
                const int tq = t0 + tid, cur = tq >> 6;
                float val[32];
#pragma unroll
                for (int j = 0; j < 32; ++j) {
                    float v = imp[(0 * 32 + tid) * 33 + j] + imp[(1 * 32 + tid) * 33 + j] + imp[(2 * 32 + tid) * 33 + j] + imp[(3 * 32 + tid) * 33 + j];
                    if (j == 0 || j == cur || j == cur - 1) v += 1000.f;
                    val[j] = (64 * j <= tq) ? v : -__builtin_inff();
                }
                unsigned m = 0u;
                for (int k = 0; k < 8; ++k) {
                    float best = -__builtin_inff(); int bi = -1;
#pragma unroll
                    for (int j = 0; j < 32; ++j) { const bool free_ = !((m >> j) & 1u); if (free_ && (bi < 0 || val[j] > best)) { best = val[j]; bi = j; } }
                    m |= 1u << bi;
                }
                selm[tid] = m;
            }
            __syncthreads();
        }
        const unsigned sel = selm[r];
        load_q<8>(qf, p.qn + tok * 1024 + hd * 128, h);
        {
#pragma unroll
            for (int dvb = 0; dvb < 4; ++dvb)
#pragma unroll
                for (int q = 0; q < 16; ++q) o[dvb][q] = 0.f;
            float m_run = -1.0e30f, l_half = 0.f;
            flash_loop<128, 64, 1>(tid, lds, qf, o, m_run, l_half, p.ks + (size_t)bkh * SEQ * 128, 128, nullptr, p.vst + (size_t)bkh * 128 * SEQ, SEQ,
                                   0, (t0 + 31) >> 6, t, t0, t0 + 31, sel, C);
            const float l = xh_sum(l_half);
            acc_branch(ot, o, l > 0.f ? gate4[1] / l : 0.f, false);
        }
        {
#pragma unroll
            for (int dvb = 0; dvb < 4; ++dvb)
#pragma unroll
                for (int q = 0; q < 16; ++q) o[dvb][q] = 0.f;
            float m_run = -1.0e30f, l_half = 0.f;
            const int lo = (t0 - 511) > 0 ? ((t0 - 511) >> 6) : 0;
            flash_loop<128, 64, 2>(tid, lds, qf, o, m_run, l_half, p.kw + (size_t)bkh * SEQ * 128, 128, nullptr, p.vwt + (size_t)bkh * 128 * SEQ, SEQ,
                                   lo, (t0 + 31) >> 6, t, t0, t0 + 31, 0u, C);
            const float l = xh_sum(l_half);
            acc_branch(ot, o, l > 0.f ? gate4[2] / l : 0.f, false);
        }
        bf16_t* orow = p.obuf + tok * 1024 + hd * 128;
#pragma unroll
        for (int dvb = 0; dvb < 4; ++dvb)
#pragma unroll
            for (int gp = 0; gp < 2; ++gp) store_pk16(orow, dvb, gp, ot[dvb * 4 + 2 * gp], ot[dvb * 4 + 2 * gp + 1], h);
    }
}

__device__ __forceinline__ void ph_sb_attn(PRef p) {
    unsigned char* lds = VLDS;
    typedef AT<128, 64> A;
    const float SC = 0.08838834764831845f, L2E = 1.4426950408889634f, LN2 = 0.6931471805599453f;
    for (int it = VB; it < 1024; it += NVB) {
        int tid = VT; asm volatile("" : "+v"(tid));
        const int lane = tid & 63, wid = tid >> 6, r = lane & 31, h = lane >> 5;
        const int vb_ = it & 511, xw_ = vb_ >> 4, pp = ((vb_ >> 1) & 7) * 64 + (((xw_ >> 3) * 2 + (vb_ & 1)) << 3) + (xw_ & 7), second = it >> 9, bh = pp >> 3, qt = second ? (pp & 7) : (15 - (pp & 7)), b = bh >> 3, hd = bh & 7;
        const int tw0 = qt * 128 + wid * 32, t = tw0 + r;
        const size_t tok = (size_t)b * SEQ + t;
        bf16x8 qf[8];
        load_q<8>(qf, p.qs + tok * 1024 + hd * 128, h);
        f32x16 o[4];
#pragma unroll
        for (int dvb = 0; dvb < 4; ++dvb)
#pragma unroll
            for (int q = 0; q < 16; ++q) o[dvb][q] = 0.f;
        float R = 0.f;
        const bf16_t* kbase = p.ksb + (size_t)b * SEQ * 1024 + hd * 128; const bf16_t* vtbase = p.vt + (size_t)(b * 8 + hd) * 128 * SEQ;
        const int kt_hi = (qt * 128 + 127) >> 6;
        A::dma(tid, lds, kbase + (size_t)kt_hi * 64 * 1024, 1024, nullptr, vtbase + kt_hi * 64, SEQ);
        __builtin_amdgcn_s_waitcnt(0x0F70); __syncthreads();
        volatile int* done_f = reinterpret_cast<volatile int*>(smem + LDS_WORK + 2 * A::STAGE);
        const int rwave = VHALF * 4 + wid;
        bool wdone = false;
        for (int kt = kt_hi; kt >= 0; --kt) {
            const int cur = (kt_hi - kt) & 1;
            if (kt < kt_hi && (done_f[0] & done_f[1] & done_f[2] & done_f[3] & done_f[4] & done_f[5] & done_f[6] & done_f[7])) break;
            const bool more = kt > 0;
            if (more) A::dma(tid, lds + (cur ^ 1) * A::STAGE, kbase + (size_t)(kt - 1) * 64 * 1024, 1024, nullptr, vtbase + (kt - 1) * 64, SEQ);
            const unsigned char* st = lds + cur * A::STAGE;
            const int key0 = kt * 64;
            if (key0 < tw0 + 31 && !wdone) {
                f32x16 z[2];
                {
                    bf16x8 kf0[8], kf1[8];
                    A::kload(st, 0, kf0, r, h); A::kload(st, 1, kf1, r, h);
                    __builtin_amdgcn_sched_barrier(0);
                    z[0] = A::qk_mma(kf0, qf); z[1] = A::qk_mma(kf1, qf);
                }
                float T[8];
#pragma unroll
                for (int kb = 0; kb < 2; ++kb)
#pragma unroll
                    for (int rg = 0; rg < 4; ++rg) {
                        float suf = 0.f;
#pragma unroll
                        for (int i = 3; i >= 0; --i) {
                            const float zz = z[kb][4 * rg + i] * SC;
                            const float sp = fmaxf(zz, 0.f) + LN2 * __builtin_amdgcn_logf(1.f + __builtin_amdgcn_exp2f(-fabsf(zz) * L2E));
                            const bool ok = (key0 + kb * 32 + 8 * rg + 4 * h + i) < t;
                            suf += ok ? -sp : 0.f;
                            z[kb][4 * rg + i] = zz + suf;
                        }
                        T[kb * 4 + rg] = suf;
                    }
                float run = 0.f;
#pragma unroll
                for (int gq = 7; gq >= 0; --gq) {
                    const float U = xh_other(T[gq], h);
                    const float after = run + (h ? 0.f : U) + R;
                    const int kb = gq >> 2, rg = gq & 3;
#pragma unroll
                    for (int i = 0; i < 4; ++i) {
                        const bool ok = (key0 + kb * 32 + 8 * rg + 4 * h + i) < t;
                        const float a = __builtin_amdgcn_exp2f((z[kb][4 * rg + i] + after) * L2E);
                        z[kb][4 * rg + i] = ok ? a : 0.f;
                    }
                    run += T[gq] + U;
                }
                R += run;
                A::pv(st, o, 0, pfrag(z[0], 0), r, h); A::pv(st, o, 1, pfrag(z[0], 1), r, h); A::pv(st, o, 2, pfrag(z[1], 0), r, h); A::pv(st, o, 3, pfrag(z[1], 1), r, h);
                wdone = __all(R < -105.f);
            }
            if (lane == 0) done_f[rwave] = wdone ? 1 : 0;
            DMA_WAIT_SYNC();
        }
        store_o(o, p.obuf + tok * 1024 + hd * 128, h, 1.f);
        __syncthreads();
    }
}


#define KARGP ((const __attribute__((address_space(4))) Params*)__builtin_amdgcn_kernarg_segment_ptr())
#define PH(call) do { if (pc >= lo && pc < hi) { { const __attribute__((address_space(4))) Params* q_ = KARGP; asm volatile("" : "+s"(q_)); PRef p = *q_; call; } if (pc + 1 < hi) xcd_barrier(bar); } ++pc; } while (0)
template <int L> __device__ __forceinline__ void ph_attn_conv(PRef p) {
    constexpr int kind = L % 3;
    const bool conv_first = false;
    (void)conv_first;
    if (kind == 0) ph_mla_attn(p); else if (kind == 1) ph_nsa_attn(p); else ph_sb_attn(p);
}
template <int L> __device__ __forceinline__ void ph_moe_a_conv(PRef p) {
    const bool conv_first = false;
    (void)conv_first;
    ph_moe_a(p, L);
    if (L == 0) convert_moe_steal(p, 0, 2);
    if (L + 1 < DEPTH) { convert_moe_steal(p, L + 1, 0); convert_moe_steal(p, L + 1, 1); }
}
template <int L> __device__ __forceinline__ void ph_moe_b_conv(PRef p) {
    const bool conv_first = false;
    (void)conv_first;
    ph_moe_b(p, L);
    if (L + 1 < DEPTH) convert_moe_steal(p, L + 1, 2);
}
template <int L> __device__ __forceinline__ void run_layer(PRef p, const XcdBarrier& bar, int lo, int hi, int& pc) {
    constexpr int kind = L % 3, j = L / 3;
    if (kind == 0) { PH(ph_mla_in(p, j)); PH(ph_mla_up(p, j)); }
    else if (kind == 1) { PH(ph_nsa_in(p)); PH(ph_nsa_cmp1(p)); PH(ph_nsa_cmp2(p)); }
    else { PH(ph_sb_in(p)); }
    PH(ph_attn_conv<L>(p));
    PH(ph_wo(p, L)); PH(ph_lna(p, L)); PH(ph_moe_a_conv<L>(p)); PH(ph_moe_b_conv<L>(p)); PH(ph_lnb(p, L));
}
__global__ void __launch_bounds__(512, 2) mega(Params pv, int lo, int hi) {
    (void)pv; PRef p = *KARGP;
    volatile LAS unsigned* stw = (volatile LAS unsigned*)smem;
    if (threadIdx.x == 0) { stw[0] = 0u; stw[1] = 0u; stw[2] = 0u; stw[3] = 0u; }
    __syncthreads();
    XcdBarrier bar; bar.bar = p.bar; bar.x = 0; bar.st = stw;
    if (hi - lo > 1) bar = xcd_barrier_post(p.bar, stw);
    int pc = 0;
    PH(ph_prologue(p));
    PH(ph_h0(p));
    run_layer<0>(p, bar, lo, hi, pc);
    run_layer<1>(p, bar, lo, hi, pc);
    run_layer<2>(p, bar, lo, hi, pc);
    run_layer<3>(p, bar, lo, hi, pc);
}
#undef PH
constexpr int N_PHASES = 2 + (3 + 5) + (4 + 5) + (2 + 5) + (3 + 5);

extern "C" void kernel_launch(void* const* d_in, const int* in_sizes, int n_in, void* d_out, int out_size, void* d_ws, size_t ws_size, hipStream_t stream) {
    (void)in_sizes; (void)n_in; (void)out_size;
    static int grid = 0;
    if (grid == 0) {
        int dev = 0, cus = 0, per_cu = 0;
        hipGetDevice(&dev);
        hipDeviceGetAttribute(&cus, hipDeviceAttributeMultiprocessorCount, dev);
        if (hipFuncSetAttribute((const void*)mega, hipFuncAttributeMaxDynamicSharedMemorySize, LDS_BYTES) != hipSuccess) { fprintf(stderr, "kernel_launch: hipFuncSetAttribute failed\n"); }
        if (hipOccupancyMaxActiveBlocksPerMultiprocessor(&per_cu, (const void*)mega, 2 * NTHR, LDS_BYTES) != hipSuccess) per_cu = 1;
        (void)hipGetLastError();
        if (per_cu < 1) per_cu = 1;
        if (per_cu > 1) per_cu = 1;
        if (cus <= 0) cus = 256;
        grid = cus * per_cu;
        if (grid >= 8) grid &= ~7;
    }
    Params p{};
    const float* const* in = (const float* const*)d_in;
    p.x = in[0]; p.c = in[1]; p.pos = (const int*)d_in[2]; p.ada_w = in[3]; p.ada_b = in[4]; p.ln_g = in[5]; p.ln_b = in[6];
    p.mla_w_in = in[7]; p.mla_g_q = in[8]; p.mla_w_uq = in[9]; p.mla_g_kv = in[10]; p.mla_w_ukv = in[11]; p.mla_w_o = in[12];
    p.nsa_w_in = in[13]; p.nsa_pe_k = in[14]; p.nsa_pe_v = in[15]; p.nsa_w_ck1 = in[16]; p.nsa_w_ck2 = in[17]; p.nsa_w_cv1 = in[18]; p.nsa_w_cv2 = in[19]; p.nsa_w_o = in[20];
    p.sb_w_qkv = in[21]; p.sb_w_o = in[22];
    p.moe_w_grp = in[23]; p.moe_b_grp = in[24]; p.moe_w_rt = in[25]; p.moe_b_rt = in[26]; p.moe_w_gate = in[27]; p.moe_w_up = in[28]; p.moe_w_down = in[29];
    p.out = (float*)d_out;
    unsigned char* ws = (unsigned char*)d_ws; size_t off = 0;
    auto take = [&](size_t bytes) { unsigned char* r = ws + off; off += (bytes + 255) & ~(size_t)255; return r; };
    p.bar = (unsigned*)take(XCD_BAR_WORDS * 4 + 16 * 256); p.wq = (int*)(p.bar + XCD_BAR_WORDS); p.cnt = (int*)take(DEPTH * 32 * 64 * 4);
    p.mod = (float*)take((size_t)8 * 8 * 3072 * 4);
    p.cosm = (float*)take((size_t)T_TOK * 32 * 4); p.sinm = (float*)take((size_t)T_TOK * 32 * 4); p.cosn = (float*)take((size_t)T_TOK * 64 * 4); p.sinn = (float*)take((size_t)T_TOK * 64 * 4);
    p.bias1 = (float*)take(2 * 128 * 4); p.wr = (float*)take((size_t)DEPTH * 1024 * 48 * 4);
    p.xbuf = (f16_t*)take((size_t)T_TOK * 1024 * 4); p.zbuf = (f16_t*)take((size_t)T_TOK * 1024 * 4); p.hbuf = (bf16_t*)take((size_t)T_TOK * 1024 * 2);
    p.wt_mla_in = (bf16_t*)take((size_t)2 * 768 * 1024 * 2); p.wt_uq = (bf16_t*)take((size_t)2 * 1536 * 256 * 2); p.wt_ukv = (bf16_t*)take((size_t)2 * 2048 * 256 * 2);
    p.wt_mla_o = (bf16_t*)take((size_t)2 * 1024 * 1024 * 2); p.wt_nsa_in = (bf16_t*)take((size_t)2816 * 1024 * 2);
    p.wt_ck1 = (bf16_t*)take((size_t)128 * 4096 * 2); p.wt_cv1 = (bf16_t*)take((size_t)128 * 4096 * 2); p.wt_ck2 = (bf16_t*)take(128 * 128 * 2); p.wt_cv2 = (bf16_t*)take(128 * 128 * 2);
    p.wt_nsa_o = (bf16_t*)take((size_t)1024 * 1024 * 2); p.wt_sb_qkv = (bf16_t*)take((size_t)3072 * 1024 * 2); p.wt_sb_o = (bf16_t*)take((size_t)1024 * 1024 * 2);
    p.wt_gu = (bf16_t*)take((size_t)DEPTH * 32 * 1024 * 1024 * 2); p.wt_dn = (bf16_t*)take((size_t)DEPTH * 32 * 1024 * 512 * 2);
    p.obuf = (bf16_t*)take((size_t)T_TOK * 1024 * 2);
    p.list = (int*)take((size_t)32 * T_TOK * 4); p.listw = (float*)take((size_t)32 * T_TOK * 4);
    p.hmoe = (bf16_t*)take((size_t)(T_TOK * 2 + 32 * 256) * 512 * 2); p.ybuf = (bf16_t*)take((size_t)T_TOK * 2 * 1024 * 2);
    const size_t arena0 = off;
    p.cbuf = (bf16_t*)take((size_t)T_TOK * 512 * 2); p.rss = (float*)take((size_t)T_TOK * 8 * 4); p.krope = (bf16_t*)take((size_t)T_TOK * 64 * 2); p.qm = (bf16_t*)take((size_t)T_TOK * 1536 * 2);
    p.kn = (bf16_t*)take((size_t)T_TOK * 1024 * 2); p.vt = (bf16_t*)take((size_t)T_TOK * 1024 * 2);
    const size_t arena_mla = off; off = arena0;
    p.qn = (bf16_t*)take((size_t)T_TOK * 1024 * 2);
    p.kc = (bf16_t*)take((size_t)(16 * SEQ + 64) * 128 * 2); p.vc = (bf16_t*)take((size_t)(16 * SEQ + 64) * 128 * 2);
    p.ks = (bf16_t*)take((size_t)16 * SEQ * 128 * 2); p.kw = (bf16_t*)take((size_t)16 * SEQ * 128 * 2);
    p.vst = (bf16_t*)take((size_t)16 * SEQ * 128 * 2); p.vwt = (bf16_t*)take((size_t)16 * SEQ * 128 * 2);
    p.gates = (float*)take((size_t)T_TOK * 32 * 4); p.cpart = (float*)take((size_t)32 * 8 * 128 * 128 * 4); p.hid = (bf16_t*)take((size_t)32 * 128 * 128 * 2);
    p.kcmp = (bf16_t*)take((size_t)16 * 128 * 128 * 2); p.vcmpt = (bf16_t*)take((size_t)16 * 128 * 128 * 2);
    const size_t arena_nsa = off; off = arena0;
    p.qs = (bf16_t*)take((size_t)T_TOK * 1024 * 2); p.ksb = (bf16_t*)take((size_t)T_TOK * 1024 * 2);
    const size_t arena_sb = off; (void)arena_sb;
    off = arena_mla > arena_nsa ? arena_mla : arena_nsa;
    if (off > ws_size) { fprintf(stderr, "kernel_launch: workspace too small (%zu > %zu)\n", off, ws_size); }
    hipMemsetAsync(p.bar, 0, XCD_BAR_WORDS * 4 + 16 * 256, stream);
#if MULTI_LAUNCH
    for (int ph = 0; ph < N_PHASES; ++ph) hipLaunchKernelGGL(mega, dim3(grid), dim3(2 * NTHR), LDS_BYTES, stream, p, ph, ph + 1);
#else
    hipLaunchKernelGGL(mega, dim3(grid), dim3(2 * NTHR), LDS_BYTES, stream, p, 0, N_PHASES);
#endif
}
```

```cpp
#include <hip/hip_runtime.h>
#include <stdint.h>
#include <stdio.h>

#ifndef MULTI_LAUNCH
#define MULTI_LAUNCH 0
#endif

typedef unsigned short bf16_t;
typedef short bf16x8 __attribute__((ext_vector_type(8)));
typedef float f32x16 __attribute__((ext_vector_type(16)));
typedef float f32x4 __attribute__((ext_vector_type(4)));
typedef _Float16 f16_t;
typedef _Float16 f16x4 __attribute__((ext_vector_type(4)));
typedef _Float16 f16x8 __attribute__((ext_vector_type(8)));
typedef float f32x8 __attribute__((ext_vector_type(8)));
__device__ __forceinline__ f32x4 ld4h(const f16_t* p) { return __builtin_convertvector(*reinterpret_cast<const f16x4*>(p), f32x4); }
__device__ __forceinline__ void st4h(f16_t* p, f32x4 v) { *reinterpret_cast<f16x4*>(p) = __builtin_convertvector(v, f16x4); }

constexpr int T_TOK = 16384, DM = 1024, NBATCH = 8, SEQ = 2048, DEPTH = 4;
constexpr float LN_EPS = 1e-5f, RMS_EPS = 1e-6f;
constexpr float DN_ALPHA = 1.6817928305074290f;
constexpr int NTHR = 256;
constexpr int LDS_WORK = 256;
constexpr int HALF_LDS = 80640;
constexpr int LDS_BYTES = LDS_WORK + 2 * HALF_LDS;
#define VHALF ((int)__builtin_amdgcn_readfirstlane((int)(threadIdx.x >> 8)))
#define VT ((int)(threadIdx.x & 255u))
#define VB ((int)(blockIdx.x * 2u) + VHALF)
#define NVB ((int)(gridDim.x * 2u))
#define VLDS (smem + LDS_WORK + VHALF * HALF_LDS)

#define XB_TMO      128
#define XB_XCNT(j)  (256  + 64 * (j))
#define XB_XSUB(j)  (1280 + 64 * (j))
#define XB_XGEN(j)  (2304 + 64 * (j))
#define XB_TOP      3328
#define XB_TOPGEN   3392
#define XCD_BAR_WORDS 3456
#define XB_SPIN_CAP (1u << 22)
#define LAS __attribute__((address_space(3)))

__device__ __forceinline__ unsigned xb_ld(unsigned* p)              { return __hip_atomic_load(p, __ATOMIC_RELAXED, __HIP_MEMORY_SCOPE_AGENT); }
__device__ __forceinline__ unsigned xb_add(unsigned* p, unsigned v) { return __hip_atomic_fetch_add(p, v, __ATOMIC_RELAXED, __HIP_MEMORY_SCOPE_AGENT); }
__device__ __forceinline__ unsigned xb_xcc_id() { return (unsigned)__builtin_amdgcn_s_getreg((3 << 11) | 20) & 0xFu; }
#define XB_SPIN(cond, bar) do { unsigned _sp = 0; while (cond) { __builtin_amdgcn_s_sleep(1); \
    if ((++_sp & 255u) == 0u) { if (xb_ld(&(bar)[XB_TMO])) break; if (_sp > XB_SPIN_CAP) { atomicAdd(&(bar)[XB_TMO], 1u); break; } } } } while (0)

struct XcdBarrier { unsigned* bar; unsigned x; volatile LAS unsigned* st; };

__device__ __forceinline__ XcdBarrier xcd_barrier_post(unsigned* bar, volatile LAS unsigned* st) {
    XcdBarrier b; b.bar = bar; b.x = xb_xcc_id(); b.st = st;
    if (threadIdx.x == 0) (void)xb_add(&bar[XB_XCNT(b.x)], 1u);
    return b;
}
__device__ __forceinline__ void xcd_barrier_complete(unsigned* bar, unsigned x, unsigned& nloc, unsigned& nx) {
    const unsigned G = gridDim.x * gridDim.y * gridDim.z;
    unsigned sum, cnt, mine, sp = 0u;
    for (;;) {
        sum = 0u; cnt = 0u; mine = 0u;
#pragma unroll
        for (unsigned j = 0; j < 16; ++j) { const unsigned c = xb_ld(&bar[XB_XCNT(j)]); sum += c; cnt += (c > 0u) ? 1u : 0u; mine = (j == x) ? c : mine; }
        if (sum == G) break;
        __builtin_amdgcn_s_sleep(1);
        if ((++sp & 255u) == 0u) { if (xb_ld(&bar[XB_TMO])) break; if (sp > XB_SPIN_CAP) { atomicAdd(&bar[XB_TMO], 1u); break; } }
    }
    nloc = mine > 0u ? mine : 1u; nx = cnt > 0u ? cnt : 1u;
}
__device__ __forceinline__ void xcd_barrier(const XcdBarrier& b) {
    asm volatile("s_waitcnt vmcnt(0)" ::: "memory");
    __syncthreads();
    if (threadIdx.x == 0) {
        unsigned* bar = b.bar;
        __builtin_amdgcn_s_waitcnt(0);
        unsigned nloc = b.st[0], nx = b.st[1];
        if (nloc == 0u) { xcd_barrier_complete(bar, b.x, nloc, nx); b.st[0] = nloc; b.st[1] = nx; }
        const unsigned old = xb_add(&bar[XB_XSUB(b.x)], 1u);
        const unsigned gen = old / nloc;
        if (old + 1u == (gen + 1u) * nloc) {
            __builtin_amdgcn_fence(__ATOMIC_RELEASE, "agent");
            asm volatile("s_waitcnt vmcnt(0)" ::: "memory");
            const unsigned og = xb_add(&bar[XB_TOP], 1u);
            const unsigned tg = og / nx;
            if (og + 1u == (tg + 1u) * nx) xb_add(&bar[XB_TOPGEN], 1u);
            else XB_SPIN(xb_ld(&bar[XB_TOPGEN]) == tg, bar);
            __builtin_amdgcn_fence(__ATOMIC_ACQUIRE, "agent");
            xb_add(&bar[XB_XGEN(b.x)], 1u);
            asm volatile("s_waitcnt vmcnt(0)" ::: "memory");
        } else {
            XB_SPIN(xb_ld(&bar[XB_XGEN(b.x)]) == gen, bar);
            __builtin_amdgcn_fence(__ATOMIC_ACQUIRE, "agent");
            asm volatile("s_waitcnt vmcnt(0)" ::: "memory");
        }
    }
    __syncthreads();
}

struct Params;
typedef const __attribute__((address_space(4))) Params& PRef;
struct Params {
    const float* x; const float* c; const int* pos; const float* ada_w; const float* ada_b; const float* ln_g; const float* ln_b;
    const float* mla_w_in; const float* mla_g_q; const float* mla_w_uq; const float* mla_g_kv; const float* mla_w_ukv; const float* mla_w_o;
    const float* nsa_w_in; const float* nsa_pe_k; const float* nsa_pe_v; const float* nsa_w_ck1; const float* nsa_w_ck2; const float* nsa_w_cv1; const float* nsa_w_cv2; const float* nsa_w_o;
    const float* sb_w_qkv; const float* sb_w_o;
    const float* moe_w_grp; const float* moe_b_grp; const float* moe_w_rt; const float* moe_b_rt; const float* moe_w_gate; const float* moe_w_up; const float* moe_w_down;
    float* out;
    unsigned* bar; int* cnt; float* mod; float* cosm; float* sinm; float* cosn; float* sinn; float* bias1; float* wr;
    f16_t* xbuf; f16_t* zbuf; bf16_t* hbuf;
    bf16_t* wt_mla_in; bf16_t* wt_uq; bf16_t* wt_ukv; bf16_t* wt_mla_o; bf16_t* wt_nsa_in; bf16_t* wt_ck1; bf16_t* wt_cv1; bf16_t* wt_ck2; bf16_t* wt_cv2;
    bf16_t* wt_nsa_o; bf16_t* wt_sb_qkv; bf16_t* wt_sb_o; bf16_t* wt_gu; bf16_t* wt_dn;
    bf16_t* cbuf; float* rss; bf16_t* krope; bf16_t* qm; bf16_t* kn; bf16_t* vt;
    bf16_t* qn; bf16_t* kc; bf16_t* vc; bf16_t* ks; bf16_t* kw; bf16_t* vst; bf16_t* vwt; float* gates; float* cpart; bf16_t* hid; bf16_t* kcmp; bf16_t* vcmpt;
    bf16_t* qs; bf16_t* ksb;
    bf16_t* obuf;
    int* wq;
    int* list; float* listw; bf16_t* hmoe; bf16_t* ybuf;
};

extern __shared__ __attribute__((aligned(16))) unsigned char smem[];

__device__ __forceinline__ unsigned cvtpk(float lo, float hi) { unsigned r; asm("s_nop 0\n\tv_cvt_pk_bf16_f32 %0, %1, %2\n\ts_nop 1" : "=v"(r) : "v"(lo), "v"(hi)); return r; }
__device__ __forceinline__ uint4 cvtpk8(float a0, float a1, float a2, float a3, float a4, float a5, float a6, float a7) {
    uint4 r;
    asm("s_nop 0\n\tv_cvt_pk_bf16_f32 %0, %4, %5\n\tv_cvt_pk_bf16_f32 %1, %6, %7\n\tv_cvt_pk_bf16_f32 %2, %8, %9\n\tv_cvt_pk_bf16_f32 %3, %10, %11\n\ts_nop 1"
        : "=&v"(r.x), "=&v"(r.y), "=&v"(r.z), "=&v"(r.w) : "v"(a0), "v"(a1), "v"(a2), "v"(a3), "v"(a4), "v"(a5), "v"(a6), "v"(a7));
    return r;
}
__device__ __forceinline__ float bf2f(unsigned v16) { return __uint_as_float(v16 << 16); }
__device__ __forceinline__ uint4 pack8(const float* v) { return cvtpk8(v[0], v[1], v[2], v[3], v[4], v[5], v[6], v[7]); }
__device__ __forceinline__ float wave_sum(float v) {
#pragma unroll
    for (int o = 32; o > 0; o >>= 1) v += __shfl_xor(v, o, 64);
    return v;
}
__device__ __forceinline__ float xh_max(float v) { auto rr = __builtin_amdgcn_permlane32_swap(__float_as_uint(v), __float_as_uint(v), false, false); return fmaxf(__uint_as_float(rr[0]), __uint_as_float(rr[1])); }
__device__ __forceinline__ float xh_sum(float v) { auto rr = __builtin_amdgcn_permlane32_swap(__float_as_uint(v), __float_as_uint(v), false, false); return __uint_as_float(rr[0]) + __uint_as_float(rr[1]); }
__device__ __forceinline__ float xh_other(float v, int h) { auto rr = __builtin_amdgcn_permlane32_swap(__float_as_uint(v), __float_as_uint(v), false, false); return h ? __uint_as_float(rr[0]) : __uint_as_float(rr[1]); }
__device__ __forceinline__ float silu_f(float v) { return v / (1.f + __expf(-v)); }
__device__ __forceinline__ float sigmoid_f(float v) { return 1.f / (1.f + __expf(-v)); }
#define MFMA32(a, b, c) __builtin_amdgcn_mfma_f32_32x32x16_bf16((a), (b), (c), 0, 0, 0)
__device__ __forceinline__ int crow(int reg, int h) { return (reg & 3) + 8 * (reg >> 2) + 4 * h; }
__device__ __forceinline__ bf16x8 lds_frag(const unsigned char* base, int off) { return *reinterpret_cast<const bf16x8*>(base + off); }

constexpr int CS_LD = 132;
constexpr int GEMM_RSTD_OFF = 128 * CS_LD * 4;
template <class RowPtr>
__device__ __forceinline__ void gemm_main(int tid, unsigned char* lds, const RowPtr& rowptr, const bf16_t* __restrict__ Bt, int ldb, int n0, int K, f32x16 (&acc)[2][2]) {
    const int lane = tid & 63, wid = tid >> 6, wr = wid >> 1, wc = wid & 1, r = lane & 31, h = lane >> 5;
    const bf16_t* pa[4]; const bf16_t* pb[4];
#pragma unroll
    for (int i = 0; i < 4; ++i) {
        const int pi = wid + 4 * i, row = 8 * pi + (lane >> 3), c = (lane & 7) ^ ((row >> 1) & 7);
        pa[i] = rowptr(row) + c * 8; pb[i] = Bt + (size_t)(n0 + row) * ldb + c * 8;
    }
    const int swz = (r >> 1) & 7;
    const int aoff = (wr * 64 + r) * 128, boff = 32768 + (wc * 64 + r) * 128;
#pragma unroll
    for (int i = 0; i < 2; ++i)
#pragma unroll
        for (int j = 0; j < 2; ++j)
#pragma unroll
            for (int q = 0; q < 16; ++q) acc[i][j][q] = 0.f;
    const int nk = K >> 6;
    auto dma = [&](int buf, int k0) {
#pragma unroll
        for (int i = 0; i < 4; ++i) {
            const int pi = wid + 4 * i;
            __builtin_amdgcn_global_load_lds((const unsigned*)(pa[i] + k0), (LAS unsigned*)(lds + buf * 16384 + pi * 1024), 16, 0, 0);
            __builtin_amdgcn_global_load_lds((const unsigned*)(pb[i] + k0), (LAS unsigned*)(lds + 32768 + buf * 16384 + pi * 1024), 16, 0, 0);
        }
    };
    dma(0, 0);
    asm volatile("s_waitcnt vmcnt(0)" ::: "memory"); __syncthreads();
    for (int kt = 0; kt < nk; ++kt) {
        if (kt + 1 < nk) dma((kt + 1) & 1, (kt + 1) << 6);
        const unsigned char* sa = lds + (kt & 1) * 16384;
#pragma unroll
        for (int kk = 0; kk < 4; ++kk) {
            const int co = ((2 * kk + h) ^ swz) << 4;
            const bf16x8 a0 = lds_frag(sa, aoff + co), a1 = lds_frag(sa, aoff + 4096 + co);
            const bf16x8 b0 = lds_frag(sa, boff + co), b1 = lds_frag(sa, boff + 4096 + co);
            acc[0][0] = MFMA32(a0, b0, acc[0][0]); acc[0][1] = MFMA32(a0, b1, acc[0][1]);
            acc[1][0] = MFMA32(a1, b0, acc[1][0]); acc[1][1] = MFMA32(a1, b1, acc[1][1]);
        }
        asm volatile("s_waitcnt vmcnt(0)" ::: "memory"); __syncthreads();
    }
    float* Cs = reinterpret_cast<float*>(lds);
#pragma unroll
    for (int i = 0; i < 2; ++i)
#pragma unroll
        for (int j = 0; j < 2; ++j)
#pragma unroll
            for (int q = 0; q < 16; ++q) Cs[(wr * 64 + i * 32 + crow(q, h)) * CS_LD + wc * 64 + j * 32 + r] = acc[i][j][q];
    __syncthreads();
}
#define ITEM_END_SYNC() do { asm volatile("s_waitcnt lgkmcnt(0)" ::: "memory"); __builtin_amdgcn_s_barrier(); asm volatile("" ::: "memory"); } while (0)
__device__ __forceinline__ void cs_load8(const float* Cs, int row, int c0, float* v) {
    const f32x4 a = *reinterpret_cast<const f32x4*>(Cs + row * CS_LD + c0), b = *reinterpret_cast<const f32x4*>(Cs + row * CS_LD + c0 + 4);
    v[0] = a[0]; v[1] = a[1]; v[2] = a[2]; v[3] = a[3]; v[4] = b[0]; v[5] = b[1]; v[6] = b[2]; v[7] = b[3];
}
__device__ __forceinline__ void epi_plain(const float* __restrict__ Cs, bf16_t* __restrict__ dst, size_t ld, const float* __restrict__ rowscale) {
    const int tid = VT, c0 = (tid & 15) * 8;
#pragma unroll
    for (int ps = 0; ps < 8; ++ps) {
        const int row = (tid >> 4) + 16 * ps; float v[8]; cs_load8(Cs, row, c0, v);
        if (rowscale) { const float s = rowscale[row];
#pragma unroll
            for (int q = 0; q < 8; ++q) v[q] *= s; }
        *reinterpret_cast<uint4*>(dst + (size_t)row * ld + c0) = pack8(v);
    }
}
__device__ __forceinline__ void epi_rope128(const float* __restrict__ Cs, bf16_t* __restrict__ dst, size_t ld, const float* __restrict__ cs, const float* __restrict__ sn, int tok0) {
    const int tid = VT, c0 = (tid & 15) * 8;
    if (c0 >= 64) return;
#pragma unroll
    for (int ps = 0; ps < 8; ++ps) {
        const int row = (tid >> 4) + 16 * ps; float a[8], b[8], o1[8], o2[8]; cs_load8(Cs, row, c0, a); cs_load8(Cs, row, c0 + 64, b);
        const float* cp = cs + (size_t)(tok0 + row) * 64 + c0; const float* sp = sn + (size_t)(tok0 + row) * 64 + c0;
#pragma unroll
        for (int q = 0; q < 8; ++q) { const float c = cp[q], s = sp[q]; o1[q] = a[q] * c - b[q] * s; o2[q] = b[q] * c + a[q] * s; }
        *reinterpret_cast<uint4*>(dst + (size_t)row * ld + c0) = pack8(o1);
        *reinterpret_cast<uint4*>(dst + (size_t)row * ld + c0 + 64) = pack8(o2);
    }
}
__device__ __forceinline__ void epi_transpose(const float* __restrict__ Cs, bf16_t* __restrict__ dst  , size_t ld, const float* __restrict__ rowscale) {
    const int tid = VT, dv = tid & 127, sh = tid >> 7;
#pragma unroll
    for (int j = 0; j < 8; ++j) {
        float v[8];
#pragma unroll
        for (int q = 0; q < 8; ++q) { const int row = sh * 64 + j * 8 + q; v[q] = Cs[row * CS_LD + dv] * (rowscale ? rowscale[row] : 1.f); }
        *reinterpret_cast<uint4*>(dst + (size_t)dv * ld + sh * 64 + j * 8) = pack8(v);
    }
}

struct RowPlain { const bf16_t* base; size_t ld; __device__ __forceinline__ const bf16_t* operator()(int r) const { return base + (size_t)r * ld; } };


namespace g8 {
typedef float f32x4_t __attribute__((ext_vector_type(4)));
constexpr int BK = 64, HALFR = 128, HTB = HALFR * BK * 2, STAGE_BYTES = 8 * HTB;
__device__ __forceinline__ int lds_byte(int r, int c) { const int st = (r >> 4) * 2 + (c >> 5), rr = r & 15, cc = c & 31, ob = rr * 64 + cc * 2; return st * 1024 + (ob ^ (((ob >> 9) & 1) << 5)); }
__device__ __forceinline__ void stage_rc(int b, int& R, int& C) { const int st = b / 1024, sb = b % 1024, swz = sb ^ (((sb >> 9) & 1) << 5); R = (st >> 1) * 16 + swz / 64; C = (st & 1) * 32 + (swz % 64) / 2; }
struct Unit { int pm, pn, par, e; };
template <class Sched, class Epi>
__device__ __forceinline__ void gemm8(LAS unsigned char* lds, const char* __restrict__ Abase, int ldb, int K, const Sched& S, const Epi& E) {
    const int tid = threadIdx.x;
    const int wid = __builtin_amdgcn_readfirstlane(tid >> 6), lane = tid & 63, wr = wid >> 2, wc = wid & 3, fr = lane & 15, fq = lane >> 4;
    const int nt = K / BK;
    unsigned voffB0; { int R, C; stage_rc(tid * 16, R, C); voffB0 = (unsigned)(R * ldb + C) * 2u; }
    const unsigned voffBd = (unsigned)(64 * ldb) * 2u;
    const size_t kstep = (size_t)(BK * 2), hstepB = (size_t)HALFR * ldb * 2;
    const unsigned ldsw = (unsigned)wid * 1024u;
    const int lpart = lds_byte(fr, fq * 8);
    const int aoff = lpart + wr * 8192, boff = lpart + wc * 4096;
#define G8_SA(b, h) (((b) * 2 + (h)) * HTB)
#define G8_SB(b, h) ((4 + (b) * 2 + (h)) * HTB)
#define G8_STAGE_B(bufoff, gbase) do { \
        __builtin_amdgcn_global_load_lds((const unsigned*)((const char*)(gbase) + voffB0), (LAS unsigned*)(lds + (bufoff) + ldsw), 16, 0, 0); \
        __builtin_amdgcn_global_load_lds((const unsigned*)((const char*)(gbase) + voffBd + voffB0), (LAS unsigned*)(lds + (bufoff) + ldsw + 8192), 16, 0, 0); } while (0)
#define G8_STAGE_A(bufoff, hnd, kbytes) do { \
        __builtin_amdgcn_global_load_lds((const unsigned*)(Abase + (size_t)S.a_off(hnd, 0, tid) + (kbytes)), (LAS unsigned*)(lds + (bufoff) + ldsw), 16, 0, 0); \
        __builtin_amdgcn_global_load_lds((const unsigned*)(Abase + (size_t)S.a_off(hnd, 1, tid) + (kbytes)), (LAS unsigned*)(lds + (bufoff) + ldsw + 8192), 16, 0, 0); } while (0)
#define G8_LDA(dst, b, h) do { _Pragma("unroll") for (int m = 0; m < 4; ++m) _Pragma("unroll") for (int k = 0; k < 2; ++k) dst[m][k] = *(const LAS bf16x8*)(lds + G8_SA(b, h) + aoff + m * 2048 + k * 1024); } while (0)
#define G8_LDB(dst, b, h) do { _Pragma("unroll") for (int n = 0; n < 2; ++n) _Pragma("unroll") for (int k = 0; k < 2; ++k) dst[n][k] = *(const LAS bf16x8*)(lds + G8_SB(b, h) + boff + n * 2048 + k * 1024); } while (0)
#define G8_MMA(ai, bj, At, Bt) do { __builtin_amdgcn_s_setprio(1); _Pragma("unroll") for (int m = 0; m < 4; ++m) _Pragma("unroll") for (int n = 0; n < 2; ++n) _Pragma("unroll") for (int k = 0; k < 2; ++k) \
        acc[ai][bj][m][n] = __builtin_amdgcn_mfma_f32_16x16x32_bf16(Bt[n][k], At[m][k], acc[ai][bj][m][n], 0, 0, 0); __builtin_amdgcn_s_setprio(0); } while (0)
#define G8_WAIT_V(n) asm volatile("s_waitcnt vmcnt(" #n ")" ::: "memory")
#define G8_WAIT_L(n) asm volatile("s_waitcnt lgkmcnt(" #n ")" ::: "memory")
#define G8_BAR __builtin_amdgcn_s_barrier()
#define G8_SCHED __builtin_amdgcn_sched_barrier(0)
    Unit cur, nxt; int ui = 0;
    if (!S.next(0, cur)) return;
    f32x4_t acc[2][2][4][2];
#pragma unroll
    for (int a = 0; a < 2; ++a)
#pragma unroll
        for (int b = 0; b < 2; ++b)
#pragma unroll
            for (int m = 0; m < 4; ++m)
#pragma unroll
                for (int n = 0; n < 2; ++n) acc[a][b][m][n] = (f32x4_t){0.f, 0.f, 0.f, 0.f};
    bf16x8 At[4][2], B0[2][2], B1[2][2];
    unsigned c0, c1;
    cur.par = 0; S.stash(cur, tid); S.stash_wait(); S.a_handles(cur, tid, c0, c1);
    const char* cB = S.b_base(cur);
    G8_STAGE_B(G8_SB(0, 0), cB); G8_STAGE_A(G8_SA(0, 0), c0, 0); G8_STAGE_B(G8_SB(0, 1), cB + hstepB); G8_STAGE_A(G8_SA(0, 1), c1, 0);
    if (wr == 1) G8_BAR;
    G8_WAIT_V(4); G8_BAR;
    G8_STAGE_B(G8_SB(1, 0), cB + kstep); G8_STAGE_A(G8_SA(1, 0), c0, kstep); G8_STAGE_B(G8_SB(1, 1), cB + hstepB + kstep);
    G8_WAIT_V(6); G8_BAR;
    for (;;) {
        const bool has_next = S.next(ui + 1, nxt); nxt.par = (ui + 1) % 3;
        const char* nB = cB;
        if (has_next) { S.stash(nxt, tid); nB = S.b_base(nxt); }
#pragma unroll 1
        for (int t = 0; t < nt; t += 2) {
            const bool last = (t == nt - 2);
            const size_t k1 = (size_t)(t + 1) * kstep;
            const size_t k2 = last ? 0 : (size_t)(t + 2) * kstep, k3 = k2 + kstep;
            const char* b2 = last ? nB : cB + k2; const char* b3 = b2 + kstep;
            G8_LDB(B0, 0, 0); G8_SCHED; G8_LDA(At, 0, 0); G8_STAGE_A(G8_SA(1, 1), c1, k1);
            if (last && has_next) S.a_handles(nxt, tid, c0, c1);
            G8_WAIT_L(8); G8_BAR; G8_WAIT_L(0); G8_MMA(0, 0, At, B0); G8_BAR; G8_SCHED;
            G8_LDB(B1, 0, 1); G8_STAGE_B(G8_SB(0, 0), b2);
            G8_BAR; G8_WAIT_L(0); G8_MMA(0, 1, At, B1); G8_BAR;
            G8_LDA(At, 0, 1); G8_STAGE_A(G8_SA(0, 0), c0, k2);
            G8_BAR; G8_WAIT_L(0); G8_MMA(1, 0, At, B0); G8_BAR; G8_SCHED;
            G8_STAGE_B(G8_SB(0, 1), b2 + hstepB);
            G8_WAIT_V(6); G8_BAR; G8_MMA(1, 1, At, B1); G8_BAR;
            G8_LDB(B0, 1, 0); G8_SCHED; G8_LDA(At, 1, 0); G8_STAGE_A(G8_SA(0, 1), c1, k2);
            G8_WAIT_L(8); G8_BAR; G8_WAIT_L(0); G8_MMA(0, 0, At, B0); G8_BAR; G8_SCHED;
            G8_LDB(B1, 1, 1); G8_STAGE_B(G8_SB(1, 0), b3);
            G8_BAR; G8_WAIT_L(0); G8_MMA(0, 1, At, B1); G8_BAR;
            G8_LDA(At, 1, 1); G8_STAGE_A(G8_SA(1, 0), c0, k3);
            G8_BAR; G8_WAIT_L(0); G8_MMA(1, 0, At, B0); G8_BAR; G8_SCHED;
            G8_STAGE_B(G8_SB(1, 1), b3 + hstepB);
            G8_WAIT_V(6); G8_BAR; G8_MMA(1, 1, At, B1); G8_BAR;
        }
        E(acc, cur, wr, wc, fr, fq);
        if (!has_next) break;
#pragma unroll
        for (int a = 0; a < 2; ++a)
#pragma unroll
            for (int b = 0; b < 2; ++b)
#pragma unroll
                for (int m = 0; m < 4; ++m)
#pragma unroll
                    for (int n = 0; n < 2; ++n) acc[a][b][m][n] = (f32x4_t){0.f, 0.f, 0.f, 0.f};
        cur = nxt; cB = nB; ++ui;
    }
    G8_WAIT_V(0);
    if (wr == 0) G8_BAR;
    G8_BAR;
#undef G8_SA
#undef G8_SB
#undef G8_STAGE_A
#undef G8_STAGE_B
#undef G8_LDA
#undef G8_LDB
#undef G8_MMA
#undef G8_WAIT_V
#undef G8_WAIT_L
#undef G8_BAR
#undef G8_SCHED
}
struct SchedPlain {
    int nM, nN, nwg, G, c, lda; const char* Bt; size_t ldb_bytes;
    __device__ __forceinline__ void init(int M, int N, int lda_, const void* Bt_, int ldb) { nM = M / 256; nN = N / 256; nwg = nM * nN; G = gridDim.x; c = blockIdx.x; lda = lda_; Bt = (const char*)Bt_; ldb_bytes = (size_t)ldb * 2; }
    __device__ __forceinline__ bool next(int i, Unit& u) const {
        const long L = (long)i * G + c; if (L >= nwg) return false;
        int wgid = (int)L; { const int q = nwg / 8, r = nwg % 8, xcd = wgid % 8, off = wgid / 8; wgid = (xcd < r ? xcd * (q + 1) : r * (q + 1) + (xcd - r) * q) + off; }
        const int nig = 8 * nN, gid = wgid / nig, fm = gid * 8, gsz = (nM - fm) < 8 ? (nM - fm) : 8;
        u.pm = fm + ((wgid % nig) % gsz); u.pn = (wgid % nig) / gsz; return true;
    }
    __device__ __forceinline__ void a_handles(const Unit& u, int tid, unsigned& h0, unsigned& h1) const {
        int R, C; stage_rc(tid * 16, R, C);
        h0 = ((unsigned)(u.pm * 256 + R) * (unsigned)lda + (unsigned)C) * 2u; h1 = h0 + (unsigned)(128 * lda) * 2u;
    }
    __device__ __forceinline__ unsigned a_off(unsigned h, int piece, int) const { return h + (unsigned)(piece * 64 * lda) * 2u; }
    __device__ __forceinline__ const char* b_base(const Unit& u) const { return Bt + (size_t)u.pn * 256 * ldb_bytes; }
    __device__ __forceinline__ void stash(const Unit&, int) const {}
    __device__ __forceinline__ void stash_wait() const {}
};
struct SchedMoe {
    const int* pre; const int* list; const float* listw; const char* Bt; size_t estride, ustride; int nunits, G, c, gather; int* tab;
    __device__ __forceinline__ int expert(int panel) const { int e = 0; for (int q = 1; q < 32; ++q) e = (pre[q] <= panel) ? q : e; return e; }
    __device__ __forceinline__ bool next(int i, Unit& u) const {
        const int per = (nunits + 7) >> 3, x = c & 7, Lx = i * (G >> 3) + (c >> 3), L = x * per + Lx;
        if (Lx >= per || L >= nunits) return false;
        u.pn = L & 3; u.pm = L >> 2; u.e = __builtin_amdgcn_readfirstlane(expert(u.pm)); return true;
    }
    __device__ __forceinline__ void stash(const Unit& u, int tid) const {
        const int e = u.e, b0 = (u.pm - pre[e]) * 256; const int* l = list + (size_t)e * T_TOK + b0;
        const int wv = __builtin_amdgcn_readfirstlane(tid >> 6);
        if (gather) {
            int R, C; stage_rc(tid * 16, R, C);
#pragma unroll
            for (int k = 0; k < 4; ++k)
                __builtin_amdgcn_global_load_lds((const unsigned*)(l + R + 64 * (k & 1) + 128 * (k >> 1)), (LAS unsigned*)((LAS unsigned char*)(LAS int*)tab + k * 2048 + wv * 256), 4, 0, 0);
        } else {
            const int r = tid & 255; const int* src = (tid < 256) ? (l + r) : reinterpret_cast<const int*>(listw + (size_t)e * T_TOK + b0 + r);
            __builtin_amdgcn_global_load_lds((const unsigned*)src, (LAS unsigned*)((LAS unsigned char*)(LAS int*)tab + u.par * 2048 + wv * 256), 4, 0, 0);
        }
    }
    __device__ __forceinline__ void stash_wait() const { asm volatile("s_waitcnt vmcnt(0)" ::: "memory"); }
    __device__ __forceinline__ void a_handles(const Unit& u, int tid, unsigned& h0, unsigned& h1) const {
        if (gather) {
            asm volatile("" ::: "memory");
            const unsigned t0 = ((unsigned)tab[tid] >> 1) & 16383u, t1 = ((unsigned)tab[512 + tid] >> 1) & 16383u, t2 = ((unsigned)tab[1024 + tid] >> 1) & 16383u, t3 = ((unsigned)tab[1536 + tid] >> 1) & 16383u;
            h0 = t0 | (t1 << 16); h1 = t2 | (t3 << 16);
        }
        else { int R, C; stage_rc(tid * 16, R, C); h0 = ((unsigned)(u.pm * 256 + R) * 512u + (unsigned)C) * 2u; h1 = h0 + 128u * 512u * 2u; }
    }
    __device__ __forceinline__ unsigned a_off(unsigned h, int piece, int tid) const {
        if (gather) { int R, C; stage_rc(tid * 16, R, C); return (((h >> (16 * piece)) & 0xffffu) * 1024u + (unsigned)C) * 2u; }
        return h + (unsigned)(piece * 64 * 512) * 2u;
    }
    __device__ __forceinline__ const char* b_base(const Unit& u) const { return Bt + (size_t)u.e * estride + (size_t)u.pn * ustride; }
};
}

__device__ __forceinline__ void convert_T(unsigned char* lds, const float* __restrict__ src, int nb, int K, int N, bf16_t* __restrict__ dst, size_t dst_bstride,
                                       const float* __restrict__ rowscale, int grp, int grp_stride, int off, int b0 = 0, int perm = 0) {
    (void)lds;
    int tid = VT; asm volatile("" : "+v"(tid));
    const int lane = tid & 63, wid = tid >> 6;
    const int nkt = K >> 7, nnt = (N + 63) >> 6, per = nkt * nnt, total = nb * per;
    for (int it = VB; it < total; it += NVB) {
        const int bl = it / per, b = b0 + bl, rem = it - bl * per, ktile = rem / nnt, ntile = rem - ktile * nnt;
        const int k0 = (ktile << 7) + (wid * 4 + (lane >> 4)) * 8, n = (ntile << 6) + (lane & 15) * 4;
        if (n < N) {
            const float* s = src + (size_t)b * K * N + (size_t)k0 * N + n;
            f32x4 v[8];
#pragma unroll
            for (int j = 0; j < 8; ++j) v[j] = *reinterpret_cast<const f32x4*>(s + (size_t)j * N);
            if (rowscale) {
#pragma unroll
                for (int j = 0; j < 8; ++j) { const float sc = rowscale[(size_t)b * K + k0 + j]; v[j] *= sc; }
            }
#pragma unroll
            for (int q = 0; q < 4; ++q) {
                const int nn = n + q; int drow = (nn / grp) * grp_stride + off + (nn % grp);
                if (perm == 1) { const int l = drow & 127; drow = (drow & ~127) | (32 * ((l >> 4) & 3) + 16 * (l >> 6) + (l & 15)); }
                if (perm == 3) { const int l = drow & 31; drow = (drow & ~31) | (16 * ((l >> 2) & 1) + 4 * (l >> 3) + (l & 3)); }
                else if (perm == 2) { const int l = drow & 63; drow = (drow & ~63) | (32 * ((l >> 4) & 1) + 16 * (l >> 5) + (l & 15)); }
                *reinterpret_cast<uint4*>(dst + (size_t)b * dst_bstride + (size_t)drow * K + k0) = cvtpk8(v[0][q], v[1][q], v[2][q], v[3][q], v[4][q], v[5][q], v[6][q], v[7][q]);
            }
        }
    }
}

__device__ __forceinline__ void job_mod(PRef p, unsigned char* lds) {
    int tid = VT; asm volatile("" : "+v"(tid));
    const int lane = tid & 63, wid = tid >> 6;
    float* sc = reinterpret_cast<float*>(lds);
    float* part = reinterpret_cast<float*>(lds + 32768);
    for (int i = tid; i < 8192; i += NTHR) { const int b = i >> 10, k = i & 1023; const float v = p.c[b * 1024 + k]; sc[k * 8 + b] = v / (1.f + expf(-v)); }
    __syncthreads();
    for (int it = VB; it < 384; it += NVB) {
        const int sl = it / 48, n0 = (it % 48) * 64;
        const float* W = p.ada_w + (size_t)sl * 1024 * 3072 + n0 + lane;
        float acc[8] = {0.f, 0.f, 0.f, 0.f, 0.f, 0.f, 0.f, 0.f};
        const int kb = wid * 256;
#pragma unroll 16
        for (int k = 0; k < 256; ++k) {
            const float w = W[(size_t)(kb + k) * 3072];
            const f32x4 s0 = *reinterpret_cast<const f32x4*>(sc + (kb + k) * 8), s1 = *reinterpret_cast<const f32x4*>(sc + (kb + k) * 8 + 4);
            acc[0] += s0[0] * w; acc[1] += s0[1] * w; acc[2] += s0[2] * w; acc[3] += s0[3] * w;
            acc[4] += s1[0] * w; acc[5] += s1[1] * w; acc[6] += s1[2] * w; acc[7] += s1[3] * w;
        }
#pragma unroll
        for (int b = 0; b < 8; ++b) part[(wid * 8 + b) * 64 + lane] = acc[b];
        __syncthreads();
        for (int o = tid; o < 512; o += NTHR) {
            const int b = o >> 6, l = o & 63;
            const float s = part[(0 * 8 + b) * 64 + l] + part[(1 * 8 + b) * 64 + l] + part[(2 * 8 + b) * 64 + l] + part[(3 * 8 + b) * 64 + l] + p.ada_b[sl * 3072 + n0 + l];
            p.mod[(size_t)(sl * 8 + b) * 3072 + n0 + l] = s;
        }
        __syncthreads();
    }
}

__device__ __forceinline__ void job_misc(PRef p, unsigned char* lds) {
    const int tid = VT;
    const size_t gtid = (size_t)VB * NTHR + tid, gsz = (size_t)NVB * NTHR;
    for (size_t i = gtid; i < (size_t)T_TOK * 32; i += gsz) {
        const int t = (int)(i >> 5), f = (int)(i & 31);
        const float inv = 1.0f / powf(10000.f, (float)(2 * f) / 64.f);
        const float ang = (float)p.pos[t] * inv;
        p.cosm[i] = cosf(ang); p.sinm[i] = sinf(ang);
    }
    for (size_t i = gtid; i < (size_t)T_TOK * 64; i += gsz) {
        const int t = (int)(i >> 6), f = (int)(i & 63);
        const float inv = 1.0f / powf(10000.f, (float)(2 * f) / 128.f);
        const float ang = (float)p.pos[t] * inv;
        p.cosn[i] = cosf(ang); p.sinn[i] = sinf(ang);
    }
    for (size_t i = gtid; i < (size_t)DEPTH * 1024 * 48; i += gsz) {
        const int e = (int)(i % 48); const size_t lk = i / 48;
        float v = 0.f;
        if (e < 4) v = p.moe_w_grp[lk * 4 + e]; else if (e < 36) v = p.moe_w_rt[lk * 32 + (e - 4)];
        p.wr[i] = v;
    }
    if (gtid < DEPTH * 32) p.cnt[gtid * 64] = 0;
    {
        const int lane = tid & 63, wid = tid >> 6;
        for (int o = VB * 4 + wid; o < 256; o += NVB * 4) {
            const int which = o >> 7, e = o & 127;
            const float* pe = which ? p.nsa_pe_v : p.nsa_pe_k; const float* w1 = which ? p.nsa_w_cv1 : p.nsa_w_ck1;
            float a = 0.f;
#pragma unroll 16
            for (int j = 0; j < 64; ++j) { const int k = lane + 64 * j; a += pe[k] * w1[(size_t)k * 128 + e]; }
            a = wave_sum(a);
            if (lane == 0) p.bias1[o] = a;
        }
    }
}

struct CvtJob { const float* src; int nb, K, N; bf16_t* dst; size_t bstride; const float* rowscale; int grp, gstride, off, perm; };
__device__ __forceinline__ CvtJob cvt_job(PRef p, int j) {
    const int BIG = 1 << 30;
    CvtJob c;
    switch (j) {
    case 0:  c = CvtJob{p.moe_w_gate, DEPTH * 32, 1024, 512, p.wt_gu, (size_t)1024 * 1024, nullptr, 64, 128, 0, 0}; break;
    case 1:  c = CvtJob{p.moe_w_up, DEPTH * 32, 1024, 512, p.wt_gu, (size_t)1024 * 1024, nullptr, 64, 128, 64, 0}; break;
    case 2:  c = CvtJob{p.moe_w_down, DEPTH * 32, 512, 1024, p.wt_dn, (size_t)1024 * 512, nullptr, BIG, 0, 0, 0}; break;
    case 3:  c = CvtJob{p.mla_w_in, 2, 1024, 576, p.wt_mla_in, (size_t)768 * 1024, nullptr, BIG, 0, 0, 2}; break;
    case 4:  c = CvtJob{p.mla_w_uq, 2, 256, 1536, p.wt_uq, (size_t)1536 * 256, p.mla_g_q, BIG, 0, 0, 2}; break;
    case 5:  c = CvtJob{p.mla_w_ukv, 2, 256, 2048, p.wt_ukv, (size_t)2048 * 256, p.mla_g_kv, BIG, 0, 0, 3}; break;
    case 6:  c = CvtJob{p.mla_w_o, 2, 1024, 1024, p.wt_mla_o, (size_t)1024 * 1024, nullptr, BIG, 0, 0, 3}; break;
    case 7:  c = CvtJob{p.nsa_w_in, 1, 1024, 2584, p.wt_nsa_in, 0, nullptr, BIG, 0, 0, 1}; break;
    case 8:  c = CvtJob{p.nsa_w_ck1, 1, 4096, 128, p.wt_ck1, 0, nullptr, BIG, 0, 0, 0}; break;
    case 9:  c = CvtJob{p.nsa_w_cv1, 1, 4096, 128, p.wt_cv1, 0, nullptr, BIG, 0, 0, 0}; break;
    case 10: c = CvtJob{p.nsa_w_ck2, 1, 128, 128, p.wt_ck2, 0, nullptr, BIG, 0, 0, 0}; break;
    case 11: c = CvtJob{p.nsa_w_cv2, 1, 128, 128, p.wt_cv2, 0, nullptr, BIG, 0, 0, 0}; break;
    case 12: c = CvtJob{p.nsa_w_o, 1, 1024, 1024, p.wt_nsa_o, 0, nullptr, BIG, 0, 0, 3}; break;
    case 13: c = CvtJob{p.sb_w_qkv, 1, 1024, 3072, p.wt_sb_qkv, 0, nullptr, BIG, 0, 0, 3}; break;
    default: c = CvtJob{p.sb_w_o, 1, 1024, 1024, p.wt_sb_o, 0, nullptr, BIG, 0, 0, 3}; break;
    }
    return c;
}
template <int K, int N, int grp, int grp_stride, int perm>
__device__ __forceinline__ void convert_T_steal(int* ctr, const float* __restrict__ src, bf16_t* __restrict__ dst, int off, int b0) {
    constexpr int nb = 32; constexpr size_t dst_bstride = (size_t)K * N * (grp_stride ? 2 : 1);
    int tid = threadIdx.x; asm volatile("" : "+v"(tid));
    const int lane = tid & 63;
    constexpr int nkt = K >> 7, nnt = N >> 6, per = nkt * nnt, total = nb * per * 4;
    for (;;) {
        int w0 = 0;
        if (lane == 0) w0 = __hip_atomic_fetch_add(ctr, 8, __ATOMIC_RELAXED, __HIP_MEMORY_SCOPE_AGENT);
        w0 = __builtin_amdgcn_readfirstlane(w0);
        if (w0 >= total) break;
#pragma unroll 1
        for (int w = w0; w < w0 + 8; ++w) {
            const int it = w >> 2, wq = w & 3;
            const int bl = it / per, b = b0 + bl, rem = it - bl * per, ktile = rem / nnt, ntile = rem - ktile * nnt;
            const int k0 = (ktile << 7) + (wq * 4 + (lane >> 4)) * 8, n = (ntile << 6) + (lane & 15) * 4;
            const float* sp = src + (size_t)b * K * N + (size_t)k0 * N + n;
            f32x4 v[8];
#pragma unroll
            for (int j = 0; j < 8; ++j) v[j] = *reinterpret_cast<const f32x4*>(sp + (size_t)j * N);
#pragma unroll
            for (int q = 0; q < 4; ++q) {
                const int nn = n + q; int drow = (nn / grp) * grp_stride + off + (nn % grp);
                if (perm == 1) { const int l = drow & 127; drow = (drow & ~127) | (32 * ((l >> 4) & 3) + 16 * (l >> 6) + (l & 15)); }
                if (perm == 3) { const int l = drow & 31; drow = (drow & ~31) | (16 * ((l >> 2) & 1) + 4 * (l >> 3) + (l & 3)); }
                *reinterpret_cast<uint4*>(dst + (size_t)b * dst_bstride + (size_t)drow * K + k0) = cvtpk8(v[0][q], v[1][q], v[2][q], v[3][q], v[4][q], v[5][q], v[6][q], v[7][q]);
            }
        }
    }
}
__device__ __forceinline__ void convert_moe_steal(PRef p, int layer, int which) {
    int* ctr = p.wq + (layer * 3 + which) * 64;
    if (which == 0) convert_T_steal<1024, 512, 128, 256, 3>(ctr, p.moe_w_gate, p.wt_gu, 0, layer * 32);
    else if (which == 1) convert_T_steal<1024, 512, 128, 256, 3>(ctr, p.moe_w_up, p.wt_gu, 128, layer * 32);
    else convert_T_steal<512, 1024, 1 << 30, 0, 3>(ctr, p.moe_w_down, p.wt_dn, 0, layer * 32);
}
__device__ __forceinline__ void convert_moe(PRef p, int layer, int which) {
    if (which == 0) convert_T(nullptr, p.moe_w_gate, 32, 1024, 512, p.wt_gu, (size_t)1024 * 1024, nullptr, 128, 256, 0, layer * 32, 3);
    else if (which == 1) convert_T(nullptr, p.moe_w_up, 32, 1024, 512, p.wt_gu, (size_t)1024 * 1024, nullptr, 128, 256, 128, layer * 32, 3);
    else convert_T(nullptr, p.moe_w_down, 32, 512, 1024, p.wt_dn, (size_t)1024 * 512, nullptr, 1 << 30, 0, 0, layer * 32, 3);
}
__device__ __forceinline__ void ph_prologue(PRef p) {
    unsigned char* lds = VLDS;
    job_mod(p, lds);
    job_misc(p, lds);
    for (int j = 3; j < 15; ++j) {
        const CvtJob c = cvt_job(p, j);
        convert_T(lds, c.src, c.nb, c.K, c.N, c.dst, c.bstride, c.rowscale, c.grp, c.gstride, c.off, 0, c.perm);
    }
    for (int w = 0; w < 2; ++w) convert_moe(p, 0, w);
}

__device__ __forceinline__ void ph_h0(PRef p) {
    const size_t gtid = (size_t)VB * NTHR + VT, gsz = (size_t)NVB * NTHR;
    for (size_t i = gtid; i < (size_t)T_TOK * 128; i += gsz) {
        const int row = (int)(i >> 7), c0 = (int)(i & 127) * 8, b = row >> 11;
        const float* xs = p.x + (size_t)row * 1024 + c0; const float* sh = p.mod + (size_t)b * 3072 + c0; const float* scp = sh + 1024;
        float v[8];
#pragma unroll
        for (int q = 0; q < 8; ++q) v[q] = xs[q] * (1.f + scp[q]) + sh[q];
        *reinterpret_cast<uint4*>(p.hbuf + (size_t)row * 1024 + c0) = pack8(v);
    }
}

__device__ __forceinline__ void st4bf(bf16_t* p, float a, float b, float c, float d) { uint2 pk; pk.x = cvtpk(a, b); pk.y = cvtpk(c, d); *reinterpret_cast<uint2*>(p) = pk; }
__device__ __forceinline__ int vt_pos(int s) { return (s & ~12) | ((s & 4) << 1) | ((s & 8) >> 1); }
__device__ __forceinline__ void st_vt4(bf16_t* vt_feat0  , const g8::f32x4_t& a, float sc) {
#pragma unroll
    for (int q = 0; q < 4; ++q) vt_feat0[(size_t)q * SEQ] = (bf16_t)(cvtpk(a[q] * sc, 0.f) & 0xffffu);
}
struct EpiMlaIn {
    bf16_t* cbuf; float* rss; bf16_t* krope; const float* cosm; const float* sinm;
    __device__ __forceinline__ void operator()(const g8::f32x4_t (&acc)[2][2][4][2], const g8::Unit& u, int wr, int wc, int fr, int fq) const {
        const int lc = 64 * (wc >> 1) + 16 * (wc & 1) + 4 * fq;
#pragma unroll
        for (int ai = 0; ai < 2; ++ai) {
            f32x4 csb[4], snb[4];
            if (u.pn >= 2 && wc < 2) {
#pragma unroll
                for (int m = 0; m < 4; ++m) {
                    const int row = u.pm * 256 + ai * 128 + wr * 64 + m * 16 + fr, i0 = 16 * wc + 4 * fq;
                    csb[m] = *reinterpret_cast<const f32x4*>(cosm + (size_t)row * 32 + i0); snb[m] = *reinterpret_cast<const f32x4*>(sinm + (size_t)row * 32 + i0);
                }
            }
#pragma unroll
            for (int m = 0; m < 4; ++m) {
                const int row = u.pm * 256 + ai * 128 + wr * 64 + m * 16 + fr;
                if (u.pn < 2) {
                    float sq = 0.f;
#pragma unroll
                    for (int bj = 0; bj < 2; ++bj)
#pragma unroll
                        for (int n = 0; n < 2; ++n) {
                            const g8::f32x4_t a = acc[ai][bj][m][n];
                            st4bf(cbuf + (size_t)row * 512 + u.pn * 256 + bj * 128 + lc + 32 * n, a[0], a[1], a[2], a[3]);
                            sq += a[0] * a[0] + a[1] * a[1] + a[2] * a[2] + a[3] * a[3];
                        }
                    sq += __shfl_xor(sq, 16, 64); sq += __shfl_xor(sq, 32, 64);
                    if (fq == 0) rss[(size_t)row * 8 + u.pn * 4 + wc] = sq;
                } else if (wc < 2) {
                    const int i0 = 16 * wc + 4 * fq;
                    const f32x4 cs = csb[m], sn = snb[m];
                    const g8::f32x4_t x1 = acc[ai][0][m][0], x2 = acc[ai][0][m][1];
                    st4bf(krope + (size_t)row * 64 + i0, x1[0] * cs[0] - x2[0] * sn[0], x1[1] * cs[1] - x2[1] * sn[1], x1[2] * cs[2] - x2[2] * sn[2], x1[3] * cs[3] - x2[3] * sn[3]);
                    st4bf(krope + (size_t)row * 64 + 32 + i0, x2[0] * cs[0] + x1[0] * sn[0], x2[1] * cs[1] + x1[1] * sn[1], x2[2] * cs[2] + x1[2] * sn[2], x2[3] * cs[3] + x1[3] * sn[3]);
                }
            }
        }
    }
};
__device__ __forceinline__ void ph_mla_in(PRef p, int j) {
    g8::SchedPlain S; S.init(T_TOK, 768, 1024, p.wt_mla_in + (size_t)j * 768 * 1024, 1024);
    g8::gemm8((LAS unsigned char*)(smem + LDS_WORK), (const char*)p.hbuf, 1024, 1024, S, EpiMlaIn{p.cbuf, p.rss, p.krope, p.cosm, p.sinm});
    __syncthreads();
}
__device__ __forceinline__ float mla_rstd(const float* rss, int row, int which) {
    const f32x4 q = *reinterpret_cast<const f32x4*>(rss + (size_t)row * 8 + which * 4);
    return rsqrtf((q[0] + q[1] + q[2] + q[3]) * (1.f / 256.f) + RMS_EPS);
}
struct EpiMlaQ {
    bf16_t* qm; const float* rss; const float* cosm; const float* sinm;
    __device__ __forceinline__ void operator()(const g8::f32x4_t (&acc)[2][2][4][2], const g8::Unit& u, int wr, int wc, int fr, int fq) const {
        const int i0 = 16 * (wc & 1) + 4 * fq;
#pragma unroll
        for (int ai = 0; ai < 2; ++ai) {
            f32x4 qs[4], csb[4], snb[4];
#pragma unroll
            for (int m = 0; m < 4; ++m) {
                const int row = u.pm * 256 + ai * 128 + wr * 64 + m * 16 + fr;
                qs[m] = *reinterpret_cast<const f32x4*>(rss + (size_t)row * 8);
                csb[m] = *reinterpret_cast<const f32x4*>(cosm + (size_t)row * 32 + i0); snb[m] = *reinterpret_cast<const f32x4*>(sinm + (size_t)row * 32 + i0);
            }
#pragma unroll
            for (int m = 0; m < 4; ++m) {
                const int row = u.pm * 256 + ai * 128 + wr * 64 + m * 16 + fr;
                const float sc = rsqrtf((qs[m][0] + qs[m][1] + qs[m][2] + qs[m][3]) * (1.f / 256.f) + RMS_EPS);
                const f32x4 cs = csb[m], sn = snb[m];
#pragma unroll
                for (int bj = 0; bj < 2; ++bj) {
                    const int c64 = u.pn * 256 + bj * 128 + 64 * (wc >> 1);
                    bf16_t* dst = qm + (size_t)row * 1536 + c64 + i0;
                    const g8::f32x4_t x1 = acc[ai][bj][m][0], x2 = acc[ai][bj][m][1];
                    if ((c64 % 192) == 128) {
                        st4bf(dst, (x1[0] * cs[0] - x2[0] * sn[0]) * sc, (x1[1] * cs[1] - x2[1] * sn[1]) * sc, (x1[2] * cs[2] - x2[2] * sn[2]) * sc, (x1[3] * cs[3] - x2[3] * sn[3]) * sc);
                        st4bf(dst + 32, (x2[0] * cs[0] + x1[0] * sn[0]) * sc, (x2[1] * cs[1] + x1[1] * sn[1]) * sc, (x2[2] * cs[2] + x1[2] * sn[2]) * sc, (x2[3] * cs[3] + x1[3] * sn[3]) * sc);
                    } else {
                        st4bf(dst, x1[0] * sc, x1[1] * sc, x1[2] * sc, x1[3] * sc);
                        st4bf(dst + 32, x2[0] * sc, x2[1] * sc, x2[2] * sc, x2[3] * sc);
                    }
                }
            }
        }
    }
};
struct EpiMlaKv {
    bf16_t* kn; bf16_t* vt; const float* rss;
    __device__ __forceinline__ void operator()(const g8::f32x4_t (&acc)[2][2][4][2], const g8::Unit& u, int wr, int wc, int fr, int fq) const {
        const int hd = u.pn;
#pragma unroll
        for (int ai = 0; ai < 2; ++ai) {
            f32x4 qs[4];
#pragma unroll
            for (int m = 0; m < 4; ++m) qs[m] = *reinterpret_cast<const f32x4*>(rss + (size_t)(u.pm * 256 + ai * 128 + wr * 64 + m * 16 + fr) * 8 + 4);
#pragma unroll
            for (int m = 0; m < 4; ++m) {
                const int row = u.pm * 256 + ai * 128 + wr * 64 + m * 16 + fr, b = row >> 11, sq = row & 2047;
                const float sc = rsqrtf((qs[m][0] + qs[m][1] + qs[m][2] + qs[m][3]) * (1.f / 256.f) + RMS_EPS);
                const int c = 32 * wc + 8 * fq;
                const g8::f32x4_t k0 = acc[ai][0][m][0], k1 = acc[ai][0][m][1];
                *reinterpret_cast<uint4*>(kn + (size_t)row * 1024 + hd * 128 + c) = cvtpk8(k0[0] * sc, k0[1] * sc, k0[2] * sc, k0[3] * sc, k1[0] * sc, k1[1] * sc, k1[2] * sc, k1[3] * sc);
#pragma unroll
                for (int n = 0; n < 2; ++n) st_vt4(vt + ((size_t)(b * 8 + hd) * 128 + c + 4 * n) * SEQ + vt_pos(sq), acc[ai][1][m][n], sc);
            }
        }
    }
};
__device__ __forceinline__ void ph_mla_up(PRef p, int j) {
    { g8::SchedPlain S; S.init(T_TOK, 1536, 512, p.wt_uq + (size_t)j * 1536 * 256, 256);
      g8::gemm8((LAS unsigned char*)(smem + LDS_WORK), (const char*)p.cbuf, 256, 256, S, EpiMlaQ{p.qm, p.rss, p.cosm, p.sinm}); }
    { g8::SchedPlain S; S.init(T_TOK, 2048, 512, p.wt_ukv + (size_t)j * 2048 * 256, 256);
      g8::gemm8((LAS unsigned char*)(smem + LDS_WORK), (const char*)(p.cbuf + 256), 256, 256, S, EpiMlaKv{p.kn, p.vt, p.rss}); }
    __syncthreads();
}
struct EpiNsaIn {
    PRef p;
    __device__ __forceinline__ void operator()(const g8::f32x4_t (&acc)[2][2][4][2], const g8::Unit& u, int wr, int wc, int fr, int fq) const {
        const int i0 = 16 * wc + 4 * fq;
        const bool rot = (u.pn < 5) || u.pn == 6 || u.pn == 8;
#pragma unroll
        for (int ai = 0; ai < 2; ++ai) {
            f32x4 cs[4], sn[4];
            if (rot) {
#pragma unroll
                for (int m = 0; m < 4; ++m) {
                    const int row = u.pm * 256 + ai * 128 + wr * 64 + m * 16 + fr;
                    cs[m] = *reinterpret_cast<const f32x4*>(p.cosn + (size_t)row * 64 + i0); sn[m] = *reinterpret_cast<const f32x4*>(p.sinn + (size_t)row * 64 + i0);
                }
            }
#pragma unroll
            for (int bj = 0; bj < 2; ++bj) {
                const int tn = 2 * u.pn + bj;
                if (tn >= 21) continue;
#pragma unroll
                for (int m = 0; m < 4; ++m) {
                    const int row = u.pm * 256 + ai * 128 + wr * 64 + m * 16 + fr, b = row >> 11, sq = row & 2047;
                    const g8::f32x4_t x1 = acc[ai][bj][m][0], x2 = acc[ai][bj][m][1];
                    if (tn == 20) {
                        if (i0 < 24) {
#pragma unroll
                            for (int q = 0; q < 4; ++q) { const int c = i0 + q; p.gates[(size_t)row * 32 + (c / 3) * 4 + (c % 3)] = sigmoid_f(x1[q]); }
                        }
                        continue;
                    }
                    const int g = (tn - 8) >> 1, kh = (tn - 8) & 1;
                    const size_t slab = (size_t)(b * 2 + kh) * SEQ * 128;
                    if (tn >= 8 && (g == 3 || g == 5)) {
                        bf16_t* vt = (g == 3 ? p.vst : p.vwt) + slab + vt_pos(sq);
                        st_vt4(vt + (size_t)i0 * SEQ, x1, 1.f); st_vt4(vt + (size_t)(i0 + 64) * SEQ, x2, 1.f);
                    } else if (tn >= 8 && g == 1) {
                        bf16_t* dst = p.vc + slab + (size_t)sq * 128 + i0;
                        st4bf(dst, x1[0], x1[1], x1[2], x1[3]); st4bf(dst + 64, x2[0], x2[1], x2[2], x2[3]);
                    } else {
                        bf16_t* dst = (tn < 8) ? p.qn + (size_t)row * 1024 + tn * 128 + i0 : (g == 0 ? p.kc : (g == 2 ? p.ks : p.kw)) + slab + (size_t)sq * 128 + i0;
                        const f32x4 c_ = cs[m], s_ = sn[m];
                        st4bf(dst, x1[0] * c_[0] - x2[0] * s_[0], x1[1] * c_[1] - x2[1] * s_[1], x1[2] * c_[2] - x2[2] * s_[2], x1[3] * c_[3] - x2[3] * s_[3]);
                        st4bf(dst + 64, x2[0] * c_[0] + x1[0] * s_[0], x2[1] * c_[1] + x1[1] * s_[1], x2[2] * c_[2] + x1[2] * s_[2], x2[3] * c_[3] + x1[3] * s_[3]);
                    }
                }
            }
        }
    }
};
__device__ __forceinline__ void ph_nsa_in(PRef p) {
    g8::SchedPlain S; S.init(T_TOK, 2816, 1024, p.wt_nsa_in, 1024);
    g8::gemm8((LAS unsigned char*)(smem + LDS_WORK), (const char*)p.hbuf, 1024, 1024, S, EpiNsaIn{p});
    __syncthreads();
}
struct RowWin { const bf16_t* base; __device__ __forceinline__ const bf16_t* operator()(int r) const { return base + (size_t)r * 2048; } };
__device__ __forceinline__ void ph_nsa_cmp1(PRef p) {
    unsigned char* lds = VLDS; const float* Cs = reinterpret_cast<const float*>(lds);
    for (int it = VB; it < 256; it += NVB) {
        const int item = it >> 3, sp = it & 7, which = item & 1, bkh = item >> 1;
        const bf16_t* src = (which ? p.vc : p.kc) + (size_t)bkh * SEQ * 128 + sp * 512;
        int tid = VT; asm volatile("" : "+v"(tid));
        f32x16 acc[2][2];
        gemm_main(tid, lds, RowWin{src}, (which ? p.wt_cv1 : p.wt_ck1) + sp * 512, 4096, 0, 512, acc);
        float* dst = p.cpart + (size_t)(item * 8 + sp) * 128 * 128;
        const int c0 = (tid & 15) * 8;
#pragma unroll
        for (int ps = 0; ps < 8; ++ps) {
            const int row = (tid >> 4) + 16 * ps;
            *reinterpret_cast<f32x4*>(dst + row * 128 + c0) = *reinterpret_cast<const f32x4*>(Cs + row * CS_LD + c0);
            *reinterpret_cast<f32x4*>(dst + row * 128 + c0 + 4) = *reinterpret_cast<const f32x4*>(Cs + row * CS_LD + c0 + 4);
        }
        ITEM_END_SYNC();
    }
}
__device__ __forceinline__ void ph_nsa_cmp2(PRef p) {
    unsigned char* lds = VLDS; const float* Cs = reinterpret_cast<const float*>(lds);
    for (int item = VB; item < 32; item += NVB) {
        const int which = item & 1, bkh = item >> 1;
        int tid = VT; asm volatile("" : "+v"(tid));
        bf16_t* hid = p.hid + (size_t)item * 128 * 128;
        for (int o = tid; o < 128 * 16; o += NTHR) {
            const int row = o >> 4, c0 = (o & 15) * 8; float v[8];
#pragma unroll
            for (int q = 0; q < 8; ++q) v[q] = p.bias1[which * 128 + c0 + q];
            for (int sp = 0; sp < 8; ++sp) {
                const float* src = p.cpart + (size_t)(item * 8 + sp) * 128 * 128 + row * 128 + c0;
#pragma unroll
                for (int q = 0; q < 8; ++q) v[q] += src[q];
            }
#pragma unroll
            for (int q = 0; q < 8; ++q) v[q] = silu_f(v[q]);
            *reinterpret_cast<uint4*>(hid + row * 128 + c0) = pack8(v);
        }
        __threadfence();
        __syncthreads();
        f32x16 acc[2][2];
        gemm_main(tid, lds, RowPlain{hid, 128}, which ? p.wt_cv2 : p.wt_ck2, 128, 0, 128, acc);
        if (!which) {
            const int c0 = (tid & 15) * 8;
#pragma unroll
            for (int ps = 0; ps < 8; ++ps) {
                const int row = (tid >> 4) + 16 * ps; float v[8]; cs_load8(Cs, row, c0, v);
                if (row == 127) {
#pragma unroll
                    for (int q = 0; q < 8; ++q) v[q] = 0.f; }
                *reinterpret_cast<uint4*>(p.kcmp + (size_t)bkh * 128 * 128 + row * 128 + c0) = pack8(v);
            }
        } else {
            const int dv = tid & 127, sh = tid >> 7;
#pragma unroll
            for (int jj = 0; jj < 8; ++jj) {
                float v[8];
#pragma unroll
                for (int q = 0; q < 8; ++q) { const int row = vt_pos(sh * 64 + jj * 8 + q); v[q] = (row == 127) ? 0.f : Cs[row * CS_LD + dv]; }
                *reinterpret_cast<uint4*>(p.vcmpt + (size_t)bkh * 128 * 128 + dv * 128 + sh * 64 + jj * 8) = pack8(v);
            }
        }
        ITEM_END_SYNC();
    }
}
struct EpiSbIn {
    bf16_t* qs; bf16_t* ksb; bf16_t* vt;
    __device__ __forceinline__ void operator()(const g8::f32x4_t (&acc)[2][2][4][2], const g8::Unit& u, int wr, int wc, int fr, int fq) const {
#pragma unroll
        for (int ai = 0; ai < 2; ++ai)
#pragma unroll
            for (int m = 0; m < 4; ++m) {
                const int row = u.pm * 256 + ai * 128 + wr * 64 + m * 16 + fr, b = row >> 11, sq = row & 2047;
#pragma unroll
                for (int bj = 0; bj < 2; ++bj) {
                    const int c = (u.pn & 3) * 256 + bj * 128 + 32 * wc + 8 * fq;
                    const g8::f32x4_t a = acc[ai][bj][m][0], d = acc[ai][bj][m][1];
                    if (u.pn < 8) *reinterpret_cast<uint4*>((u.pn < 4 ? qs : ksb) + (size_t)row * 1024 + c) = cvtpk8(a[0], a[1], a[2], a[3], d[0], d[1], d[2], d[3]);
                    else { st_vt4(vt + ((size_t)b * 1024 + c) * SEQ + vt_pos(sq), a, 1.f); st_vt4(vt + ((size_t)b * 1024 + c + 4) * SEQ + vt_pos(sq), d, 1.f); }
                }
            }
    }
};
__device__ __forceinline__ void ph_sb_in(PRef p) {
    g8::SchedPlain S; S.init(T_TOK, 3072, 1024, p.wt_sb_qkv, 1024);
    g8::gemm8((LAS unsigned char*)(smem + LDS_WORK), (const char*)p.hbuf, 1024, 1024, S, EpiSbIn{p.qs, p.ksb, p.vt});
    __syncthreads();
}
template <bool XF32> struct EpiWo {
    const float* xs; const f16_t* xh; f16_t* z; const float* mod; int L;
    __device__ __forceinline__ void operator()(const g8::f32x4_t (&acc)[2][2][4][2], const g8::Unit& u, int wr, int wc, int fr, int fq) const {
        const int row0 = u.pm * 256 + wr * 64 + fr, col0 = u.pn * 256 + wc * 32 + 8 * fq, b = (u.pm * 256) >> 11;
        const float* gate = mod + (size_t)((L * 2 + 0) * 8 + b) * 3072 + 2048 + col0;
        f32x4 gv[2][2];
#pragma unroll
        for (int bj = 0; bj < 2; ++bj)
#pragma unroll
            for (int n = 0; n < 2; ++n) gv[bj][n] = *reinterpret_cast<const f32x4*>(gate + bj * 128 + n * 4);
#pragma unroll
        for (int ai = 0; ai < 2; ++ai) {
            f32x4 xv[4][2][2];
#pragma unroll
            for (int m = 0; m < 4; ++m)
#pragma unroll
                for (int bj = 0; bj < 2; ++bj) {
                    const size_t o = (size_t)(row0 + ai * 128 + m * 16) * 1024 + col0 + bj * 128;
                    if (XF32) { xv[m][bj][0] = *reinterpret_cast<const f32x4*>(xs + o); xv[m][bj][1] = *reinterpret_cast<const f32x4*>(xs + o + 4); }
                    else { const f16x8 hx = *reinterpret_cast<const f16x8*>(xh + o); const f32x8 fx = __builtin_convertvector(hx, f32x8); xv[m][bj][0] = (f32x4){fx[0], fx[1], fx[2], fx[3]}; xv[m][bj][1] = (f32x4){fx[4], fx[5], fx[6], fx[7]}; }
                }
#pragma unroll
            for (int m = 0; m < 4; ++m)
#pragma unroll
                for (int bj = 0; bj < 2; ++bj) {
                    f32x8 zv;
#pragma unroll
                    for (int n = 0; n < 2; ++n)
#pragma unroll
                        for (int q = 0; q < 4; ++q) zv[n * 4 + q] = DN_ALPHA * xv[m][bj][n][q] + gv[bj][n][q] * acc[ai][bj][m][n][q];
                    *reinterpret_cast<f16x8*>(z + (size_t)(row0 + ai * 128 + m * 16) * 1024 + col0 + bj * 128) = __builtin_convertvector(zv, f16x8);
                }
        }
    }
};
__device__ __forceinline__ void ph_wo(PRef p, int L) {
    const int kind = L % 3, j = L / 3;
    const bf16_t* Bt = kind == 0 ? p.wt_mla_o + (size_t)j * 1024 * 1024 : (kind == 1 ? p.wt_nsa_o : p.wt_sb_o);
    g8::SchedPlain S; S.init(T_TOK, 1024, 1024, Bt, 1024);
    if (L == 0) g8::gemm8((LAS unsigned char*)(smem + LDS_WORK), (const char*)p.obuf, 1024, 1024, S, EpiWo<true>{p.x, p.xbuf, p.zbuf, p.mod, L});
    else g8::gemm8((LAS unsigned char*)(smem + LDS_WORK), (const char*)p.obuf, 1024, 1024, S, EpiWo<false>{p.x, p.xbuf, p.zbuf, p.mod, L});
}

#define LNC(i) (lane * 8 + 512 * ((i) >> 1) + 4 * ((i) & 1))
__device__ __forceinline__ void ln_row(float (&v)[16], const f32x4 (&gg)[4], const f32x4 (&bb)[4]) {
    float s = 0.f;
#pragma unroll
    for (int q = 0; q < 16; ++q) s += v[q];
    const float mu = wave_sum(s) * (1.f / 1024.f);
    float s2 = 0.f;
#pragma unroll
    for (int q = 0; q < 16; ++q) { const float d = v[q] - mu; s2 += d * d; }
    const float rstd = rsqrtf(wave_sum(s2) * (1.f / 1024.f) + LN_EPS);
#pragma unroll
    for (int i = 0; i < 4; ++i)
#pragma unroll
        for (int q = 0; q < 4; ++q) v[i * 4 + q] = (v[i * 4 + q] - mu) * rstd * gg[i][q] + bb[i][q];
}
__device__ __forceinline__ void ld8h_f(const uint4& w, float* v) { const f32x8 f = __builtin_convertvector(*reinterpret_cast<const f16x8*>(&w), f32x8);
#pragma unroll
    for (int q = 0; q < 8; ++q) v[q] = f[q]; }
__device__ __forceinline__ uint4 pk8h(const float* v) { f32x8 f;
#pragma unroll
    for (int q = 0; q < 8; ++q) f[q] = v[q];
    const f16x8 hh = __builtin_convertvector(f, f16x8); return *reinterpret_cast<const uint4*>(&hh); }
__device__ __forceinline__ void ph_lna(PRef p, int L, bool dry = false) {
    unsigned char* lds = VLDS;
    float* hs = reinterpret_cast<float*>(lds);
    float* part = reinterpret_cast<float*>(lds + 16 * 1028 * 4);
    int* lcnt = reinterpret_cast<int*>(lds + 78080); int* lbase = lcnt + 32; int* rexp = lcnt + 64; int* rslot = lcnt + 96; float* rwt = reinterpret_cast<float*>(lcnt + 128);
    if (VT < 32) lcnt[VT] = 0;
    __syncthreads();
    int tid = VT; asm volatile("" : "+v"(tid));
    const int lane = tid & 63, wid = tid >> 6;
    const float* g = p.ln_g + (size_t)(L * 2 + 0) * 1024; const float* bt = p.ln_b + (size_t)(L * 2 + 0) * 1024;
    const float* wr = p.wr + (size_t)L * 1024 * 48;
    int* cnt = p.cnt + L * 32 * 64;
    f32x4 lg[4], lb[4];
#pragma unroll
    for (int i = 0; i < 4; ++i) { lg[i] = *reinterpret_cast<const f32x4*>(g + LNC(i)); lb[i] = *reinterpret_cast<const f32x4*>(bt + LNC(i)); }
    for (int it = VB; it < T_TOK / 16; it += NVB) {
        const int R0 = it * 16, b = R0 >> 11;
        const float* md = p.mod + (size_t)((L * 2 + 1) * 8 + b) * 3072;
        f32x4 shv[4], scv[4];
#pragma unroll
        for (int i = 0; i < 4; ++i) { shv[i] = *reinterpret_cast<const f32x4*>(md + LNC(i)); scv[i] = *reinterpret_cast<const f32x4*>(md + 1024 + LNC(i)); }
        uint4 zr[2];
#pragma unroll
        for (int k = 0; k < 2; ++k) zr[k] = *reinterpret_cast<const uint4*>(p.zbuf + (size_t)(R0 + wid * 4) * 1024 + LNC(2 * k));
#pragma unroll 1
        for (int rr = 0; rr < 4; ++rr) {
            const int lrow = wid * 4 + rr, row = R0 + lrow;
            float v[16];
            ld8h_f(zr[0], v); ld8h_f(zr[1], v + 8);
            if (rr < 3) {
#pragma unroll
                for (int k = 0; k < 2; ++k) zr[k] = *reinterpret_cast<const uint4*>(p.zbuf + (size_t)(row + 1) * 1024 + LNC(2 * k));
            }
            ln_row(v, lg, lb);
#pragma unroll
            for (int k = 0; k < 2; ++k) {
                *reinterpret_cast<uint4*>((dry ? reinterpret_cast<f16_t*>(p.ybuf) : p.xbuf) + (size_t)row * 1024 + LNC(2 * k)) = pk8h(v + 8 * k);
                float hv[8];
#pragma unroll
                for (int q = 0; q < 8; ++q) hv[q] = v[8 * k + q] * (1.f + scv[2 * k + (q >> 2)][q & 3]) + shv[2 * k + (q >> 2)][q & 3];
                *reinterpret_cast<f32x4*>(hs + lrow * 1028 + LNC(2 * k)) = (f32x4){hv[0], hv[1], hv[2], hv[3]};
                *reinterpret_cast<f32x4*>(hs + lrow * 1028 + LNC(2 * k + 1)) = (f32x4){hv[4], hv[5], hv[6], hv[7]};
                *reinterpret_cast<uint4*>((dry ? p.hmoe : p.hbuf) + (size_t)row * 1024 + LNC(2 * k)) = cvtpk8(hv[0], hv[1], hv[2], hv[3], hv[4], hv[5], hv[6], hv[7]);
            }
        }
        __syncthreads();
        {
            f32x4 a0 = {0.f, 0.f, 0.f, 0.f}, a1 = a0, a2 = a0;
            const int rl = lane & 15, kq = lane >> 4;
#pragma unroll 32
            for (int kk = 0; kk < 64; ++kk) {
                const int k = wid * 256 + kk * 4 + kq;
                const float a = hs[rl * 1028 + k];
                const float* wp = wr + (size_t)k * 48 + rl;
                a0 = __builtin_amdgcn_mfma_f32_16x16x4f32(a, wp[0], a0, 0, 0, 0);
                a1 = __builtin_amdgcn_mfma_f32_16x16x4f32(a, wp[16], a1, 0, 0, 0);
                a2 = __builtin_amdgcn_mfma_f32_16x16x4f32(a, wp[32], a2, 0, 0, 0);
            }
#pragma unroll
            for (int q = 0; q < 4; ++q) {
                const int row = kq * 4 + q;
                part[(wid * 16 + row) * 48 + rl] = a0[q]; part[(wid * 16 + row) * 48 + 16 + rl] = a1[q]; part[(wid * 16 + row) * 48 + 32 + rl] = a2[q];
            }
        }
        __syncthreads();
        if (tid < 16) {
            const int row = R0 + tid;
            auto LG = [&](int e) { return part[(0 * 16 + tid) * 48 + e] + part[(1 * 16 + tid) * 48 + e] + part[(2 * 16 + tid) * 48 + e] + part[(3 * 16 + tid) * 48 + e]; };
            const float g0 = LG(0) + p.moe_b_grp[L * 4 + 0], g1 = LG(1) + p.moe_b_grp[L * 4 + 1], g2 = LG(2) + p.moe_b_grp[L * 4 + 2], g3 = LG(3) + p.moe_b_grp[L * 4 + 3];
            int gi = 0; float gm = g0;
            if (g1 > gm) { gm = g1; gi = 1; }
            if (g2 > gm) { gm = g2; gi = 2; }
            if (g3 > gm) { gm = g3; gi = 3; }
            const float gw = 1.f / (expf(g0 - gm) + expf(g1 - gm) + expf(g2 - gm) + expf(g3 - gm));
            int i1 = 0, i2 = 0; float m1 = -3.0e38f, m2 = -3.0e38f;
            for (int e = 0; e < 8; ++e) {
                const float v = LG(4 + gi * 8 + e) + p.moe_b_rt[L * 32 + gi * 8 + e];
                if (v > m1) { m2 = m1; i2 = i1; m1 = v; i1 = e; }
                else if (v > m2) { m2 = v; i2 = e; }
            }
            const float r = expf(m2 - m1);
            const float w1 = gw / (1.f + r), w2 = gw * r / (1.f + r);
            const int e1 = gi * 8 + i1, e2 = gi * 8 + i2;
            rwt[tid * 2] = w1; rwt[tid * 2 + 1] = w2;
            rexp[tid * 2] = e1; rexp[tid * 2 + 1] = e2;
            rslot[tid * 2] = atomicAdd(&lcnt[e1], 1); rslot[tid * 2 + 1] = atomicAdd(&lcnt[e2], 1);
        }
        __syncthreads();
        if (tid < 32) { const int c = lcnt[tid]; lbase[tid] = (c && !dry) ? atomicAdd(&cnt[tid * 64], c) : 0; lcnt[tid] = 0; }
        __syncthreads();
        if (tid < 32 && !dry) { const int e = rexp[tid]; const size_t o = (size_t)e * T_TOK + lbase[e] + rslot[tid]; p.list[o] = (R0 + (tid >> 1)) * 2 + (tid & 1); p.listw[o] = rwt[tid]; }
        __syncthreads();
    }
}
__device__ __forceinline__ void ph_lnb(PRef p, int L, bool dry = false) {
    int tid = VT; asm volatile("" : "+v"(tid));
    const int lane = tid & 63, wid = tid >> 6;
    const float* g = p.ln_g + (size_t)(L * 2 + 1) * 1024; const float* bt = p.ln_b + (size_t)(L * 2 + 1) * 1024;
    const bool last = (L == DEPTH - 1);
    f32x4 lg[4], lb[4];
#pragma unroll
    for (int i = 0; i < 4; ++i) { lg[i] = *reinterpret_cast<const f32x4*>(g + LNC(i)); lb[i] = *reinterpret_cast<const f32x4*>(bt + LNC(i)); }
    constexpr int RW = T_TOK / 2048;
    static_assert(2048 % RW == 0, "a wave's rows stay inside one batch element");
    for (int w0 = VB * 4 + wid; w0 * RW < T_TOK; w0 += NVB * 4) {
        const int row0 = w0 * RW, b = row0 >> 11;
        const float* gate = p.mod + (size_t)((L * 2 + 1) * 8 + b) * 3072 + 2048;
        const float* md = p.mod + (size_t)(((last ? L : L + 1) * 2 + 0) * 8 + b) * 3072;
        f32x4 gv[4], sh[4], sc[4];
#pragma unroll
        for (int i = 0; i < 4; ++i) { const int c = LNC(i); gv[i] = *reinterpret_cast<const f32x4*>(gate + c); if (!last) { sh[i] = *reinterpret_cast<const f32x4*>(md + c); sc[i] = *reinterpret_cast<const f32x4*>(md + 1024 + c); } }
        uint4 xr[2], y0[2], y1[2];
        auto issue = [&](int row) {
#pragma unroll
            for (int k = 0; k < 2; ++k) {
                const int c = LNC(2 * k);
                xr[k] = *reinterpret_cast<const uint4*>(p.xbuf + (size_t)row * 1024 + c);
                y0[k] = *reinterpret_cast<const uint4*>(p.ybuf + (size_t)(row * 2) * 1024 + c); y1[k] = *reinterpret_cast<const uint4*>(p.ybuf + (size_t)(row * 2 + 1) * 1024 + c);
            }
        };
        issue(row0);
#pragma unroll 1
        for (int ri = 0; ri < RW; ++ri) {
            const int row = row0 + ri;
            float v[16];
#pragma unroll
            for (int k = 0; k < 2; ++k) {
                float xv[8]; ld8h_f(xr[k], xv);
                const unsigned a0[4] = {y0[k].x, y0[k].y, y0[k].z, y0[k].w}, a1[4] = {y1[k].x, y1[k].y, y1[k].z, y1[k].w};
#pragma unroll
                for (int q = 0; q < 8; ++q) {
                    const unsigned w0 = a0[q >> 1], w1 = a1[q >> 1];
                    const float ys = (q & 1) ? (bf2f(w0 >> 16) + bf2f(w1 >> 16)) : (bf2f(w0 & 0xffffu) + bf2f(w1 & 0xffffu));
                    v[8 * k + q] = DN_ALPHA * xv[q] + gv[2 * k + (q >> 2)][q & 3] * ys;
                }
            }
            if (ri + 1 < RW) issue(row + 1);
            ln_row(v, lg, lb);
            if (last) {
#pragma unroll
                for (int i = 0; i < 4; ++i) *reinterpret_cast<f32x4*>((dry ? reinterpret_cast<float*>(p.zbuf) : p.out) + (size_t)row * 1024 + LNC(i)) = (f32x4){v[i * 4], v[i * 4 + 1], v[i * 4 + 2], v[i * 4 + 3]};
            } else {
#pragma unroll
                for (int k = 0; k < 2; ++k) {
                    const int c = LNC(2 * k);
                    *reinterpret_cast<uint4*>((dry ? p.zbuf : p.xbuf) + (size_t)row * 1024 + c) = pk8h(v + 8 * k);
                    float hv[8];
#pragma unroll
                    for (int q = 0; q < 8; ++q) hv[q] = v[8 * k + q] * (1.f + sc[2 * k + (q >> 2)][q & 3]) + sh[2 * k + (q >> 2)][q & 3];
                    *reinterpret_cast<uint4*>((dry ? p.obuf : p.hbuf) + (size_t)row * 1024 + c) = cvtpk8(hv[0], hv[1], hv[2], hv[3], hv[4], hv[5], hv[6], hv[7]);
                }
            }
        }
    }
}
#undef LNC

struct RowGather { const bf16_t* hb; const int* lst; int base, n; __device__ __forceinline__ const bf16_t* operator()(int r) const { const int idx = base + r; const int tok = (idx < n) ? (lst[idx] >> 1) : 0; return hb + (size_t)tok * 1024; } };
constexpr int G8_PRE_OFF = LDS_WORK + 131072;
__device__ __forceinline__ const int* moe_prefix256(const int* cnt) {
    int* pre = reinterpret_cast<int*>(smem + G8_PRE_OFF);
    int t_ = threadIdx.x; asm volatile("" : "+v"(t_));
    if (t_ == 0) { int s = 0; for (int e = 0; e < 32; ++e) { pre[e] = s; s += (cnt[e * 64] + 255) >> 8; } pre[32] = s; }
    if (t_ >= 64 && t_ < 96) pre[48 + t_ - 64] = cnt[(t_ - 64) * 64];
    __syncthreads();
    return pre;
}
struct EpiMoeA {
    bf16_t* hmoe;
    __device__ __forceinline__ void operator()(const g8::f32x4_t (&acc)[2][2][4][2], const g8::Unit& u, int wr, int wc, int fr, int fq) const {
#pragma unroll
        for (int ai = 0; ai < 2; ++ai)
#pragma unroll
            for (int m = 0; m < 4; ++m) {
                bf16_t* rowp = hmoe + (size_t)(u.pm * 256 + ai * 128 + wr * 64 + m * 16 + fr) * 512 + u.pn * 128 + wc * 32 + fq * 8;
                float hv[8];
#pragma unroll
                for (int n = 0; n < 2; ++n) {
                    const g8::f32x4_t g = acc[ai][0][m][n], up = acc[ai][1][m][n];
#pragma unroll
                    for (int q = 0; q < 4; ++q) hv[n * 4 + q] = silu_f(g[q]) * up[q];
                }
                *reinterpret_cast<uint4*>(rowp) = cvtpk8(hv[0], hv[1], hv[2], hv[3], hv[4], hv[5], hv[6], hv[7]);
            }
    }
};
__device__ __forceinline__ void ph_moe_a(PRef p, int L) {
    const int* cnt = p.cnt + L * 32 * 64;
    const int* pre = moe_prefix256(cnt);
    g8::SchedMoe S{pre, p.list, p.listw, (const char*)(p.wt_gu + (size_t)L * 32 * 1024 * 1024), (size_t)1024 * 1024 * 2, (size_t)256 * 1024 * 2, pre[32] * 4, (int)gridDim.x, (int)blockIdx.x, 1, reinterpret_cast<int*>(smem + G8_PRE_OFF + 512)};
    g8::gemm8((LAS unsigned char*)(smem + LDS_WORK), (const char*)p.hbuf, 1024, 1024, S, EpiMoeA{p.hmoe});
    __syncthreads();
}
struct EpiMoeB {
    const int* pre; const int* tab; bf16_t* ybuf;
    __device__ __forceinline__ void operator()(const g8::f32x4_t (&acc)[2][2][4][2], const g8::Unit& u, int wr, int wc, int fr, int fq) const {
        const int e = u.e;
        const int n = pre[48 + e] - (u.pm - pre[e]) * 256, r0 = wr * 64 + fr;
        const int col0 = u.pn * 256 + wc * 32 + fq * 8;
        const int* tb = tab + u.par * 512;
        asm volatile("" ::: "memory");
#pragma unroll
        for (int ai = 0; ai < 2; ++ai) {
#pragma unroll
            for (int m = 0; m < 4; ++m) {
                const int r = r0 + ai * 128 + m * 16;
                if (r < n) {
                    const int ent = tb[r]; const float ww = __int_as_float(tb[256 + r]);
                    bf16_t* rowp = ybuf + (size_t)ent * 1024 + col0;
#pragma unroll
                    for (int bj = 0; bj < 2; ++bj) {
                        const g8::f32x4_t a = acc[ai][bj][m][0], c = acc[ai][bj][m][1];
                        *reinterpret_cast<uint4*>(rowp + bj * 128) = cvtpk8(a[0] * ww, a[1] * ww, a[2] * ww, a[3] * ww, c[0] * ww, c[1] * ww, c[2] * ww, c[3] * ww);
                    }
                }
            }
        }
    }
};
__device__ __forceinline__ void ph_moe_b(PRef p, int L) {
    const int* cnt = p.cnt + L * 32 * 64;
    const int* pre = moe_prefix256(cnt);
    g8::SchedMoe S{pre, p.list, p.listw, (const char*)(p.wt_dn + (size_t)L * 32 * 1024 * 512), (size_t)1024 * 512 * 2, (size_t)256 * 512 * 2, pre[32] * 4, (int)gridDim.x, (int)blockIdx.x, 0, reinterpret_cast<int*>(smem + G8_PRE_OFF + 512)};
    g8::gemm8((LAS unsigned char*)(smem + LDS_WORK), (const char*)p.hmoe, 512, 512, S, EpiMoeB{pre, reinterpret_cast<const int*>(smem + G8_PRE_OFF + 512), p.ybuf});
    __syncthreads();
}

__device__ __forceinline__ void dma16_asm(const void* g, const unsigned char* lds_wave_base) {
    const unsigned m = __builtin_amdgcn_readfirstlane((unsigned)(size_t)(LAS const unsigned char*)lds_wave_base);
    asm volatile("s_mov_b32 m0, %1\n\ts_nop 0\n\tglobal_load_lds_dwordx4 %0, off" :: "v"(g), "s"(m) : "memory", "m0");
}
__device__ __forceinline__ unsigned lds_addr(const unsigned char* p) { return (unsigned)(size_t)(LAS const unsigned char*)p; }
__device__ __forceinline__ bf16x8 lds_ld128(unsigned a) { return *(const LAS bf16x8*)(size_t)a; }
__device__ __forceinline__ void dma16_asm_s(const void* ubase, unsigned voff, const unsigned char* lds_wave_base) {
    const unsigned m = __builtin_amdgcn_readfirstlane((unsigned)(size_t)(LAS const unsigned char*)lds_wave_base);
    asm volatile("s_mov_b32 m0, %2\n\ts_nop 0\n\tglobal_load_lds_dwordx4 %0, %1" :: "v"(voff), "s"(ubase), "s"(m) : "memory", "m0");
}
template <int DQK, int KT> struct AT {
    static constexpr int KB = KT / 32, NKK = DQK / 16;
    static constexpr bool ROPE = (DQK == 192);
    static constexpr int K_BYTES = KT * 256, KR_BYTES = ROPE ? KT * 128 : 0, V_BYTES = 256 * KT, STAGE = K_BYTES + KR_BYTES + V_BYTES;
    static constexpr int VRB = KT * 2;
    static __device__ __forceinline__ void dma(int tid, unsigned char* st, const bf16_t* kp  , size_t ldk, const bf16_t* krp  , const bf16_t* vp  , size_t ldv) {
        const int wid = tid >> 6, l = tid & 63;
#pragma unroll
        for (int i = 0; i < KT / 16; ++i) {
            const int pi = wid + 4 * i, row = 4 * pi + (l >> 4), c = (l & 15) ^ (row & 15);
            dma16_asm_s(kp, (unsigned)(row * (int)ldk + c * 8) * 2u, st + pi * 1024);
        }
        if (ROPE) {
            const int pi = wid, row = 8 * pi + (l >> 3), c = (l & 7) ^ ((row >> 1) & 7);
            dma16_asm_s(krp, (unsigned)(row * 64 + c * 8) * 2u, st + K_BYTES + pi * 1024);
        }
#pragma unroll
        for (int i = 0; i < KT / 16; ++i) {
            const int pi = wid + 4 * i;
            int row, c;
            if (KT == 64) { row = 8 * pi + (l >> 3); c = (l & 7) ^ ((row >> 1) & 7); }
            else          { row = 16 * pi + (l >> 2); c = (l & 3) ^ ((row >> 2) & 3); }
            dma16_asm_s(vp, (unsigned)(row * (int)ldv + c * 8) * 2u, st + K_BYTES + KR_BYTES + pi * 1024);
        }
    }
    static __device__ __forceinline__ void kload(const unsigned char* st, int kb, bf16x8 (&kf)[NKK], int r, int h) {
        const int row = kb * 32 + r, m = r & 15, m2 = (r >> 1) & 7;
        const unsigned a0 = lds_addr(st) + row * 256 + ((((m & ~1) | (h ^ (m & 1)))) << 4);
#pragma unroll
        for (int kk = 0; kk < 8; ++kk) kf[kk] = lds_ld128(a0 ^ (kk << 5));
        if (ROPE) {
            const unsigned a1 = lds_addr(st) + K_BYTES + row * 128 + ((((m2 & ~1) | (h ^ (m2 & 1)))) << 4);
#pragma unroll
            for (int kk = 0; kk < 4; ++kk) kf[8 + kk] = lds_ld128(a1 ^ (kk << 5));
        }
    }
    static __device__ __forceinline__ f32x16 qk_mma(const bf16x8 (&kf)[NKK], const bf16x8* qf) {
        f32x16 s;
#pragma unroll
        for (int q = 0; q < 16; ++q) s[q] = 0.f;
#pragma unroll
        for (int kk = 0; kk < NKK; ++kk) s = MFMA32(kf[kk], qf[kk], s);
        return s;
    }
    static __device__ __forceinline__ f32x16 qk(const unsigned char* st, int kb, const bf16x8* qf, int r, int h) {
        f32x16 s;
#pragma unroll
        for (int q = 0; q < 16; ++q) s[q] = 0.f;
        const int row = kb * 32 + r;
#pragma unroll
        for (int kk = 0; kk < 8; ++kk) s = MFMA32(lds_frag(st, row * 256 + (((2 * kk + h) ^ (r & 15)) << 4)), qf[kk], s);
        return s;
    }
    static __device__ __forceinline__ void vload(const unsigned char* st, int ks, bf16x8 (&vf)[4], int r, int h) {
        const int swz = (KT == 64) ? ((r >> 1) & 7) : ((r >> 2) & 3);
        const unsigned v0 = lds_addr(st) + K_BYTES + KR_BYTES + r * VRB + ((swz ^ h) << 4);
#pragma unroll
        for (int dvb = 0; dvb < 4; ++dvb) vf[dvb] = lds_ld128((v0 ^ ((2 * ks) << 4)) + dvb * 32 * VRB);
    }
    static __device__ __forceinline__ void pv_mma(f32x16 (&o)[4], const bf16x8 (&vf)[4], bf16x8 pf) {
#pragma unroll
        for (int dvb = 0; dvb < 4; ++dvb) o[dvb] = MFMA32(vf[dvb], pf, o[dvb]);
    }
    static __device__ __forceinline__ void pv(const unsigned char* st, f32x16 (&o)[4], int ks, bf16x8 pf, int r, int h) {
        bf16x8 vf[4];
        vload(st, ks, vf, r, h);
        pv_mma(o, vf, pf);
    }
};
struct HalfBar { volatile LAS unsigned* ctr; unsigned target; };
__device__ __forceinline__ void half_bar(HalfBar& hb, int lane) {
    asm volatile("s_waitcnt lgkmcnt(0)" ::: "memory");
    hb.target += 4u;
    if (lane == 0) __hip_atomic_fetch_add((LAS unsigned*)hb.ctr, 1u, __ATOMIC_RELAXED, __HIP_MEMORY_SCOPE_WORKGROUP);
    while ((unsigned)__builtin_amdgcn_readfirstlane((int)*hb.ctr) < hb.target) __builtin_amdgcn_s_sleep(1);
    asm volatile("" ::: "memory");
}
#define DMA_WAIT_SYNC() do { asm volatile("s_waitcnt vmcnt(0)" ::: "memory"); __syncthreads(); } while (0)
__device__ __forceinline__ bf16x8 pfrag(const f32x16& s, int half) {
    const int b = half * 8;
    uint4 w = cvtpk8(s[b + 0], s[b + 1], s[b + 2], s[b + 3], s[b + 4], s[b + 5], s[b + 6], s[b + 7]);
    return *reinterpret_cast<bf16x8*>(&w);
}
template <int NKK> __device__ __forceinline__ void load_q(bf16x8 (&qf)[NKK], const bf16_t* qrow, int h) {
#pragma unroll
    for (int kk = 0; kk < NKK; ++kk) qf[kk] = *reinterpret_cast<const bf16x8*>(qrow + kk * 16 + h * 8);
}
__device__ __forceinline__ void store_pk16(bf16_t* orow, int dvb, int gp, uint2 X  , uint2 Y  , int h) {
    auto r0 = __builtin_amdgcn_permlane32_swap(X.x, Y.x, false, false), r1 = __builtin_amdgcn_permlane32_swap(X.y, Y.y, false, false);
    uint4 w; w.x = r0[0]; w.y = r1[0]; w.z = r0[1]; w.w = r1[1];
    *reinterpret_cast<uint4*>(orow + dvb * 32 + 8 * (2 * gp + h)) = w;
}
__device__ __forceinline__ void store_o(const f32x16 (&o)[4], bf16_t* orow, int h, float scale) {
#pragma unroll
    for (int dvb = 0; dvb < 4; ++dvb)
#pragma unroll
        for (int gp = 0; gp < 2; ++gp) {
            const int a = 8 * gp, c = 8 * gp + 4;
            uint2 X, Y;
            X.x = cvtpk(o[dvb][a] * scale, o[dvb][a + 1] * scale); X.y = cvtpk(o[dvb][a + 2] * scale, o[dvb][a + 3] * scale);
            Y.x = cvtpk(o[dvb][c] * scale, o[dvb][c + 1] * scale); Y.y = cvtpk(o[dvb][c + 2] * scale, o[dvb][c + 3] * scale);
            store_pk16(orow, dvb, gp, X, Y, h);
        }
}

template <int DQK, int KT, int MODE>
__device__ __forceinline__ void flash_loop(int tid, unsigned char* lds, const bf16x8* qf, f32x16 (&o)[4], float& m_run, float& l_half,
                                           const bf16_t* kbase, size_t ldk, const bf16_t* krbase, const bf16_t* vtbase, size_t ldv,
                                           int kt_lo, int kt_hi, int t  , int tw_min, int tw_max  , unsigned selmask, float C, int key_off = 0, HalfBar* hbp = nullptr) {
    typedef AT<DQK, KT> A;
    constexpr bool RING3 = (KT == 32);
    constexpr int NDMA = KT / 16 + KT / 16 + (DQK == 192 ? 1 : 0);
    auto tile_dma = [&](int stage, int kt) { A::dma(tid, lds + stage * A::STAGE, kbase + (size_t)kt * KT * ldk, ldk, krbase ? krbase + (size_t)kt * KT * 64 : nullptr, vtbase + (size_t)kt * KT, ldv); };
    if (RING3) { __builtin_amdgcn_s_waitcnt(0x0F70); tile_dma(0, kt_lo); if (kt_lo + 1 <= kt_hi) tile_dma(1, kt_lo + 1); }
    else { tile_dma(0, kt_lo); __builtin_amdgcn_s_waitcnt(0x0F70); __syncthreads(); }
    int stc = 0, stn = 2;
    for (int kt = kt_lo; kt <= kt_hi; ++kt) {
        asm volatile("" : "+v"(tid));
        const int lane = tid & 63, r = lane & 31, h = lane >> 5;
        const bool more = kt < kt_hi;
        const unsigned char* st;
        if (RING3) {
            if (more) { static_assert(!RING3 || NDMA == 5, "counted wait below is written for 5 DMA instructions per tile"); asm volatile("s_waitcnt vmcnt(5)" ::: "memory"); }
            else asm volatile("s_waitcnt vmcnt(0)" ::: "memory");
            if (hbp) half_bar(*hbp, lane); else __builtin_amdgcn_s_barrier();
            asm volatile("" ::: "memory");
            if (kt + 2 <= kt_hi) tile_dma(stn, kt + 2);
            st = lds + stc * A::STAGE;
            stc = (stc == 2) ? 0 : stc + 1; stn = (stn == 2) ? 0 : stn + 1;
        } else {
            const int cur = (kt - kt_lo) & 1;
            if (more) tile_dma(cur ^ 1, kt + 1);
            st = lds + cur * A::STAGE;
        }
        const int key0 = key_off + kt * KT;
        bool active = (key0 <= tw_max);
        if (MODE == 2) active = active && (key0 + KT - 1 > tw_min - 512);
        if (active) {
            f32x16 s[A::KB];
            bf16x8 vf[2][4];
            if constexpr (KT == 32) {
                bf16x8 kf[A::NKK];
                A::kload(st, 0, kf, r, h);
                __builtin_amdgcn_sched_barrier(0);
                s[0] = A::qk_mma(kf, qf);
                __builtin_amdgcn_sched_barrier(0);
                A::vload(st, 0, vf[0], r, h); A::vload(st, 1, vf[1], r, h);
            } else {
#pragma unroll
                for (int kb = 0; kb < A::KB; ++kb) s[kb] = A::qk(st, kb, qf, r, h);
            }
            const bool need_mask = (MODE == 1) || (key0 + KT - 1 > tw_min) || (MODE == 2 && key0 <= tw_max - 512);
            if (MODE == 1 && !(key0 + KT - 1 > tw_min)) {
                static_assert(MODE != 1 || KT == 64, "selected branch: tile = selection block");
                asm volatile("" ::: "memory");
                const float drop = ((selmask >> (key0 >> 6)) & 1u) ? 0.f : -__builtin_inff();
#pragma unroll
                for (int kb = 0; kb < A::KB; ++kb)
#pragma unroll
                    for (int q = 0; q < 16; ++q) s[kb][q] += drop;
            } else if (need_mask) {
                asm volatile("" ::: "memory");
#pragma unroll
                for (int kb = 0; kb < A::KB; ++kb)
#pragma unroll
                    for (int q = 0; q < 16; ++q) {
                        const int key = key0 + kb * 32 + crow(q, h);
                        bool ok = key <= t;
                        if (MODE == 1) ok = ok && ((selmask >> (key >> 6)) & 1u);
                        if (MODE == 2) ok = ok && (t - key < 512);
                        s[kb][q] = ok ? s[kb][q] : -__builtin_inff();
                    }
            }
            float mx = -__builtin_inff();
#pragma unroll
            for (int kb = 0; kb < A::KB; ++kb)
#pragma unroll
                for (int q = 0; q < 16; ++q) mx = fmaxf(mx, s[kb][q]);
            mx = xh_max(mx) * C;
            if (__any(mx > m_run + 8.f)) {
                const float mn = fmaxf(m_run, mx);
                const float alpha = __builtin_amdgcn_exp2f(m_run - mn);
                m_run = mn;
                l_half *= alpha;
#pragma unroll
                for (int dvb = 0; dvb < 4; ++dvb)
#pragma unroll
                    for (int q = 0; q < 16; ++q) o[dvb][q] *= alpha;
            }
            const float nm = -m_run;
            float ps = 0.f;
#pragma unroll
            for (int kb = 0; kb < A::KB; ++kb)
#pragma unroll
                for (int q = 0; q < 16; ++q) { const float e = __builtin_amdgcn_exp2f(__builtin_fmaf(s[kb][q], C, nm)); s[kb][q] = e; ps += e; }
            l_half += ps;
            if constexpr (KT == 32) { A::pv_mma(o, vf[0], pfrag(s[0], 0)); A::pv_mma(o, vf[1], pfrag(s[0], 1)); }
            else {
#pragma unroll
                for (int kb = 0; kb < A::KB; ++kb) { A::pv(st, o, kb * 2, pfrag(s[kb], 0), r, h); A::pv(st, o, kb * 2 + 1, pfrag(s[kb], 1), r, h); }
            }
        }
        if (!RING3) DMA_WAIT_SYNC();
    }
    if (RING3) { if (hbp) half_bar(*hbp, tid & 63); else __syncthreads(); }
}

__device__ __forceinline__ void mla_flash(int tid0, unsigned char* lds, const bf16x8* qf, f32x16 (&o)[4], float& m_run, float& l_half,
                                          const bf16_t* kbase, const bf16_t* krbase, const bf16_t* vtbase, int kt_hi, int t, int tw_min, float C) {
    typedef AT<192, 32> A;
    constexpr int KST = A::K_BYTES + A::KR_BYTES, VST = A::V_BYTES;
    static_assert(3 * KST + 4 * VST <= HALF_LDS, "rings");
    unsigned char* kring = lds; unsigned char* vring = lds + 3 * KST;
    auto tile_dma = [&](int tid, int kt) {
        unsigned char* ks = kring + (kt % 3) * KST; unsigned char* vs = vring + (kt & 3) * VST;
        const bf16_t* kp = kbase + (size_t)kt * 32 * 1024; const bf16_t* krp = krbase + (size_t)kt * 32 * 64; const bf16_t* vp = vtbase + (size_t)kt * 32;
        const int wid = tid >> 6, l = tid & 63;
#pragma unroll
        for (int i = 0; i < 2; ++i) { const int pi = wid + 4 * i, row = 4 * pi + (l >> 4), c = (l & 15) ^ (row & 15); dma16_asm_s(kp, (unsigned)(row * 1024 + c * 8) * 2u, ks + pi * 1024); }
        { const int pi = wid, row = 8 * pi + (l >> 3), c = (l & 7) ^ ((row >> 1) & 7); dma16_asm_s(krp, (unsigned)(row * 64 + c * 8) * 2u, ks + A::K_BYTES + pi * 1024); }
#pragma unroll
        for (int i = 0; i < 2; ++i) { const int pi = wid + 4 * i, row = 16 * pi + (l >> 2), c = (l & 3) ^ ((row >> 2) & 3); dma16_asm_s(vp, (unsigned)(row * SEQ + c * 8) * 2u, vs + pi * 1024); }
    };
    auto finish = [&](f32x16& sv, float mxraw, int kt, int h) {
        const int key0 = kt * 32;
        if (key0 + 31 > tw_min) {
            asm volatile("" ::: "memory");
            mxraw = -__builtin_inff();
#pragma unroll
            for (int q = 0; q < 16; ++q) { sv[q] = (key0 + crow(q, h) <= t) ? sv[q] : -__builtin_inff(); mxraw = fmaxf(mxraw, sv[q]); }
        }
        const float mx = xh_max(mxraw) * C;
        if (__any(mx > m_run + 8.f)) {
            const float mn = fmaxf(m_run, mx);
            const float alpha = __builtin_amdgcn_exp2f(m_run - mn);
            m_run = mn; l_half *= alpha;
#pragma unroll
            for (int dvb = 0; dvb < 4; ++dvb)
#pragma unroll
                for (int q = 0; q < 16; ++q) o[dvb][q] *= alpha;
        }
    };
    f32x16 sc;
    {
        int tid = tid0; asm volatile("" : "+v"(tid));
        tile_dma(tid, 0); if (kt_hi >= 1) tile_dma(tid, 1); if (kt_hi >= 2) tile_dma(tid, 2);
        __builtin_amdgcn_s_waitcnt(0x0F70);
        __builtin_amdgcn_s_barrier();
        asm volatile("" ::: "memory");
        const int lane = tid & 63, r = lane & 31, h = lane >> 5;
        bf16x8 kf[12];
        A::kload(kring, 0, kf, r, h);
        sc = A::qk_mma(kf, qf);
        float mxr = -__builtin_inff();
#pragma unroll
        for (int q = 0; q < 16; ++q) mxr = fmaxf(mxr, sc[q]);
        finish(sc, mxr, 0, h);
    }
    for (int kt = 0; kt <= kt_hi; ++kt) {
        const int tid = tid0, lane = tid & 63, r = lane & 31, h = lane >> 5;
        if (kt + 1 <= kt_hi) { if (kt + 2 <= kt_hi) asm volatile("s_waitcnt vmcnt(5)" ::: "memory"); else asm volatile("s_waitcnt vmcnt(0)" ::: "memory"); }
        __builtin_amdgcn_s_barrier();
        asm volatile("" ::: "memory");
        if (kt + 3 <= kt_hi) tile_dma(tid, kt + 3);
        const int kn = (kt + 1) % 3;
        bf16x8 kf[12];
        A::kload(kring + kn * KST, 0, kf, r, h);
        __builtin_amdgcn_sched_barrier(0);
        f32x16 sn = A::qk_mma(kf, qf);
        const float nm = -m_run;
        float ps = 0.f;
#pragma unroll
        for (int q = 0; q < 16; ++q) { const float e = __builtin_amdgcn_exp2f(__builtin_fmaf(sc[q], C, nm)); sc[q] = e; ps += e; }
        l_half += ps;
        const bf16x8 pf0 = pfrag(sc, 0), pf1 = pfrag(sc, 1);
        bf16x8 vf[2][4];
        const unsigned char* vadj = vring + (kt & 3) * VST - (A::K_BYTES + A::KR_BYTES);
        A::vload(vadj, 0, vf[0], r, h); A::vload(vadj, 1, vf[1], r, h);
        float mxr = -__builtin_inff();
#pragma unroll
        for (int q = 0; q < 16; ++q) mxr = fmaxf(mxr, sn[q]);
        A::pv_mma(o, vf[0], pf0); A::pv_mma(o, vf[1], pf1);
        if (kt + 1 <= kt_hi) finish(sn, mxr, kt + 1, h);
        sc = sn;
    }
    __syncthreads();
}

__device__ __forceinline__ void ph_mla_attn(PRef p) {
    unsigned char* lds = VLDS;
    const float C = 0.07216878364870322f * 1.4426950408889634f;
    for (int it = VB; it < 1024; it += NVB) {
        int tid = VT; asm volatile("" : "+v"(tid));
        const int lane = tid & 63, wid = tid >> 6, r = lane & 31, h = lane >> 5;
        const int vb_ = it & 511, xw_ = vb_ >> 4, pp = ((vb_ >> 1) & 7) * 64 + (((xw_ >> 3) * 2 + (vb_ & 1)) << 3) + (xw_ & 7), second = it >> 9, bh = pp >> 3, qt = second ? (pp & 7) : (15 - (pp & 7)), b = bh >> 3, hd = bh & 7;
        const int tw0 = qt * 128 + wid * 32, t = tw0 + r;
        const size_t tok = (size_t)b * SEQ + t;
        bf16x8 qf[12];
        load_q<12>(qf, p.qm + tok * 1536 + hd * 192, h);
        f32x16 o[4];
#pragma unroll
        for (int dvb = 0; dvb < 4; ++dvb)
#pragma unroll
            for (int q = 0; q < 16; ++q) o[dvb][q] = 0.f;
        float m_run = -1.0e30f, l_half = 0.f;
        mla_flash(tid, lds, qf, o, m_run, l_half, p.kn + (size_t)b * SEQ * 1024 + hd * 128, p.krope + (size_t)b * SEQ * 64,
                  p.vt + (size_t)(b * 8 + hd) * 128 * SEQ, (qt * 128 + 127) >> 5, t, tw0, C);
        const float l = xh_sum(l_half);
        store_o(o, p.obuf + tok * 1024 + hd * 128, h, l > 0.f ? 1.f / l : 0.f);
    }
}

__device__ __forceinline__ void acc_branch(uint2 (&ot)[16], const f32x16 (&o)[4], float sc, bool first) {
#pragma unroll
    for (int dvb = 0; dvb < 4; ++dvb)
#pragma unroll
        for (int g = 0; g < 4; ++g) {
            float a0 = o[dvb][4 * g] * sc, a1 = o[dvb][4 * g + 1] * sc, a2 = o[dvb][4 * g + 2] * sc, a3 = o[dvb][4 * g + 3] * sc;
            if (!first) { const uint2 pv = ot[dvb * 4 + g]; a0 += bf2f(pv.x & 0xffffu); a1 += bf2f(pv.x >> 16); a2 += bf2f(pv.y & 0xffffu); a3 += bf2f(pv.y >> 16); }
            ot[dvb * 4 + g] = make_uint2(cvtpk(a0, a1), cvtpk(a2, a3));
        }
}
__device__ __forceinline__ void ph_nsa_attn(PRef p) {
    unsigned char* lds = VLDS;
    typedef AT<128, 64> A;
    float* imp = reinterpret_cast<float*>(lds);
    unsigned* selm = reinterpret_cast<unsigned*>(lds + 2 * A::STAGE);
    const float C = 0.08838834764831845f * 1.4426950408889634f;
    for (int it = VB; it < 1024; it += NVB) {
        int tid = VT; asm volatile("" : "+v"(tid));
        const int lane = tid & 63, wid = tid >> 6, r = lane & 31, h = lane >> 5;
        const int vb_ = it & 511, pp = ((vb_ >> 1) & 7) * 64 + ((vb_ & 1) << 5) + (vb_ >> 4), second = it >> 9, bkh = pp >> 5, qc = second ? (pp & 31) : (63 - (pp & 31)), b = bkh >> 1, kh = bkh & 1;
        const int hd = kh * 4 + wid, t0 = qc * 32, t = t0 + r;
        const size_t tok = (size_t)b * SEQ + t;
        bf16x8 qf[8];
        load_q<8>(qf, p.qn + tok * 1024 + hd * 128, h);
        const f32x4 gate4 = *reinterpret_cast<const f32x4*>(p.gates + tok * 32 + hd * 4);
        uint2 ot[16];
        f32x16 o[4];
        {
            const bf16_t* kb_ = p.kcmp + (size_t)bkh * 128 * 128; const bf16_t* vb_ = p.vcmpt + (size_t)bkh * 128 * 128;
            A::dma(tid, lds, kb_, 128, nullptr, vb_, 128);
            A::dma(tid, lds + A::STAGE, kb_ + 64 * 128, 128, nullptr, vb_ + 64, 128);
            DMA_WAIT_SYNC();
            f32x16 s[4];
            s[0] = A::qk(lds, 0, qf, r, h); s[1] = A::qk(lds, 1, qf, r, h); s[2] = A::qk(lds + A::STAGE, 0, qf, r, h); s[3] = A::qk(lds + A::STAGE, 1, qf, r, h);
            float mx = -3.0e38f;
#pragma unroll
            for (int kb = 0; kb < 4; ++kb)
#pragma unroll
                for (int q = 0; q < 16; ++q) {
                    const int n = kb * 32 + crow(q, h);
                    const float v = (16 * n + 31 <= t) ? s[kb][q] * C : -__builtin_inff();
                    s[kb][q] = v; mx = fmaxf(mx, v);
                }
            mx = fmaxf(xh_max(mx), -1.0e30f);
            float ps = 0.f;
#pragma unroll
            for (int kb = 0; kb < 4; ++kb)
#pragma unroll
                for (int q = 0; q < 16; ++q) { const float e = __builtin_amdgcn_exp2f(s[kb][q] - mx); s[kb][q] = e; ps += e; }
            const float l = xh_sum(ps), inv = l > 0.f ? 1.f / l : 0.f;
#pragma unroll
            for (int kb = 0; kb < 4; ++kb)
#pragma unroll
                for (int q = 0; q < 16; ++q) s[kb][q] *= inv;
            float impv[16];
            {
                float prev = 0.f;
#pragma unroll
                for (int gi = 0; gi < 16; ++gi) {
                    const int kb = gi >> 2, rg = gi & 3;
                    const float p3 = 0.5f * s[kb][4 * rg + 3];
                    const float av = s[kb][4 * rg] + s[kb][4 * rg + 1] + s[kb][4 * rg + 2] + p3;
                    const float co = xh_other(p3, h);
                    impv[gi] = av + (h ? co : prev);
                    prev = co;
                }
            }
            bf16x8 pf[8];
#pragma unroll
            for (int kb = 0; kb < 4; ++kb) { pf[2 * kb] = pfrag(s[kb], 0); pf[2 * kb + 1] = pfrag(s[kb], 1); }
#pragma unroll
            for (int dvb = 0; dvb < 4; ++dvb)
#pragma unroll
                for (int q = 0; q < 16; ++q) o[dvb][q] = 0.f;
#pragma unroll
            for (int ks = 0; ks < 4; ++ks) A::pv(lds, o, ks, pf[ks], r, h);
#pragma unroll
            for (int ks = 0; ks < 4; ++ks) A::pv(lds + A::STAGE, o, ks, pf[4 + ks], r, h);
            acc_branch(ot, o, gate4[0], true);
            __syncthreads();
#pragma unroll
            for (int gi = 0; gi < 16; ++gi) imp[(wid * 32 + r) * 33 + (2 * gi + h)] = impv[gi];
            __syncthreads();
            if (tid < 32) {
                const int tq = t0 + tid, cur = tq >> 6;
                float val[32];
#pragma unroll
                for (int j = 0; j < 32; ++j) {
                    float v = imp[(0 * 32 + tid) * 33 + j] + imp[(1 * 32 + tid) * 33 + j] + imp[(2 * 32 + tid) * 33 + j] + imp[(3 * 32 + tid) * 33 + j];
                    if (j == 0 || j == cur || j == cur - 1) v += 1000.f;
                    val[j] = (64 * j <= tq) ? v : -__builtin_inff();
                }
                unsigned m = 0u;
                for (int k = 0; k < 8; ++k) {
                    float best = -__builtin_inff(); int bi = -1;
#pragma unroll
                    for (int j = 0; j < 32; ++j) { const bool free_ = !((m >> j) & 1u); if (free_ && (bi < 0 || val[j] > best)) { best = val[j]; bi = j; } }
                    m |= 1u << bi;
                }
                selm[tid] = m;
            }
            __syncthreads();
        }
        const unsigned sel = selm[r];
        load_q<8>(qf, p.qn + tok * 1024 + hd * 128, h);
        {
#pragma unroll
            for (int dvb = 0; dvb < 4; ++dvb)
#pragma unroll
                for (int q = 0; q < 16; ++q) o[dvb][q] = 0.f;
            float m_run = -1.0e30f, l_half = 0.f;
            flash_loop<128, 64, 1>(tid, lds, qf, o, m_run, l_half, p.ks + (size_t)bkh * SEQ * 128, 128, nullptr, p.vst + (size_t)bkh * 128 * SEQ, SEQ,
                                   0, (t0 + 31) >> 6, t, t0, t0 + 31, sel, C);
            const float l = xh_sum(l_half);
            acc_branch(ot, o, l > 0.f ? gate4[1] / l : 0.f, false);
        }
        {
#pragma unroll
            for (int dvb = 0; dvb < 4; ++dvb)
#pragma unroll
                for (int q = 0; q < 16; ++q) o[dvb][q] = 0.f;
            float m_run = -1.0e30f, l_half = 0.f;
            const int lo = (t0 - 511) > 0 ? ((t0 - 511) >> 6) : 0;
            flash_loop<128, 64, 2>(tid, lds, qf, o, m_run, l_half, p.kw + (size_t)bkh * SEQ * 128, 128, nullptr, p.vwt + (size_t)bkh * 128 * SEQ, SEQ,
                                   lo, (t0 + 31) >> 6, t, t0, t0 + 31, 0u, C);
            const float l = xh_sum(l_half);
            acc_branch(ot, o, l > 0.f ? gate4[2] / l : 0.f, false);
        }
        bf16_t* orow = p.obuf + tok * 1024 + hd * 128;
#pragma unroll
        for (int dvb = 0; dvb < 4; ++dvb)
#pragma unroll
            for (int gp = 0; gp < 2; ++gp) store_pk16(orow, dvb, gp, ot[dvb * 4 + 2 * gp], ot[dvb * 4 + 2 * gp + 1], h);
    }
}

__device__ __forceinline__ void ph_sb_attn(PRef p) {
    unsigned char* lds = VLDS;
    typedef AT<128, 64> A;
    const float SC = 0.08838834764831845f, L2E = 1.4426950408889634f, LN2 = 0.6931471805599453f;
    for (int it = VB; it < 1024; it += NVB) {
        int tid = VT; asm volatile("" : "+v"(tid));
        const int lane = tid & 63, wid = tid >> 6, r = lane & 31, h = lane >> 5;
        const int vb_ = it & 511, xw_ = vb_ >> 4, pp = ((vb_ >> 1) & 7) * 64 + (((xw_ >> 3) * 2 + (vb_ & 1)) << 3) + (xw_ & 7), second = it >> 9, bh = pp >> 3, qt = second ? (pp & 7) : (15 - (pp & 7)), b = bh >> 3, hd = bh & 7;
        const int tw0 = qt * 128 + wid * 32, t = tw0 + r;
        const size_t tok = (size_t)b * SEQ + t;
        bf16x8 qf[8];
        load_q<8>(qf, p.qs + tok * 1024 + hd * 128, h);
        f32x16 o[4];
#pragma unroll
        for (int dvb = 0; dvb < 4; ++dvb)
#pragma unroll
            for (int q = 0; q < 16; ++q) o[dvb][q] = 0.f;
        float R = 0.f;
        const bf16_t* kbase = p.ksb + (size_t)b * SEQ * 1024 + hd * 128; const bf16_t* vtbase = p.vt + (size_t)(b * 8 + hd) * 128 * SEQ;
        const int kt_hi = (qt * 128 + 127) >> 6;
        A::dma(tid, lds, kbase + (size_t)kt_hi * 64 * 1024, 1024, nullptr, vtbase + kt_hi * 64, SEQ);
        __builtin_amdgcn_s_waitcnt(0x0F70); __syncthreads();
        volatile int* done_f = reinterpret_cast<volatile int*>(smem + LDS_WORK + 2 * A::STAGE);
        const int rwave = VHALF * 4 + wid;
        bool wdone = false;
        for (int kt = kt_hi; kt >= 0; --kt) {
            const int cur = (kt_hi - kt) & 1;
            if (kt < kt_hi && (done_f[0] & done_f[1] & done_f[2] & done_f[3] & done_f[4] & done_f[5] & done_f[6] & done_f[7])) break;
            const bool more = kt > 0;
            if (more) A::dma(tid, lds + (cur ^ 1) * A::STAGE, kbase + (size_t)(kt - 1) * 64 * 1024, 1024, nullptr, vtbase + (kt - 1) * 64, SEQ);
            const unsigned char* st = lds + cur * A::STAGE;
            const int key0 = kt * 64;
            if (key0 < tw0 + 31 && !wdone) {
                f32x16 z[2];
                {
                    bf16x8 kf0[8], kf1[8];
                    A::kload(st, 0, kf0, r, h); A::kload(st, 1, kf1, r, h);
                    __builtin_amdgcn_sched_barrier(0);
                    z[0] = A::qk_mma(kf0, qf); z[1] = A::qk_mma(kf1, qf);
                }
                float T[8];
#pragma unroll
                for (int kb = 0; kb < 2; ++kb)
#pragma unroll
                    for (int rg = 0; rg < 4; ++rg) {
                        float suf = 0.f;
#pragma unroll
                        for (int i = 3; i >= 0; --i) {
                            const float zz = z[kb][4 * rg + i] * SC;
                            const float sp = fmaxf(zz, 0.f) + LN2 * __builtin_amdgcn_logf(1.f + __builtin_amdgcn_exp2f(-fabsf(zz) * L2E));
                            const bool ok = (key0 + kb * 32 + 8 * rg + 4 * h + i) < t;
                            suf += ok ? -sp : 0.f;
                            z[kb][4 * rg + i] = zz + suf;
                        }
                        T[kb * 4 + rg] = suf;
                    }
                float run = 0.f;
#pragma unroll
                for (int gq = 7; gq >= 0; --gq) {
                    const float U = xh_other(T[gq], h);
                    const float after = run + (h ? 0.f : U) + R;
                    const int kb = gq >> 2, rg = gq & 3;
#pragma unroll
                    for (int i = 0; i < 4; ++i) {
                        const bool ok = (key0 + kb * 32 + 8 * rg + 4 * h + i) < t;
                        const float a = __builtin_amdgcn_exp2f((z[kb][4 * rg + i] + after) * L2E);
                        z[kb][4 * rg + i] = ok ? a : 0.f;
                    }
                    run += T[gq] + U;
                }
                R += run;
                A::pv(st, o, 0, pfrag(z[0], 0), r, h); A::pv(st, o, 1, pfrag(z[0], 1), r, h); A::pv(st, o, 2, pfrag(z[1], 0), r, h); A::pv(st, o, 3, pfrag(z[1], 1), r, h);
                wdone = __all(R < -105.f);
            }
            if (lane == 0) done_f[rwave] = wdone ? 1 : 0;
            DMA_WAIT_SYNC();
        }
        store_o(o, p.obuf + tok * 1024 + hd * 128, h, 1.f);
        __syncthreads();
    }
}


#define KARGP ((const __attribute__((address_space(4))) Params*)__builtin_amdgcn_kernarg_segment_ptr())
#define PH(call) do { if (pc >= lo && pc < hi) { { const __attribute__((address_space(4))) Params* q_ = KARGP; asm volatile("" : "+s"(q_)); PRef p = *q_; call; } if (pc + 1 < hi) xcd_barrier(bar); } ++pc; } while (0)
template <int L> __device__ __forceinline__ void ph_attn_conv(PRef p) {
    constexpr int kind = L % 3;
    const bool conv_first = false;
    (void)conv_first;
    if (kind == 0) ph_mla_attn(p); else if (kind == 1) ph_nsa_attn(p); else ph_sb_attn(p);
}
template <int L> __device__ __forceinline__ void ph_moe_a_conv(PRef p) {
    const bool conv_first = false;
    (void)conv_first;
    ph_moe_a(p, L);
    if (L == 0) convert_moe_steal(p, 0, 2);
    if (L + 1 < DEPTH) { convert_moe_steal(p, L + 1, 0); convert_moe_steal(p, L + 1, 1); }
}
template <int L> __device__ __forceinline__ void ph_moe_b_conv(PRef p) {
    const bool conv_first = false;
    (void)conv_first;
    ph_moe_b(p, L);
    if (L + 1 < DEPTH) convert_moe_steal(p, L + 1, 2);
}
template <int L> __device__ __forceinline__ void run_layer(PRef p, const XcdBarrier& bar, int lo, int hi, int& pc) {
    constexpr int kind = L % 3, j = L / 3;
    if (kind == 0) { PH(ph_mla_in(p, j)); PH(ph_mla_up(p, j)); }
    else if (kind == 1) { PH(ph_nsa_in(p)); PH(ph_nsa_cmp1(p)); PH(ph_nsa_cmp2(p)); }
    else { PH(ph_sb_in(p)); }
    PH(ph_attn_conv<L>(p));
    PH(ph_wo(p, L)); PH(ph_lna(p, L)); PH(ph_moe_a_conv<L>(p)); PH(ph_moe_b_conv<L>(p)); PH(ph_lnb(p, L));
}
__global__ void __launch_bounds__(512, 2) mega(Params pv, int lo, int hi) {
    (void)pv; PRef p = *KARGP;
    volatile LAS unsigned* stw = (volatile LAS unsigned*)smem;
    if (threadIdx.x == 0) { stw[0] = 0u; stw[1] = 0u; stw[2] = 0u; stw[3] = 0u; }
    __syncthreads();
    XcdBarrier bar; bar.bar = p.bar; bar.x = 0; bar.st = stw;
    if (hi - lo > 1) bar = xcd_barrier_post(p.bar, stw);
    int pc = 0;
    PH(ph_prologue(p));
    PH(ph_h0(p));
    run_layer<0>(p, bar, lo, hi, pc);
    run_layer<1>(p, bar, lo, hi, pc);
    run_layer<2>(p, bar, lo, hi, pc);
    run_layer<3>(p, bar, lo, hi, pc);
}
#undef PH
constexpr int N_PHASES = 2 + (3 + 5) + (4 + 5) + (2 + 5) + (3 + 5);

extern "C" void kernel_launch(void* const* d_in, const int* in_sizes, int n_in, void* d_out, int out_size, void* d_ws, size_t ws_size, hipStream_t stream) {
    (void)in_sizes; (void)n_in; (void)out_size;
    static int grid = 0;
    if (grid == 0) {
        int dev = 0, cus = 0, per_cu = 0;
        hipGetDevice(&dev);
        hipDeviceGetAttribute(&cus, hipDeviceAttributeMultiprocessorCount, dev);
        if (hipFuncSetAttribute((const void*)mega, hipFuncAttributeMaxDynamicSharedMemorySize, LDS_BYTES) != hipSuccess) { fprintf(stderr, "kernel_launch: hipFuncSetAttribute failed\n"); }
        if (hipOccupancyMaxActiveBlocksPerMultiprocessor(&per_cu, (const void*)mega, 2 * NTHR, LDS_BYTES) != hipSuccess) per_cu = 1;
        (void)hipGetLastError();
        if (per_cu < 1) per_cu = 1;
        if (per_cu > 1) per_cu = 1;
        if (cus <= 0) cus = 256;
        grid = cus * per_cu;
        if (grid >= 8) grid &= ~7;
    }
    Params p{};
    const float* const* in = (const float* const*)d_in;
    p.x = in[0]; p.c = in[1]; p.pos = (const int*)d_in[2]; p.ada_w = in[3]; p.ada_b = in[4]; p.ln_g = in[5]; p.ln_b = in[6];
    p.mla_w_in = in[7]; p.mla_g_q = in[8]; p.mla_w_uq = in[9]; p.mla_g_kv = in[10]; p.mla_w_ukv = in[11]; p.mla_w_o = in[12];
    p.nsa_w_in = in[13]; p.nsa_pe_k = in[14]; p.nsa_pe_v = in[15]; p.nsa_w_ck1 = in[16]; p.nsa_w_ck2 = in[17]; p.nsa_w_cv1 = in[18]; p.nsa_w_cv2 = in[19]; p.nsa_w_o = in[20];
    p.sb_w_qkv = in[21]; p.sb_w_o = in[22];
    p.moe_w_grp = in[23]; p.moe_b_grp = in[24]; p.moe_w_rt = in[25]; p.moe_b_rt = in[26]; p.moe_w_gate = in[27]; p.moe_w_up = in[28]; p.moe_w_down = in[29];
    p.out = (float*)d_out;
    unsigned char* ws = (unsigned char*)d_ws; size_t off = 0;
    auto take = [&](size_t bytes) { unsigned char* r = ws + off; off += (bytes + 255) & ~(size_t)255; return r; };
    p.bar = (unsigned*)take(XCD_BAR_WORDS * 4 + 16 * 256); p.wq = (int*)(p.bar + XCD_BAR_WORDS); p.cnt = (int*)take(DEPTH * 32 * 64 * 4);
    p.mod = (float*)take((size_t)8 * 8 * 3072 * 4);
    p.cosm = (float*)take((size_t)T_TOK * 32 * 4); p.sinm = (float*)take((size_t)T_TOK * 32 * 4); p.cosn = (float*)take((size_t)T_TOK * 64 * 4); p.sinn = (float*)take((size_t)T_TOK * 64 * 4);
    p.bias1 = (float*)take(2 * 128 * 4); p.wr = (float*)take((size_t)DEPTH * 1024 * 48 * 4);
    p.xbuf = (f16_t*)take((size_t)T_TOK * 1024 * 4); p.zbuf = (f16_t*)take((size_t)T_TOK * 1024 * 4); p.hbuf = (bf16_t*)take((size_t)T_TOK * 1024 * 2);
    p.wt_mla_in = (bf16_t*)take((size_t)2 * 768 * 1024 * 2); p.wt_uq = (bf16_t*)take((size_t)2 * 1536 * 256 * 2); p.wt_ukv = (bf16_t*)take((size_t)2 * 2048 * 256 * 2);
    p.wt_mla_o = (bf16_t*)take((size_t)2 * 1024 * 1024 * 2); p.wt_nsa_in = (bf16_t*)take((size_t)2816 * 1024 * 2);
    p.wt_ck1 = (bf16_t*)take((size_t)128 * 4096 * 2); p.wt_cv1 = (bf16_t*)take((size_t)128 * 4096 * 2); p.wt_ck2 = (bf16_t*)take(128 * 128 * 2); p.wt_cv2 = (bf16_t*)take(128 * 128 * 2);
    p.wt_nsa_o = (bf16_t*)take((size_t)1024 * 1024 * 2); p.wt_sb_qkv = (bf16_t*)take((size_t)3072 * 1024 * 2); p.wt_sb_o = (bf16_t*)take((size_t)1024 * 1024 * 2);
    p.wt_gu = (bf16_t*)take((size_t)DEPTH * 32 * 1024 * 1024 * 2); p.wt_dn = (bf16_t*)take((size_t)DEPTH * 32 * 1024 * 512 * 2);
    p.obuf = (bf16_t*)take((size_t)T_TOK * 1024 * 2);
    p.list = (int*)take((size_t)32 * T_TOK * 4); p.listw = (float*)take((size_t)32 * T_TOK * 4);
    p.hmoe = (bf16_t*)take((size_t)(T_TOK * 2 + 32 * 256) * 512 * 2); p.ybuf = (bf16_t*)take((size_t)T_TOK * 2 * 1024 * 2);
    const size_t arena0 = off;
    p.cbuf = (bf16_t*)take((size_t)T_TOK * 512 * 2); p.rss = (float*)take((size_t)T_TOK * 8 * 4); p.krope = (bf16_t*)take((size_t)T_TOK * 64 * 2); p.qm = (bf16_t*)take((size_t)T_TOK * 1536 * 2);
    p.kn = (bf16_t*)take((size_t)T_TOK * 1024 * 2); p.vt = (bf16_t*)take((size_t)T_TOK * 1024 * 2);
    const size_t arena_mla = off; off = arena0;
    p.qn = (bf16_t*)take((size_t)T_TOK * 1024 * 2);
    p.kc = (bf16_t*)take((size_t)(16 * SEQ + 64) * 128 * 2); p.vc = (bf16_t*)take((size_t)(16 * SEQ + 64) * 128 * 2);
    p.ks = (bf16_t*)take((size_t)16 * SEQ * 128 * 2); p.kw = (bf16_t*)take((size_t)16 * SEQ * 128 * 2);
    p.vst = (bf16_t*)take((size_t)16 * SEQ * 128 * 2); p.vwt = (bf16_t*)take((size_t)16 * SEQ * 128 * 2);
    p.gates = (float*)take((size_t)T_TOK * 32 * 4); p.cpart = (float*)take((size_t)32 * 8 * 128 * 128 * 4); p.hid = (bf16_t*)take((size_t)32 * 128 * 128 * 2);
    p.kcmp = (bf16_t*)take((size_t)16 * 128 * 128 * 2); p.vcmpt = (bf16_t*)take((size_t)16 * 128 * 128 * 2);
    const size_t arena_nsa = off; off = arena0;
    p.qs = (bf16_t*)take((size_t)T_TOK * 1024 * 2); p.ksb = (bf16_t*)take((size_t)T_TOK * 1024 * 2);
    const size_t arena_sb = off; (void)arena_sb;
    off = arena_mla > arena_nsa ? arena_mla : arena_nsa;
    if (off > ws_size) { fprintf(stderr, "kernel_launch: workspace too small (%zu > %zu)\n", off, ws_size); }
    hipMemsetAsync(p.bar, 0, XCD_BAR_WORDS * 4 + 16 * 256, stream);
#if MULTI_LAUNCH
    for (int ph = 0; ph < N_PHASES; ++ph) hipLaunchKernelGGL(mega, dim3(grid), dim3(2 * NTHR), LDS_BYTES, stream, p, ph, ph + 1);
#else
    hipLaunchKernelGGL(mega, dim3(grid), dim3(2 * NTHR), LDS_BYTES, stream, p, 0, N_PHASES);
#endif
}
```

```cpp
#include <hip/hip_runtime.h>
#include <stdint.h>
#include <stdio.h>

#ifndef MULTI_LAUNCH
#define MULTI_LAUNCH 0
#endif

typedef unsigned short bf16_t;
typedef short bf16x8 __attribute__((ext_vector_type(8)));
typedef float f32x16 __attribute__((ext_vector_type(16)));
typedef float f32x4 __attribute__((ext_vector_type(4)));
typedef _Float16 f16_t;
typedef _Float16 f16x4 __attribute__((ext_vector_type(4)));
typedef _Float16 f16x8 __attribute__((ext_vector_type(8)));
typedef float f32x8 __attribute__((ext_vector_type(8)));
__device__ __forceinline__ f32x4 ld4h(const f16_t* p) { return __builtin_convertvector(*reinterpret_cast<const f16x4*>(p), f32x4); }
__device__ __forceinline__ void st4h(f16_t* p, f32x4 v) { *reinterpret_cast<f16x4*>(p) = __builtin_convertvector(v, f16x4); }

constexpr int T_TOK = 16384, DM = 1024, NBATCH = 8, SEQ = 2048, DEPTH = 4;
constexpr float LN_EPS = 1e-5f, RMS_EPS = 1e-6f;
constexpr float DN_ALPHA = 1.6817928305074290f;
constexpr int NTHR = 256;
constexpr int LDS_WORK = 256;
constexpr int HALF_LDS = 80640;
constexpr int LDS_BYTES = LDS_WORK + 2 * HALF_LDS;
#define VHALF ((int)__builtin_amdgcn_readfirstlane((int)(threadIdx.x >> 8)))
#define VT ((int)(threadIdx.x & 255u))
#define VB ((int)(blockIdx.x * 2u) + VHALF)
#define NVB ((int)(gridDim.x * 2u))
#define VLDS (smem + LDS_WORK + VHALF * HALF_LDS)

#define XB_TMO      128
#define XB_XCNT(j)  (256  + 64 * (j))
#define XB_XSUB(j)  (1280 + 64 * (j))
#define XB_XGEN(j)  (2304 + 64 * (j))
#define XB_TOP      3328
#define XB_TOPGEN   3392
#define XCD_BAR_WORDS 3456
#define XB_SPIN_CAP (1u << 22)
#define LAS __attribute__((address_space(3)))

__device__ __forceinline__ unsigned xb_ld(unsigned* p)              { return __hip_atomic_load(p, __ATOMIC_RELAXED, __HIP_MEMORY_SCOPE_AGENT); }
__device__ __forceinline__ unsigned xb_add(unsigned* p, unsigned v) { return __hip_atomic_fetch_add(p, v, __ATOMIC_RELAXED, __HIP_MEMORY_SCOPE_AGENT); }
__device__ __forceinline__ unsigned xb_xcc_id() { return (unsigned)__builtin_amdgcn_s_getreg((3 << 11) | 20) & 0xFu; }
#define XB_SPIN(cond, bar) do { unsigned _sp = 0; while (cond) { __builtin_amdgcn_s_sleep(1); \
    if ((++_sp & 255u) == 0u) { if (xb_ld(&(bar)[XB_TMO])) break; if (_sp > XB_SPIN_CAP) { atomicAdd(&(bar)[XB_TMO], 1u); break; } } } } while (0)

struct XcdBarrier { unsigned* bar; unsigned x; volatile LAS unsigned* st; };

__device__ __forceinline__ XcdBarrier xcd_barrier_post(unsigned* bar, volatile LAS unsigned* st) {
    XcdBarrier b; b.bar = bar; b.x = xb_xcc_id(); b.st = st;
    if (threadIdx.x == 0) (void)xb_add(&bar[XB_XCNT(b.x)], 1u);
    return b;
}
__device__ __forceinline__ void xcd_barrier_complete(unsigned* bar, unsigned x, unsigned& nloc, unsigned& nx) {
    const unsigned G = gridDim.x * gridDim.y * gridDim.z;
    unsigned sum, cnt, mine, sp = 0u;
    for (;;) {
        sum = 0u; cnt = 0u; mine = 0u;
#pragma unroll
        for (unsigned j = 0; j < 16; ++j) { const unsigned c = xb_ld(&bar[XB_XCNT(j)]); sum += c; cnt += (c > 0u) ? 1u : 0u; mine = (j == x) ? c : mine; }
        if (sum == G) break;
        __builtin_amdgcn_s_sleep(1);
        if ((++sp & 255u) == 0u) { if (xb_ld(&bar[XB_TMO])) break; if (sp > XB_SPIN_CAP) { atomicAdd(&bar[XB_TMO], 1u); break; } }
    }
    nloc = mine > 0u ? mine : 1u; nx = cnt > 0u ? cnt : 1u;
}
__device__ __forceinline__ void xcd_barrier(const XcdBarrier& b) {
    asm volatile("s_waitcnt vmcnt(0)" ::: "memory");
    __syncthreads();
    if (threadIdx.x == 0) {
        unsigned* bar = b.bar;
        __builtin_amdgcn_s_waitcnt(0);
        unsigned nloc = b.st[0], nx = b.st[1];
        if (nloc == 0u) { xcd_barrier_complete(bar, b.x, nloc, nx); b.st[0] = nloc; b.st[1] = nx; }
        const unsigned old = xb_add(&bar[XB_XSUB(b.x)], 1u);
        const unsigned gen = old / nloc;
        if (old + 1u == (gen + 1u) * nloc) {
            __builtin_amdgcn_fence(__ATOMIC_RELEASE, "agent");
            asm volatile("s_waitcnt vmcnt(0)" ::: "memory");
            const unsigned og = xb_add(&bar[XB_TOP], 1u);
            const unsigned tg = og / nx;
            if (og + 1u == (tg + 1u) * nx) xb_add(&bar[XB_TOPGEN], 1u);
            else XB_SPIN(xb_ld(&bar[XB_TOPGEN]) == tg, bar);
            __builtin_amdgcn_fence(__ATOMIC_ACQUIRE, "agent");
            xb_add(&bar[XB_XGEN(b.x)], 1u);
            asm volatile("s_waitcnt vmcnt(0)" ::: "memory");
        } else {
            XB_SPIN(xb_ld(&bar[XB_XGEN(b.x)]) == gen, bar);
            __builtin_amdgcn_fence(__ATOMIC_ACQUIRE, "agent");
            asm volatile("s_waitcnt vmcnt(0)" ::: "memory");
        }
    }
    __syncthreads();
}

struct Params;
typedef const __attribute__((address_space(4))) Params& PRef;
struct Params {
    const float* x; const float* c; const int* pos; const float* ada_w; const float* ada_b; const float* ln_g; const float* ln_b;
    const float* mla_w_in; const float* mla_g_q; const float* mla_w_uq; const float* mla_g_kv; const float* mla_w_ukv; const float* mla_w_o;
    const float* nsa_w_in; const float* nsa_pe_k; const float* nsa_pe_v; const float* nsa_w_ck1; const float* nsa_w_ck2; const float* nsa_w_cv1; const float* nsa_w_cv2; const float* nsa_w_o;
    const float* sb_w_qkv; const float* sb_w_o;
    const float* moe_w_grp; const float* moe_b_grp; const float* moe_w_rt; const float* moe_b_rt; const float* moe_w_gate; const float* moe_w_up; const float* moe_w_down;
    float* out;
    unsigned* bar; int* cnt; float* mod; float* cosm; float* sinm; float* cosn; float* sinn; float* bias1; float* wr;
    f16_t* xbuf; f16_t* zbuf; bf16_t* hbuf;
    bf16_t* wt_mla_in; bf16_t* wt_uq; bf16_t* wt_ukv; bf16_t* wt_mla_o; bf16_t* wt_nsa_in; bf16_t* wt_ck1; bf16_t* wt_cv1; bf16_t* wt_ck2; bf16_t* wt_cv2;
    bf16_t* wt_nsa_o; bf16_t* wt_sb_qkv; bf16_t* wt_sb_o; bf16_t* wt_gu; bf16_t* wt_dn;
    bf16_t* cbuf; float* rss; bf16_t* krope; bf16_t* qm; bf16_t* kn; bf16_t* vt;
    bf16_t* qn; bf16_t* kc; bf16_t* vc; bf16_t* ks; bf16_t* kw; bf16_t* vst; bf16_t* vwt; float* gates; float* cpart; bf16_t* hid; bf16_t* kcmp; bf16_t* vcmpt;
    bf16_t* qs; bf16_t* ksb;
    bf16_t* obuf;
    int* wq;
    int* list; float* listw; bf16_t* hmoe; bf16_t* ybuf;
};

extern __shared__ __attribute__((aligned(16))) unsigned char smem[];

__device__ __forceinline__ unsigned cvtpk(float lo, float hi) { unsigned r; asm("s_nop 0\n\tv_cvt_pk_bf16_f32 %0, %1, %2\n\ts_nop 1" : "=v"(r) : "v"(lo), "v"(hi)); return r; }
__device__ __forceinline__ uint4 cvtpk8(float a0, float a1, float a2, float a3, float a4, float a5, float a6, float a7) {
    uint4 r;
    asm("s_nop 0\n\tv_cvt_pk_bf16_f32 %0, %4, %5\n\tv_cvt_pk_bf16_f32 %1, %6, %7\n\tv_cvt_pk_bf16_f32 %2, %8, %9\n\tv_cvt_pk_bf16_f32 %3, %10, %11\n\ts_nop 1"
        : "=&v"(r.x), "=&v"(r.y), "=&v"(r.z), "=&v"(r.w) : "v"(a0), "v"(a1), "v"(a2), "v"(a3), "v"(a4), "v"(a5), "v"(a6), "v"(a7));
    return r;
}
__device__ __forceinline__ float bf2f(unsigned v16) { return __uint_as_float(v16 << 16); }
__device__ __forceinline__ uint4 pack8(const float* v) { return cvtpk8(v[0], v[1], v[2], v[3], v[4], v[5], v[6], v[7]); }
__device__ __forceinline__ float wave_sum(float v) {
#pragma unroll
    for (int o = 32; o > 0; o >>= 1) v += __shfl_xor(v, o, 64);
    return v;
}
__device__ __forceinline__ float xh_max(float v) { auto rr = __builtin_amdgcn_permlane32_swap(__float_as_uint(v), __float_as_uint(v), false, false); return fmaxf(__uint_as_float(rr[0]), __uint_as_float(rr[1])); }
__device__ __forceinline__ float xh_sum(float v) { auto rr = __builtin_amdgcn_permlane32_swap(__float_as_uint(v), __float_as_uint(v), false, false); return __uint_as_float(rr[0]) + __uint_as_float(rr[1]); }
__device__ __forceinline__ float xh_other(float v, int h) { auto rr = __builtin_amdgcn_permlane32_swap(__float_as_uint(v), __float_as_uint(v), false, false); return h ? __uint_as_float(rr[0]) : __uint_as_float(rr[1]); }
__device__ __forceinline__ float silu_f(float v) { return v / (1.f + __expf(-v)); }
__device__ __forceinline__ float sigmoid_f(float v) { return 1.f / (1.f + __expf(-v)); }
#define MFMA32(a, b, c) __builtin_amdgcn_mfma_f32_32x32x16_bf16((a), (b), (c), 0, 0, 0)
__device__ __forceinline__ int crow(int reg, int h) { return (reg & 3) + 8 * (reg >> 2) + 4 * h; }
__device__ __forceinline__ bf16x8 lds_frag(const unsigned char* base, int off) { return *reinterpret_cast<const bf16x8*>(base + off); }

constexpr int CS_LD = 132;
constexpr int GEMM_RSTD_OFF = 128 * CS_LD * 4;
template <class RowPtr>
__device__ __forceinline__ void gemm_main(int tid, unsigned char* lds, const RowPtr& rowptr, const bf16_t* __restrict__ Bt, int ldb, int n0, int K, f32x16 (&acc)[2][2]) {
    const int lane = tid & 63, wid = tid >> 6, wr = wid >> 1, wc = wid & 1, r = lane & 31, h = lane >> 5;
    const bf16_t* pa[4]; const bf16_t* pb[4];
#pragma unroll
    for (int i = 0; i < 4; ++i) {
        const int pi = wid + 4 * i, row = 8 * pi + (lane >> 3), c = (lane & 7) ^ ((row >> 1) & 7);
        pa[i] = rowptr(row) + c * 8; pb[i] = Bt + (size_t)(n0 + row) * ldb + c * 8;
    }
    const int swz = (r >> 1) & 7;
    const int aoff = (wr * 64 + r) * 128, boff = 32768 + (wc * 64 + r) * 128;
#pragma unroll
    for (int i = 0; i < 2; ++i)
#pragma unroll
        for (int j = 0; j < 2; ++j)
#pragma unroll
            for (int q = 0; q < 16; ++q) acc[i][j][q] = 0.f;
    const int nk = K >> 6;
    auto dma = [&](int buf, int k0) {
#pragma unroll
        for (int i = 0; i < 4; ++i) {
            const int pi = wid + 4 * i;
            __builtin_amdgcn_global_load_lds((const unsigned*)(pa[i] + k0), (LAS unsigned*)(lds + buf * 16384 + pi * 1024), 16, 0, 0);
            __builtin_amdgcn_global_load_lds((const unsigned*)(pb[i] + k0), (LAS unsigned*)(lds + 32768 + buf * 16384 + pi * 1024), 16, 0, 0);
        }
    };
    dma(0, 0);
    asm volatile("s_waitcnt vmcnt(0)" ::: "memory"); __syncthreads();
    for (int kt = 0; kt < nk; ++kt) {
        if (kt + 1 < nk) dma((kt + 1) & 1, (kt + 1) << 6);
        const unsigned char* sa = lds + (kt & 1) * 16384;
#pragma unroll
        for (int kk = 0; kk < 4; ++kk) {
            const int co = ((2 * kk + h) ^ swz) << 4;
            const bf16x8 a0 = lds_frag(sa, aoff + co), a1 = lds_frag(sa, aoff + 4096 + co);
            const bf16x8 b0 = lds_frag(sa, boff + co), b1 = lds_frag(sa, boff + 4096 + co);
            acc[0][0] = MFMA32(a0, b0, acc[0][0]); acc[0][1] = MFMA32(a0, b1, acc[0][1]);
            acc[1][0] = MFMA32(a1, b0, acc[1][0]); acc[1][1] = MFMA32(a1, b1, acc[1][1]);
        }
        asm volatile("s_waitcnt vmcnt(0)" ::: "memory"); __syncthreads();
    }
    float* Cs = reinterpret_cast<float*>(lds);
#pragma unroll
    for (int i = 0; i < 2; ++i)
#pragma unroll
        for (int j = 0; j < 2; ++j)
#pragma unroll
            for (int q = 0; q < 16; ++q) Cs[(wr * 64 + i * 32 + crow(q, h)) * CS_LD + wc * 64 + j * 32 + r] = acc[i][j][q];
    __syncthreads();
}
#define ITEM_END_SYNC() do { asm volatile("s_waitcnt lgkmcnt(0)" ::: "memory"); __builtin_amdgcn_s_barrier(); asm volatile("" ::: "memory"); } while (0)
__device__ __forceinline__ void cs_load8(const float* Cs, int row, int c0, float* v) {
    const f32x4 a = *reinterpret_cast<const f32x4*>(Cs + row * CS_LD + c0), b = *reinterpret_cast<const f32x4*>(Cs + row * CS_LD + c0 + 4);
    v[0] = a[0]; v[1] = a[1]; v[2] = a[2]; v[3] = a[3]; v[4] = b[0]; v[5] = b[1]; v[6] = b[2]; v[7] = b[3];
}
__device__ __forceinline__ void epi_plain(const float* __restrict__ Cs, bf16_t* __restrict__ dst, size_t ld, const float* __restrict__ rowscale) {
    const int tid = VT, c0 = (tid & 15) * 8;
#pragma unroll
    for (int ps = 0; ps < 8; ++ps) {
        const int row = (tid >> 4) + 16 * ps; float v[8]; cs_load8(Cs, row, c0, v);
        if (rowscale) { const float s = rowscale[row];
#pragma unroll
            for (int q = 0; q < 8; ++q) v[q] *= s; }
        *reinterpret_cast<uint4*>(dst + (size_t)row * ld + c0) = pack8(v);
    }
}
__device__ __forceinline__ void epi_rope128(const float* __restrict__ Cs, bf16_t* __restrict__ dst, size_t ld, const float* __restrict__ cs, const float* __restrict__ sn, int tok0) {
    const int tid = VT, c0 = (tid & 15) * 8;
    if (c0 >= 64) return;
#pragma unroll
    for (int ps = 0; ps < 8; ++ps) {
        const int row = (tid >> 4) + 16 * ps; float a[8], b[8], o1[8], o2[8]; cs_load8(Cs, row, c0, a); cs_load8(Cs, row, c0 + 64, b);
        const float* cp = cs + (size_t)(tok0 + row) * 64 + c0; const float* sp = sn + (size_t)(tok0 + row) * 64 + c0;
#pragma unroll
        for (int q = 0; q < 8; ++q) { const float c = cp[q], s = sp[q]; o1[q] = a[q] * c - b[q] * s; o2[q] = b[q] * c + a[q] * s; }
        *reinterpret_cast<uint4*>(dst + (size_t)row * ld + c0) = pack8(o1);
        *reinterpret_cast<uint4*>(dst + (size_t)row * ld + c0 + 64) = pack8(o2);
    }
}
__device__ __forceinline__ void epi_transpose(const float* __restrict__ Cs, bf16_t* __restrict__ dst  , size_t ld, const float* __restrict__ rowscale) {
    const int tid = VT, dv = tid & 127, sh = tid >> 7;
#pragma unroll
    for (int j = 0; j < 8; ++j) {
        float v[8];
#pragma unroll
        for (int q = 0; q < 8; ++q) { const int row = sh * 64 + j * 8 + q; v[q] = Cs[row * CS_LD + dv] * (rowscale ? rowscale[row] : 1.f); }
        *reinterpret_cast<uint4*>(dst + (size_t)dv * ld + sh * 64 + j * 8) = pack8(v);
    }
}

struct RowPlain { const bf16_t* base; size_t ld; __device__ __forceinline__ const bf16_t* operator()(int r) const { return base + (size_t)r * ld; } };


namespace g8 {
typedef float f32x4_t __attribute__((ext_vector_type(4)));
constexpr int BK = 64, HALFR = 128, HTB = HALFR * BK * 2, STAGE_BYTES = 8 * HTB;
__device__ __forceinline__ int lds_byte(int r, int c) { const int st = (r >> 4) * 2 + (c >> 5), rr = r & 15, cc = c & 31, ob = rr * 64 + cc * 2; return st * 1024 + (ob ^ (((ob >> 9) & 1) << 5)); }
__device__ __forceinline__ void stage_rc(int b, int& R, int& C) { const int st = b / 1024, sb = b % 1024, swz = sb ^ (((sb >> 9) & 1) << 5); R = (st >> 1) * 16 + swz / 64; C = (st & 1) * 32 + (swz % 64) / 2; }
struct Unit { int pm, pn, par, e; };
template <class Sched, class Epi>
__device__ __forceinline__ void gemm8(LAS unsigned char* lds, const char* __restrict__ Abase, int ldb, int K, const Sched& S, const Epi& E) {
    const int tid = threadIdx.x;
    const int wid = __builtin_amdgcn_readfirstlane(tid >> 6), lane = tid & 63, wr = wid >> 2, wc = wid & 3, fr = lane & 15, fq = lane >> 4;
    const int nt = K / BK;
    unsigned voffB0; { int R, C; stage_rc(tid * 16, R, C); voffB0 = (unsigned)(R * ldb + C) * 2u; }
    const unsigned voffBd = (unsigned)(64 * ldb) * 2u;
    const size_t kstep = (size_t)(BK * 2), hstepB = (size_t)HALFR * ldb * 2;
    const unsigned ldsw = (unsigned)wid * 1024u;
    const int lpart = lds_byte(fr, fq * 8);
    const int aoff = lpart + wr * 8192, boff = lpart + wc * 4096;
#define G8_SA(b, h) (((b) * 2 + (h)) * HTB)
#define G8_SB(b, h) ((4 + (b) * 2 + (h)) * HTB)
#define G8_STAGE_B(bufoff, gbase) do { \
        __builtin_amdgcn_global_load_lds((const unsigned*)((const char*)(gbase) + voffB0), (LAS unsigned*)(lds + (bufoff) + ldsw), 16, 0, 0); \
        __builtin_amdgcn_global_load_lds((const unsigned*)((const char*)(gbase) + voffBd + voffB0), (LAS unsigned*)(lds + (bufoff) + ldsw + 8192), 16, 0, 0); } while (0)
#define G8_STAGE_A(bufoff, hnd, kbytes) do { \
        __builtin_amdgcn_global_load_lds((const unsigned*)(Abase + (size_t)S.a_off(hnd, 0, tid) + (kbytes)), (LAS unsigned*)(lds + (bufoff) + ldsw), 16, 0, 0); \
        __builtin_amdgcn_global_load_lds((const unsigned*)(Abase + (size_t)S.a_off(hnd, 1, tid) + (kbytes)), (LAS unsigned*)(lds + (bufoff) + ldsw + 8192), 16, 0, 0); } while (0)
#define G8_LDA(dst, b, h) do { _Pragma("unroll") for (int m = 0; m < 4; ++m) _Pragma("unroll") for (int k = 0; k < 2; ++k) dst[m][k] = *(const LAS bf16x8*)(lds + G8_SA(b, h) + aoff + m * 2048 + k * 1024); } while (0)
#define G8_LDB(dst, b, h) do { _Pragma("unroll") for (int n = 0; n < 2; ++n) _Pragma("unroll") for (int k = 0; k < 2; ++k) dst[n][k] = *(const LAS bf16x8*)(lds + G8_SB(b, h) + boff + n * 2048 + k * 1024); } while (0)
#define G8_MMA(ai, bj, At, Bt) do { __builtin_amdgcn_s_setprio(1); _Pragma("unroll") for (int m = 0; m < 4; ++m) _Pragma("unroll") for (int n = 0; n < 2; ++n) _Pragma("unroll") for (int k = 0; k < 2; ++k) \
        acc[ai][bj][m][n] = __builtin_amdgcn_mfma_f32_16x16x32_bf16(Bt[n][k], At[m][k], acc[ai][bj][m][n], 0, 0, 0); __builtin_amdgcn_s_setprio(0); } while (0)
#define G8_WAIT_V(n) asm volatile("s_waitcnt vmcnt(" #n ")" ::: "memory")
#define G8_WAIT_L(n) asm volatile("s_waitcnt lgkmcnt(" #n ")" ::: "memory")
#define G8_BAR __builtin_amdgcn_s_barrier()
#define G8_SCHED __builtin_amdgcn_sched_barrier(0)
    Unit cur, nxt; int ui = 0;
    if (!S.next(0, cur)) return;
    f32x4_t acc[2][2][4][2];
#pragma unroll
    for (int a = 0; a < 2; ++a)
#pragma unroll
        for (int b = 0; b < 2; ++b)
#pragma unroll
            for (int m = 0; m < 4; ++m)
#pragma unroll
                for (int n = 0; n < 2; ++n) acc[a][b][m][n] = (f32x4_t){0.f, 0.f, 0.f, 0.f};
    bf16x8 At[4][2], B0[2][2], B1[2][2];
    unsigned c0, c1;
    cur.par = 0; S.stash(cur, tid); S.stash_wait(); S.a_handles(cur, tid, c0, c1);
    const char* cB = S.b_base(cur);
    G8_STAGE_B(G8_SB(0, 0), cB); G8_STAGE_A(G8_SA(0, 0), c0, 0); G8_STAGE_B(G8_SB(0, 1), cB + hstepB); G8_STAGE_A(G8_SA(0, 1), c1, 0);
    if (wr == 1) G8_BAR;
    G8_WAIT_V(4); G8_BAR;
    G8_STAGE_B(G8_SB(1, 0), cB + kstep); G8_STAGE_A(G8_SA(1, 0), c0, kstep); G8_STAGE_B(G8_SB(1, 1), cB + hstepB + kstep);
    G8_WAIT_V(6); G8_BAR;
    for (;;) {
        const bool has_next = S.next(ui + 1, nxt); nxt.par = (ui + 1) % 3;
        const char* nB = cB;
        if (has_next) { S.stash(nxt, tid); nB = S.b_base(nxt); }
#pragma unroll 1
        for (int t = 0; t < nt; t += 2) {
            const bool last = (t == nt - 2);
            const size_t k1 = (size_t)(t + 1) * kstep;
            const size_t k2 = last ? 0 : (size_t)(t + 2) * kstep, k3 = k2 + kstep;
            const char* b2 = last ? nB : cB + k2; const char* b3 = b2 + kstep;
            G8_LDB(B0, 0, 0); G8_SCHED; G8_LDA(At, 0, 0); G8_STAGE_A(G8_SA(1, 1), c1, k1);
            if (last && has_next) S.a_handles(nxt, tid, c0, c1);
            G8_WAIT_L(8); G8_BAR; G8_WAIT_L(0); G8_MMA(0, 0, At, B0); G8_BAR; G8_SCHED;
            G8_LDB(B1, 0, 1); G8_STAGE_B(G8_SB(0, 0), b2);
            G8_BAR; G8_WAIT_L(0); G8_MMA(0, 1, At, B1); G8_BAR;
            G8_LDA(At, 0, 1); G8_STAGE_A(G8_SA(0, 0), c0, k2);
            G8_BAR; G8_WAIT_L(0); G8_MMA(1, 0, At, B0); G8_BAR; G8_SCHED;
            G8_STAGE_B(G8_SB(0, 1), b2 + hstepB);
            G8_WAIT_V(6); G8_BAR; G8_MMA(1, 1, At, B1); G8_BAR;
            G8_LDB(B0, 1, 0); G8_SCHED; G8_LDA(At, 1, 0); G8_STAGE_A(G8_SA(0, 1), c1, k2);
            G8_WAIT_L(8); G8_BAR; G8_WAIT_L(0); G8_MMA(0, 0, At, B0); G8_BAR; G8_SCHED;
            G8_LDB(B1, 1, 1); G8_STAGE_B(G8_SB(1, 0), b3);
            G8_BAR; G8_WAIT_L(0); G8_MMA(0, 1, At, B1); G8_BAR;
            G8_LDA(At, 1, 1); G8_STAGE_A(G8_SA(1, 0), c0, k3);
            G8_BAR; G8_WAIT_L(0); G8_MMA(1, 0, At, B0); G8_BAR; G8_SCHED;
            G8_STAGE_B(G8_SB(1, 1), b3 + hstepB);
            G8_WAIT_V(6); G8_BAR; G8_MMA(1, 1, At, B1); G8_BAR;
        }
        E(acc, cur, wr, wc, fr, fq);
        if (!has_next) break;
#pragma unroll
        for (int a = 0; a < 2; ++a)
#pragma unroll
            for (int b = 0; b < 2; ++b)
#pragma unroll
                for (int m = 0; m < 4; ++m)
#pragma unroll
                    for (int n = 0; n < 2; ++n) acc[a][b][m][n] = (f32x4_t){0.f, 0.f, 0.f, 0.f};
        cur = nxt; cB = nB; ++ui;
    }
    G8_WAIT_V(0);
    if (wr == 0) G8_BAR;
    G8_BAR;
#undef G8_SA
#undef G8_SB
#undef G8_STAGE_A
#undef G8_STAGE_B
#undef G8_LDA
#undef G8_LDB
#undef G8_MMA
#undef G8_WAIT_V
#undef G8_WAIT_L
#undef G8_BAR
#undef G8_SCHED
}
struct SchedPlain {
    int nM, nN, nwg, G, c, lda; const char* Bt; size_t ldb_bytes;
    __device__ __forceinline__ void init(int M, int N, int lda_, const void* Bt_, int ldb) { nM = M / 256; nN = N / 256; nwg = nM * nN; G = gridDim.x; c = blockIdx.x; lda = lda_; Bt = (const char*)Bt_; ldb_bytes = (size_t)ldb * 2; }
    __device__ __forceinline__ bool next(int i, Unit& u) const {
        const long L = (long)i * G + c; if (L >= nwg) return false;
        int wgid = (int)L; { const int q = nwg / 8, r = nwg % 8, xcd = wgid % 8, off = wgid / 8; wgid = (xcd < r ? xcd * (q + 1) : r * (q + 1) + (xcd - r) * q) + off; }
        const int nig = 8 * nN, gid = wgid / nig, fm = gid * 8, gsz = (nM - fm) < 8 ? (nM - fm) : 8;
        u.pm = fm + ((wgid % nig) % gsz); u.pn = (wgid % nig) / gsz; return true;
    }
    __device__ __forceinline__ void a_handles(const Unit& u, int tid, unsigned& h0, unsigned& h1) const {
        int R, C; stage_rc(tid * 16, R, C);
        h0 = ((unsigned)(u.pm * 256 + R) * (unsigned)lda + (unsigned)C) * 2u; h1 = h0 + (unsigned)(128 * lda) * 2u;
    }
    __device__ __forceinline__ unsigned a_off(unsigned h, int piece, int) const { return h + (unsigned)(piece * 64 * lda) * 2u; }
    __device__ __forceinline__ const char* b_base(const Unit& u) const { return Bt + (size_t)u.pn * 256 * ldb_bytes; }
    __device__ __forceinline__ void stash(const Unit&, int) const {}
    __device__ __forceinline__ void stash_wait() const {}
};
struct SchedMoe {
    const int* pre; const int* list; const float* listw; const char* Bt; size_t estride, ustride; int nunits, G, c, gather; int* tab;
    __device__ __forceinline__ int expert(int panel) const { int e = 0; for (int q = 1; q < 32; ++q) e = (pre[q] <= panel) ? q : e; return e; }
    __device__ __forceinline__ bool next(int i, Unit& u) const {
        const int per = (nunits + 7) >> 3, x = c & 7, Lx = i * (G >> 3) + (c >> 3), L = x * per + Lx;
        if (Lx >= per || L >= nunits) return false;
        u.pn = L & 3; u.pm = L >> 2; u.e = __builtin_amdgcn_readfirstlane(expert(u.pm)); return true;
    }
    __device__ __forceinline__ void stash(const Unit& u, int tid) const {
        const int e = u.e, b0 = (u.pm - pre[e]) * 256; const int* l = list + (size_t)e * T_TOK + b0;
        const int wv = __builtin_amdgcn_readfirstlane(tid >> 6);
        if (gather) {
            int R, C; stage_rc(tid * 16, R, C);
#pragma unroll
            for (int k = 0; k < 4; ++k)
                __builtin_amdgcn_global_load_lds((const unsigned*)(l + R + 64 * (k & 1) + 128 * (k >> 1)), (LAS unsigned*)((LAS unsigned char*)(LAS int*)tab + k * 2048 + wv * 256), 4, 0, 0);
        } else {
            const int r = tid & 255; const int* src = (tid < 256) ? (l + r) : reinterpret_cast<const int*>(listw + (size_t)e * T_TOK + b0 + r);
            __builtin_amdgcn_global_load_lds((const unsigned*)src, (LAS unsigned*)((LAS unsigned char*)(LAS int*)tab + u.par * 2048 + wv * 256), 4, 0, 0);
        }
    }
    __device__ __forceinline__ void stash_wait() const { asm volatile("s_waitcnt vmcnt(0)" ::: "memory"); }
    __device__ __forceinline__ void a_handles(const Unit& u, int tid, unsigned& h0, unsigned& h1) const {
        if (gather) {
            asm volatile("" ::: "memory");
            const unsigned t0 = ((unsigned)tab[tid] >> 1) & 16383u, t1 = ((unsigned)tab[512 + tid] >> 1) & 16383u, t2 = ((unsigned)tab[1024 + tid] >> 1) & 16383u, t3 = ((unsigned)tab[1536 + tid] >> 1) & 16383u;
            h0 = t0 | (t1 << 16); h1 = t2 | (t3 << 16);
        }
        else { int R, C; stage_rc(tid * 16, R, C); h0 = ((unsigned)(u.pm * 256 + R) * 512u + (unsigned)C) * 2u; h1 = h0 + 128u * 512u * 2u; }
    }
    __device__ __forceinline__ unsigned a_off(unsigned h, int piece, int tid) const {
        if (gather) { int R, C; stage_rc(tid * 16, R, C); return (((h >> (16 * piece)) & 0xffffu) * 1024u + (unsigned)C) * 2u; }
        return h + (unsigned)(piece * 64 * 512) * 2u;
    }
    __device__ __forceinline__ const char* b_base(const Unit& u) const { return Bt + (size_t)u.e * estride + (size_t)u.pn * ustride; }
};
}

__device__ __forceinline__ void convert_T(unsigned char* lds, const float* __restrict__ src, int nb, int K, int N, bf16_t* __restrict__ dst, size_t dst_bstride,
                                       const float* __restrict__ rowscale, int grp, int grp_stride, int off, int b0 = 0, int perm = 0) {
    (void)lds;
    int tid = VT; asm volatile("" : "+v"(tid));
    const int lane = tid & 63, wid = tid >> 6;
    const int nkt = K >> 7, nnt = (N + 63) >> 6, per = nkt * nnt, total = nb * per;
    for (int it = VB; it < total; it += NVB) {
        const int bl = it / per, b = b0 + bl, rem = it - bl * per, ktile = rem / nnt, ntile = rem - ktile * nnt;
        const int k0 = (ktile << 7) + (wid * 4 + (lane >> 4)) * 8, n = (ntile << 6) + (lane & 15) * 4;
        if (n < N) {
            const float* s = src + (size_t)b * K * N + (size_t)k0 * N + n;
            f32x4 v[8];
#pragma unroll
            for (int j = 0; j < 8; ++j) v[j] = *reinterpret_cast<const f32x4*>(s + (size_t)j * N);
            if (rowscale) {
#pragma unroll
                for (int j = 0; j < 8; ++j) { const float sc = rowscale[(size_t)b * K + k0 + j]; v[j] *= sc; }
            }
#pragma unroll
            for (int q = 0; q < 4; ++q) {
                const int nn = n + q; int drow = (nn / grp) * grp_stride + off + (nn % grp);
                if (perm == 1) { const int l = drow & 127; drow = (drow & ~127) | (32 * ((l >> 4) & 3) + 16 * (l >> 6) + (l & 15)); }
                if (perm == 3) { const int l = drow & 31; drow = (drow & ~31) | (16 * ((l >> 2) & 1) + 4 * (l >> 3) + (l & 3)); }
                else if (perm == 2) { const int l = drow & 63; drow = (drow & ~63) | (32 * ((l >> 4) & 1) + 16 * (l >> 5) + (l & 15)); }
                *reinterpret_cast<uint4*>(dst + (size_t)b * dst_bstride + (size_t)drow * K + k0) = cvtpk8(v[0][q], v[1][q], v[2][q], v[3][q], v[4][q], v[5][q], v[6][q], v[7][q]);
            }
        }
    }
}

__device__ __forceinline__ void job_mod(PRef p, unsigned char* lds) {
    int tid = VT; asm volatile("" : "+v"(tid));
    const int lane = tid & 63, wid = tid >> 6;
    float* sc = reinterpret_cast<float*>(lds);
    float* part = reinterpret_cast<float*>(lds + 32768);
    for (int i = tid; i < 8192; i += NTHR) { const int b = i >> 10, k = i & 1023; const float v = p.c[b * 1024 + k]; sc[k * 8 + b] = v / (1.f + expf(-v)); }
    __syncthreads();
    for (int it = VB; it < 384; it += NVB) {
        const int sl = it / 48, n0 = (it % 48) * 64;
        const float* W = p.ada_w + (size_t)sl * 1024 * 3072 + n0 + lane;
        float acc[8] = {0.f, 0.f, 0.f, 0.f, 0.f, 0.f, 0.f, 0.f};
        const int kb = wid * 256;
#pragma unroll 16
        for (int k = 0; k < 256; ++k) {
            const float w = W[(size_t)(kb + k) * 3072];
            const f32x4 s0 = *reinterpret_cast<const f32x4*>(sc + (kb + k) * 8), s1 = *reinterpret_cast<const f32x4*>(sc + (kb + k) * 8 + 4);
            acc[0] += s0[0] * w; acc[1] += s0[1] * w; acc[2] += s0[2] * w; acc[3] += s0[3] * w;
            acc[4] += s1[0] * w; acc[5] += s1[1] * w; acc[6] += s1[2] * w; acc[7] += s1[3] * w;
        }
#pragma unroll
        for (int b = 0; b < 8; ++b) part[(wid * 8 + b) * 64 + lane] = acc[b];
        __syncthreads();
        for (int o = tid; o < 512; o += NTHR) {
            const int b = o >> 6, l = o & 63;
            const float s = part[(0 * 8 + b) * 64 + l] + part[(1 * 8 + b) * 64 + l] + part[(2 * 8 + b) * 64 + l] + part[(3 * 8 + b) * 64 + l] + p.ada_b[sl * 3072 + n0 + l];
            p.mod[(size_t)(sl * 8 + b) * 3072 + n0 + l] = s;
        }
        __syncthreads();
    }
}

__device__ __forceinline__ void job_misc(PRef p, unsigned char* lds) {
    const int tid = VT;
    const size_t gtid = (size_t)VB * NTHR + tid, gsz = (size_t)NVB * NTHR;
    for (size_t i = gtid; i < (size_t)T_TOK * 32; i += gsz) {
        const int t = (int)(i >> 5), f = (int)(i & 31);
        const float inv = 1.0f / powf(10000.f, (float)(2 * f) / 64.f);
        const float ang = (float)p.pos[t] * inv;
        p.cosm[i] = cosf(ang); p.sinm[i] = sinf(ang);
    }
    for (size_t i = gtid; i < (size_t)T_TOK * 64; i += gsz) {
        const int t = (int)(i >> 6), f = (int)(i & 63);
        const float inv = 1.0f / powf(10000.f, (float)(2 * f) / 128.f);
        const float ang = (float)p.pos[t] * inv;
        p.cosn[i] = cosf(ang); p.sinn[i] = sinf(ang);
    }
    for (size_t i = gtid; i < (size_t)DEPTH * 1024 * 48; i += gsz) {
        const int e = (int)(i % 48); const size_t lk = i / 48;
        float v = 0.f;
        if (e < 4) v = p.moe_w_grp[lk * 4 + e]; else if (e < 36) v = p.moe_w_rt[lk * 32 + (e - 4)];
        p.wr[i] = v;
    }
    if (gtid < DEPTH * 32) p.cnt[gtid * 64] = 0;
    {
        const int lane = tid & 63, wid = tid >> 6;
        for (int o = VB * 4 + wid; o < 256; o += NVB * 4) {
            const int which = o >> 7, e = o & 127;
            const float* pe = which ? p.nsa_pe_v : p.nsa_pe_k; const float* w1 = which ? p.nsa_w_cv1 : p.nsa_w_ck1;
            float a = 0.f;
#pragma unroll 16
            for (int j = 0; j < 64; ++j) { const int k = lane + 64 * j; a += pe[k] * w1[(size_t)k * 128 + e]; }
            a = wave_sum(a);
            if (lane == 0) p.bias1[o] = a;
        }
    }
}

struct CvtJob { const float* src; int nb, K, N; bf16_t* dst; size_t bstride; const float* rowscale; int grp, gstride, off, perm; };
__device__ __forceinline__ CvtJob cvt_job(PRef p, int j) {
    const int BIG = 1 << 30;
    CvtJob c;
    switch (j) {
    case 0:  c = CvtJob{p.moe_w_gate, DEPTH * 32, 1024, 512, p.wt_gu, (size_t)1024 * 1024, nullptr, 64, 128, 0, 0}; break;
    case 1:  c = CvtJob{p.moe_w_up, DEPTH * 32, 1024, 512, p.wt_gu, (size_t)1024 * 1024, nullptr, 64, 128, 64, 0}; break;
    case 2:  c = CvtJob{p.moe_w_down, DEPTH * 32, 512, 1024, p.wt_dn, (size_t)1024 * 512, nullptr, BIG, 0, 0, 0}; break;
    case 3:  c = CvtJob{p.mla_w_in, 2, 1024, 576, p.wt_mla_in, (size_t)768 * 1024, nullptr, BIG, 0, 0, 2}; break;
    case 4:  c = CvtJob{p.mla_w_uq, 2, 256, 1536, p.wt_uq, (size_t)1536 * 256, p.mla_g_q, BIG, 0, 0, 2}; break;
    case 5:  c = CvtJob{p.mla_w_ukv, 2, 256, 2048, p.wt_ukv, (size_t)2048 * 256, p.mla_g_kv, BIG, 0, 0, 3}; break;
    case 6:  c = CvtJob{p.mla_w_o, 2, 1024, 1024, p.wt_mla_o, (size_t)1024 * 1024, nullptr, BIG, 0, 0, 3}; break;
    case 7:  c = CvtJob{p.nsa_w_in, 1, 1024, 2584, p.wt_nsa_in, 0, nullptr, BIG, 0, 0, 1}; break;
    case 8:  c = CvtJob{p.nsa_w_ck1, 1, 4096, 128, p.wt_ck1, 0, nullptr, BIG, 0, 0, 0}; break;
    case 9:  c = CvtJob{p.nsa_w_cv1, 1, 4096, 128, p.wt_cv1, 0, nullptr, BIG, 0, 0, 0}; break;
    case 10: c = CvtJob{p.nsa_w_ck2, 1, 128, 128, p.wt_ck2, 0, nullptr, BIG, 0, 0, 0}; break;
    case 11: c = CvtJob{p.nsa_w_cv2, 1, 128, 128, p.wt_cv2, 0, nullptr, BIG, 0, 0, 0}; break;
    case 12: c = CvtJob{p.nsa_w_o, 1, 1024, 1024, p.wt_nsa_o, 0, nullptr, BIG, 0, 0, 3}; break;
    case 13: c = CvtJob{p.sb_w_qkv, 1, 1024, 3072, p.wt_sb_qkv, 0, nullptr, BIG, 0, 0, 3}; break;
    default: c = CvtJob{p.sb_w_o, 1, 1024, 1024, p.wt_sb_o, 0, nullptr, BIG, 0, 0, 3}; break;
    }
    return c;
}
template <int K, int N, int grp, int grp_stride, int perm>
__device__ __forceinline__ void convert_T_steal(int* ctr, const float* __restrict__ src, bf16_t* __restrict__ dst, int off, int b0) {
    constexpr int nb = 32; constexpr size_t dst_bstride = (size_t)K * N * (grp_stride ? 2 : 1);
    int tid = threadIdx.x; asm volatile("" : "+v"(tid));
    const int lane = tid & 63;
    constexpr int nkt = K >> 7, nnt = N >> 6, per = nkt * nnt, total = nb * per * 4;
    static_assert(total % 64 == 0, "eighths in whole chunks");
    const int xq = (int)(blockIdx.x & 7u), wend = (xq + 1) * (total / 8);
    int* qh = ctr + xq * 16;
    for (;;) {
        int w0 = 0;
        if (lane == 0) w0 = __hip_atomic_fetch_add(qh, 8, __ATOMIC_RELAXED, __HIP_MEMORY_SCOPE_AGENT);
        w0 = __builtin_amdgcn_readfirstlane(w0) + xq * (total / 8);
        if (w0 >= wend) break;
#pragma unroll 1
        for (int w = w0; w < w0 + 8; ++w) {
            const int it = w >> 2, wq = w & 3;
            const int bl = it / per, b = b0 + bl, rem = it - bl * per, ktile = rem / nnt, ntile = rem - ktile * nnt;
            const int k0 = (ktile << 7) + (wq * 4 + (lane >> 4)) * 8, n = (ntile << 6) + (lane & 15) * 4;
            const float* sp = src + (size_t)b * K * N + (size_t)k0 * N + n;
            f32x4 v[8];
#pragma unroll
            for (int j = 0; j < 8; ++j) v[j] = *reinterpret_cast<const f32x4*>(sp + (size_t)j * N);
#pragma unroll
            for (int q = 0; q < 4; ++q) {
                const int nn = n + q; int drow = (nn / grp) * grp_stride + off + (nn % grp);
                if (perm == 1) { const int l = drow & 127; drow = (drow & ~127) | (32 * ((l >> 4) & 3) + 16 * (l >> 6) + (l & 15)); }
                if (perm == 3) { const int l = drow & 31; drow = (drow & ~31) | (16 * ((l >> 2) & 1) + 4 * (l >> 3) + (l & 3)); }
                *reinterpret_cast<uint4*>(dst + (size_t)b * dst_bstride + (size_t)drow * K + k0) = cvtpk8(v[0][q], v[1][q], v[2][q], v[3][q], v[4][q], v[5][q], v[6][q], v[7][q]);
            }
        }
    }
}
__device__ __forceinline__ void convert_moe_steal(PRef p, int layer, int which) {
    int* ctr = p.wq + (layer * 3 + which) * 128;
    if (which == 0) convert_T_steal<1024, 512, 128, 256, 3>(ctr, p.moe_w_gate, p.wt_gu, 0, layer * 32);
    else if (which == 1) convert_T_steal<1024, 512, 128, 256, 3>(ctr, p.moe_w_up, p.wt_gu, 128, layer * 32);
    else convert_T_steal<512, 1024, 1 << 30, 0, 3>(ctr, p.moe_w_down, p.wt_dn, 0, layer * 32);
}
__device__ __forceinline__ void convert_moe(PRef p, int layer, int which) {
    if (which == 0) convert_T(nullptr, p.moe_w_gate, 32, 1024, 512, p.wt_gu, (size_t)1024 * 1024, nullptr, 128, 256, 0, layer * 32, 3);
    else if (which == 1) convert_T(nullptr, p.moe_w_up, 32, 1024, 512, p.wt_gu, (size_t)1024 * 1024, nullptr, 128, 256, 128, layer * 32, 3);
    else convert_T(nullptr, p.moe_w_down, 32, 512, 1024, p.wt_dn, (size_t)1024 * 512, nullptr, 1 << 30, 0, 0, layer * 32, 3);
}
__device__ __forceinline__ void ph_prologue(PRef p) {
    unsigned char* lds = VLDS;
    job_mod(p, lds);
    job_misc(p, lds);
    for (int j = 3; j < 15; ++j) {
        const CvtJob c = cvt_job(p, j);
        convert_T(lds, c.src, c.nb, c.K, c.N, c.dst, c.bstride, c.rowscale, c.grp, c.gstride, c.off, 0, c.perm);
    }
    for (int w = 0; w < 2; ++w) convert_moe(p, 0, w);
}

__device__ __forceinline__ void ph_h0(PRef p) {
    const size_t gtid = (size_t)VB * NTHR + VT, gsz = (size_t)NVB * NTHR;
    for (size_t i = gtid; i < (size_t)T_TOK * 128; i += gsz) {
        const int row = (int)(i >> 7), c0 = (int)(i & 127) * 8, b = row >> 11;
        const float* xs = p.x + (size_t)row * 1024 + c0; const float* sh = p.mod + (size_t)b * 3072 + c0; const float* scp = sh + 1024;
        float v[8];
#pragma unroll
        for (int q = 0; q < 8; ++q) v[q] = xs[q] * (1.f + scp[q]) + sh[q];
        *reinterpret_cast<uint4*>(p.hbuf + (size_t)row * 1024 + c0) = pack8(v);
    }
}

__device__ __forceinline__ void st4bf(bf16_t* p, float a, float b, float c, float d) { uint2 pk; pk.x = cvtpk(a, b); pk.y = cvtpk(c, d); *reinterpret_cast<uint2*>(p) = pk; }
__device__ __forceinline__ int vt_pos(int s) { return (s & ~12) | ((s & 4) << 1) | ((s & 8) >> 1); }
__device__ __forceinline__ void st_vt4(bf16_t* vt_feat0  , const g8::f32x4_t& a, float sc) {
#pragma unroll
    for (int q = 0; q < 4; ++q) vt_feat0[(size_t)q * SEQ] = (bf16_t)(cvtpk(a[q] * sc, 0.f) & 0xffffu);
}
struct EpiMlaIn {
    bf16_t* cbuf; float* rss; bf16_t* krope; const float* cosm; const float* sinm;
    __device__ __forceinline__ void operator()(const g8::f32x4_t (&acc)[2][2][4][2], const g8::Unit& u, int wr, int wc, int fr, int fq) const {
        const int lc = 64 * (wc >> 1) + 16 * (wc & 1) + 4 * fq;
#pragma unroll
        for (int ai = 0; ai < 2; ++ai) {
            f32x4 csb[4], snb[4];
            if (u.pn >= 2 && wc < 2) {
#pragma unroll
                for (int m = 0; m < 4; ++m) {
                    const int row = u.pm * 256 + ai * 128 + wr * 64 + m * 16 + fr, i0 = 16 * wc + 4 * fq;
                    csb[m] = *reinterpret_cast<const f32x4*>(cosm + (size_t)row * 32 + i0); snb[m] = *reinterpret_cast<const f32x4*>(sinm + (size_t)row * 32 + i0);
                }
            }
#pragma unroll
            for (int m = 0; m < 4; ++m) {
                const int row = u.pm * 256 + ai * 128 + wr * 64 + m * 16 + fr;
                if (u.pn < 2) {
                    float sq = 0.f;
#pragma unroll
                    for (int bj = 0; bj < 2; ++bj)
#pragma unroll
                        for (int n = 0; n < 2; ++n) {
                            const g8::f32x4_t a = acc[ai][bj][m][n];
                            st4bf(cbuf + (size_t)row * 512 + u.pn * 256 + bj * 128 + lc + 32 * n, a[0], a[1], a[2], a[3]);
                            sq += a[0] * a[0] + a[1] * a[1] + a[2] * a[2] + a[3] * a[3];
                        }
                    sq += __shfl_xor(sq, 16, 64); sq += __shfl_xor(sq, 32, 64);
                    if (fq == 0) rss[(size_t)row * 8 + u.pn * 4 + wc] = sq;
                } else if (wc < 2) {
                    const int i0 = 16 * wc + 4 * fq;
                    const f32x4 cs = csb[m], sn = snb[m];
                    const g8::f32x4_t x1 = acc[ai][0][m][0], x2 = acc[ai][0][m][1];
                    st4bf(krope + (size_t)row * 64 + i0, x1[0] * cs[0] - x2[0] * sn[0], x1[1] * cs[1] - x2[1] * sn[1], x1[2] * cs[2] - x2[2] * sn[2], x1[3] * cs[3] - x2[3] * sn[3]);
                    st4bf(krope + (size_t)row * 64 + 32 + i0, x2[0] * cs[0] + x1[0] * sn[0], x2[1] * cs[1] + x1[1] * sn[1], x2[2] * cs[2] + x1[2] * sn[2], x2[3] * cs[3] + x1[3] * sn[3]);
                }
            }
        }
    }
};
__device__ __forceinline__ void ph_mla_in(PRef p, int j) {
    g8::SchedPlain S; S.init(T_TOK, 768, 1024, p.wt_mla_in + (size_t)j * 768 * 1024, 1024);
    g8::gemm8((LAS unsigned char*)(smem + LDS_WORK), (const char*)p.hbuf, 1024, 1024, S, EpiMlaIn{p.cbuf, p.rss, p.krope, p.cosm, p.sinm});
    __syncthreads();
}
__device__ __forceinline__ float mla_rstd(const float* rss, int row, int which) {
    const f32x4 q = *reinterpret_cast<const f32x4*>(rss + (size_t)row * 8 + which * 4);
    return rsqrtf((q[0] + q[1] + q[2] + q[3]) * (1.f / 256.f) + RMS_EPS);
}
struct EpiMlaQ {
    bf16_t* qm; const float* rss; const float* cosm; const float* sinm;
    __device__ __forceinline__ void operator()(const g8::f32x4_t (&acc)[2][2][4][2], const g8::Unit& u, int wr, int wc, int fr, int fq) const {
        const int i0 = 16 * (wc & 1) + 4 * fq;
#pragma unroll
        for (int ai = 0; ai < 2; ++ai) {
            f32x4 qs[4], csb[4], snb[4];
#pragma unroll
            for (int m = 0; m < 4; ++m) {
                const int row = u.pm * 256 + ai * 128 + wr * 64 + m * 16 + fr;
                qs[m] = *reinterpret_cast<const f32x4*>(rss + (size_t)row * 8);
                csb[m] = *reinterpret_cast<const f32x4*>(cosm + (size_t)row * 32 + i0); snb[m] = *reinterpret_cast<const f32x4*>(sinm + (size_t)row * 32 + i0);
            }
#pragma unroll
            for (int m = 0; m < 4; ++m) {
                const int row = u.pm * 256 + ai * 128 + wr * 64 + m * 16 + fr;
                const float sc = rsqrtf((qs[m][0] + qs[m][1] + qs[m][2] + qs[m][3]) * (1.f / 256.f) + RMS_EPS);
                const f32x4 cs = csb[m], sn = snb[m];
#pragma unroll
                for (int bj = 0; bj < 2; ++bj) {
                    const int c64 = u.pn * 256 + bj * 128 + 64 * (wc >> 1);
                    bf16_t* dst = qm + (size_t)row * 1536 + c64 + i0;
                    const g8::f32x4_t x1 = acc[ai][bj][m][0], x2 = acc[ai][bj][m][1];
                    if ((c64 % 192) == 128) {
                        st4bf(dst, (x1[0] * cs[0] - x2[0] * sn[0]) * sc, (x1[1] * cs[1] - x2[1] * sn[1]) * sc, (x1[2] * cs[2] - x2[2] * sn[2]) * sc, (x1[3] * cs[3] - x2[3] * sn[3]) * sc);
                        st4bf(dst + 32, (x2[0] * cs[0] + x1[0] * sn[0]) * sc, (x2[1] * cs[1] + x1[1] * sn[1]) * sc, (x2[2] * cs[2] + x1[2] * sn[2]) * sc, (x2[3] * cs[3] + x1[3] * sn[3]) * sc);
                    } else {
                        st4bf(dst, x1[0] * sc, x1[1] * sc, x1[2] * sc, x1[3] * sc);
                        st4bf(dst + 32, x2[0] * sc, x2[1] * sc, x2[2] * sc, x2[3] * sc);
                    }
                }
            }
        }
    }
};
struct EpiMlaKv {
    bf16_t* kn; bf16_t* vt; const float* rss;
    __device__ __forceinline__ void operator()(const g8::f32x4_t (&acc)[2][2][4][2], const g8::Unit& u, int wr, int wc, int fr, int fq) const {
        const int hd = u.pn;
#pragma unroll
        for (int ai = 0; ai < 2; ++ai) {
            f32x4 qs[4];
#pragma unroll
            for (int m = 0; m < 4; ++m) qs[m] = *reinterpret_cast<const f32x4*>(rss + (size_t)(u.pm * 256 + ai * 128 + wr * 64 + m * 16 + fr) * 8 + 4);
#pragma unroll
            for (int m = 0; m < 4; ++m) {
                const int row = u.pm * 256 + ai * 128 + wr * 64 + m * 16 + fr, b = row >> 11, sq = row & 2047;
                const float sc = rsqrtf((qs[m][0] + qs[m][1] + qs[m][2] + qs[m][3]) * (1.f / 256.f) + RMS_EPS);
                const int c = 32 * wc + 8 * fq;
                const g8::f32x4_t k0 = acc[ai][0][m][0], k1 = acc[ai][0][m][1];
                *reinterpret_cast<uint4*>(kn + (size_t)row * 1024 + hd * 128 + c) = cvtpk8(k0[0] * sc, k0[1] * sc, k0[2] * sc, k0[3] * sc, k1[0] * sc, k1[1] * sc, k1[2] * sc, k1[3] * sc);
#pragma unroll
                for (int n = 0; n < 2; ++n) st_vt4(vt + ((size_t)(b * 8 + hd) * 128 + c + 4 * n) * SEQ + vt_pos(sq), acc[ai][1][m][n], sc);
            }
        }
    }
};
__device__ __forceinline__ void ph_mla_up(PRef p, int j) {
    { g8::SchedPlain S; S.init(T_TOK, 1536, 512, p.wt_uq + (size_t)j * 1536 * 256, 256);
      g8::gemm8((LAS unsigned char*)(smem + LDS_WORK), (const char*)p.cbuf, 256, 256, S, EpiMlaQ{p.qm, p.rss, p.cosm, p.sinm}); }
    { g8::SchedPlain S; S.init(T_TOK, 2048, 512, p.wt_ukv + (size_t)j * 2048 * 256, 256);
      g8::gemm8((LAS unsigned char*)(smem + LDS_WORK), (const char*)(p.cbuf + 256), 256, 256, S, EpiMlaKv{p.kn, p.vt, p.rss}); }
    __syncthreads();
}
struct EpiNsaIn {
    PRef p;
    __device__ __forceinline__ void operator()(const g8::f32x4_t (&acc)[2][2][4][2], const g8::Unit& u, int wr, int wc, int fr, int fq) const {
        const int i0 = 16 * wc + 4 * fq;
        const bool rot = (u.pn < 5) || u.pn == 6 || u.pn == 8;
#pragma unroll
        for (int ai = 0; ai < 2; ++ai) {
            f32x4 cs[4], sn[4];
            if (rot) {
#pragma unroll
                for (int m = 0; m < 4; ++m) {
                    const int row = u.pm * 256 + ai * 128 + wr * 64 + m * 16 + fr;
                    cs[m] = *reinterpret_cast<const f32x4*>(p.cosn + (size_t)row * 64 + i0); sn[m] = *reinterpret_cast<const f32x4*>(p.sinn + (size_t)row * 64 + i0);
                }
            }
#pragma unroll
            for (int bj = 0; bj < 2; ++bj) {
                const int tn = 2 * u.pn + bj;
                if (tn >= 21) continue;
#pragma unroll
                for (int m = 0; m < 4; ++m) {
                    const int row = u.pm * 256 + ai * 128 + wr * 64 + m * 16 + fr, b = row >> 11, sq = row & 2047;
                    const g8::f32x4_t x1 = acc[ai][bj][m][0], x2 = acc[ai][bj][m][1];
                    if (tn == 20) {
                        if (i0 < 24) {
#pragma unroll
                            for (int q = 0; q < 4; ++q) { const int c = i0 + q; p.gates[(size_t)row * 32 + (c / 3) * 4 + (c % 3)] = sigmoid_f(x1[q]); }
                        }
                        continue;
                    }
                    const int g = (tn - 8) >> 1, kh = (tn - 8) & 1;
                    const size_t slab = (size_t)(b * 2 + kh) * SEQ * 128;
                    if (tn >= 8 && (g == 3 || g == 5)) {
                        bf16_t* vt = (g == 3 ? p.vst : p.vwt) + slab + vt_pos(sq);
                        st_vt4(vt + (size_t)i0 * SEQ, x1, 1.f); st_vt4(vt + (size_t)(i0 + 64) * SEQ, x2, 1.f);
                    } else if (tn >= 8 && g == 1) {
                        bf16_t* dst = p.vc + slab + (size_t)sq * 128 + i0;
                        st4bf(dst, x1[0], x1[1], x1[2], x1[3]); st4bf(dst + 64, x2[0], x2[1], x2[2], x2[3]);
                    } else {
                        bf16_t* dst = (tn < 8) ? p.qn + (size_t)row * 1024 + tn * 128 + i0 : (g == 0 ? p.kc : (g == 2 ? p.ks : p.kw)) + slab + (size_t)sq * 128 + i0;
                        const f32x4 c_ = cs[m], s_ = sn[m];
                        st4bf(dst, x1[0] * c_[0] - x2[0] * s_[0], x1[1] * c_[1] - x2[1] * s_[1], x1[2] * c_[2] - x2[2] * s_[2], x1[3] * c_[3] - x2[3] * s_[3]);
                        st4bf(dst + 64, x2[0] * c_[0] + x1[0] * s_[0], x2[1] * c_[1] + x1[1] * s_[1], x2[2] * c_[2] + x1[2] * s_[2], x2[3] * c_[3] + x1[3] * s_[3]);
                    }
                }
            }
        }
    }
};
__device__ __forceinline__ void ph_nsa_in(PRef p) {
    g8::SchedPlain S; S.init(T_TOK, 2816, 1024, p.wt_nsa_in, 1024);
    g8::gemm8((LAS unsigned char*)(smem + LDS_WORK), (const char*)p.hbuf, 1024, 1024, S, EpiNsaIn{p});
    __syncthreads();
}
struct RowWin { const bf16_t* base; __device__ __forceinline__ const bf16_t* operator()(int r) const { return base + (size_t)r * 2048; } };
__device__ __forceinline__ void ph_nsa_cmp1(PRef p) {
    unsigned char* lds = VLDS; const float* Cs = reinterpret_cast<const float*>(lds);
    for (int it = VB; it < 256; it += NVB) {
        const int item = it >> 3, sp = it & 7, which = item & 1, bkh = item >> 1;
        const bf16_t* src = (which ? p.vc : p.kc) + (size_t)bkh * SEQ * 128 + sp * 512;
        int tid = VT; asm volatile("" : "+v"(tid));
        f32x16 acc[2][2];
        gemm_main(tid, lds, RowWin{src}, (which ? p.wt_cv1 : p.wt_ck1) + sp * 512, 4096, 0, 512, acc);
        float* dst = p.cpart + (size_t)(item * 8 + sp) * 128 * 128;
        const int c0 = (tid & 15) * 8;
#pragma unroll
        for (int ps = 0; ps < 8; ++ps) {
            const int row = (tid >> 4) + 16 * ps;
            *reinterpret_cast<f32x4*>(dst + row * 128 + c0) = *reinterpret_cast<const f32x4*>(Cs + row * CS_LD + c0);
            *reinterpret_cast<f32x4*>(dst + row * 128 + c0 + 4) = *reinterpret_cast<const f32x4*>(Cs + row * CS_LD + c0 + 4);
        }
        ITEM_END_SYNC();
    }
}
__device__ __forceinline__ void ph_nsa_cmp2(PRef p) {
    unsigned char* lds = VLDS; const float* Cs = reinterpret_cast<const float*>(lds);
    for (int item = VB; item < 32; item += NVB) {
        const int which = item & 1, bkh = item >> 1;
        int tid = VT; asm volatile("" : "+v"(tid));
        bf16_t* hid = p.hid + (size_t)item * 128 * 128;
        for (int o = tid; o < 128 * 16; o += NTHR) {
            const int row = o >> 4, c0 = (o & 15) * 8; float v[8];
#pragma unroll
            for (int q = 0; q < 8; ++q) v[q] = p.bias1[which * 128 + c0 + q];
            for (int sp = 0; sp < 8; ++sp) {
                const float* src = p.cpart + (size_t)(item * 8 + sp) * 128 * 128 + row * 128 + c0;
#pragma unroll
                for (int q = 0; q < 8; ++q) v[q] += src[q];
            }
#pragma unroll
            for (int q = 0; q < 8; ++q) v[q] = silu_f(v[q]);
            *reinterpret_cast<uint4*>(hid + row * 128 + c0) = pack8(v);
        }
        __threadfence();
        __syncthreads();
        f32x16 acc[2][2];
        gemm_main(tid, lds, RowPlain{hid, 128}, which ? p.wt_cv2 : p.wt_ck2, 128, 0, 128, acc);
        if (!which) {
            const int c0 = (tid & 15) * 8;
#pragma unroll
            for (int ps = 0; ps < 8; ++ps) {
                const int row = (tid >> 4) + 16 * ps; float v[8]; cs_load8(Cs, row, c0, v);
                if (row == 127) {
#pragma unroll
                    for (int q = 0; q < 8; ++q) v[q] = 0.f; }
                *reinterpret_cast<uint4*>(p.kcmp + (size_t)bkh * 128 * 128 + row * 128 + c0) = pack8(v);
            }
        } else {
            const int dv = tid & 127, sh = tid >> 7;
#pragma unroll
            for (int jj = 0; jj < 8; ++jj) {
                float v[8];
#pragma unroll
                for (int q = 0; q < 8; ++q) { const int row = vt_pos(sh * 64 + jj * 8 + q); v[q] = (row == 127) ? 0.f : Cs[row * CS_LD + dv]; }
                *reinterpret_cast<uint4*>(p.vcmpt + (size_t)bkh * 128 * 128 + dv * 128 + sh * 64 + jj * 8) = pack8(v);
            }
        }
        ITEM_END_SYNC();
    }
}
struct EpiSbIn {
    bf16_t* qs; bf16_t* ksb; bf16_t* vt;
    __device__ __forceinline__ void operator()(const g8::f32x4_t (&acc)[2][2][4][2], const g8::Unit& u, int wr, int wc, int fr, int fq) const {
#pragma unroll
        for (int ai = 0; ai < 2; ++ai)
#pragma unroll
            for (int m = 0; m < 4; ++m) {
                const int row = u.pm * 256 + ai * 128 + wr * 64 + m * 16 + fr, b = row >> 11, sq = row & 2047;
#pragma unroll
                for (int bj = 0; bj < 2; ++bj) {
                    const int c = (u.pn & 3) * 256 + bj * 128 + 32 * wc + 8 * fq;
                    const g8::f32x4_t a = acc[ai][bj][m][0], d = acc[ai][bj][m][1];
                    if (u.pn < 8) *reinterpret_cast<uint4*>((u.pn < 4 ? qs : ksb) + (size_t)row * 1024 + c) = cvtpk8(a[0], a[1], a[2], a[3], d[0], d[1], d[2], d[3]);
                    else { st_vt4(vt + ((size_t)b * 1024 + c) * SEQ + vt_pos(sq), a, 1.f); st_vt4(vt + ((size_t)b * 1024 + c + 4) * SEQ + vt_pos(sq), d, 1.f); }
                }
            }
    }
};
__device__ __forceinline__ void ph_sb_in(PRef p) {
    g8::SchedPlain S; S.init(T_TOK, 3072, 1024, p.wt_sb_qkv, 1024);
    g8::gemm8((LAS unsigned char*)(smem + LDS_WORK), (const char*)p.hbuf, 1024, 1024, S, EpiSbIn{p.qs, p.ksb, p.vt});
    __syncthreads();
}
template <bool XF32> struct EpiWo {
    const float* xs; const f16_t* xh; f16_t* z; const float* mod; int L;
    __device__ __forceinline__ void operator()(const g8::f32x4_t (&acc)[2][2][4][2], const g8::Unit& u, int wr, int wc, int fr, int fq) const {
        const int row0 = u.pm * 256 + wr * 64 + fr, col0 = u.pn * 256 + wc * 32 + 8 * fq, b = (u.pm * 256) >> 11;
        const float* gate = mod + (size_t)((L * 2 + 0) * 8 + b) * 3072 + 2048 + col0;
        f32x4 gv[2][2];
#pragma unroll
        for (int bj = 0; bj < 2; ++bj)
#pragma unroll
            for (int n = 0; n < 2; ++n) gv[bj][n] = *reinterpret_cast<const f32x4*>(gate + bj * 128 + n * 4);
#pragma unroll
        for (int ai = 0; ai < 2; ++ai) {
            f32x4 xv[4][2][2];
#pragma unroll
            for (int m = 0; m < 4; ++m)
#pragma unroll
                for (int bj = 0; bj < 2; ++bj) {
                    const size_t o = (size_t)(row0 + ai * 128 + m * 16) * 1024 + col0 + bj * 128;
                    if (XF32) { xv[m][bj][0] = *reinterpret_cast<const f32x4*>(xs + o); xv[m][bj][1] = *reinterpret_cast<const f32x4*>(xs + o + 4); }
                    else { const f16x8 hx = *reinterpret_cast<const f16x8*>(xh + o); const f32x8 fx = __builtin_convertvector(hx, f32x8); xv[m][bj][0] = (f32x4){fx[0], fx[1], fx[2], fx[3]}; xv[m][bj][1] = (f32x4){fx[4], fx[5], fx[6], fx[7]}; }
                }
#pragma unroll
            for (int m = 0; m < 4; ++m)
#pragma unroll
                for (int bj = 0; bj < 2; ++bj) {
                    f32x8 zv;
#pragma unroll
                    for (int n = 0; n < 2; ++n)
#pragma unroll
                        for (int q = 0; q < 4; ++q) zv[n * 4 + q] = DN_ALPHA * xv[m][bj][n][q] + gv[bj][n][q] * acc[ai][bj][m][n][q];
                    *reinterpret_cast<f16x8*>(z + (size_t)(row0 + ai * 128 + m * 16) * 1024 + col0 + bj * 128) = __builtin_convertvector(zv, f16x8);
                }
        }
    }
};
__device__ __forceinline__ void ph_wo(PRef p, int L) {
    const int kind = L % 3, j = L / 3;
    const bf16_t* Bt = kind == 0 ? p.wt_mla_o + (size_t)j * 1024 * 1024 : (kind == 1 ? p.wt_nsa_o : p.wt_sb_o);
    g8::SchedPlain S; S.init(T_TOK, 1024, 1024, Bt, 1024);
    if (L == 0) g8::gemm8((LAS unsigned char*)(smem + LDS_WORK), (const char*)p.obuf, 1024, 1024, S, EpiWo<true>{p.x, p.xbuf, p.zbuf, p.mod, L});
    else g8::gemm8((LAS unsigned char*)(smem + LDS_WORK), (const char*)p.obuf, 1024, 1024, S, EpiWo<false>{p.x, p.xbuf, p.zbuf, p.mod, L});
}

#define LNC(i) (lane * 8 + 512 * ((i) >> 1) + 4 * ((i) & 1))
__device__ __forceinline__ void ln_row(float (&v)[16], const f32x4 (&gg)[4], const f32x4 (&bb)[4]) {
    float s = 0.f;
#pragma unroll
    for (int q = 0; q < 16; ++q) s += v[q];
    const float mu = wave_sum(s) * (1.f / 1024.f);
    float s2 = 0.f;
#pragma unroll
    for (int q = 0; q < 16; ++q) { const float d = v[q] - mu; s2 += d * d; }
    const float rstd = rsqrtf(wave_sum(s2) * (1.f / 1024.f) + LN_EPS);
#pragma unroll
    for (int i = 0; i < 4; ++i)
#pragma unroll
        for (int q = 0; q < 4; ++q) v[i * 4 + q] = (v[i * 4 + q] - mu) * rstd * gg[i][q] + bb[i][q];
}
__device__ __forceinline__ void ld8h_f(const uint4& w, float* v) { const f32x8 f = __builtin_convertvector(*reinterpret_cast<const f16x8*>(&w), f32x8);
#pragma unroll
    for (int q = 0; q < 8; ++q) v[q] = f[q]; }
__device__ __forceinline__ uint4 pk8h(const float* v) { f32x8 f;
#pragma unroll
    for (int q = 0; q < 8; ++q) f[q] = v[q];
    const f16x8 hh = __builtin_convertvector(f, f16x8); return *reinterpret_cast<const uint4*>(&hh); }
__device__ __forceinline__ void ph_lna(PRef p, int L, bool dry = false) {
    unsigned char* lds = VLDS;
    float* hs = reinterpret_cast<float*>(lds);
    float* part = reinterpret_cast<float*>(lds + 16 * 1028 * 4);
    int* lcnt = reinterpret_cast<int*>(lds + 78080); int* lbase = lcnt + 32; int* rexp = lcnt + 64; int* rslot = lcnt + 96; float* rwt = reinterpret_cast<float*>(lcnt + 128);
    if (VT < 32) lcnt[VT] = 0;
    __syncthreads();
    int tid = VT; asm volatile("" : "+v"(tid));
    const int lane = tid & 63, wid = tid >> 6;
    const float* g = p.ln_g + (size_t)(L * 2 + 0) * 1024; const float* bt = p.ln_b + (size_t)(L * 2 + 0) * 1024;
    const float* wr = p.wr + (size_t)L * 1024 * 48;
    int* cnt = p.cnt + L * 32 * 64;
    f32x4 lg[4], lb[4];
#pragma unroll
    for (int i = 0; i < 4; ++i) { lg[i] = *reinterpret_cast<const f32x4*>(g + LNC(i)); lb[i] = *reinterpret_cast<const f32x4*>(bt + LNC(i)); }
    for (int it = VB; it < T_TOK / 16; it += NVB) {
        const int R0 = it * 16, b = R0 >> 11;
        const float* md = p.mod + (size_t)((L * 2 + 1) * 8 + b) * 3072;
        f32x4 shv[4], scv[4];
#pragma unroll
        for (int i = 0; i < 4; ++i) { shv[i] = *reinterpret_cast<const f32x4*>(md + LNC(i)); scv[i] = *reinterpret_cast<const f32x4*>(md + 1024 + LNC(i)); }
        uint4 zr[2];
#pragma unroll
        for (int k = 0; k < 2; ++k) zr[k] = *reinterpret_cast<const uint4*>(p.zbuf + (size_t)(R0 + wid * 4) * 1024 + LNC(2 * k));
#pragma unroll 1
        for (int rr = 0; rr < 4; ++rr) {
            const int lrow = wid * 4 + rr, row = R0 + lrow;
            float v[16];
            ld8h_f(zr[0], v); ld8h_f(zr[1], v + 8);
            if (rr < 3) {
#pragma unroll
                for (int k = 0; k < 2; ++k) zr[k] = *reinterpret_cast<const uint4*>(p.zbuf + (size_t)(row + 1) * 1024 + LNC(2 * k));
            }
            ln_row(v, lg, lb);
#pragma unroll
            for (int k = 0; k < 2; ++k) {
                *reinterpret_cast<uint4*>((dry ? reinterpret_cast<f16_t*>(p.ybuf) : p.xbuf) + (size_t)row * 1024 + LNC(2 * k)) = pk8h(v + 8 * k);
                float hv[8];
#pragma unroll
                for (int q = 0; q < 8; ++q) hv[q] = v[8 * k + q] * (1.f + scv[2 * k + (q >> 2)][q & 3]) + shv[2 * k + (q >> 2)][q & 3];
                *reinterpret_cast<f32x4*>(hs + lrow * 1028 + LNC(2 * k)) = (f32x4){hv[0], hv[1], hv[2], hv[3]};
                *reinterpret_cast<f32x4*>(hs + lrow * 1028 + LNC(2 * k + 1)) = (f32x4){hv[4], hv[5], hv[6], hv[7]};
                *reinterpret_cast<uint4*>((dry ? p.hmoe : p.hbuf) + (size_t)row * 1024 + LNC(2 * k)) = cvtpk8(hv[0], hv[1], hv[2], hv[3], hv[4], hv[5], hv[6], hv[7]);
            }
        }
        __syncthreads();
        {
            f32x4 a0 = {0.f, 0.f, 0.f, 0.f}, a1 = a0, a2 = a0;
            const int rl = lane & 15, kq = lane >> 4;
#pragma unroll 32
            for (int kk = 0; kk < 64; ++kk) {
                const int k = wid * 256 + kk * 4 + kq;
                const float a = hs[rl * 1028 + k];
                const float* wp = wr + (size_t)k * 48 + rl;
                a0 = __builtin_amdgcn_mfma_f32_16x16x4f32(a, wp[0], a0, 0, 0, 0);
                a1 = __builtin_amdgcn_mfma_f32_16x16x4f32(a, wp[16], a1, 0, 0, 0);
                a2 = __builtin_amdgcn_mfma_f32_16x16x4f32(a, wp[32], a2, 0, 0, 0);
            }
#pragma unroll
            for (int q = 0; q < 4; ++q) {
                const int row = kq * 4 + q;
                part[(wid * 16 + row) * 48 + rl] = a0[q]; part[(wid * 16 + row) * 48 + 16 + rl] = a1[q]; part[(wid * 16 + row) * 48 + 32 + rl] = a2[q];
            }
        }
        __syncthreads();
        if (tid < 16) {
            const int row = R0 + tid;
            auto LG = [&](int e) { return part[(0 * 16 + tid) * 48 + e] + part[(1 * 16 + tid) * 48 + e] + part[(2 * 16 + tid) * 48 + e] + part[(3 * 16 + tid) * 48 + e]; };
            const float g0 = LG(0) + p.moe_b_grp[L * 4 + 0], g1 = LG(1) + p.moe_b_grp[L * 4 + 1], g2 = LG(2) + p.moe_b_grp[L * 4 + 2], g3 = LG(3) + p.moe_b_grp[L * 4 + 3];
            int gi = 0; float gm = g0;
            if (g1 > gm) { gm = g1; gi = 1; }
            if (g2 > gm) { gm = g2; gi = 2; }
            if (g3 > gm) { gm = g3; gi = 3; }
            const float gw = 1.f / (expf(g0 - gm) + expf(g1 - gm) + expf(g2 - gm) + expf(g3 - gm));
            int i1 = 0, i2 = 0; float m1 = -3.0e38f, m2 = -3.0e38f;
            for (int e = 0; e < 8; ++e) {
                const float v = LG(4 + gi * 8 + e) + p.moe_b_rt[L * 32 + gi * 8 + e];
                if (v > m1) { m2 = m1; i2 = i1; m1 = v; i1 = e; }
                else if (v > m2) { m2 = v; i2 = e; }
            }
            const float r = expf(m2 - m1);
            const float w1 = gw / (1.f + r), w2 = gw * r / (1.f + r);
            const int e1 = gi * 8 + i1, e2 = gi * 8 + i2;
            rwt[tid * 2] = w1; rwt[tid * 2 + 1] = w2;
            rexp[tid * 2] = e1; rexp[tid * 2 + 1] = e2;
            rslot[tid * 2] = atomicAdd(&lcnt[e1], 1); rslot[tid * 2 + 1] = atomicAdd(&lcnt[e2], 1);
        }
        __syncthreads();
        if (tid < 32) { const int c = lcnt[tid]; lbase[tid] = (c && !dry) ? atomicAdd(&cnt[tid * 64], c) : 0; lcnt[tid] = 0; }
        __syncthreads();
        if (tid < 32 && !dry) { const int e = rexp[tid]; const size_t o = (size_t)e * T_TOK + lbase[e] + rslot[tid]; p.list[o] = (R0 + (tid >> 1)) * 2 + (tid & 1); p.listw[o] = rwt[tid]; }
        __syncthreads();
    }
}
__device__ __forceinline__ void ph_lnb(PRef p, int L, bool dry = false) {
    int tid = VT; asm volatile("" : "+v"(tid));
    const int lane = tid & 63, wid = tid >> 6;
    const float* g = p.ln_g + (size_t)(L * 2 + 1) * 1024; const float* bt = p.ln_b + (size_t)(L * 2 + 1) * 1024;
    const bool last = (L == DEPTH - 1);
    f32x4 lg[4], lb[4];
#pragma unroll
    for (int i = 0; i < 4; ++i) { lg[i] = *reinterpret_cast<const f32x4*>(g + LNC(i)); lb[i] = *reinterpret_cast<const f32x4*>(bt + LNC(i)); }
    constexpr int RW = T_TOK / 2048;
    static_assert(2048 % RW == 0, "a wave's rows stay inside one batch element");
    for (int w0 = VB * 4 + wid; w0 * RW < T_TOK; w0 += NVB * 4) {
        const int row0 = w0 * RW, b = row0 >> 11;
        const float* gate = p.mod + (size_t)((L * 2 + 1) * 8 + b) * 3072 + 2048;
        const float* md = p.mod + (size_t)(((last ? L : L + 1) * 2 + 0) * 8 + b) * 3072;
        f32x4 gv[4], sh[4], sc[4];
#pragma unroll
        for (int i = 0; i < 4; ++i) { const int c = LNC(i); gv[i] = *reinterpret_cast<const f32x4*>(gate + c); if (!last) { sh[i] = *reinterpret_cast<const f32x4*>(md + c); sc[i] = *reinterpret_cast<const f32x4*>(md + 1024 + c); } }
        uint4 xr[2], y0[2], y1[2];
        auto issue = [&](int row) {
#pragma unroll
            for (int k = 0; k < 2; ++k) {
                const int c = LNC(2 * k);
                xr[k] = *reinterpret_cast<const uint4*>(p.xbuf + (size_t)row * 1024 + c);
                y0[k] = *reinterpret_cast<const uint4*>(p.ybuf + (size_t)(row * 2) * 1024 + c); y1[k] = *reinterpret_cast<const uint4*>(p.ybuf + (size_t)(row * 2 + 1) * 1024 + c);
            }
        };
        issue(row0);
#pragma unroll 1
        for (int ri = 0; ri < RW; ++ri) {
            const int row = row0 + ri;
            float v[16];
#pragma unroll
            for (int k = 0; k < 2; ++k) {
                float xv[8]; ld8h_f(xr[k], xv);
                const unsigned a0[4] = {y0[k].x, y0[k].y, y0[k].z, y0[k].w}, a1[4] = {y1[k].x, y1[k].y, y1[k].z, y1[k].w};
#pragma unroll
                for (int q = 0; q < 8; ++q) {
                    const unsigned w0 = a0[q >> 1], w1 = a1[q >> 1];
                    const float ys = (q & 1) ? (bf2f(w0 >> 16) + bf2f(w1 >> 16)) : (bf2f(w0 & 0xffffu) + bf2f(w1 & 0xffffu));
                    v[8 * k + q] = DN_ALPHA * xv[q] + gv[2 * k + (q >> 2)][q & 3] * ys;
                }
            }
            if (ri + 1 < RW) issue(row + 1);
            ln_row(v, lg, lb);
            if (last) {
#pragma unroll
                for (int i = 0; i < 4; ++i) *reinterpret_cast<f32x4*>((dry ? reinterpret_cast<float*>(p.zbuf) : p.out) + (size_t)row * 1024 + LNC(i)) = (f32x4){v[i * 4], v[i * 4 + 1], v[i * 4 + 2], v[i * 4 + 3]};
            } else {
#pragma unroll
                for (int k = 0; k < 2; ++k) {
                    const int c = LNC(2 * k);
                    *reinterpret_cast<uint4*>((dry ? p.zbuf : p.xbuf) + (size_t)row * 1024 + c) = pk8h(v + 8 * k);
                    float hv[8];
#pragma unroll
                    for (int q = 0; q < 8; ++q) hv[q] = v[8 * k + q] * (1.f + sc[2 * k + (q >> 2)][q & 3]) + sh[2 * k + (q >> 2)][q & 3];
                    *reinterpret_cast<uint4*>((dry ? p.obuf : p.hbuf) + (size_t)row * 1024 + c) = cvtpk8(hv[0], hv[1], hv[2], hv[3], hv[4], hv[5], hv[6], hv[7]);
                }
            }
        }
    }
}
#undef LNC

struct RowGather { const bf16_t* hb; const int* lst; int base, n; __device__ __forceinline__ const bf16_t* operator()(int r) const { const int idx = base + r; const int tok = (idx < n) ? (lst[idx] >> 1) : 0; return hb + (size_t)tok * 1024; } };
constexpr int G8_PRE_OFF = LDS_WORK + 131072;
__device__ __forceinline__ const int* moe_prefix256(const int* cnt) {
    int* pre = reinterpret_cast<int*>(smem + G8_PRE_OFF);
    int t_ = threadIdx.x; asm volatile("" : "+v"(t_));
    if (t_ == 0) { int s = 0; for (int e = 0; e < 32; ++e) { pre[e] = s; s += (cnt[e * 64] + 255) >> 8; } pre[32] = s; }
    if (t_ >= 64 && t_ < 96) pre[48 + t_ - 64] = cnt[(t_ - 64) * 64];
    __syncthreads();
    return pre;
}
struct EpiMoeA {
    bf16_t* hmoe;
    __device__ __forceinline__ void operator()(const g8::f32x4_t (&acc)[2][2][4][2], const g8::Unit& u, int wr, int wc, int fr, int fq) const {
#pragma unroll
        for (int ai = 0; ai < 2; ++ai)
#pragma unroll
            for (int m = 0; m < 4; ++m) {
                bf16_t* rowp = hmoe + (size_t)(u.pm * 256 + ai * 128 + wr * 64 + m * 16 + fr) * 512 + u.pn * 128 + wc * 32 + fq * 8;
                float hv[8];
#pragma unroll
                for (int n = 0; n < 2; ++n) {
                    const g8::f32x4_t g = acc[ai][0][m][n], up = acc[ai][1][m][n];
#pragma unroll
                    for (int q = 0; q < 4; ++q) hv[n * 4 + q] = silu_f(g[q]) * up[q];
                }
                *reinterpret_cast<uint4*>(rowp) = cvtpk8(hv[0], hv[1], hv[2], hv[3], hv[4], hv[5], hv[6], hv[7]);
            }
    }
};
__device__ __forceinline__ void ph_moe_a(PRef p, int L) {
    const int* cnt = p.cnt + L * 32 * 64;
    const int* pre = moe_prefix256(cnt);
    g8::SchedMoe S{pre, p.list, p.listw, (const char*)(p.wt_gu + (size_t)L * 32 * 1024 * 1024), (size_t)1024 * 1024 * 2, (size_t)256 * 1024 * 2, pre[32] * 4, (int)gridDim.x, (int)blockIdx.x, 1, reinterpret_cast<int*>(smem + G8_PRE_OFF + 512)};
    g8::gemm8((LAS unsigned char*)(smem + LDS_WORK), (const char*)p.hbuf, 1024, 1024, S, EpiMoeA{p.hmoe});
    __syncthreads();
}
struct EpiMoeB {
    const int* pre; const int* tab; bf16_t* ybuf;
    __device__ __forceinline__ void operator()(const g8::f32x4_t (&acc)[2][2][4][2], const g8::Unit& u, int wr, int wc, int fr, int fq) const {
        const int e = u.e;
        const int n = pre[48 + e] - (u.pm - pre[e]) * 256, r0 = wr * 64 + fr;
        const int col0 = u.pn * 256 + wc * 32 + fq * 8;
        const int* tb = tab + u.par * 512;
        asm volatile("" ::: "memory");
#pragma unroll
        for (int ai = 0; ai < 2; ++ai) {
#pragma unroll
            for (int m = 0; m < 4; ++m) {
                const int r = r0 + ai * 128 + m * 16;
                if (r < n) {
                    const int ent = tb[r]; const float ww = __int_as_float(tb[256 + r]);
                    bf16_t* rowp = ybuf + (size_t)ent * 1024 + col0;
#pragma unroll
                    for (int bj = 0; bj < 2; ++bj) {
                        const g8::f32x4_t a = acc[ai][bj][m][0], c = acc[ai][bj][m][1];
                        *reinterpret_cast<uint4*>(rowp + bj * 128) = cvtpk8(a[0] * ww, a[1] * ww, a[2] * ww, a[3] * ww, c[0] * ww, c[1] * ww, c[2] * ww, c[3] * ww);
                    }
                }
            }
        }
    }
};
__device__ __forceinline__ void ph_moe_b(PRef p, int L) {
    const int* cnt = p.cnt + L * 32 * 64;
    const int* pre = moe_prefix256(cnt);
    g8::SchedMoe S{pre, p.list, p.listw, (const char*)(p.wt_dn + (size_t)L * 32 * 1024 * 512), (size_t)1024 * 512 * 2, (size_t)256 * 512 * 2, pre[32] * 4, (int)gridDim.x, (int)blockIdx.x, 0, reinterpret_cast<int*>(smem + G8_PRE_OFF + 512)};
    g8::gemm8((LAS unsigned char*)(smem + LDS_WORK), (const char*)p.hmoe, 512, 512, S, EpiMoeB{pre, reinterpret_cast<const int*>(smem + G8_PRE_OFF + 512), p.ybuf});
    __syncthreads();
}

__device__ __forceinline__ void dma16_asm(const void* g, const unsigned char* lds_wave_base) {
    const unsigned m = __builtin_amdgcn_readfirstlane((unsigned)(size_t)(LAS const unsigned char*)lds_wave_base);
    asm volatile("s_mov_b32 m0, %1\n\ts_nop 0\n\tglobal_load_lds_dwordx4 %0, off" :: "v"(g), "s"(m) : "memory", "m0");
}
__device__ __forceinline__ unsigned lds_addr(const unsigned char* p) { return (unsigned)(size_t)(LAS const unsigned char*)p; }
__device__ __forceinline__ bf16x8 lds_ld128(unsigned a) { return *(const LAS bf16x8*)(size_t)a; }
__device__ __forceinline__ void dma16_asm_s(const void* ubase, unsigned voff, const unsigned char* lds_wave_base) {
    const unsigned m = __builtin_amdgcn_readfirstlane((unsigned)(size_t)(LAS const unsigned char*)lds_wave_base);
    asm volatile("s_mov_b32 m0, %2\n\ts_nop 0\n\tglobal_load_lds_dwordx4 %0, %1" :: "v"(voff), "s"(ubase), "s"(m) : "memory", "m0");
}
template <int DQK, int KT> struct AT {
    static constexpr int KB = KT / 32, NKK = DQK / 16;
    static constexpr bool ROPE = (DQK == 192);
    static constexpr int K_BYTES = KT * 256, KR_BYTES = ROPE ? KT * 128 : 0, V_BYTES = 256 * KT, STAGE = K_BYTES + KR_BYTES + V_BYTES;
    static constexpr int VRB = KT * 2;
    static __device__ __forceinline__ void dma(int tid, unsigned char* st, const bf16_t* kp  , size_t ldk, const bf16_t* krp  , const bf16_t* vp  , size_t ldv) {
        const int wid = tid >> 6, l = tid & 63;
#pragma unroll
        for (int i = 0; i < KT / 16; ++i) {
            const int pi = wid + 4 * i, row = 4 * pi + (l >> 4), c = (l & 15) ^ (row & 15);
            dma16_asm_s(kp, (unsigned)(row * (int)ldk + c * 8) * 2u, st + pi * 1024);
        }
        if (ROPE) {
            const int pi = wid, row = 8 * pi + (l >> 3), c = (l & 7) ^ ((row >> 1) & 7);
            dma16_asm_s(krp, (unsigned)(row * 64 + c * 8) * 2u, st + K_BYTES + pi * 1024);
        }
#pragma unroll
        for (int i = 0; i < KT / 16; ++i) {
            const int pi = wid + 4 * i;
            int row, c;
            if (KT == 64) { row = 8 * pi + (l >> 3); c = (l & 7) ^ ((row >> 1) & 7); }
            else          { row = 16 * pi + (l >> 2); c = (l & 3) ^ ((row >> 2) & 3); }
            dma16_asm_s(vp, (unsigned)(row * (int)ldv + c * 8) * 2u, st + K_BYTES + KR_BYTES + pi * 1024);
        }
    }
    static __device__ __forceinline__ void kload(const unsigned char* st, int kb, bf16x8 (&kf)[NKK], int r, int h) {
        const int row = kb * 32 + r, m = r & 15, m2 = (r >> 1) & 7;
        const unsigned a0 = lds_addr(st) + row * 256 + ((((m & ~1) | (h ^ (m & 1)))) << 4);
#pragma unroll
        for (int kk = 0; kk < 8; ++kk) kf[kk] = lds_ld128(a0 ^ (kk << 5));
        if (ROPE) {
            const unsigned a1 = lds_addr(st) + K_BYTES + row * 128 + ((((m2 & ~1) | (h ^ (m2 & 1)))) << 4);
#pragma unroll
            for (int kk = 0; kk < 4; ++kk) kf[8 + kk] = lds_ld128(a1 ^ (kk << 5));
        }
    }
    static __device__ __forceinline__ f32x16 qk_mma(const bf16x8 (&kf)[NKK], const bf16x8* qf) {
        f32x16 s;
#pragma unroll
        for (int q = 0; q < 16; ++q) s[q] = 0.f;
#pragma unroll
        for (int kk = 0; kk < NKK; ++kk) s = MFMA32(kf[kk], qf[kk], s);
        return s;
    }
    static __device__ __forceinline__ f32x16 qk(const unsigned char* st, int kb, const bf16x8* qf, int r, int h) {
        f32x16 s;
#pragma unroll
        for (int q = 0; q < 16; ++q) s[q] = 0.f;
        const int row = kb * 32 + r;
#pragma unroll
        for (int kk = 0; kk < 8; ++kk) s = MFMA32(lds_frag(st, row * 256 + (((2 * kk + h) ^ (r & 15)) << 4)), qf[kk], s);
        return s;
    }
    static __device__ __forceinline__ void vload(const unsigned char* st, int ks, bf16x8 (&vf)[4], int r, int h) {
        const int swz = (KT == 64) ? ((r >> 1) & 7) : ((r >> 2) & 3);
        const unsigned v0 = lds_addr(st) + K_BYTES + KR_BYTES + r * VRB + ((swz ^ h) << 4);
#pragma unroll
        for (int dvb = 0; dvb < 4; ++dvb) vf[dvb] = lds_ld128((v0 ^ ((2 * ks) << 4)) + dvb * 32 * VRB);
    }
    static __device__ __forceinline__ void pv_mma(f32x16 (&o)[4], const bf16x8 (&vf)[4], bf16x8 pf) {
#pragma unroll
        for (int dvb = 0; dvb < 4; ++dvb) o[dvb] = MFMA32(vf[dvb], pf, o[dvb]);
    }
    static __device__ __forceinline__ void pv(const unsigned char* st, f32x16 (&o)[4], int ks, bf16x8 pf, int r, int h) {
        bf16x8 vf[4];
        vload(st, ks, vf, r, h);
        pv_mma(o, vf, pf);
    }
};
struct HalfBar { volatile LAS unsigned* ctr; unsigned target; };
__device__ __forceinline__ void half_bar(HalfBar& hb, int lane) {
    asm volatile("s_waitcnt lgkmcnt(0)" ::: "memory");
    hb.target += 4u;
    if (lane == 0) __hip_atomic_fetch_add((LAS unsigned*)hb.ctr, 1u, __ATOMIC_RELAXED, __HIP_MEMORY_SCOPE_WORKGROUP);
    while ((unsigned)__builtin_amdgcn_readfirstlane((int)*hb.ctr) < hb.target) __builtin_amdgcn_s_sleep(1);
    asm volatile("" ::: "memory");
}
#define DMA_WAIT_SYNC() do { asm volatile("s_waitcnt vmcnt(0)" ::: "memory"); __syncthreads(); } while (0)
__device__ __forceinline__ bf16x8 pfrag(const f32x16& s, int half) {
    const int b = half * 8;
    uint4 w = cvtpk8(s[b + 0], s[b + 1], s[b + 2], s[b + 3], s[b + 4], s[b + 5], s[b + 6], s[b + 7]);
    return *reinterpret_cast<bf16x8*>(&w);
}
template <int NKK> __device__ __forceinline__ void load_q(bf16x8 (&qf)[NKK], const bf16_t* qrow, int h) {
#pragma unroll
    for (int kk = 0; kk < NKK; ++kk) qf[kk] = *reinterpret_cast<const bf16x8*>(qrow + kk * 16 + h * 8);
}
__device__ __forceinline__ void store_pk16(bf16_t* orow, int dvb, int gp, uint2 X  , uint2 Y  , int h) {
    auto r0 = __builtin_amdgcn_permlane32_swap(X.x, Y.x, false, false), r1 = __builtin_amdgcn_permlane32_swap(X.y, Y.y, false, false);
    uint4 w; w.x = r0[0]; w.y = r1[0]; w.z = r0[1]; w.w = r1[1];
    *reinterpret_cast<uint4*>(orow + dvb * 32 + 8 * (2 * gp + h)) = w;
}
__device__ __forceinline__ void store_o(const f32x16 (&o)[4], bf16_t* orow, int h, float scale) {
#pragma unroll
    for (int dvb = 0; dvb < 4; ++dvb)
#pragma unroll
        for (int gp = 0; gp < 2; ++gp) {
            const int a = 8 * gp, c = 8 * gp + 4;
            uint2 X, Y;
            X.x = cvtpk(o[dvb][a] * scale, o[dvb][a + 1] * scale); X.y = cvtpk(o[dvb][a + 2] * scale, o[dvb][a + 3] * scale);
            Y.x = cvtpk(o[dvb][c] * scale, o[dvb][c + 1] * scale); Y.y = cvtpk(o[dvb][c + 2] * scale, o[dvb][c + 3] * scale);
            store_pk16(orow, dvb, gp, X, Y, h);
        }
}

template <int DQK, int KT, int MODE>
__device__ __forceinline__ void flash_loop(int tid, unsigned char* lds, const bf16x8* qf, f32x16 (&o)[4], float& m_run, float& l_half,
                                           const bf16_t* kbase, size_t ldk, const bf16_t* krbase, const bf16_t* vtbase, size_t ldv,
                                           int kt_lo, int kt_hi, int t  , int tw_min, int tw_max  , unsigned selmask, float C, int key_off = 0, HalfBar* hbp = nullptr) {
    typedef AT<DQK, KT> A;
    constexpr bool RING3 = (KT == 32);
    constexpr int NDMA = KT / 16 + KT / 16 + (DQK == 192 ? 1 : 0);
    auto tile_dma = [&](int stage, int kt) { A::dma(tid, lds + stage * A::STAGE, kbase + (size_t)kt * KT * ldk, ldk, krbase ? krbase + (size_t)kt * KT * 64 : nullptr, vtbase + (size_t)kt * KT, ldv); };
    if (RING3) { __builtin_amdgcn_s_waitcnt(0x0F70); tile_dma(0, kt_lo); if (kt_lo + 1 <= kt_hi) tile_dma(1, kt_lo + 1); }
    else { tile_dma(0, kt_lo); __builtin_amdgcn_s_waitcnt(0x0F70); __syncthreads(); }
    int stc = 0, stn = 2;
    for (int kt = kt_lo; kt <= kt_hi; ++kt) {
        asm volatile("" : "+v"(tid));
        const int lane = tid & 63, r = lane & 31, h = lane >> 5;
        const bool more = kt < kt_hi;
        const unsigned char* st;
        if (RING3) {
            if (more) { static_assert(!RING3 || NDMA == 5, "counted wait below is written for 5 DMA instructions per tile"); asm volatile("s_waitcnt vmcnt(5)" ::: "memory"); }
            else asm volatile("s_waitcnt vmcnt(0)" ::: "memory");
            if (hbp) half_bar(*hbp, lane); else __builtin_amdgcn_s_barrier();
            asm volatile("" ::: "memory");
            if (kt + 2 <= kt_hi) tile_dma(stn, kt + 2);
            st = lds + stc * A::STAGE;
            stc = (stc == 2) ? 0 : stc + 1; stn = (stn == 2) ? 0 : stn + 1;
        } else {
            const int cur = (kt - kt_lo) & 1;
            if (more) tile_dma(cur ^ 1, kt + 1);
            st = lds + cur * A::STAGE;
        }
        const int key0 = key_off + kt * KT;
        bool active = (key0 <= tw_max);
        if (MODE == 2) active = active && (key0 + KT - 1 > tw_min - 512);
        if (active) {
            f32x16 s[A::KB];
            bf16x8 vf[2][4];
            if constexpr (KT == 32) {
                bf16x8 kf[A::NKK];
                A::kload(st, 0, kf, r, h);
                __builtin_amdgcn_sched_barrier(0);
                s[0] = A::qk_mma(kf, qf);
                __builtin_amdgcn_sched_barrier(0);
                A::vload(st, 0, vf[0], r, h); A::vload(st, 1, vf[1], r, h);
            } else {
#pragma unroll
                for (int kb = 0; kb < A::KB; ++kb) s[kb] = A::qk(st, kb, qf, r, h);
            }
            const bool need_mask = (MODE == 1) || (key0 + KT - 1 > tw_min) || (MODE == 2 && key0 <= tw_max - 512);
            if (MODE == 1 && !(key0 + KT - 1 > tw_min)) {
                static_assert(MODE != 1 || KT == 64, "selected branch: tile = selection block");
                asm volatile("" ::: "memory");
                const float drop = ((selmask >> (key0 >> 6)) & 1u) ? 0.f : -__builtin_inff();
#pragma unroll
                for (int kb = 0; kb < A::KB; ++kb)
#pragma unroll
                    for (int q = 0; q < 16; ++q) s[kb][q] += drop;
            } else if (need_mask) {
                asm volatile("" ::: "memory");
#pragma unroll
                for (int kb = 0; kb < A::KB; ++kb)
#pragma unroll
                    for (int q = 0; q < 16; ++q) {
                        const int key = key0 + kb * 32 + crow(q, h);
                        bool ok = key <= t;
                        if (MODE == 1) ok = ok && ((selmask >> (key >> 6)) & 1u);
                        if (MODE == 2) ok = ok && (t - key < 512);
                        s[kb][q] = ok ? s[kb][q] : -__builtin_inff();
                    }
            }
            float mx = -__builtin_inff();
#pragma unroll
            for (int kb = 0; kb < A::KB; ++kb)
#pragma unroll
                for (int q = 0; q < 16; ++q) mx = fmaxf(mx, s[kb][q]);
            mx = xh_max(mx) * C;
            if (__any(mx > m_run + 8.f)) {
                const float mn = fmaxf(m_run, mx);
                const float alpha = __builtin_amdgcn_exp2f(m_run - mn);
                m_run = mn;
                l_half *= alpha;
#pragma unroll
                for (int dvb = 0; dvb < 4; ++dvb)
#pragma unroll
                    for (int q = 0; q < 16; ++q) o[dvb][q] *= alpha;
            }
            const float nm = -m_run;
            float ps = 0.f;
#pragma unroll
            for (int kb = 0; kb < A::KB; ++kb)
#pragma unroll
                for (int q = 0; q < 16; ++q) { const float e = __builtin_amdgcn_exp2f(__builtin_fmaf(s[kb][q], C, nm)); s[kb][q] = e; ps += e; }
            l_half += ps;
            if constexpr (KT == 32) { A::pv_mma(o, vf[0], pfrag(s[0], 0)); A::pv_mma(o, vf[1], pfrag(s[0], 1)); }
            else {
#pragma unroll
                for (int kb = 0; kb < A::KB; ++kb) { A::pv(st, o, kb * 2, pfrag(s[kb], 0), r, h); A::pv(st, o, kb * 2 + 1, pfrag(s[kb], 1), r, h); }
            }
        }
        if (!RING3) DMA_WAIT_SYNC();
    }
    if (RING3) { if (hbp) half_bar(*hbp, tid & 63); else __syncthreads(); }
}

__device__ __forceinline__ void mla_flash(int tid0, unsigned char* lds, const bf16x8* qf, f32x16 (&o)[4], float& m_run, float& l_half,
                                          const bf16_t* kbase, const bf16_t* krbase, const bf16_t* vtbase, int kt_hi, int t, int tw_min, float C) {
    typedef AT<192, 32> A;
    constexpr int KST = A::K_BYTES + A::KR_BYTES, VST = A::V_BYTES;
    static_assert(3 * KST + 4 * VST <= HALF_LDS, "rings");
    unsigned char* kring = lds; unsigned char* vring = lds + 3 * KST;
    auto tile_dma = [&](int tid, int kt) {
        unsigned char* ks = kring + (kt % 3) * KST; unsigned char* vs = vring + (kt & 3) * VST;
        const bf16_t* kp = kbase + (size_t)kt * 32 * 1024; const bf16_t* krp = krbase + (size_t)kt * 32 * 64; const bf16_t* vp = vtbase + (size_t)kt * 32;
        const int wid = tid >> 6, l = tid & 63;
#pragma unroll
        for (int i = 0; i < 2; ++i) { const int pi = wid + 4 * i, row = 4 * pi + (l >> 4), c = (l & 15) ^ (row & 15); dma16_asm_s(kp, (unsigned)(row * 1024 + c * 8) * 2u, ks + pi * 1024); }
        { const int pi = wid, row = 8 * pi + (l >> 3), c = (l & 7) ^ ((row >> 1) & 7); dma16_asm_s(krp, (unsigned)(row * 64 + c * 8) * 2u, ks + A::K_BYTES + pi * 1024); }
#pragma unroll
        for (int i = 0; i < 2; ++i) { const int pi = wid + 4 * i, row = 16 * pi + (l >> 2), c = (l & 3) ^ ((row >> 2) & 3); dma16_asm_s(vp, (unsigned)(row * SEQ + c * 8) * 2u, vs + pi * 1024); }
    };
    auto finish = [&](f32x16& sv, float mxraw, int kt, int h) {
        const int key0 = kt * 32;
        if (key0 + 31 > tw_min) {
            asm volatile("" ::: "memory");
            mxraw = -__builtin_inff();
#pragma unroll
            for (int q = 0; q < 16; ++q) { sv[q] = (key0 + crow(q, h) <= t) ? sv[q] : -__builtin_inff(); mxraw = fmaxf(mxraw, sv[q]); }
        }
        const float mx = xh_max(mxraw) * C;
        if (__any(mx > m_run + 8.f)) {
            const float mn = fmaxf(m_run, mx);
            const float alpha = __builtin_amdgcn_exp2f(m_run - mn);
            m_run = mn; l_half *= alpha;
#pragma unroll
            for (int dvb = 0; dvb < 4; ++dvb)
#pragma unroll
                for (int q = 0; q < 16; ++q) o[dvb][q] *= alpha;
        }
    };
    f32x16 sc;
    {
        int tid = tid0; asm volatile("" : "+v"(tid));
        tile_dma(tid, 0); if (kt_hi >= 1) tile_dma(tid, 1); if (kt_hi >= 2) tile_dma(tid, 2);
        __builtin_amdgcn_s_waitcnt(0x0F70);
        __builtin_amdgcn_s_barrier();
        asm volatile("" ::: "memory");
        const int lane = tid & 63, r = lane & 31, h = lane >> 5;
        bf16x8 kf[12];
        A::kload(kring, 0, kf, r, h);
        sc = A::qk_mma(kf, qf);
        float mxr = -__builtin_inff();
#pragma unroll
        for (int q = 0; q < 16; ++q) mxr = fmaxf(mxr, sc[q]);
        finish(sc, mxr, 0, h);
    }
    for (int kt = 0; kt <= kt_hi; ++kt) {
        const int tid = tid0, lane = tid & 63, r = lane & 31, h = lane >> 5;
        if (kt + 1 <= kt_hi) { if (kt + 2 <= kt_hi) asm volatile("s_waitcnt vmcnt(5)" ::: "memory"); else asm volatile("s_waitcnt vmcnt(0)" ::: "memory"); }
        __builtin_amdgcn_s_barrier();
        asm volatile("" ::: "memory");
        if (kt + 3 <= kt_hi) tile_dma(tid, kt + 3);
        const int kn = (kt + 1) % 3;
        bf16x8 kf[12];
        A::kload(kring + kn * KST, 0, kf, r, h);
        __builtin_amdgcn_sched_barrier(0);
        f32x16 sn = A::qk_mma(kf, qf);
        const float nm = -m_run;
        float ps = 0.f;
#pragma unroll
        for (int q = 0; q < 16; ++q) { const float e = __builtin_amdgcn_exp2f(__builtin_fmaf(sc[q], C, nm)); sc[q] = e; ps += e; }
        l_half += ps;
        const bf16x8 pf0 = pfrag(sc, 0), pf1 = pfrag(sc, 1);
        bf16x8 vf[2][4];
        const unsigned char* vadj = vring + (kt & 3) * VST - (A::K_BYTES + A::KR_BYTES);
        A::vload(vadj, 0, vf[0], r, h); A::vload(vadj, 1, vf[1], r, h);
        float mxr = -__builtin_inff();
#pragma unroll
        for (int q = 0; q < 16; ++q) mxr = fmaxf(mxr, sn[q]);
        A::pv_mma(o, vf[0], pf0); A::pv_mma(o, vf[1], pf1);
        if (kt + 1 <= kt_hi) finish(sn, mxr, kt + 1, h);
        sc = sn;
    }
    __syncthreads();
}

__device__ __forceinline__ void ph_mla_attn(PRef p) {
    unsigned char* lds = VLDS;
    const float C = 0.07216878364870322f * 1.4426950408889634f;
    for (int it = VB; it < 1024; it += NVB) {
        int tid = VT; asm volatile("" : "+v"(tid));
        const int lane = tid & 63, wid = tid >> 6, r = lane & 31, h = lane >> 5;
        const int vb_ = it & 511, xw_ = vb_ >> 4, pp = ((vb_ >> 1) & 7) * 64 + (((xw_ >> 3) * 2 + (vb_ & 1)) << 3) + (xw_ & 7), second = it >> 9, bh = pp >> 3, qt = second ? (pp & 7) : (15 - (pp & 7)), b = bh >> 3, hd = bh & 7;
        const int tw0 = qt * 128 + wid * 32, t = tw0 + r;
        const size_t tok = (size_t)b * SEQ + t;
        bf16x8 qf[12];
        load_q<12>(qf, p.qm + tok * 1536 + hd * 192, h);
        f32x16 o[4];
#pragma unroll
        for (int dvb = 0; dvb < 4; ++dvb)
#pragma unroll
            for (int q = 0; q < 16; ++q) o[dvb][q] = 0.f;
        float m_run = -1.0e30f, l_half = 0.f;
        mla_flash(tid, lds, qf, o, m_run, l_half, p.kn + (size_t)b * SEQ * 1024 + hd * 128, p.krope + (size_t)b * SEQ * 64,
                  p.vt + (size_t)(b * 8 + hd) * 128 * SEQ, (qt * 128 + 127) >> 5, t, tw0, C);
        const float l = xh_sum(l_half);
        store_o(o, p.obuf + tok * 1024 + hd * 128, h, l > 0.f ? 1.f / l : 0.f);
    }
}

__device__ __forceinline__ void acc_branch(uint2 (&ot)[16], const f32x16 (&o)[4], float sc, bool first) {
#pragma unroll
    for (int dvb = 0; dvb < 4; ++dvb)
#pragma unroll
        for (int g = 0; g < 4; ++g) {
            float a0 = o[dvb][4 * g] * sc, a1 = o[dvb][4 * g + 1] * sc, a2 = o[dvb][4 * g + 2] * sc, a3 = o[dvb][4 * g + 3] * sc;
            if (!first) { const uint2 pv = ot[dvb * 4 + g]; a0 += bf2f(pv.x & 0xffffu); a1 += bf2f(pv.x >> 16); a2 += bf2f(pv.y & 0xffffu); a3 += bf2f(pv.y >> 16); }
            ot[dvb * 4 + g] = make_uint2(cvtpk(a0, a1), cvtpk(a2, a3));
        }
}
__device__ __forceinline__ void ph_nsa_attn(PRef p) {
    unsigned char* lds = VLDS;
    typedef AT<128, 64> A;
    float* imp = reinterpret_cast<float*>(lds);
    unsigned* selm = reinterpret_cast<unsigned*>(lds + 2 * A::STAGE);
    const float C = 0.08838834764831845f * 1.4426950408889634f;
    for (int it = VB; it < 1024; it += NVB) {
        int tid = VT; asm volatile("" : "+v"(tid));
        const int lane = tid & 63, wid = tid >> 6, r = lane & 31, h = lane >> 5;
        const int vb_ = it & 511, pp = ((vb_ >> 1) & 7) * 64 + ((vb_ & 1) << 5) + (vb_ >> 4), second = it >> 9, bkh = pp >> 5, qc = second ? (pp & 31) : (63 - (pp & 31)), b = bkh >> 1, kh = bkh & 1;
        const int hd = kh * 4 + wid, t0 = qc * 32, t = t0 + r;
        const size_t tok = (size_t)b * SEQ + t;
        bf16x8 qf[8];
        load_q<8>(qf, p.qn + tok * 1024 + hd * 128, h);
        const f32x4 gate4 = *reinterpret_cast<const f32x4*>(p.gates + tok * 32 + hd * 4);
        uint2 ot[16];
        f32x16 o[4];
        {
            const bf16_t* kb_ = p.kcmp + (size_t)bkh * 128 * 128; const bf16_t* vb_ = p.vcmpt + (size_t)bkh * 128 * 128;
            A::dma(tid, lds, kb_, 128, nullptr, vb_, 128);
            A::dma(tid, lds + A::STAGE, kb_ + 64 * 128, 128, nullptr, vb_ + 64, 128);
            DMA_WAIT_SYNC();
            f32x16 s[4];
            s[0] = A::qk(lds, 0, qf, r, h); s[1] = A::qk(lds, 1, qf, r, h); s[2] = A::qk(lds + A::STAGE, 0, qf, r, h); s[3] = A::qk(lds + A::STAGE, 1, qf, r, h);
            float mx = -3.0e38f;
#pragma unroll
            for (int kb = 0; kb < 4; ++kb)
#pragma unroll
                for (int q = 0; q < 16; ++q) {
                    const int n = kb * 32 + crow(q, h);
                    const float v = (16 * n + 31 <= t) ? s[kb][q] * C : -__builtin_inff();
                    s[kb][q] = v; mx = fmaxf(mx, v);
                }
            mx = fmaxf(xh_max(mx), -1.0e30f);
            float ps = 0.f;
#pragma unroll
            for (int kb = 0; kb < 4; ++kb)
#pragma unroll
                for (int q = 0; q < 16; ++q) { const float e = __builtin_amdgcn_exp2f(s[kb][q] - mx); s[kb][q] = e; ps += e; }
            const float l = xh_sum(ps), inv = l > 0.f ? 1.f / l : 0.f;
#pragma unroll
            for (int kb = 0; kb < 4; ++kb)
#pragma unroll
                for (int q = 0; q < 16; ++q) s[kb][q] *= inv;
            float impv[16];
            {
                float prev = 0.f;
#pragma unroll
                for (int gi = 0; gi < 16; ++gi) {
                    const int kb = gi >> 2, rg = gi & 3;
                    const float p3 = 0.5f * s[kb][4 * rg + 3];
                    const float av = s[kb][4 * rg] + s[kb][4 * rg + 1] + s[kb][4 * rg + 2] + p3;
                    const float co = xh_other(p3, h);
                    impv[gi] = av + (h ? co : prev);
                    prev = co;
                }
            }
            bf16x8 pf[8];
#pragma unroll
            for (int kb = 0; kb < 4; ++kb) { pf[2 * kb] = pfrag(s[kb], 0); pf[2 * kb + 1] = pfrag(s[kb], 1); }
#pragma unroll
            for (int dvb = 0; dvb < 4; ++dvb)
#pragma unroll
                for (int q = 0; q < 16; ++q) o[dvb][q] = 0.f;
#pragma unroll
            for (int ks = 0; ks < 4; ++ks) A::pv(lds, o, ks, pf[ks], r, h);
#pragma unroll
            for (int ks = 0; ks < 4; ++ks) A::pv(lds + A::STAGE, o, ks, pf[4 + ks], r, h);
            acc_branch(ot, o, gate4[0], true);
            __syncthreads();
#pragma unroll
            for (int gi = 0; gi < 16; ++gi) imp[(wid * 32 + r) * 33 + (2 * gi + h)] = impv[gi];
            __syncthreads();
            if (tid < 32) {
                const int tq = t0 + tid, cur = tq >> 6;
                float val[32];
#pragma unroll
                for (int j = 0; j < 32; ++j) {
                    float v = imp[(0 * 32 + tid) * 33 + j] + imp[(1 * 32 + tid) * 33 + j] + imp[(2 * 32 + tid) * 33 + j] + imp[(3 * 32 + tid) * 33 + j];
                    if (j == 0 || j == cur || j == cur - 1) v += 1000.f;
                    val[j] = (64 * j <= tq) ? v : -__builtin_inff();
                }
                unsigned m = 0u;
                for (int k = 0; k < 8; ++k) {
                    float best = -__builtin_inff(); int bi = -1;
#pragma unroll
                    for (int j = 0; j < 32; ++j) { const bool free_ = !((m >> j) & 1u); if (free_ && (bi < 0 || val[j] > best)) { best = val[j]; bi = j; } }
                    m |= 1u << bi;
                }
                selm[tid] = m;
            }
            __syncthreads();
        }
        const unsigned sel = selm[r];
        load_q<8>(qf, p.qn + tok * 1024 + hd * 128, h);
        {
#pragma unroll
            for (int dvb = 0; dvb < 4; ++dvb)
#pragma unroll
                for (int q = 0; q < 16; ++q) o[dvb][q] = 0.f;
            float m_run = -1.0e30f, l_half = 0.f;
            flash_loop<128, 64, 1>(tid, lds, qf, o, m_run, l_half, p.ks + (size_t)bkh * SEQ * 128, 128, nullptr, p.vst + (size_t)bkh * 128 * SEQ, SEQ,
                                   0, (t0 + 31) >> 6, t, t0, t0 + 31, sel, C);
            const float l = xh_sum(l_half);
            acc_branch(ot, o, l > 0.f ? gate4[1] / l : 0.f, false);
        }
        {
#pragma unroll
            for (int dvb = 0; dvb < 4; ++dvb)
#pragma unroll
                for (int q = 0; q < 16; ++q) o[dvb][q] = 0.f;
            float m_run = -1.0e30f, l_half = 0.f;
            const int lo = (t0 - 511) > 0 ? ((t0 - 511) >> 6) : 0;
            flash_loop<128, 64, 2>(tid, lds, qf, o, m_run, l_half, p.kw + (size_t)bkh * SEQ * 128, 128, nullptr, p.vwt + (size_t)bkh * 128 * SEQ, SEQ,
                                   lo, (t0 + 31) >> 6, t, t0, t0 + 31, 0u, C);
            const float l = xh_sum(l_half);
            acc_branch(ot, o, l > 0.f ? gate4[2] / l : 0.f, false);
        }
        bf16_t* orow = p.obuf + tok * 1024 + hd * 128;
#pragma unroll
        for (int dvb = 0; dvb < 4; ++dvb)
#pragma unroll
            for (int gp = 0; gp < 2; ++gp) store_pk16(orow, dvb, gp, ot[dvb * 4 + 2 * gp], ot[dvb * 4 + 2 * gp + 1], h);
    }
}

__device__ __forceinline__ void ph_sb_attn(PRef p) {
    unsigned char* lds = VLDS;
    typedef AT<128, 64> A;
    const float SC = 0.08838834764831845f, L2E = 1.4426950408889634f, LN2 = 0.6931471805599453f;
    for (int it = VB; it < 1024; it += NVB) {
        int tid = VT; asm volatile("" : "+v"(tid));
        const int lane = tid & 63, wid = tid >> 6, r = lane & 31, h = lane >> 5;
        const int vb_ = it & 511, xw_ = vb_ >> 4, pp = ((vb_ >> 1) & 7) * 64 + (((xw_ >> 3) * 2 + (vb_ & 1)) << 3) + (xw_ & 7), second = it >> 9, bh = pp >> 3, qt = second ? (pp & 7) : (15 - (pp & 7)), b = bh >> 3, hd = bh & 7;
        const int tw0 = qt * 128 + wid * 32, t = tw0 + r;
        const size_t tok = (size_t)b * SEQ + t;
        bf16x8 qf[8];
        load_q<8>(qf, p.qs + tok * 1024 + hd * 128, h);
        f32x16 o[4];
#pragma unroll
        for (int dvb = 0; dvb < 4; ++dvb)
#pragma unroll
            for (int q = 0; q < 16; ++q) o[dvb][q] = 0.f;
        float R = 0.f;
        const bf16_t* kbase = p.ksb + (size_t)b * SEQ * 1024 + hd * 128; const bf16_t* vtbase = p.vt + (size_t)(b * 8 + hd) * 128 * SEQ;
        const int kt_hi = (qt * 128 + 127) >> 6;
        A::dma(tid, lds, kbase + (size_t)kt_hi * 64 * 1024, 1024, nullptr, vtbase + kt_hi * 64, SEQ);
        __builtin_amdgcn_s_waitcnt(0x0F70); __syncthreads();
        volatile int* done_f = reinterpret_cast<volatile int*>(smem + LDS_WORK + 2 * A::STAGE);
        const int rwave = VHALF * 4 + wid;
        bool wdone = false;
        for (int kt = kt_hi; kt >= 0; --kt) {
            const int cur = (kt_hi - kt) & 1;
            if (kt < kt_hi && (done_f[0] & done_f[1] & done_f[2] & done_f[3] & done_f[4] & done_f[5] & done_f[6] & done_f[7])) break;
            const bool more = kt > 0;
            if (more) A::dma(tid, lds + (cur ^ 1) * A::STAGE, kbase + (size_t)(kt - 1) * 64 * 1024, 1024, nullptr, vtbase + (kt - 1) * 64, SEQ);
            const unsigned char* st = lds + cur * A::STAGE;
            const int key0 = kt * 64;
            if (key0 < tw0 + 31 && !wdone) {
                f32x16 z[2];
                {
                    bf16x8 kf0[8], kf1[8];
                    A::kload(st, 0, kf0, r, h); A::kload(st, 1, kf1, r, h);
                    __builtin_amdgcn_sched_barrier(0);
                    z[0] = A::qk_mma(kf0, qf); z[1] = A::qk_mma(kf1, qf);
                }
                float T[8];
#pragma unroll
                for (int kb = 0; kb < 2; ++kb)
#pragma unroll
                    for (int rg = 0; rg < 4; ++rg) {
                        float suf = 0.f;
#pragma unroll
                        for (int i = 3; i >= 0; --i) {
                            const float zz = z[kb][4 * rg + i] * SC;
                            const float sp = fmaxf(zz, 0.f) + LN2 * __builtin_amdgcn_logf(1.f + __builtin_amdgcn_exp2f(-fabsf(zz) * L2E));
                            const bool ok = (key0 + kb * 32 + 8 * rg + 4 * h + i) < t;
                            suf += ok ? -sp : 0.f;
                            z[kb][4 * rg + i] = zz + suf;
                        }
                        T[kb * 4 + rg] = suf;
                    }
                float run = 0.f;
#pragma unroll
                for (int gq = 7; gq >= 0; --gq) {
                    const float U = xh_other(T[gq], h);
                    const float after = run + (h ? 0.f : U) + R;
                    const int kb = gq >> 2, rg = gq & 3;
#pragma unroll
                    for (int i = 0; i < 4; ++i) {
                        const bool ok = (key0 + kb * 32 + 8 * rg + 4 * h + i) < t;
                        const float a = __builtin_amdgcn_exp2f((z[kb][4 * rg + i] + after) * L2E);
                        z[kb][4 * rg + i] = ok ? a : 0.f;
                    }
                    run += T[gq] + U;
                }
                R += run;
                A::pv(st, o, 0, pfrag(z[0], 0), r, h); A::pv(st, o, 1, pfrag(z[0], 1), r, h); A::pv(st, o, 2, pfrag(z[1], 0), r, h); A::pv(st, o, 3, pfrag(z[1], 1), r, h);
                wdone = __all(R < -105.f);
            }
            if (lane == 0) done_f[rwave] = wdone ? 1 : 0;
            DMA_WAIT_SYNC();
        }
        store_o(o, p.obuf + tok * 1024 + hd * 128, h, 1.f);
        __syncthreads();
    }
}


#define KARGP ((const __attribute__((address_space(4))) Params*)__builtin_amdgcn_kernarg_segment_ptr())
#define PH(call) do { if (pc >= lo && pc < hi) { { const __attribute__((address_space(4))) Params* q_ = KARGP; asm volatile("" : "+s"(q_)); PRef p = *q_; call; } if (pc + 1 < hi) xcd_barrier(bar); } ++pc; } while (0)
template <int L> __device__ __forceinline__ void ph_attn_conv(PRef p) {
    constexpr int kind = L % 3;
    const bool conv_first = false;
    (void)conv_first;
    if (kind == 0) ph_mla_attn(p); else if (kind == 1) ph_nsa_attn(p); else ph_sb_attn(p);
}
template <int L> __device__ __forceinline__ void ph_moe_a_conv(PRef p) {
    const bool conv_first = false;
    (void)conv_first;
    ph_moe_a(p, L);
    if (L == 0) convert_moe_steal(p, 0, 2);
    if (L + 1 < DEPTH) { convert_moe_steal(p, L + 1, 0); convert_moe_steal(p, L + 1, 1); }
}
template <int L> __device__ __forceinline__ void ph_moe_b_conv(PRef p) {
    const bool conv_first = false;
    (void)conv_first;
    ph_moe_b(p, L);
    if (L + 1 < DEPTH) convert_moe_steal(p, L + 1, 2);
}
template <int L> __device__ __forceinline__ void run_layer(PRef p, const XcdBarrier& bar, int lo, int hi, int& pc) {
    constexpr int kind = L % 3, j = L / 3;
    if (kind == 0) { PH(ph_mla_in(p, j)); PH(ph_mla_up(p, j)); }
    else if (kind == 1) { PH(ph_nsa_in(p)); PH(ph_nsa_cmp1(p)); PH(ph_nsa_cmp2(p)); }
    else { PH(ph_sb_in(p)); }
    PH(ph_attn_conv<L>(p));
    PH(ph_wo(p, L)); PH(ph_lna(p, L)); PH(ph_moe_a_conv<L>(p)); PH(ph_moe_b_conv<L>(p)); PH(ph_lnb(p, L));
}
__global__ void __launch_bounds__(512, 2) mega(Params pv, int lo, int hi) {
    (void)pv; PRef p = *KARGP;
    volatile LAS unsigned* stw = (volatile LAS unsigned*)smem;
    if (threadIdx.x == 0) { stw[0] = 0u; stw[1] = 0u; stw[2] = 0u; stw[3] = 0u; }
    __syncthreads();
    XcdBarrier bar; bar.bar = p.bar; bar.x = 0; bar.st = stw;
    if (hi - lo > 1) bar = xcd_barrier_post(p.bar, stw);
    int pc = 0;
    PH(ph_prologue(p));
    PH(ph_h0(p));
    run_layer<0>(p, bar, lo, hi, pc);
    run_layer<1>(p, bar, lo, hi, pc);
    run_layer<2>(p, bar, lo, hi, pc);
    run_layer<3>(p, bar, lo, hi, pc);
}
#undef PH
constexpr int N_PHASES = 2 + (3 + 5) + (4 + 5) + (2 + 5) + (3 + 5);

extern "C" void kernel_launch(void* const* d_in, const int* in_sizes, int n_in, void* d_out, int out_size, void* d_ws, size_t ws_size, hipStream_t stream) {
    (void)in_sizes; (void)n_in; (void)out_size;
    static int grid = 0;
    if (grid == 0) {
        int dev = 0, cus = 0, per_cu = 0;
        hipGetDevice(&dev);
        hipDeviceGetAttribute(&cus, hipDeviceAttributeMultiprocessorCount, dev);
        if (hipFuncSetAttribute((const void*)mega, hipFuncAttributeMaxDynamicSharedMemorySize, LDS_BYTES) != hipSuccess) { fprintf(stderr, "kernel_launch: hipFuncSetAttribute failed\n"); }
        if (hipOccupancyMaxActiveBlocksPerMultiprocessor(&per_cu, (const void*)mega, 2 * NTHR, LDS_BYTES) != hipSuccess) per_cu = 1;
        (void)hipGetLastError();
        if (per_cu < 1) per_cu = 1;
        if (per_cu > 1) per_cu = 1;
        if (cus <= 0) cus = 256;
        grid = cus * per_cu;
        if (grid >= 8) grid &= ~7;
    }
    Params p{};
    const float* const* in = (const float* const*)d_in;
    p.x = in[0]; p.c = in[1]; p.pos = (const int*)d_in[2]; p.ada_w = in[3]; p.ada_b = in[4]; p.ln_g = in[5]; p.ln_b = in[6];
    p.mla_w_in = in[7]; p.mla_g_q = in[8]; p.mla_w_uq = in[9]; p.mla_g_kv = in[10]; p.mla_w_ukv = in[11]; p.mla_w_o = in[12];
    p.nsa_w_in = in[13]; p.nsa_pe_k = in[14]; p.nsa_pe_v = in[15]; p.nsa_w_ck1 = in[16]; p.nsa_w_ck2 = in[17]; p.nsa_w_cv1 = in[18]; p.nsa_w_cv2 = in[19]; p.nsa_w_o = in[20];
    p.sb_w_qkv = in[21]; p.sb_w_o = in[22];
    p.moe_w_grp = in[23]; p.moe_b_grp = in[24]; p.moe_w_rt = in[25]; p.moe_b_rt = in[26]; p.moe_w_gate = in[27]; p.moe_w_up = in[28]; p.moe_w_down = in[29];
    p.out = (float*)d_out;
    unsigned char* ws = (unsigned char*)d_ws; size_t off = 0;
    auto take = [&](size_t bytes) { unsigned char* r = ws + off; off += (bytes + 255) & ~(size_t)255; return r; };
    p.bar = (unsigned*)take(XCD_BAR_WORDS * 4 + 16 * 512); p.wq = (int*)(p.bar + XCD_BAR_WORDS); p.cnt = (int*)take(DEPTH * 32 * 64 * 4);
    p.mod = (float*)take((size_t)8 * 8 * 3072 * 4);
    p.cosm = (float*)take((size_t)T_TOK * 32 * 4); p.sinm = (float*)take((size_t)T_TOK * 32 * 4); p.cosn = (float*)take((size_t)T_TOK * 64 * 4); p.sinn = (float*)take((size_t)T_TOK * 64 * 4);
    p.bias1 = (float*)take(2 * 128 * 4); p.wr = (float*)take((size_t)DEPTH * 1024 * 48 * 4);
    p.xbuf = (f16_t*)take((size_t)T_TOK * 1024 * 4); p.zbuf = (f16_t*)take((size_t)T_TOK * 1024 * 4); p.hbuf = (bf16_t*)take((size_t)T_TOK * 1024 * 2);
    p.wt_mla_in = (bf16_t*)take((size_t)2 * 768 * 1024 * 2); p.wt_uq = (bf16_t*)take((size_t)2 * 1536 * 256 * 2); p.wt_ukv = (bf16_t*)take((size_t)2 * 2048 * 256 * 2);
    p.wt_mla_o = (bf16_t*)take((size_t)2 * 1024 * 1024 * 2); p.wt_nsa_in = (bf16_t*)take((size_t)2816 * 1024 * 2);
    p.wt_ck1 = (bf16_t*)take((size_t)128 * 4096 * 2); p.wt_cv1 = (bf16_t*)take((size_t)128 * 4096 * 2); p.wt_ck2 = (bf16_t*)take(128 * 128 * 2); p.wt_cv2 = (bf16_t*)take(128 * 128 * 2);
    p.wt_nsa_o = (bf16_t*)take((size_t)1024 * 1024 * 2); p.wt_sb_qkv = (bf16_t*)take((size_t)3072 * 1024 * 2); p.wt_sb_o = (bf16_t*)take((size_t)1024 * 1024 * 2);
    p.wt_gu = (bf16_t*)take((size_t)DEPTH * 32 * 1024 * 1024 * 2); p.wt_dn = (bf16_t*)take((size_t)DEPTH * 32 * 1024 * 512 * 2);
    p.obuf = (bf16_t*)take((size_t)T_TOK * 1024 * 2);
    p.list = (int*)take((size_t)32 * T_TOK * 4); p.listw = (float*)take((size_t)32 * T_TOK * 4);
    p.hmoe = (bf16_t*)take((size_t)(T_TOK * 2 + 32 * 256) * 512 * 2); p.ybuf = (bf16_t*)take((size_t)T_TOK * 2 * 1024 * 2);
    const size_t arena0 = off;
    p.cbuf = (bf16_t*)take((size_t)T_TOK * 512 * 2); p.rss = (float*)take((size_t)T_TOK * 8 * 4); p.krope = (bf16_t*)take((size_t)T_TOK * 64 * 2); p.qm = (bf16_t*)take((size_t)T_TOK * 1536 * 2);
    p.kn = (bf16_t*)take((size_t)T_TOK * 1024 * 2); p.vt = (bf16_t*)take((size_t)T_TOK * 1024 * 2);
    const size_t arena_mla = off; off = arena0;
    p.qn = (bf16_t*)take((size_t)T_TOK * 1024 * 2);
    p.kc = (bf16_t*)take((size_t)(16 * SEQ + 64) * 128 * 2); p.vc = (bf16_t*)take((size_t)(16 * SEQ + 64) * 128 * 2);
    p.ks = (bf16_t*)take((size_t)16 * SEQ * 128 * 2); p.kw = (bf16_t*)take((size_t)16 * SEQ * 128 * 2);
    p.vst = (bf16_t*)take((size_t)16 * SEQ * 128 * 2); p.vwt = (bf16_t*)take((size_t)16 * SEQ * 128 * 2);
    p.gates = (float*)take((size_t)T_TOK * 32 * 4); p.cpart = (float*)take((size_t)32 * 8 * 128 * 128 * 4); p.hid = (bf16_t*)take((size_t)32 * 128 * 128 * 2);
    p.kcmp = (bf16_t*)take((size_t)16 * 128 * 128 * 2); p.vcmpt = (bf16_t*)take((size_t)16 * 128 * 128 * 2);
    const size_t arena_nsa = off; off = arena0;
    p.qs = (bf16_t*)take((size_t)T_TOK * 1024 * 2); p.ksb = (bf16_t*)take((size_t)T_TOK * 1024 * 2);
    const size_t arena_sb = off; (void)arena_sb;
    off = arena_mla > arena_nsa ? arena_mla : arena_nsa;
    if (off > ws_size) { fprintf(stderr, "kernel_launch: workspace too small (%zu > %zu)\n", off, ws_size); }
    hipMemsetAsync(p.bar, 0, XCD_BAR_WORDS * 4 + 16 * 512, stream);
#if MULTI_LAUNCH
    for (int ph = 0; ph < N_PHASES; ++ph) hipLaunchKernelGGL(mega, dim3(grid), dim3(2 * NTHR), LDS_BYTES, stream, p, ph, ph + 1);
#else
    hipLaunchKernelGGL(mega, dim3(grid), dim3(2 * NTHR), LDS_BYTES, stream, p, 0, N_PHASES);
#endif
}
```

```cpp
#include <hip/hip_runtime.h>
#include <stdint.h>
#include <type_traits>
#include <stdio.h>

#ifndef MULTI_LAUNCH
#define MULTI_LAUNCH 0
#endif

typedef unsigned short bf16_t;
typedef short bf16x8 __attribute__((ext_vector_type(8)));
typedef float f32x16 __attribute__((ext_vector_type(16)));
typedef float f32x4 __attribute__((ext_vector_type(4)));
typedef _Float16 f16_t;
typedef _Float16 f16x4 __attribute__((ext_vector_type(4)));
typedef _Float16 f16x8 __attribute__((ext_vector_type(8)));
typedef float f32x8 __attribute__((ext_vector_type(8)));
__device__ __forceinline__ f32x4 ld4h(const f16_t* p) { return __builtin_convertvector(*reinterpret_cast<const f16x4*>(p), f32x4); }
__device__ __forceinline__ void st4h(f16_t* p, f32x4 v) { *reinterpret_cast<f16x4*>(p) = __builtin_convertvector(v, f16x4); }

constexpr int T_TOK = 16384, DM = 1024, NBATCH = 8, SEQ = 2048, DEPTH = 4;
constexpr float LN_EPS = 1e-5f, RMS_EPS = 1e-6f;
constexpr float DN_ALPHA = 1.6817928305074290f;
constexpr int NTHR = 256;
constexpr int LDS_WORK = 256;
constexpr int HALF_LDS = 80640;
constexpr int LDS_BYTES = LDS_WORK + 2 * HALF_LDS;
#define VHALF ((int)__builtin_amdgcn_readfirstlane((int)(threadIdx.x >> 8)))
#define VT ((int)(threadIdx.x & 255u))
#define VB ((int)(blockIdx.x * 2u) + VHALF)
#define NVB ((int)(gridDim.x * 2u))
#define VLDS (smem + LDS_WORK + VHALF * HALF_LDS)

#define XB_TMO      128
#define XB_XCNT(j)  (256  + 64 * (j))
#define XB_XSUB(j)  (1280 + 64 * (j))
#define XB_XGEN(j)  (2304 + 64 * (j))
#define XB_TOP      3328
#define XB_TOPGEN   3392
#define XCD_BAR_WORDS 3456
#define XB_SPIN_CAP (1u << 22)
#define LAS __attribute__((address_space(3)))

__device__ __forceinline__ unsigned xb_ld(unsigned* p)              { return __hip_atomic_load(p, __ATOMIC_RELAXED, __HIP_MEMORY_SCOPE_AGENT); }
__device__ __forceinline__ unsigned xb_add(unsigned* p, unsigned v) { return __hip_atomic_fetch_add(p, v, __ATOMIC_RELAXED, __HIP_MEMORY_SCOPE_AGENT); }
__device__ __forceinline__ unsigned xb_xcc_id() { return (unsigned)__builtin_amdgcn_s_getreg((3 << 11) | 20) & 0xFu; }
#define XB_SPIN(cond, bar) do { unsigned _sp = 0; while (cond) { __builtin_amdgcn_s_sleep(1); \
    if ((++_sp & 255u) == 0u) { if (xb_ld(&(bar)[XB_TMO])) break; if (_sp > XB_SPIN_CAP) { atomicAdd(&(bar)[XB_TMO], 1u); break; } } } } while (0)

struct XcdBarrier { unsigned* bar; unsigned x; volatile LAS unsigned* st; };

__device__ __forceinline__ XcdBarrier xcd_barrier_post(unsigned* bar, volatile LAS unsigned* st) {
    XcdBarrier b; b.bar = bar; b.x = xb_xcc_id(); b.st = st;
    if (threadIdx.x == 0) (void)xb_add(&bar[XB_XCNT(b.x)], 1u);
    return b;
}
__device__ __forceinline__ void xcd_barrier_complete(unsigned* bar, unsigned x, unsigned& nloc, unsigned& nx) {
    const unsigned G = gridDim.x * gridDim.y * gridDim.z;
    unsigned sum, cnt, mine, sp = 0u;
    for (;;) {
        sum = 0u; cnt = 0u; mine = 0u;
#pragma unroll
        for (unsigned j = 0; j < 16; ++j) { const unsigned c = xb_ld(&bar[XB_XCNT(j)]); sum += c; cnt += (c > 0u) ? 1u : 0u; mine = (j == x) ? c : mine; }
        if (sum == G) break;
        __builtin_amdgcn_s_sleep(1);
        if ((++sp & 255u) == 0u) { if (xb_ld(&bar[XB_TMO])) break; if (sp > XB_SPIN_CAP) { atomicAdd(&bar[XB_TMO], 1u); break; } }
    }
    nloc = mine > 0u ? mine : 1u; nx = cnt > 0u ? cnt : 1u;
}
__device__ __forceinline__ void xcd_barrier(const XcdBarrier& b) {
    asm volatile("s_waitcnt vmcnt(0)" ::: "memory");
    __syncthreads();
    if (threadIdx.x == 0) {
        unsigned* bar = b.bar;
        __builtin_amdgcn_s_waitcnt(0);
        unsigned nloc = b.st[0], nx = b.st[1];
        if (nloc == 0u) { xcd_barrier_complete(bar, b.x, nloc, nx); b.st[0] = nloc; b.st[1] = nx; }
        const unsigned old = xb_add(&bar[XB_XSUB(b.x)], 1u);
        const unsigned gen = old / nloc;
        if (old + 1u == (gen + 1u) * nloc) {
            __builtin_amdgcn_fence(__ATOMIC_RELEASE, "agent");
            asm volatile("s_waitcnt vmcnt(0)" ::: "memory");
            const unsigned og = xb_add(&bar[XB_TOP], 1u);
            const unsigned tg = og / nx;
            if (og + 1u == (tg + 1u) * nx) xb_add(&bar[XB_TOPGEN], 1u);
            else XB_SPIN(xb_ld(&bar[XB_TOPGEN]) == tg, bar);
            __builtin_amdgcn_fence(__ATOMIC_ACQUIRE, "agent");
            xb_add(&bar[XB_XGEN(b.x)], 1u);
            asm volatile("s_waitcnt vmcnt(0)" ::: "memory");
        } else {
            XB_SPIN(xb_ld(&bar[XB_XGEN(b.x)]) == gen, bar);
            __builtin_amdgcn_fence(__ATOMIC_ACQUIRE, "agent");
            asm volatile("s_waitcnt vmcnt(0)" ::: "memory");
        }
    }
    __syncthreads();
}

struct Params;
typedef const __attribute__((address_space(4))) Params& PRef;
struct Params {
    const float* x; const float* c; const int* pos; const float* ada_w; const float* ada_b; const float* ln_g; const float* ln_b;
    const float* mla_w_in; const float* mla_g_q; const float* mla_w_uq; const float* mla_g_kv; const float* mla_w_ukv; const float* mla_w_o;
    const float* nsa_w_in; const float* nsa_pe_k; const float* nsa_pe_v; const float* nsa_w_ck1; const float* nsa_w_ck2; const float* nsa_w_cv1; const float* nsa_w_cv2; const float* nsa_w_o;
    const float* sb_w_qkv; const float* sb_w_o;
    const float* moe_w_grp; const float* moe_b_grp; const float* moe_w_rt; const float* moe_b_rt; const float* moe_w_gate; const float* moe_w_up; const float* moe_w_down;
    float* out;
    unsigned* bar; int* cnt; float* mod; float* cosm; float* sinm; float* cosn; float* sinn; float* bias1; float* wr;
    f16_t* xbuf; f16_t* zbuf; bf16_t* hbuf;
    bf16_t* wt_mla_in; bf16_t* wt_uq; bf16_t* wt_ukv; bf16_t* wt_mla_o; bf16_t* wt_nsa_in; bf16_t* wt_ck1; bf16_t* wt_cv1; bf16_t* wt_ck2; bf16_t* wt_cv2;
    bf16_t* wt_nsa_o; bf16_t* wt_sb_qkv; bf16_t* wt_sb_o; bf16_t* wt_gu; bf16_t* wt_dn;
    bf16_t* cbuf; float* rss; bf16_t* krope; bf16_t* qm; bf16_t* kn; bf16_t* vt;
    bf16_t* qn; bf16_t* kc; bf16_t* vc; bf16_t* ks; bf16_t* kw; bf16_t* vst; bf16_t* vwt; float* gates; float* cpart; bf16_t* hid; bf16_t* kcmp; bf16_t* vcmpt;
    bf16_t* qs; bf16_t* ksb;
    bf16_t* obuf;
    int* wq;
    int* list; float* listw; bf16_t* hmoe; bf16_t* ybuf;
};

extern __shared__ __attribute__((aligned(16))) unsigned char smem[];

__device__ __forceinline__ unsigned cvtpk(float lo, float hi) { unsigned r; asm("s_nop 0\n\tv_cvt_pk_bf16_f32 %0, %1, %2\n\ts_nop 1" : "=v"(r) : "v"(lo), "v"(hi)); return r; }
__device__ __forceinline__ uint4 cvtpk8(float a0, float a1, float a2, float a3, float a4, float a5, float a6, float a7) {
    uint4 r;
    asm("s_nop 0\n\tv_cvt_pk_bf16_f32 %0, %4, %5\n\tv_cvt_pk_bf16_f32 %1, %6, %7\n\tv_cvt_pk_bf16_f32 %2, %8, %9\n\tv_cvt_pk_bf16_f32 %3, %10, %11\n\ts_nop 1"
        : "=&v"(r.x), "=&v"(r.y), "=&v"(r.z), "=&v"(r.w) : "v"(a0), "v"(a1), "v"(a2), "v"(a3), "v"(a4), "v"(a5), "v"(a6), "v"(a7));
    return r;
}
__device__ __forceinline__ float bf2f(unsigned v16) { return __uint_as_float(v16 << 16); }
__device__ __forceinline__ uint4 pack8(const float* v) { return cvtpk8(v[0], v[1], v[2], v[3], v[4], v[5], v[6], v[7]); }
__device__ __forceinline__ float wave_sum(float v) {
#pragma unroll
    for (int o = 32; o > 0; o >>= 1) v += __shfl_xor(v, o, 64);
    return v;
}
__device__ __forceinline__ float xh_max(float v) { auto rr = __builtin_amdgcn_permlane32_swap(__float_as_uint(v), __float_as_uint(v), false, false); return fmaxf(__uint_as_float(rr[0]), __uint_as_float(rr[1])); }
__device__ __forceinline__ float xh_sum(float v) { auto rr = __builtin_amdgcn_permlane32_swap(__float_as_uint(v), __float_as_uint(v), false, false); return __uint_as_float(rr[0]) + __uint_as_float(rr[1]); }
__device__ __forceinline__ float xh_other(float v, int h) { auto rr = __builtin_amdgcn_permlane32_swap(__float_as_uint(v), __float_as_uint(v), false, false); return h ? __uint_as_float(rr[0]) : __uint_as_float(rr[1]); }
__device__ __forceinline__ float silu_f(float v) { return v / (1.f + __expf(-v)); }
__device__ __forceinline__ float sigmoid_f(float v) { return 1.f / (1.f + __expf(-v)); }
#define MFMA32(a, b, c) __builtin_amdgcn_mfma_f32_32x32x16_bf16((a), (b), (c), 0, 0, 0)
__device__ __forceinline__ int crow(int reg, int h) { return (reg & 3) + 8 * (reg >> 2) + 4 * h; }
__device__ __forceinline__ bf16x8 lds_frag(const unsigned char* base, int off) { return *reinterpret_cast<const bf16x8*>(base + off); }

constexpr int CS_LD = 132;
constexpr int GEMM_RSTD_OFF = 128 * CS_LD * 4;
template <class RowPtr>
__device__ __forceinline__ void gemm_main(int tid, unsigned char* lds, const RowPtr& rowptr, const bf16_t* __restrict__ Bt, int ldb, int n0, int K, f32x16 (&acc)[2][2]) {
    const int lane = tid & 63, wid = tid >> 6, wr = wid >> 1, wc = wid & 1, r = lane & 31, h = lane >> 5;
    const bf16_t* pa[4]; const bf16_t* pb[4];
#pragma unroll
    for (int i = 0; i < 4; ++i) {
        const int pi = wid + 4 * i, row = 8 * pi + (lane >> 3), c = (lane & 7) ^ ((row >> 1) & 7);
        pa[i] = rowptr(row) + c * 8; pb[i] = Bt + (size_t)(n0 + row) * ldb + c * 8;
    }
    const int swz = (r >> 1) & 7;
    const int aoff = (wr * 64 + r) * 128, boff = 32768 + (wc * 64 + r) * 128;
#pragma unroll
    for (int i = 0; i < 2; ++i)
#pragma unroll
        for (int j = 0; j < 2; ++j)
#pragma unroll
            for (int q = 0; q < 16; ++q) acc[i][j][q] = 0.f;
    const int nk = K >> 6;
    auto dma = [&](int buf, int k0) {
#pragma unroll
        for (int i = 0; i < 4; ++i) {
            const int pi = wid + 4 * i;
            __builtin_amdgcn_global_load_lds((const unsigned*)(pa[i] + k0), (LAS unsigned*)(lds + buf * 16384 + pi * 1024), 16, 0, 0);
            __builtin_amdgcn_global_load_lds((const unsigned*)(pb[i] + k0), (LAS unsigned*)(lds + 32768 + buf * 16384 + pi * 1024), 16, 0, 0);
        }
    };
    dma(0, 0);
    asm volatile("s_waitcnt vmcnt(0)" ::: "memory"); __syncthreads();
    for (int kt = 0; kt < nk; ++kt) {
        if (kt + 1 < nk) dma((kt + 1) & 1, (kt + 1) << 6);
        const unsigned char* sa = lds + (kt & 1) * 16384;
#pragma unroll
        for (int kk = 0; kk < 4; ++kk) {
            const int co = ((2 * kk + h) ^ swz) << 4;
            const bf16x8 a0 = lds_frag(sa, aoff + co), a1 = lds_frag(sa, aoff + 4096 + co);
            const bf16x8 b0 = lds_frag(sa, boff + co), b1 = lds_frag(sa, boff + 4096 + co);
            acc[0][0] = MFMA32(a0, b0, acc[0][0]); acc[0][1] = MFMA32(a0, b1, acc[0][1]);
            acc[1][0] = MFMA32(a1, b0, acc[1][0]); acc[1][1] = MFMA32(a1, b1, acc[1][1]);
        }
        asm volatile("s_waitcnt vmcnt(0)" ::: "memory"); __syncthreads();
    }
    float* Cs = reinterpret_cast<float*>(lds);
#pragma unroll
    for (int i = 0; i < 2; ++i)
#pragma unroll
        for (int j = 0; j < 2; ++j)
#pragma unroll
            for (int q = 0; q < 16; ++q) Cs[(wr * 64 + i * 32 + crow(q, h)) * CS_LD + wc * 64 + j * 32 + r] = acc[i][j][q];
    __syncthreads();
}
#define ITEM_END_SYNC() do { asm volatile("s_waitcnt lgkmcnt(0)" ::: "memory"); __builtin_amdgcn_s_barrier(); asm volatile("" ::: "memory"); } while (0)
__device__ __forceinline__ void cs_load8(const float* Cs, int row, int c0, float* v) {
    const f32x4 a = *reinterpret_cast<const f32x4*>(Cs + row * CS_LD + c0), b = *reinterpret_cast<const f32x4*>(Cs + row * CS_LD + c0 + 4);
    v[0] = a[0]; v[1] = a[1]; v[2] = a[2]; v[3] = a[3]; v[4] = b[0]; v[5] = b[1]; v[6] = b[2]; v[7] = b[3];
}
__device__ __forceinline__ void epi_plain(const float* __restrict__ Cs, bf16_t* __restrict__ dst, size_t ld, const float* __restrict__ rowscale) {
    const int tid = VT, c0 = (tid & 15) * 8;
#pragma unroll
    for (int ps = 0; ps < 8; ++ps) {
        const int row = (tid >> 4) + 16 * ps; float v[8]; cs_load8(Cs, row, c0, v);
        if (rowscale) { const float s = rowscale[row];
#pragma unroll
            for (int q = 0; q < 8; ++q) v[q] *= s; }
        *reinterpret_cast<uint4*>(dst + (size_t)row * ld + c0) = pack8(v);
    }
}
__device__ __forceinline__ void epi_rope128(const float* __restrict__ Cs, bf16_t* __restrict__ dst, size_t ld, const float* __restrict__ cs, const float* __restrict__ sn, int tok0) {
    const int tid = VT, c0 = (tid & 15) * 8;
    if (c0 >= 64) return;
#pragma unroll
    for (int ps = 0; ps < 8; ++ps) {
        const int row = (tid >> 4) + 16 * ps; float a[8], b[8], o1[8], o2[8]; cs_load8(Cs, row, c0, a); cs_load8(Cs, row, c0 + 64, b);
        const float* cp = cs + (size_t)(tok0 + row) * 64 + c0; const float* sp = sn + (size_t)(tok0 + row) * 64 + c0;
#pragma unroll
        for (int q = 0; q < 8; ++q) { const float c = cp[q], s = sp[q]; o1[q] = a[q] * c - b[q] * s; o2[q] = b[q] * c + a[q] * s; }
        *reinterpret_cast<uint4*>(dst + (size_t)row * ld + c0) = pack8(o1);
        *reinterpret_cast<uint4*>(dst + (size_t)row * ld + c0 + 64) = pack8(o2);
    }
}
__device__ __forceinline__ void epi_transpose(const float* __restrict__ Cs, bf16_t* __restrict__ dst  , size_t ld, const float* __restrict__ rowscale) {
    const int tid = VT, dv = tid & 127, sh = tid >> 7;
#pragma unroll
    for (int j = 0; j < 8; ++j) {
        float v[8];
#pragma unroll
        for (int q = 0; q < 8; ++q) { const int row = sh * 64 + j * 8 + q; v[q] = Cs[row * CS_LD + dv] * (rowscale ? rowscale[row] : 1.f); }
        *reinterpret_cast<uint4*>(dst + (size_t)dv * ld + sh * 64 + j * 8) = pack8(v);
    }
}

struct RowPlain { const bf16_t* base; size_t ld; __device__ __forceinline__ const bf16_t* operator()(int r) const { return base + (size_t)r * ld; } };


namespace g8 {
typedef float f32x4_t __attribute__((ext_vector_type(4)));
constexpr int BK = 64, HALFR = 128, HTB = HALFR * BK * 2, STAGE_BYTES = 8 * HTB;
__device__ __forceinline__ int lds_byte(int r, int c) { const int st = (r >> 4) * 2 + (c >> 5), rr = r & 15, cc = c & 31, ob = rr * 64 + cc * 2; return st * 1024 + (ob ^ (((ob >> 9) & 1) << 5)); }
__device__ __forceinline__ void stage_rc(int b, int& R, int& C) { const int st = b / 1024, sb = b % 1024, swz = sb ^ (((sb >> 9) & 1) << 5); R = (st >> 1) * 16 + swz / 64; C = (st & 1) * 32 + (swz % 64) / 2; }
struct Unit { int pm, pn, par, e; };
template <class Sched, class Epi>
__device__ __forceinline__ void gemm8(LAS unsigned char* lds, const char* __restrict__ Abase, int ldb, int K, const Sched& S, const Epi& E) {
    const int tid = threadIdx.x;
    const int wid = __builtin_amdgcn_readfirstlane(tid >> 6), lane = tid & 63, wr = wid >> 2, wc = wid & 3, fr = lane & 15, fq = lane >> 4;
    const int nt = K / BK;
    unsigned voffB0; { int R, C; stage_rc(tid * 16, R, C); voffB0 = (unsigned)(R * ldb + C) * 2u; }
    const unsigned voffBd = (unsigned)(64 * ldb) * 2u;
    const size_t kstep = (size_t)(BK * 2), hstepB = (size_t)HALFR * ldb * 2;
    const unsigned ldsw = (unsigned)wid * 1024u;
    const int lpart = lds_byte(fr, fq * 8);
    const int aoff = lpart + wr * 8192, boff = lpart + wc * 4096;
#define G8_SA(b, h) (((b) * 2 + (h)) * HTB)
#define G8_SB(b, h) ((4 + (b) * 2 + (h)) * HTB)
#define G8_STAGE_B(bufoff, gbase) do { \
        __builtin_amdgcn_global_load_lds((const unsigned*)((const char*)(gbase) + voffB0), (LAS unsigned*)(lds + (bufoff) + ldsw), 16, 0, 0); \
        __builtin_amdgcn_global_load_lds((const unsigned*)((const char*)(gbase) + voffBd + voffB0), (LAS unsigned*)(lds + (bufoff) + ldsw + 8192), 16, 0, 0); } while (0)
#define G8_STAGE_A(bufoff, hnd, kbytes) do { \
        __builtin_amdgcn_global_load_lds((const unsigned*)(Abase + (size_t)S.a_off(hnd, 0, tid) + (kbytes)), (LAS unsigned*)(lds + (bufoff) + ldsw), 16, 0, 0); \
        __builtin_amdgcn_global_load_lds((const unsigned*)(Abase + (size_t)S.a_off(hnd, 1, tid) + (kbytes)), (LAS unsigned*)(lds + (bufoff) + ldsw + 8192), 16, 0, 0); } while (0)
#define G8_LDA(dst, b, h) do { _Pragma("unroll") for (int m = 0; m < 4; ++m) _Pragma("unroll") for (int k = 0; k < 2; ++k) dst[m][k] = *(const LAS bf16x8*)(lds + G8_SA(b, h) + aoff + m * 2048 + k * 1024); } while (0)
#define G8_LDB(dst, b, h) do { _Pragma("unroll") for (int n = 0; n < 2; ++n) _Pragma("unroll") for (int k = 0; k < 2; ++k) dst[n][k] = *(const LAS bf16x8*)(lds + G8_SB(b, h) + boff + n * 2048 + k * 1024); } while (0)
#define G8_MMA(ai, bj, At, Bt) do { __builtin_amdgcn_s_setprio(1); _Pragma("unroll") for (int m = 0; m < 4; ++m) _Pragma("unroll") for (int n = 0; n < 2; ++n) _Pragma("unroll") for (int k = 0; k < 2; ++k) \
        acc[ai][bj][m][n] = __builtin_amdgcn_mfma_f32_16x16x32_bf16(Bt[n][k], At[m][k], acc[ai][bj][m][n], 0, 0, 0); __builtin_amdgcn_s_setprio(0); } while (0)
#define G8_WAIT_V(n) asm volatile("s_waitcnt vmcnt(" #n ")" ::: "memory")
#define G8_WAIT_L(n) asm volatile("s_waitcnt lgkmcnt(" #n ")" ::: "memory")
#define G8_BAR __builtin_amdgcn_s_barrier()
#define G8_SCHED __builtin_amdgcn_sched_barrier(0)
    Unit cur, nxt; int ui = 0;
    if (!S.next(0, cur)) return;
    f32x4_t acc[2][2][4][2];
#pragma unroll
    for (int a = 0; a < 2; ++a)
#pragma unroll
        for (int b = 0; b < 2; ++b)
#pragma unroll
            for (int m = 0; m < 4; ++m)
#pragma unroll
                for (int n = 0; n < 2; ++n) acc[a][b][m][n] = (f32x4_t){0.f, 0.f, 0.f, 0.f};
    bf16x8 At[4][2], B0[2][2], B1[2][2];
    unsigned c0, c1;
    cur.par = 0; S.stash(cur, tid); S.stash_wait(); S.a_handles(cur, tid, c0, c1);
    const char* cB = S.b_base(cur);
    G8_STAGE_B(G8_SB(0, 0), cB); G8_STAGE_A(G8_SA(0, 0), c0, 0); G8_STAGE_B(G8_SB(0, 1), cB + hstepB); G8_STAGE_A(G8_SA(0, 1), c1, 0);
    if (wr == 1) G8_BAR;
    G8_WAIT_V(4); G8_BAR;
    G8_STAGE_B(G8_SB(1, 0), cB + kstep); G8_STAGE_A(G8_SA(1, 0), c0, kstep); G8_STAGE_B(G8_SB(1, 1), cB + hstepB + kstep);
    G8_WAIT_V(6); G8_BAR;
    for (;;) {
        const bool has_next = S.next(ui + 1, nxt); nxt.par = (ui + 1) % 3;
        const char* nB = cB;
        if (has_next) { S.stash(nxt, tid); nB = S.b_base(nxt); }
#pragma unroll 1
        for (int t = 0; t < nt; t += 2) {
            const bool last = (t == nt - 2);
            const size_t k1 = (size_t)(t + 1) * kstep;
            const size_t k2 = last ? 0 : (size_t)(t + 2) * kstep, k3 = k2 + kstep;
            const char* b2 = last ? nB : cB + k2; const char* b3 = b2 + kstep;
            G8_LDB(B0, 0, 0); G8_SCHED; G8_LDA(At, 0, 0); G8_STAGE_A(G8_SA(1, 1), c1, k1);
            if (last && has_next) S.a_handles(nxt, tid, c0, c1);
            G8_WAIT_L(8); G8_BAR; G8_WAIT_L(0); G8_MMA(0, 0, At, B0); G8_BAR; G8_SCHED;
            G8_LDB(B1, 0, 1); G8_STAGE_B(G8_SB(0, 0), b2);
            G8_BAR; G8_WAIT_L(0); G8_MMA(0, 1, At, B1); G8_BAR;
            G8_LDA(At, 0, 1); G8_STAGE_A(G8_SA(0, 0), c0, k2);
            G8_BAR; G8_WAIT_L(0); G8_MMA(1, 0, At, B0); G8_BAR; G8_SCHED;
            G8_STAGE_B(G8_SB(0, 1), b2 + hstepB);
            G8_WAIT_V(6); G8_BAR; G8_MMA(1, 1, At, B1); G8_BAR;
            G8_LDB(B0, 1, 0); G8_SCHED; G8_LDA(At, 1, 0); G8_STAGE_A(G8_SA(0, 1), c1, k2);
            G8_WAIT_L(8); G8_BAR; G8_WAIT_L(0); G8_MMA(0, 0, At, B0); G8_BAR; G8_SCHED;
            G8_LDB(B1, 1, 1); G8_STAGE_B(G8_SB(1, 0), b3);
            G8_BAR; G8_WAIT_L(0); G8_MMA(0, 1, At, B1); G8_BAR;
            G8_LDA(At, 1, 1); G8_STAGE_A(G8_SA(1, 0), c0, k3);
            G8_BAR; G8_WAIT_L(0); G8_MMA(1, 0, At, B0); G8_BAR; G8_SCHED;
            G8_STAGE_B(G8_SB(1, 1), b3 + hstepB);
            G8_WAIT_V(6); G8_BAR; G8_MMA(1, 1, At, B1); G8_BAR;
        }
        E(acc, cur, wr, wc, fr, fq);
        if (!has_next) break;
#pragma unroll
        for (int a = 0; a < 2; ++a)
#pragma unroll
            for (int b = 0; b < 2; ++b)
#pragma unroll
                for (int m = 0; m < 4; ++m)
#pragma unroll
                    for (int n = 0; n < 2; ++n) acc[a][b][m][n] = (f32x4_t){0.f, 0.f, 0.f, 0.f};
        cur = nxt; cB = nB; ++ui;
    }
    G8_WAIT_V(0);
    if (wr == 0) G8_BAR;
    G8_BAR;
#undef G8_SA
#undef G8_SB
#undef G8_STAGE_A
#undef G8_STAGE_B
#undef G8_LDA
#undef G8_LDB
#undef G8_MMA
#undef G8_WAIT_V
#undef G8_WAIT_L
#undef G8_BAR
#undef G8_SCHED
}
struct SchedPlain {
    int nM, nN, nwg, G, c, lda; const char* Bt; size_t ldb_bytes;
    __device__ __forceinline__ void init(int M, int N, int lda_, const void* Bt_, int ldb) { nM = M / 256; nN = N / 256; nwg = nM * nN; G = gridDim.x; c = blockIdx.x; lda = lda_; Bt = (const char*)Bt_; ldb_bytes = (size_t)ldb * 2; }
    __device__ __forceinline__ bool next(int i, Unit& u) const {
        const long L = (long)i * G + c; if (L >= nwg) return false;
        int wgid = (int)L; { const int q = nwg / 8, r = nwg % 8, xcd = wgid % 8, off = wgid / 8; wgid = (xcd < r ? xcd * (q + 1) : r * (q + 1) + (xcd - r) * q) + off; }
        const int nig = 8 * nN, gid = wgid / nig, fm = gid * 8, gsz = (nM - fm) < 8 ? (nM - fm) : 8;
        u.pm = fm + ((wgid % nig) % gsz); u.pn = (wgid % nig) / gsz; return true;
    }
    __device__ __forceinline__ void a_handles(const Unit& u, int tid, unsigned& h0, unsigned& h1) const {
        int R, C; stage_rc(tid * 16, R, C);
        h0 = ((unsigned)(u.pm * 256 + R) * (unsigned)lda + (unsigned)C) * 2u; h1 = h0 + (unsigned)(128 * lda) * 2u;
    }
    __device__ __forceinline__ unsigned a_off(unsigned h, int piece, int) const { return h + (unsigned)(piece * 64 * lda) * 2u; }
    __device__ __forceinline__ const char* b_base(const Unit& u) const { return Bt + (size_t)u.pn * 256 * ldb_bytes; }
    __device__ __forceinline__ void stash(const Unit&, int) const {}
    __device__ __forceinline__ void stash_wait() const {}
};
struct SchedMoe {
    const int* pre; const int* list; const float* listw; const char* Bt; size_t estride, ustride; int nunits, G, c, gather; int* tab;
    __device__ __forceinline__ int expert(int panel) const { int e = 0; for (int q = 1; q < 32; ++q) e = (pre[q] <= panel) ? q : e; return e; }
    __device__ __forceinline__ bool next(int i, Unit& u) const {
        const int per = (nunits + 7) >> 3, x = c & 7, Lx = i * (G >> 3) + (c >> 3), L = x * per + Lx;
        if (Lx >= per || L >= nunits) return false;
        u.pn = L & 3; u.pm = L >> 2; u.e = __builtin_amdgcn_readfirstlane(expert(u.pm)); return true;
    }
    __device__ __forceinline__ void stash(const Unit& u, int tid) const {
        const int e = u.e, b0 = (u.pm - pre[e]) * 256; const int* l = list + (size_t)e * T_TOK + b0;
        const int wv = __builtin_amdgcn_readfirstlane(tid >> 6);
        if (gather) {
            int R, C; stage_rc(tid * 16, R, C);
#pragma unroll
            for (int k = 0; k < 4; ++k)
                __builtin_amdgcn_global_load_lds((const unsigned*)(l + R + 64 * (k & 1) + 128 * (k >> 1)), (LAS unsigned*)((LAS unsigned char*)(LAS int*)tab + k * 2048 + wv * 256), 4, 0, 0);
        } else {
            const int r = tid & 255; const int* src = (tid < 256) ? (l + r) : reinterpret_cast<const int*>(listw + (size_t)e * T_TOK + b0 + r);
            __builtin_amdgcn_global_load_lds((const unsigned*)src, (LAS unsigned*)((LAS unsigned char*)(LAS int*)tab + u.par * 2048 + wv * 256), 4, 0, 0);
        }
    }
    __device__ __forceinline__ void stash_wait() const { asm volatile("s_waitcnt vmcnt(0)" ::: "memory"); }
    __device__ __forceinline__ void a_handles(const Unit& u, int tid, unsigned& h0, unsigned& h1) const {
        if (gather) {
            asm volatile("" ::: "memory");
            const unsigned t0 = ((unsigned)tab[tid] >> 1) & 16383u, t1 = ((unsigned)tab[512 + tid] >> 1) & 16383u, t2 = ((unsigned)tab[1024 + tid] >> 1) & 16383u, t3 = ((unsigned)tab[1536 + tid] >> 1) & 16383u;
            h0 = t0 | (t1 << 16); h1 = t2 | (t3 << 16);
        }
        else { int R, C; stage_rc(tid * 16, R, C); h0 = ((unsigned)(u.pm * 256 + R) * 512u + (unsigned)C) * 2u; h1 = h0 + 128u * 512u * 2u; }
    }
    __device__ __forceinline__ unsigned a_off(unsigned h, int piece, int tid) const {
        if (gather) { int R, C; stage_rc(tid * 16, R, C); return (((h >> (16 * piece)) & 0xffffu) * 1024u + (unsigned)C) * 2u; }
        return h + (unsigned)(piece * 64 * 512) * 2u;
    }
    __device__ __forceinline__ const char* b_base(const Unit& u) const { return Bt + (size_t)u.e * estride + (size_t)u.pn * ustride; }
};
}

__device__ __forceinline__ void convert_T(unsigned char* lds, const float* __restrict__ src, int nb, int K, int N, bf16_t* __restrict__ dst, size_t dst_bstride,
                                       const float* __restrict__ rowscale, int grp, int grp_stride, int off, int b0 = 0, int perm = 0, int rot = 0) {
    (void)lds;
    int tid = VT; asm volatile("" : "+v"(tid));
    const int lane = tid & 63, wid = tid >> 6;
    const int nkt = K >> 7, nnt = (N + 63) >> 6, per = nkt * nnt, total = nb * per;
    for (int it = (VB + NVB - rot % NVB) % NVB; it < total; it += NVB) {
        const int bl = it / per, b = b0 + bl, rem = it - bl * per, ktile = rem / nnt, ntile = rem - ktile * nnt;
        const int k0 = (ktile << 7) + (wid * 4 + (lane >> 4)) * 8, n = (ntile << 6) + (lane & 15) * 4;
        if (n < N) {
            const float* s = src + (size_t)b * K * N + (size_t)k0 * N + n;
            f32x4 v[8];
#pragma unroll
            for (int j = 0; j < 8; ++j) v[j] = *reinterpret_cast<const f32x4*>(s + (size_t)j * N);
            if (rowscale) {
#pragma unroll
                for (int j = 0; j < 8; ++j) { const float sc = rowscale[(size_t)b * K + k0 + j]; v[j] *= sc; }
            }
#pragma unroll
            for (int q = 0; q < 4; ++q) {
                const int nn = n + q; int drow = (nn / grp) * grp_stride + off + (nn % grp);
                if (perm == 1) { const int l = drow & 127; drow = (drow & ~127) | (32 * ((l >> 4) & 3) + 16 * (l >> 6) + (l & 15)); }
                if (perm == 3) { const int l = drow & 31; drow = (drow & ~31) | (16 * ((l >> 2) & 1) + 4 * (l >> 3) + (l & 3)); }
                else if (perm == 2) { const int l = drow & 63; drow = (drow & ~63) | (32 * ((l >> 4) & 1) + 16 * (l >> 5) + (l & 15)); }
                *reinterpret_cast<uint4*>(dst + (size_t)b * dst_bstride + (size_t)drow * K + k0) = cvtpk8(v[0][q], v[1][q], v[2][q], v[3][q], v[4][q], v[5][q], v[6][q], v[7][q]);
            }
        }
    }
}

__device__ __forceinline__ void job_mod(PRef p, unsigned char* lds) {
    int tid = VT; asm volatile("" : "+v"(tid));
    const int lane = tid & 63, wid = tid >> 6;
    float* sc = reinterpret_cast<float*>(lds);
    float* part = reinterpret_cast<float*>(lds + 32768);
    for (int i = tid; i < 8192; i += NTHR) { const int b = i >> 10, k = i & 1023; const float v = p.c[b * 1024 + k]; sc[k * 8 + b] = v / (1.f + expf(-v)); }
    __syncthreads();
    for (int it = VB; it < 384; it += NVB) {
        const int sl = it / 48, n0 = (it % 48) * 64;
        const int lgk = lane >> 4, lc4 = (lane & 15) * 4;
        const float* W = p.ada_w + (size_t)sl * 1024 * 3072 + n0 + lc4;
        f32x4 acc[8];
#pragma unroll
        for (int b = 0; b < 8; ++b) acc[b] = (f32x4){0.f, 0.f, 0.f, 0.f};
        const int kb = wid * 256 + lgk * 64;
#pragma unroll 8
        for (int k = 0; k < 64; ++k) {
            const f32x4 w = *reinterpret_cast<const f32x4*>(W + (size_t)(kb + k) * 3072);
            const f32x4 s0 = *reinterpret_cast<const f32x4*>(sc + (kb + k) * 8), s1 = *reinterpret_cast<const f32x4*>(sc + (kb + k) * 8 + 4);
            acc[0] += s0[0] * w; acc[1] += s0[1] * w; acc[2] += s0[2] * w; acc[3] += s0[3] * w;
            acc[4] += s1[0] * w; acc[5] += s1[1] * w; acc[6] += s1[2] * w; acc[7] += s1[3] * w;
        }
#pragma unroll
        for (int b = 0; b < 8; ++b)
#pragma unroll
            for (int q = 0; q < 4; ++q) {
                float v = acc[b][q];
                v += __shfl_xor(v, 16, 64); v += __shfl_xor(v, 32, 64);
                if (lgk == 0) part[(wid * 8 + b) * 64 + lc4 + q] = v;
            }
        __syncthreads();
        for (int o = tid; o < 512; o += NTHR) {
            const int b = o >> 6, l = o & 63;
            const float s = part[(0 * 8 + b) * 64 + l] + part[(1 * 8 + b) * 64 + l] + part[(2 * 8 + b) * 64 + l] + part[(3 * 8 + b) * 64 + l] + p.ada_b[sl * 3072 + n0 + l];
            p.mod[(size_t)(sl * 8 + b) * 3072 + n0 + l] = s;
        }
        __syncthreads();
    }
}

__device__ __forceinline__ void job_misc(PRef p, unsigned char* lds) {
    const int tid = VT;
    const size_t gtid = (size_t)VB * NTHR + tid, gsz = (size_t)NVB * NTHR;
    for (size_t i = gtid; i < (size_t)T_TOK * 32; i += gsz) {
        const int t = (int)(i >> 5), f = (int)(i & 31);
        const float inv = 1.0f / powf(10000.f, (float)(2 * f) / 64.f);
        const float ang = (float)p.pos[t] * inv;
        p.cosm[i] = cosf(ang); p.sinm[i] = sinf(ang);
    }
    for (size_t i = gtid; i < (size_t)T_TOK * 64; i += gsz) {
        const int t = (int)(i >> 6), f = (int)(i & 63);
        const float inv = 1.0f / powf(10000.f, (float)(2 * f) / 128.f);
        const float ang = (float)p.pos[t] * inv;
        p.cosn[i] = cosf(ang); p.sinn[i] = sinf(ang);
    }
    for (size_t i = gtid; i < (size_t)DEPTH * 1024 * 48; i += gsz) {
        const int e = (int)(i % 48); const size_t lk = i / 48;
        float v = 0.f;
        if (e < 4) v = p.moe_w_grp[lk * 4 + e]; else if (e < 36) v = p.moe_w_rt[lk * 32 + (e - 4)];
        p.wr[(((size_t)(lk >> 10) * 256 + ((lk & 1023) >> 2)) * 48 + e) * 4 + (lk & 3)] = v;
    }
    if (gtid < DEPTH * 32) p.cnt[gtid * 64] = 0;
    {
        const int lane = tid & 63, wid = tid >> 6;
        for (int o = VB * 4 + wid; o < 256; o += NVB * 4) {
            const int which = o >> 7, e = o & 127;
            const float* pe = which ? p.nsa_pe_v : p.nsa_pe_k; const float* w1 = which ? p.nsa_w_cv1 : p.nsa_w_ck1;
            float a = 0.f;
#pragma unroll 16
            for (int j = 0; j < 64; ++j) { const int k = lane + 64 * j; a += pe[k] * w1[(size_t)k * 128 + e]; }
            a = wave_sum(a);
            if (lane == 0) p.bias1[o] = a;
        }
    }
}

struct CvtJob { const float* src; int nb, K, N; bf16_t* dst; size_t bstride; const float* rowscale; int grp, gstride, off, perm; };
__device__ __forceinline__ CvtJob cvt_job(PRef p, int j) {
    const int BIG = 1 << 30;
    CvtJob c;
    switch (j) {
    case 0:  c = CvtJob{p.moe_w_gate, DEPTH * 32, 1024, 512, p.wt_gu, (size_t)1024 * 1024, nullptr, 64, 128, 0, 0}; break;
    case 1:  c = CvtJob{p.moe_w_up, DEPTH * 32, 1024, 512, p.wt_gu, (size_t)1024 * 1024, nullptr, 64, 128, 64, 0}; break;
    case 2:  c = CvtJob{p.moe_w_down, DEPTH * 32, 512, 1024, p.wt_dn, (size_t)1024 * 512, nullptr, BIG, 0, 0, 0}; break;
    case 3:  c = CvtJob{p.mla_w_in, 2, 1024, 576, p.wt_mla_in, (size_t)768 * 1024, nullptr, BIG, 0, 0, 2}; break;
    case 4:  c = CvtJob{p.mla_w_uq, 2, 256, 1536, p.wt_uq, (size_t)1536 * 256, p.mla_g_q, BIG, 0, 0, 2}; break;
    case 5:  c = CvtJob{p.mla_w_ukv, 2, 256, 2048, p.wt_ukv, (size_t)2048 * 256, p.mla_g_kv, BIG, 0, 0, 3}; break;
    case 6:  c = CvtJob{p.mla_w_o, 2, 1024, 1024, p.wt_mla_o, (size_t)1024 * 1024, nullptr, BIG, 0, 0, 3}; break;
    case 7:  c = CvtJob{p.nsa_w_in, 1, 1024, 2584, p.wt_nsa_in, 0, nullptr, BIG, 0, 0, 1}; break;
    case 8:  c = CvtJob{p.nsa_w_ck1, 1, 4096, 128, p.wt_ck1, 0, nullptr, BIG, 0, 0, 0}; break;
    case 9:  c = CvtJob{p.nsa_w_cv1, 1, 4096, 128, p.wt_cv1, 0, nullptr, BIG, 0, 0, 0}; break;
    case 10: c = CvtJob{p.nsa_w_ck2, 1, 128, 128, p.wt_ck2, 0, nullptr, BIG, 0, 0, 0}; break;
    case 11: c = CvtJob{p.nsa_w_cv2, 1, 128, 128, p.wt_cv2, 0, nullptr, BIG, 0, 0, 0}; break;
    case 12: c = CvtJob{p.nsa_w_o, 1, 1024, 1024, p.wt_nsa_o, 0, nullptr, BIG, 0, 0, 3}; break;
    case 13: c = CvtJob{p.sb_w_qkv, 1, 1024, 3072, p.wt_sb_qkv, 0, nullptr, BIG, 0, 0, 3}; break;
    default: c = CvtJob{p.sb_w_o, 1, 1024, 1024, p.wt_sb_o, 0, nullptr, BIG, 0, 0, 3}; break;
    }
    return c;
}
template <int K, int N, int grp, int grp_stride, int perm>
__device__ __forceinline__ void convert_T_steal(int* ctr, const float* __restrict__ src, bf16_t* __restrict__ dst, int off, int b0) {
    constexpr int nb = 32; constexpr size_t dst_bstride = (size_t)K * N * (grp_stride ? 2 : 1);
    int tid = threadIdx.x; asm volatile("" : "+v"(tid));
    const int lane = tid & 63;
    constexpr int nkt = K >> 7, nnt = N >> 6, per = nkt * nnt, total = nb * per * 4;
    static_assert(total % 128 == 0, "32 equal parts in whole chunks");
    const int xq = (int)(blockIdx.x & 31u), wend = (xq + 1) * (total / 32);
    int* qh = ctr + xq * 16;
    for (;;) {
        int w0 = 0;
        if (lane == 0) w0 = __hip_atomic_fetch_add(qh, 1, __ATOMIC_RELAXED, __HIP_MEMORY_SCOPE_AGENT);
        w0 = __builtin_amdgcn_readfirstlane(w0) + xq * (total / 32);
        if (w0 >= wend) break;
#pragma unroll 1
        for (int w = w0; w < w0 + 1; ++w) {
            const int it = w >> 2, wq = w & 3;
            const int bl = it / per, b = b0 + bl, rem = it - bl * per, ktile = rem / nnt, ntile = rem - ktile * nnt;
            const int k0 = (ktile << 7) + (wq * 4 + (lane >> 4)) * 8, n = (ntile << 6) + (lane & 15) * 4;
            const float* sp = src + (size_t)b * K * N + (size_t)k0 * N + n;
            f32x4 v[8];
#pragma unroll
            for (int j = 0; j < 8; ++j) v[j] = *reinterpret_cast<const f32x4*>(sp + (size_t)j * N);
#pragma unroll
            for (int q = 0; q < 4; ++q) {
                const int nn = n + q; int drow = (nn / grp) * grp_stride + off + (nn % grp);
                if (perm == 1) { const int l = drow & 127; drow = (drow & ~127) | (32 * ((l >> 4) & 3) + 16 * (l >> 6) + (l & 15)); }
                if (perm == 3) { const int l = drow & 31; drow = (drow & ~31) | (16 * ((l >> 2) & 1) + 4 * (l >> 3) + (l & 3)); }
                *reinterpret_cast<uint4*>(dst + (size_t)b * dst_bstride + (size_t)drow * K + k0) = cvtpk8(v[0][q], v[1][q], v[2][q], v[3][q], v[4][q], v[5][q], v[6][q], v[7][q]);
            }
        }
    }
}
__device__ __forceinline__ void convert_moe_steal(PRef p, int layer, int which) {
    int* ctr = p.wq + (layer * 3 + which) * 512;
    if (which == 0) convert_T_steal<1024, 512, 128, 256, 3>(ctr, p.moe_w_gate, p.wt_gu, 0, layer * 32);
    else if (which == 1) convert_T_steal<1024, 512, 128, 256, 3>(ctr, p.moe_w_up, p.wt_gu, 128, layer * 32);
    else convert_T_steal<512, 1024, 1 << 30, 0, 3>(ctr, p.moe_w_down, p.wt_dn, 0, layer * 32);
}
__device__ __forceinline__ void convert_moe(PRef p, int layer, int which) {
    if (which == 0) convert_T(nullptr, p.moe_w_gate, 32, 1024, 512, p.wt_gu, (size_t)1024 * 1024, nullptr, 128, 256, 0, layer * 32, 3);
    else if (which == 1) convert_T(nullptr, p.moe_w_up, 32, 1024, 512, p.wt_gu, (size_t)1024 * 1024, nullptr, 128, 256, 128, layer * 32, 3);
    else convert_T(nullptr, p.moe_w_down, 32, 512, 1024, p.wt_dn, (size_t)1024 * 512, nullptr, 1 << 30, 0, 0, layer * 32, 3);
}
__device__ __forceinline__ void ph_prologue(PRef p) {
    unsigned char* lds = VLDS;
    job_mod(p, lds);
    job_misc(p, lds);
    int rot = 384;
    for (int j = 3; j < 15; ++j) {
        const CvtJob c = cvt_job(p, j);
        convert_T(lds, c.src, c.nb, c.K, c.N, c.dst, c.bstride, c.rowscale, c.grp, c.gstride, c.off, 0, c.perm, rot);
        rot = (rot + c.nb * (c.K >> 7) * ((c.N + 63) >> 6)) % NVB;
    }
    for (int w = 0; w < 2; ++w) convert_moe_steal(p, 0, w);
}

__device__ __forceinline__ void ph_h0(PRef p) {
    const size_t gtid = (size_t)VB * NTHR + VT, gsz = (size_t)NVB * NTHR;
    for (size_t i = gtid; i < (size_t)T_TOK * 128; i += gsz) {
        const int row = (int)(i >> 7), c0 = (int)(i & 127) * 8, b = row >> 11;
        const float* xs = p.x + (size_t)row * 1024 + c0; const float* sh = p.mod + (size_t)b * 3072 + c0; const float* scp = sh + 1024;
        const f32x4 x0 = *reinterpret_cast<const f32x4*>(xs), x1 = *reinterpret_cast<const f32x4*>(xs + 4), h0 = *reinterpret_cast<const f32x4*>(sh), h1 = *reinterpret_cast<const f32x4*>(sh + 4);
        const f32x4 s0 = *reinterpret_cast<const f32x4*>(scp), s1 = *reinterpret_cast<const f32x4*>(scp + 4);
        float v[8];
#pragma unroll
        for (int q = 0; q < 4; ++q) { v[q] = x0[q] * (1.f + s0[q]) + h0[q]; v[4 + q] = x1[q] * (1.f + s1[q]) + h1[q]; }
        *reinterpret_cast<uint4*>(p.hbuf + (size_t)row * 1024 + c0) = pack8(v);
    }
}

__device__ __forceinline__ void st4bf(bf16_t* p, float a, float b, float c, float d) { uint2 pk; pk.x = cvtpk(a, b); pk.y = cvtpk(c, d); *reinterpret_cast<uint2*>(p) = pk; }
__device__ __forceinline__ int vt_pos(int s) { return (s & ~12) | ((s & 4) << 1) | ((s & 8) >> 1); }
__device__ __forceinline__ void st_vt4(bf16_t* vt_feat0  , const g8::f32x4_t& a, float sc) {
#pragma unroll
    for (int q = 0; q < 4; ++q) vt_feat0[(size_t)q * SEQ] = (bf16_t)(cvtpk(a[q] * sc, 0.f) & 0xffffu);
}
struct EpiMlaIn {
    bf16_t* cbuf; float* rss; bf16_t* krope; const float* cosm; const float* sinm;
    __device__ __forceinline__ void operator()(const g8::f32x4_t (&acc)[2][2][4][2], const g8::Unit& u, int wr, int wc, int fr, int fq) const {
        const int lc = 64 * (wc >> 1) + 16 * (wc & 1) + 4 * fq;
#pragma unroll
        for (int ai = 0; ai < 2; ++ai) {
            f32x4 csb[4], snb[4];
            if (u.pn >= 2 && wc < 2) {
#pragma unroll
                for (int m = 0; m < 4; ++m) {
                    const int row = u.pm * 256 + ai * 128 + wr * 64 + m * 16 + fr, i0 = 16 * wc + 4 * fq;
                    csb[m] = *reinterpret_cast<const f32x4*>(cosm + (size_t)row * 32 + i0); snb[m] = *reinterpret_cast<const f32x4*>(sinm + (size_t)row * 32 + i0);
                }
            }
#pragma unroll
            for (int m = 0; m < 4; ++m) {
                const int row = u.pm * 256 + ai * 128 + wr * 64 + m * 16 + fr;
                if (u.pn < 2) {
                    float sq = 0.f;
#pragma unroll
                    for (int bj = 0; bj < 2; ++bj)
#pragma unroll
                        for (int n = 0; n < 2; ++n) {
                            const g8::f32x4_t a = acc[ai][bj][m][n];
                            st4bf(cbuf + (size_t)row * 512 + u.pn * 256 + bj * 128 + lc + 32 * n, a[0], a[1], a[2], a[3]);
                            sq += a[0] * a[0] + a[1] * a[1] + a[2] * a[2] + a[3] * a[3];
                        }
                    sq += __shfl_xor(sq, 16, 64); sq += __shfl_xor(sq, 32, 64);
                    if (fq == 0) rss[(size_t)row * 8 + u.pn * 4 + wc] = sq;
                } else if (wc < 2) {
                    const int i0 = 16 * wc + 4 * fq;
                    const f32x4 cs = csb[m], sn = snb[m];
                    const g8::f32x4_t x1 = acc[ai][0][m][0], x2 = acc[ai][0][m][1];
                    st4bf(krope + (size_t)row * 64 + i0, x1[0] * cs[0] - x2[0] * sn[0], x1[1] * cs[1] - x2[1] * sn[1], x1[2] * cs[2] - x2[2] * sn[2], x1[3] * cs[3] - x2[3] * sn[3]);
                    st4bf(krope + (size_t)row * 64 + 32 + i0, x2[0] * cs[0] + x1[0] * sn[0], x2[1] * cs[1] + x1[1] * sn[1], x2[2] * cs[2] + x1[2] * sn[2], x2[3] * cs[3] + x1[3] * sn[3]);
                }
            }
        }
    }
};
__device__ __forceinline__ void ph_mla_in(PRef p, int j) {
    g8::SchedPlain S; S.init(T_TOK, 768, 1024, p.wt_mla_in + (size_t)j * 768 * 1024, 1024);
    g8::gemm8((LAS unsigned char*)(smem + LDS_WORK), (const char*)p.hbuf, 1024, 1024, S, EpiMlaIn{p.cbuf, p.rss, p.krope, p.cosm, p.sinm});
    __syncthreads();
}
__device__ __forceinline__ float mla_rstd(const float* rss, int row, int which) {
    const f32x4 q = *reinterpret_cast<const f32x4*>(rss + (size_t)row * 8 + which * 4);
    return rsqrtf((q[0] + q[1] + q[2] + q[3]) * (1.f / 256.f) + RMS_EPS);
}
struct EpiMlaQ {
    bf16_t* qm; const float* rss; const float* cosm; const float* sinm;
    __device__ __forceinline__ void operator()(const g8::f32x4_t (&acc)[2][2][4][2], const g8::Unit& u, int wr, int wc, int fr, int fq) const {
        const int i0 = 16 * (wc & 1) + 4 * fq;
#pragma unroll
        for (int ai = 0; ai < 2; ++ai) {
            f32x4 qs[4], csb[4], snb[4];
#pragma unroll
            for (int m = 0; m < 4; ++m) {
                const int row = u.pm * 256 + ai * 128 + wr * 64 + m * 16 + fr;
                qs[m] = *reinterpret_cast<const f32x4*>(rss + (size_t)row * 8);
                csb[m] = *reinterpret_cast<const f32x4*>(cosm + (size_t)row * 32 + i0); snb[m] = *reinterpret_cast<const f32x4*>(sinm + (size_t)row * 32 + i0);
            }
#pragma unroll
            for (int m = 0; m < 4; ++m) {
                const int row = u.pm * 256 + ai * 128 + wr * 64 + m * 16 + fr;
                const float sc = rsqrtf((qs[m][0] + qs[m][1] + qs[m][2] + qs[m][3]) * (1.f / 256.f) + RMS_EPS);
                const f32x4 cs = csb[m], sn = snb[m];
#pragma unroll
                for (int bj = 0; bj < 2; ++bj) {
                    const int c64 = u.pn * 256 + bj * 128 + 64 * (wc >> 1);
                    bf16_t* dst = qm + (size_t)row * 1536 + c64 + i0;
                    const g8::f32x4_t x1 = acc[ai][bj][m][0], x2 = acc[ai][bj][m][1];
                    if ((c64 % 192) == 128) {
                        st4bf(dst, (x1[0] * cs[0] - x2[0] * sn[0]) * sc, (x1[1] * cs[1] - x2[1] * sn[1]) * sc, (x1[2] * cs[2] - x2[2] * sn[2]) * sc, (x1[3] * cs[3] - x2[3] * sn[3]) * sc);
                        st4bf(dst + 32, (x2[0] * cs[0] + x1[0] * sn[0]) * sc, (x2[1] * cs[1] + x1[1] * sn[1]) * sc, (x2[2] * cs[2] + x1[2] * sn[2]) * sc, (x2[3] * cs[3] + x1[3] * sn[3]) * sc);
                    } else {
                        st4bf(dst, x1[0] * sc, x1[1] * sc, x1[2] * sc, x1[3] * sc);
                        st4bf(dst + 32, x2[0] * sc, x2[1] * sc, x2[2] * sc, x2[3] * sc);
                    }
                }
            }
        }
    }
};
struct EpiMlaKv {
    bf16_t* kn; bf16_t* vt; const float* rss;
    __device__ __forceinline__ void operator()(const g8::f32x4_t (&acc)[2][2][4][2], const g8::Unit& u, int wr, int wc, int fr, int fq) const {
        const int hd = u.pn;
#pragma unroll
        for (int ai = 0; ai < 2; ++ai) {
            f32x4 qs[4];
#pragma unroll
            for (int m = 0; m < 4; ++m) qs[m] = *reinterpret_cast<const f32x4*>(rss + (size_t)(u.pm * 256 + ai * 128 + wr * 64 + m * 16 + fr) * 8 + 4);
#pragma unroll
            for (int m = 0; m < 4; ++m) {
                const int row = u.pm * 256 + ai * 128 + wr * 64 + m * 16 + fr, b = row >> 11, sq = row & 2047;
                const float sc = rsqrtf((qs[m][0] + qs[m][1] + qs[m][2] + qs[m][3]) * (1.f / 256.f) + RMS_EPS);
                const int c = 32 * wc + 8 * fq;
                const g8::f32x4_t k0 = acc[ai][0][m][0], k1 = acc[ai][0][m][1];
                *reinterpret_cast<uint4*>(kn + (size_t)row * 1024 + hd * 128 + c) = cvtpk8(k0[0] * sc, k0[1] * sc, k0[2] * sc, k0[3] * sc, k1[0] * sc, k1[1] * sc, k1[2] * sc, k1[3] * sc);
#pragma unroll
                for (int n = 0; n < 2; ++n) st_vt4(vt + ((size_t)(b * 8 + hd) * 128 + c + 4 * n) * SEQ + vt_pos(sq), acc[ai][1][m][n], sc);
            }
        }
    }
};
__device__ __forceinline__ void ph_mla_up(PRef p, int j) {
    { g8::SchedPlain S; S.init(T_TOK, 1536, 512, p.wt_uq + (size_t)j * 1536 * 256, 256);
      g8::gemm8((LAS unsigned char*)(smem + LDS_WORK), (const char*)p.cbuf, 256, 256, S, EpiMlaQ{p.qm, p.rss, p.cosm, p.sinm}); }
    { g8::SchedPlain S; S.init(T_TOK, 2048, 512, p.wt_ukv + (size_t)j * 2048 * 256, 256);
      g8::gemm8((LAS unsigned char*)(smem + LDS_WORK), (const char*)(p.cbuf + 256), 256, 256, S, EpiMlaKv{p.kn, p.vt, p.rss}); }
    __syncthreads();
}
struct EpiNsaIn {
    PRef p;
    __device__ __forceinline__ void operator()(const g8::f32x4_t (&acc)[2][2][4][2], const g8::Unit& u, int wr, int wc, int fr, int fq) const {
        const int i0 = 16 * wc + 4 * fq;
        const bool rot = (u.pn < 5) || u.pn == 6 || u.pn == 8;
#pragma unroll
        for (int ai = 0; ai < 2; ++ai) {
            f32x4 cs[4], sn[4];
            if (rot) {
#pragma unroll
                for (int m = 0; m < 4; ++m) {
                    const int row = u.pm * 256 + ai * 128 + wr * 64 + m * 16 + fr;
                    cs[m] = *reinterpret_cast<const f32x4*>(p.cosn + (size_t)row * 64 + i0); sn[m] = *reinterpret_cast<const f32x4*>(p.sinn + (size_t)row * 64 + i0);
                }
            }
#pragma unroll
            for (int bj = 0; bj < 2; ++bj) {
                const int tn = 2 * u.pn + bj;
                if (tn >= 21) continue;
#pragma unroll
                for (int m = 0; m < 4; ++m) {
                    const int row = u.pm * 256 + ai * 128 + wr * 64 + m * 16 + fr, b = row >> 11, sq = row & 2047;
                    const g8::f32x4_t x1 = acc[ai][bj][m][0], x2 = acc[ai][bj][m][1];
                    if (tn == 20) {
                        if (i0 < 24) {
#pragma unroll
                            for (int q = 0; q < 4; ++q) { const int c = i0 + q; p.gates[(size_t)row * 32 + (c / 3) * 4 + (c % 3)] = sigmoid_f(x1[q]); }
                        }
                        continue;
                    }
                    const int g = (tn - 8) >> 1, kh = (tn - 8) & 1;
                    const size_t slab = (size_t)(b * 2 + kh) * SEQ * 128;
                    if (tn >= 8 && (g == 3 || g == 5)) {
                        bf16_t* vt = (g == 3 ? p.vst : p.vwt) + slab + vt_pos(sq);
                        st_vt4(vt + (size_t)i0 * SEQ, x1, 1.f); st_vt4(vt + (size_t)(i0 + 64) * SEQ, x2, 1.f);
                    } else if (tn >= 8 && g == 1) {
                        bf16_t* dst = p.vc + slab + (size_t)sq * 128 + i0;
                        st4bf(dst, x1[0], x1[1], x1[2], x1[3]); st4bf(dst + 64, x2[0], x2[1], x2[2], x2[3]);
                    } else {
                        bf16_t* dst = (tn < 8) ? p.qn + (size_t)row * 1024 + tn * 128 + i0 : (g == 0 ? p.kc : (g == 2 ? p.ks : p.kw)) + slab + (size_t)sq * 128 + i0;
                        const f32x4 c_ = cs[m], s_ = sn[m];
                        st4bf(dst, x1[0] * c_[0] - x2[0] * s_[0], x1[1] * c_[1] - x2[1] * s_[1], x1[2] * c_[2] - x2[2] * s_[2], x1[3] * c_[3] - x2[3] * s_[3]);
                        st4bf(dst + 64, x2[0] * c_[0] + x1[0] * s_[0], x2[1] * c_[1] + x1[1] * s_[1], x2[2] * c_[2] + x1[2] * s_[2], x2[3] * c_[3] + x1[3] * s_[3]);
                    }
                }
            }
        }
    }
};
__device__ __forceinline__ void ph_nsa_in(PRef p) {
    g8::SchedPlain S; S.init(T_TOK, 2816, 1024, p.wt_nsa_in, 1024);
    g8::gemm8((LAS unsigned char*)(smem + LDS_WORK), (const char*)p.hbuf, 1024, 1024, S, EpiNsaIn{p});
    __syncthreads();
}
struct RowWin { const bf16_t* base; __device__ __forceinline__ const bf16_t* operator()(int r) const { return base + (size_t)r * 2048; } };
__device__ __forceinline__ void ph_nsa_cmp1(PRef p) {
    unsigned char* lds = VLDS; const float* Cs = reinterpret_cast<const float*>(lds);
    for (int it = VB; it < 256; it += NVB) {
        const int item = it >> 3, sp = it & 7, which = item & 1, bkh = item >> 1;
        const bf16_t* src = (which ? p.vc : p.kc) + (size_t)bkh * SEQ * 128 + sp * 512;
        int tid = VT; asm volatile("" : "+v"(tid));
        f32x16 acc[2][2];
        gemm_main(tid, lds, RowWin{src}, (which ? p.wt_cv1 : p.wt_ck1) + sp * 512, 4096, 0, 512, acc);
        float* dst = p.cpart + (size_t)(item * 8 + sp) * 128 * 128;
        const int c0 = (tid & 15) * 8;
#pragma unroll
        for (int ps = 0; ps < 8; ++ps) {
            const int row = (tid >> 4) + 16 * ps;
            *reinterpret_cast<f32x4*>(dst + row * 128 + c0) = *reinterpret_cast<const f32x4*>(Cs + row * CS_LD + c0);
            *reinterpret_cast<f32x4*>(dst + row * 128 + c0 + 4) = *reinterpret_cast<const f32x4*>(Cs + row * CS_LD + c0 + 4);
        }
        ITEM_END_SYNC();
    }
}
__device__ __forceinline__ void ph_nsa_cmp2(PRef p) {
    unsigned char* lds = VLDS; const float* Cs = reinterpret_cast<const float*>(lds);
    for (int item = VB; item < 32; item += NVB) {
        const int which = item & 1, bkh = item >> 1;
        int tid = VT; asm volatile("" : "+v"(tid));
        bf16_t* hid = p.hid + (size_t)item * 128 * 128;
        for (int o = tid; o < 128 * 16; o += NTHR) {
            const int row = o >> 4, c0 = (o & 15) * 8; float v[8];
#pragma unroll
            for (int q = 0; q < 8; ++q) v[q] = p.bias1[which * 128 + c0 + q];
            for (int sp = 0; sp < 8; ++sp) {
                const float* src = p.cpart + (size_t)(item * 8 + sp) * 128 * 128 + row * 128 + c0;
#pragma unroll
                for (int q = 0; q < 8; ++q) v[q] += src[q];
            }
#pragma unroll
            for (int q = 0; q < 8; ++q) v[q] = silu_f(v[q]);
            *reinterpret_cast<uint4*>(hid + row * 128 + c0) = pack8(v);
        }
        __threadfence();
        __syncthreads();
        f32x16 acc[2][2];
        gemm_main(tid, lds, RowPlain{hid, 128}, which ? p.wt_cv2 : p.wt_ck2, 128, 0, 128, acc);
        if (!which) {
            const int c0 = (tid & 15) * 8;
#pragma unroll
            for (int ps = 0; ps < 8; ++ps) {
                const int row = (tid >> 4) + 16 * ps; float v[8]; cs_load8(Cs, row, c0, v);
                if (row == 127) {
#pragma unroll
                    for (int q = 0; q < 8; ++q) v[q] = 0.f; }
                *reinterpret_cast<uint4*>(p.kcmp + (size_t)bkh * 128 * 128 + row * 128 + c0) = pack8(v);
            }
        } else {
            const int dv = tid & 127, sh = tid >> 7;
#pragma unroll
            for (int jj = 0; jj < 8; ++jj) {
                float v[8];
#pragma unroll
                for (int q = 0; q < 8; ++q) { const int row = vt_pos(sh * 64 + jj * 8 + q); v[q] = (row == 127) ? 0.f : Cs[row * CS_LD + dv]; }
                *reinterpret_cast<uint4*>(p.vcmpt + (size_t)bkh * 128 * 128 + dv * 128 + sh * 64 + jj * 8) = pack8(v);
            }
        }
        ITEM_END_SYNC();
    }
}
struct EpiSbIn {
    bf16_t* qs; bf16_t* ksb; bf16_t* vt;
    __device__ __forceinline__ void operator()(const g8::f32x4_t (&acc)[2][2][4][2], const g8::Unit& u, int wr, int wc, int fr, int fq) const {
#pragma unroll
        for (int ai = 0; ai < 2; ++ai)
#pragma unroll
            for (int m = 0; m < 4; ++m) {
                const int row = u.pm * 256 + ai * 128 + wr * 64 + m * 16 + fr, b = row >> 11, sq = row & 2047;
#pragma unroll
                for (int bj = 0; bj < 2; ++bj) {
                    const int c = (u.pn & 3) * 256 + bj * 128 + 32 * wc + 8 * fq;
                    const g8::f32x4_t a = acc[ai][bj][m][0], d = acc[ai][bj][m][1];
                    if (u.pn < 8) *reinterpret_cast<uint4*>((u.pn < 4 ? qs : ksb) + (size_t)row * 1024 + c) = cvtpk8(a[0], a[1], a[2], a[3], d[0], d[1], d[2], d[3]);
                    else { st_vt4(vt + ((size_t)b * 1024 + c) * SEQ + vt_pos(sq), a, 1.f); st_vt4(vt + ((size_t)b * 1024 + c + 4) * SEQ + vt_pos(sq), d, 1.f); }
                }
            }
    }
};
__device__ __forceinline__ void ph_sb_in(PRef p) {
    g8::SchedPlain S; S.init(T_TOK, 3072, 1024, p.wt_sb_qkv, 1024);
    g8::gemm8((LAS unsigned char*)(smem + LDS_WORK), (const char*)p.hbuf, 1024, 1024, S, EpiSbIn{p.qs, p.ksb, p.vt});
    __syncthreads();
}
template <bool XF32> struct EpiWo {
    const float* xs; const f16_t* xh; f16_t* z; const float* mod; int L;
    __device__ __forceinline__ void operator()(const g8::f32x4_t (&acc)[2][2][4][2], const g8::Unit& u, int wr, int wc, int fr, int fq) const {
        const int row0 = u.pm * 256 + wr * 64 + fr, col0 = u.pn * 256 + wc * 32 + 8 * fq, b = (u.pm * 256) >> 11;
        const float* gate = mod + (size_t)((L * 2 + 0) * 8 + b) * 3072 + 2048 + col0;
        f32x4 gv[2][2];
#pragma unroll
        for (int bj = 0; bj < 2; ++bj)
#pragma unroll
            for (int n = 0; n < 2; ++n) gv[bj][n] = *reinterpret_cast<const f32x4*>(gate + bj * 128 + n * 4);
#pragma unroll
        for (int ai = 0; ai < 2; ++ai) {
            f32x4 xv[4][2][2];
#pragma unroll
            for (int m = 0; m < 4; ++m)
#pragma unroll
                for (int bj = 0; bj < 2; ++bj) {
                    const size_t o = (size_t)(row0 + ai * 128 + m * 16) * 1024 + col0 + bj * 128;
                    if (XF32) { xv[m][bj][0] = *reinterpret_cast<const f32x4*>(xs + o); xv[m][bj][1] = *reinterpret_cast<const f32x4*>(xs + o + 4); }
                    else { const f16x8 hx = *reinterpret_cast<const f16x8*>(xh + o); const f32x8 fx = __builtin_convertvector(hx, f32x8); xv[m][bj][0] = (f32x4){fx[0], fx[1], fx[2], fx[3]}; xv[m][bj][1] = (f32x4){fx[4], fx[5], fx[6], fx[7]}; }
                }
#pragma unroll
            for (int m = 0; m < 4; ++m)
#pragma unroll
                for (int bj = 0; bj < 2; ++bj) {
                    f32x8 zv;
#pragma unroll
                    for (int n = 0; n < 2; ++n)
#pragma unroll
                        for (int q = 0; q < 4; ++q) zv[n * 4 + q] = DN_ALPHA * xv[m][bj][n][q] + gv[bj][n][q] * acc[ai][bj][m][n][q];
                    *reinterpret_cast<f16x8*>(z + (size_t)(row0 + ai * 128 + m * 16) * 1024 + col0 + bj * 128) = __builtin_convertvector(zv, f16x8);
                }
        }
    }
};
__device__ __forceinline__ void ph_wo(PRef p, int L) {
    const int kind = L % 3, j = L / 3;
    const bf16_t* Bt = kind == 0 ? p.wt_mla_o + (size_t)j * 1024 * 1024 : (kind == 1 ? p.wt_nsa_o : p.wt_sb_o);
    g8::SchedPlain S; S.init(T_TOK, 1024, 1024, Bt, 1024);
    if (L == 0) g8::gemm8((LAS unsigned char*)(smem + LDS_WORK), (const char*)p.obuf, 1024, 1024, S, EpiWo<true>{p.x, p.xbuf, p.zbuf, p.mod, L});
    else g8::gemm8((LAS unsigned char*)(smem + LDS_WORK), (const char*)p.obuf, 1024, 1024, S, EpiWo<false>{p.x, p.xbuf, p.zbuf, p.mod, L});
}

#define LNC(i) (lane * 8 + 512 * ((i) >> 1) + 4 * ((i) & 1))
__device__ __forceinline__ void ln_row(float (&v)[16], const f32x4 (&gg)[4], const f32x4 (&bb)[4]) {
    float s = 0.f;
#pragma unroll
    for (int q = 0; q < 16; ++q) s += v[q];
    const float mu = wave_sum(s) * (1.f / 1024.f);
    float s2 = 0.f;
#pragma unroll
    for (int q = 0; q < 16; ++q) { const float d = v[q] - mu; s2 += d * d; }
    const float rstd = rsqrtf(wave_sum(s2) * (1.f / 1024.f) + LN_EPS);
#pragma unroll
    for (int i = 0; i < 4; ++i)
#pragma unroll
        for (int q = 0; q < 4; ++q) v[i * 4 + q] = (v[i * 4 + q] - mu) * rstd * gg[i][q] + bb[i][q];
}
__device__ __forceinline__ void ld8h_f(const uint4& w, float* v) { const f32x8 f = __builtin_convertvector(*reinterpret_cast<const f16x8*>(&w), f32x8);
#pragma unroll
    for (int q = 0; q < 8; ++q) v[q] = f[q]; }
__device__ __forceinline__ uint4 pk8h(const float* v) { f32x8 f;
#pragma unroll
    for (int q = 0; q < 8; ++q) f[q] = v[q];
    const f16x8 hh = __builtin_convertvector(f, f16x8); return *reinterpret_cast<const uint4*>(&hh); }
__device__ __forceinline__ void ph_lna(PRef p, int L, bool dry = false) {
    unsigned char* lds = VLDS;
    float* hs = reinterpret_cast<float*>(lds);
    float* part = reinterpret_cast<float*>(lds + 16 * 1028 * 4);
    int* lcnt = reinterpret_cast<int*>(lds + 78080); int* lbase = lcnt + 32; int* rexp = lcnt + 64; int* rslot = lcnt + 96; float* rwt = reinterpret_cast<float*>(lcnt + 128);
    if (VT < 32) lcnt[VT] = 0;
    __syncthreads();
    int tid = VT; asm volatile("" : "+v"(tid));
    const int lane = tid & 63, wid = tid >> 6;
    const float* g = p.ln_g + (size_t)(L * 2 + 0) * 1024; const float* bt = p.ln_b + (size_t)(L * 2 + 0) * 1024;
    const float* wr = p.wr + (size_t)L * 1024 * 48;
    int* cnt = p.cnt + L * 32 * 64;
    f32x4 lg[4], lb[4];
#pragma unroll
    for (int i = 0; i < 4; ++i) { lg[i] = *reinterpret_cast<const f32x4*>(g + LNC(i)); lb[i] = *reinterpret_cast<const f32x4*>(bt + LNC(i)); }
    for (int it = VB; it < T_TOK / 16; it += NVB) {
        const int R0 = it * 16, b = R0 >> 11;
        const float* md = p.mod + (size_t)((L * 2 + 1) * 8 + b) * 3072;
        f32x4 shv[4], scv[4];
#pragma unroll
        for (int i = 0; i < 4; ++i) { shv[i] = *reinterpret_cast<const f32x4*>(md + LNC(i)); scv[i] = *reinterpret_cast<const f32x4*>(md + 1024 + LNC(i)); }
        uint4 zr[2];
#pragma unroll
        for (int k = 0; k < 2; ++k) zr[k] = *reinterpret_cast<const uint4*>(p.zbuf + (size_t)(R0 + wid * 4) * 1024 + LNC(2 * k));
#pragma unroll 1
        for (int rr = 0; rr < 4; ++rr) {
            const int lrow = wid * 4 + rr, row = R0 + lrow;
            float v[16];
            ld8h_f(zr[0], v); ld8h_f(zr[1], v + 8);
            if (rr < 3) {
#pragma unroll
                for (int k = 0; k < 2; ++k) zr[k] = *reinterpret_cast<const uint4*>(p.zbuf + (size_t)(row + 1) * 1024 + LNC(2 * k));
            }
            ln_row(v, lg, lb);
#pragma unroll
            for (int k = 0; k < 2; ++k) {
                *reinterpret_cast<uint4*>((dry ? reinterpret_cast<f16_t*>(p.ybuf) : p.xbuf) + (size_t)row * 1024 + LNC(2 * k)) = pk8h(v + 8 * k);
                float hv[8];
#pragma unroll
                for (int q = 0; q < 8; ++q) hv[q] = v[8 * k + q] * (1.f + scv[2 * k + (q >> 2)][q & 3]) + shv[2 * k + (q >> 2)][q & 3];
                *reinterpret_cast<f32x4*>(hs + lrow * 1028 + LNC(2 * k)) = (f32x4){hv[0], hv[1], hv[2], hv[3]};
                *reinterpret_cast<f32x4*>(hs + lrow * 1028 + LNC(2 * k + 1)) = (f32x4){hv[4], hv[5], hv[6], hv[7]};
                *reinterpret_cast<uint4*>((dry ? p.hmoe : p.hbuf) + (size_t)row * 1024 + LNC(2 * k)) = cvtpk8(hv[0], hv[1], hv[2], hv[3], hv[4], hv[5], hv[6], hv[7]);
            }
        }
        __syncthreads();
        {
            f32x4 a0 = {0.f, 0.f, 0.f, 0.f}, a1 = a0, a2 = a0;
            const int rl = lane & 15, kq = lane >> 4;
            const float* wcol = wr + ((size_t)(wid * 64 + kq * 16) * 48 + rl) * 4;
            const float* hrow = hs + rl * 1028 + wid * 256 + kq * 64;
#pragma unroll 8
            for (int k4 = 0; k4 < 16; ++k4) {
                const f32x4 a = *reinterpret_cast<const f32x4*>(hrow + k4 * 4);
                const float* wq_ = wcol + (size_t)k4 * 48 * 4;
                const f32x4 w0 = *reinterpret_cast<const f32x4*>(wq_), w1 = *reinterpret_cast<const f32x4*>(wq_ + 16 * 4), w2 = *reinterpret_cast<const f32x4*>(wq_ + 32 * 4);
#pragma unroll
                for (int j = 0; j < 4; ++j) {
                    a0 = __builtin_amdgcn_mfma_f32_16x16x4f32(a[j], w0[j], a0, 0, 0, 0);
                    a1 = __builtin_amdgcn_mfma_f32_16x16x4f32(a[j], w1[j], a1, 0, 0, 0);
                    a2 = __builtin_amdgcn_mfma_f32_16x16x4f32(a[j], w2[j], a2, 0, 0, 0);
                }
            }
#pragma unroll
            for (int q = 0; q < 4; ++q) {
                const int row = kq * 4 + q;
                part[(wid * 16 + row) * 48 + rl] = a0[q]; part[(wid * 16 + row) * 48 + 16 + rl] = a1[q]; part[(wid * 16 + row) * 48 + 32 + rl] = a2[q];
            }
        }
        __syncthreads();
        if (tid < 16) {
            const int row = R0 + tid;
            auto LG = [&](int e) { return part[(0 * 16 + tid) * 48 + e] + part[(1 * 16 + tid) * 48 + e] + part[(2 * 16 + tid) * 48 + e] + part[(3 * 16 + tid) * 48 + e]; };
            const float g0 = LG(0) + p.moe_b_grp[L * 4 + 0], g1 = LG(1) + p.moe_b_grp[L * 4 + 1], g2 = LG(2) + p.moe_b_grp[L * 4 + 2], g3 = LG(3) + p.moe_b_grp[L * 4 + 3];
            int gi = 0; float gm = g0;
            if (g1 > gm) { gm = g1; gi = 1; }
            if (g2 > gm) { gm = g2; gi = 2; }
            if (g3 > gm) { gm = g3; gi = 3; }
            const float gw = 1.f / (expf(g0 - gm) + expf(g1 - gm) + expf(g2 - gm) + expf(g3 - gm));
            int i1 = 0, i2 = 0; float m1 = -3.0e38f, m2 = -3.0e38f;
            for (int e = 0; e < 8; ++e) {
                const float v = LG(4 + gi * 8 + e) + p.moe_b_rt[L * 32 + gi * 8 + e];
                if (v > m1) { m2 = m1; i2 = i1; m1 = v; i1 = e; }
                else if (v > m2) { m2 = v; i2 = e; }
            }
            const float r = expf(m2 - m1);
            const float w1 = gw / (1.f + r), w2 = gw * r / (1.f + r);
            const int e1 = gi * 8 + i1, e2 = gi * 8 + i2;
            rwt[tid * 2] = w1; rwt[tid * 2 + 1] = w2;
            rexp[tid * 2] = e1; rexp[tid * 2 + 1] = e2;
            rslot[tid * 2] = atomicAdd(&lcnt[e1], 1); rslot[tid * 2 + 1] = atomicAdd(&lcnt[e2], 1);
        }
        __syncthreads();
        if (tid < 32) { const int c = lcnt[tid]; lbase[tid] = (c && !dry) ? atomicAdd(&cnt[tid * 64], c) : 0; lcnt[tid] = 0; }
        __syncthreads();
        if (tid < 32 && !dry) { const int e = rexp[tid]; const size_t o = (size_t)e * T_TOK + lbase[e] + rslot[tid]; p.list[o] = (R0 + (tid >> 1)) * 2 + (tid & 1); p.listw[o] = rwt[tid]; }
        __syncthreads();
    }
}
__device__ __forceinline__ void ph_lnb(PRef p, int L, bool dry = false) {
    int tid = VT; asm volatile("" : "+v"(tid));
    const int lane = tid & 63, wid = tid >> 6;
    const float* g = p.ln_g + (size_t)(L * 2 + 1) * 1024; const float* bt = p.ln_b + (size_t)(L * 2 + 1) * 1024;
    const bool last = (L == DEPTH - 1);
    f32x4 lg[4], lb[4];
#pragma unroll
    for (int i = 0; i < 4; ++i) { lg[i] = *reinterpret_cast<const f32x4*>(g + LNC(i)); lb[i] = *reinterpret_cast<const f32x4*>(bt + LNC(i)); }
    constexpr int RW = T_TOK / 2048;
    static_assert(2048 % RW == 0, "a wave's rows stay inside one batch element");
    for (int w0 = VB * 4 + wid; w0 * RW < T_TOK; w0 += NVB * 4) {
        const int row0 = w0 * RW, b = row0 >> 11;
        const float* gate = p.mod + (size_t)((L * 2 + 1) * 8 + b) * 3072 + 2048;
        const float* md = p.mod + (size_t)(((last ? L : L + 1) * 2 + 0) * 8 + b) * 3072;
        f32x4 gv[4], sh[4], sc[4];
#pragma unroll
        for (int i = 0; i < 4; ++i) { const int c = LNC(i); gv[i] = *reinterpret_cast<const f32x4*>(gate + c); if (!last) { sh[i] = *reinterpret_cast<const f32x4*>(md + c); sc[i] = *reinterpret_cast<const f32x4*>(md + 1024 + c); } }
        uint4 xr[2], y0[2], y1[2];
        auto issue = [&](int row) {
#pragma unroll
            for (int k = 0; k < 2; ++k) {
                const int c = LNC(2 * k);
                xr[k] = *reinterpret_cast<const uint4*>(p.xbuf + (size_t)row * 1024 + c);
                y0[k] = *reinterpret_cast<const uint4*>(p.ybuf + (size_t)(row * 2) * 1024 + c); y1[k] = *reinterpret_cast<const uint4*>(p.ybuf + (size_t)(row * 2 + 1) * 1024 + c);
            }
        };
        issue(row0);
#pragma unroll 1
        for (int ri = 0; ri < RW; ++ri) {
            const int row = row0 + ri;
            float v[16];
#pragma unroll
            for (int k = 0; k < 2; ++k) {
                float xv[8]; ld8h_f(xr[k], xv);
                const unsigned a0[4] = {y0[k].x, y0[k].y, y0[k].z, y0[k].w}, a1[4] = {y1[k].x, y1[k].y, y1[k].z, y1[k].w};
#pragma unroll
                for (int q = 0; q < 8; ++q) {
                    const unsigned w0 = a0[q >> 1], w1 = a1[q >> 1];
                    const float ys = (q & 1) ? (bf2f(w0 >> 16) + bf2f(w1 >> 16)) : (bf2f(w0 & 0xffffu) + bf2f(w1 & 0xffffu));
                    v[8 * k + q] = DN_ALPHA * xv[q] + gv[2 * k + (q >> 2)][q & 3] * ys;
                }
            }
            if (ri + 1 < RW) issue(row + 1);
            ln_row(v, lg, lb);
            if (last) {
#pragma unroll
                for (int i = 0; i < 4; ++i) *reinterpret_cast<f32x4*>((dry ? reinterpret_cast<float*>(p.zbuf) : p.out) + (size_t)row * 1024 + LNC(i)) = (f32x4){v[i * 4], v[i * 4 + 1], v[i * 4 + 2], v[i * 4 + 3]};
            } else {
#pragma unroll
                for (int k = 0; k < 2; ++k) {
                    const int c = LNC(2 * k);
                    *reinterpret_cast<uint4*>((dry ? p.zbuf : p.xbuf) + (size_t)row * 1024 + c) = pk8h(v + 8 * k);
                    float hv[8];
#pragma unroll
                    for (int q = 0; q < 8; ++q) hv[q] = v[8 * k + q] * (1.f + sc[2 * k + (q >> 2)][q & 3]) + sh[2 * k + (q >> 2)][q & 3];
                    *reinterpret_cast<uint4*>((dry ? p.obuf : p.hbuf) + (size_t)row * 1024 + c) = cvtpk8(hv[0], hv[1], hv[2], hv[3], hv[4], hv[5], hv[6], hv[7]);
                }
            }
        }
    }
}
#undef LNC

struct RowGather { const bf16_t* hb; const int* lst; int base, n; __device__ __forceinline__ const bf16_t* operator()(int r) const { const int idx = base + r; const int tok = (idx < n) ? (lst[idx] >> 1) : 0; return hb + (size_t)tok * 1024; } };
constexpr int G8_PRE_OFF = LDS_WORK + 131072;
__device__ __forceinline__ const int* moe_prefix256(const int* cnt) {
    int* pre = reinterpret_cast<int*>(smem + G8_PRE_OFF);
    int t_ = threadIdx.x; asm volatile("" : "+v"(t_));
    if (t_ == 0) { int s = 0; for (int e = 0; e < 32; ++e) { pre[e] = s; s += (cnt[e * 64] + 255) >> 8; } pre[32] = s; }
    if (t_ >= 64 && t_ < 96) pre[48 + t_ - 64] = cnt[(t_ - 64) * 64];
    __syncthreads();
    return pre;
}
struct EpiMoeA {
    bf16_t* hmoe;
    __device__ __forceinline__ void operator()(const g8::f32x4_t (&acc)[2][2][4][2], const g8::Unit& u, int wr, int wc, int fr, int fq) const {
#pragma unroll
        for (int ai = 0; ai < 2; ++ai)
#pragma unroll
            for (int m = 0; m < 4; ++m) {
                bf16_t* rowp = hmoe + (size_t)(u.pm * 256 + ai * 128 + wr * 64 + m * 16 + fr) * 512 + u.pn * 128 + wc * 32 + fq * 8;
                float hv[8];
#pragma unroll
                for (int n = 0; n < 2; ++n) {
                    const g8::f32x4_t g = acc[ai][0][m][n], up = acc[ai][1][m][n];
#pragma unroll
                    for (int q = 0; q < 4; ++q) hv[n * 4 + q] = silu_f(g[q]) * up[q];
                }
                *reinterpret_cast<uint4*>(rowp) = cvtpk8(hv[0], hv[1], hv[2], hv[3], hv[4], hv[5], hv[6], hv[7]);
            }
    }
};
__device__ __forceinline__ void ph_moe_a(PRef p, int L) {
    const int* cnt = p.cnt + L * 32 * 64;
    const int* pre = moe_prefix256(cnt);
    g8::SchedMoe S{pre, p.list, p.listw, (const char*)(p.wt_gu + (size_t)L * 32 * 1024 * 1024), (size_t)1024 * 1024 * 2, (size_t)256 * 1024 * 2, pre[32] * 4, (int)gridDim.x, (int)blockIdx.x, 1, reinterpret_cast<int*>(smem + G8_PRE_OFF + 512)};
    g8::gemm8((LAS unsigned char*)(smem + LDS_WORK), (const char*)p.hbuf, 1024, 1024, S, EpiMoeA{p.hmoe});
    __syncthreads();
}
struct EpiMoeB {
    const int* pre; const int* tab; bf16_t* ybuf;
    __device__ __forceinline__ void operator()(const g8::f32x4_t (&acc)[2][2][4][2], const g8::Unit& u, int wr, int wc, int fr, int fq) const {
        const int e = u.e;
        const int n = pre[48 + e] - (u.pm - pre[e]) * 256, r0 = wr * 64 + fr;
        const int col0 = u.pn * 256 + wc * 32 + fq * 8;
        const int* tb = tab + u.par * 512;
        asm volatile("" ::: "memory");
#pragma unroll
        for (int ai = 0; ai < 2; ++ai) {
#pragma unroll
            for (int m = 0; m < 4; ++m) {
                const int r = r0 + ai * 128 + m * 16;
                if (r < n) {
                    const int ent = tb[r]; const float ww = __int_as_float(tb[256 + r]);
                    bf16_t* rowp = ybuf + (size_t)ent * 1024 + col0;
#pragma unroll
                    for (int bj = 0; bj < 2; ++bj) {
                        const g8::f32x4_t a = acc[ai][bj][m][0], c = acc[ai][bj][m][1];
                        *reinterpret_cast<uint4*>(rowp + bj * 128) = cvtpk8(a[0] * ww, a[1] * ww, a[2] * ww, a[3] * ww, c[0] * ww, c[1] * ww, c[2] * ww, c[3] * ww);
                    }
                }
            }
        }
    }
};
__device__ __forceinline__ void ph_moe_b(PRef p, int L) {
    const int* cnt = p.cnt + L * 32 * 64;
#if MULTI_LAUNCH
    const int* pre = moe_prefix256(cnt);
#else
    (void)cnt; const int* pre = reinterpret_cast<const int*>(smem + G8_PRE_OFF);
#endif
    g8::SchedMoe S{pre, p.list, p.listw, (const char*)(p.wt_dn + (size_t)L * 32 * 1024 * 512), (size_t)1024 * 512 * 2, (size_t)256 * 512 * 2, pre[32] * 4, (int)gridDim.x, (int)blockIdx.x, 0, reinterpret_cast<int*>(smem + G8_PRE_OFF + 512)};
    g8::gemm8((LAS unsigned char*)(smem + LDS_WORK), (const char*)p.hmoe, 512, 512, S, EpiMoeB{pre, reinterpret_cast<const int*>(smem + G8_PRE_OFF + 512), p.ybuf});
    __syncthreads();
}

__device__ __forceinline__ void dma16_asm(const void* g, const unsigned char* lds_wave_base) {
    const unsigned m = __builtin_amdgcn_readfirstlane((unsigned)(size_t)(LAS const unsigned char*)lds_wave_base);
    asm volatile("s_mov_b32 m0, %1\n\ts_nop 0\n\tglobal_load_lds_dwordx4 %0, off" :: "v"(g), "s"(m) : "memory", "m0");
}
__device__ __forceinline__ unsigned lds_addr(const unsigned char* p) { return (unsigned)(size_t)(LAS const unsigned char*)p; }
__device__ __forceinline__ bf16x8 lds_ld128(unsigned a) { return *(const LAS bf16x8*)(size_t)a; }
__device__ __forceinline__ void dma16_asm_s(const void* ubase, unsigned voff, const unsigned char* lds_wave_base) {
    const unsigned m = __builtin_amdgcn_readfirstlane((unsigned)(size_t)(LAS const unsigned char*)lds_wave_base);
    asm volatile("s_mov_b32 m0, %2\n\ts_nop 0\n\tglobal_load_lds_dwordx4 %0, %1" :: "v"(voff), "s"(ubase), "s"(m) : "memory", "m0");
}
template <int DQK, int KT> struct AT {
    static constexpr int KB = KT / 32, NKK = DQK / 16;
    static constexpr bool ROPE = (DQK == 192);
    static constexpr int K_BYTES = KT * 256, KR_BYTES = ROPE ? KT * 128 : 0, V_BYTES = 256 * KT, STAGE = K_BYTES + KR_BYTES + V_BYTES;
    static constexpr int VRB = KT * 2;
    static __device__ __forceinline__ void dma(int tid, unsigned char* st, const bf16_t* kp  , size_t ldk, const bf16_t* krp  , const bf16_t* vp  , size_t ldv) {
        const int wid = tid >> 6, l = tid & 63;
#pragma unroll
        for (int i = 0; i < KT / 16; ++i) {
            const int pi = wid + 4 * i, row = 4 * pi + (l >> 4), c = (l & 15) ^ (row & 15);
            dma16_asm_s(kp, (unsigned)(row * (int)ldk + c * 8) * 2u, st + pi * 1024);
        }
        if (ROPE) {
            const int pi = wid, row = 8 * pi + (l >> 3), c = (l & 7) ^ ((row >> 1) & 7);
            dma16_asm_s(krp, (unsigned)(row * 64 + c * 8) * 2u, st + K_BYTES + pi * 1024);
        }
#pragma unroll
        for (int i = 0; i < KT / 16; ++i) {
            const int pi = wid + 4 * i;
            int row, c;
            if (KT == 64) { row = 8 * pi + (l >> 3); c = (l & 7) ^ ((row >> 1) & 7); }
            else          { row = 16 * pi + (l >> 2); c = (l & 3) ^ ((row >> 2) & 3); }
            dma16_asm_s(vp, (unsigned)(row * (int)ldv + c * 8) * 2u, st + K_BYTES + KR_BYTES + pi * 1024);
        }
    }
    static __device__ __forceinline__ void kload(const unsigned char* st, int kb, bf16x8 (&kf)[NKK], int r, int h) {
        const int row = kb * 32 + r, m = r & 15, m2 = (r >> 1) & 7;
        const unsigned a0 = lds_addr(st) + row * 256 + ((((m & ~1) | (h ^ (m & 1)))) << 4);
#pragma unroll
        for (int kk = 0; kk < 8; ++kk) kf[kk] = lds_ld128(a0 ^ (kk << 5));
        if (ROPE) {
            const unsigned a1 = lds_addr(st) + K_BYTES + row * 128 + ((((m2 & ~1) | (h ^ (m2 & 1)))) << 4);
#pragma unroll
            for (int kk = 0; kk < 4; ++kk) kf[8 + kk] = lds_ld128(a1 ^ (kk << 5));
        }
    }
    static __device__ __forceinline__ f32x16 qk_mma(const bf16x8 (&kf)[NKK], const bf16x8* qf) {
        f32x16 s;
#pragma unroll
        for (int q = 0; q < 16; ++q) s[q] = 0.f;
#pragma unroll
        for (int kk = 0; kk < NKK; ++kk) s = MFMA32(kf[kk], qf[kk], s);
        return s;
    }
    static __device__ __forceinline__ f32x16 qk(const unsigned char* st, int kb, const bf16x8* qf, int r, int h) {
        f32x16 s;
#pragma unroll
        for (int q = 0; q < 16; ++q) s[q] = 0.f;
        const int row = kb * 32 + r;
#pragma unroll
        for (int kk = 0; kk < 8; ++kk) s = MFMA32(lds_frag(st, row * 256 + (((2 * kk + h) ^ (r & 15)) << 4)), qf[kk], s);
        return s;
    }
    static __device__ __forceinline__ void vload(const unsigned char* st, int ks, bf16x8 (&vf)[4], int r, int h) {
        const int swz = (KT == 64) ? ((r >> 1) & 7) : ((r >> 2) & 3);
        const unsigned v0 = lds_addr(st) + K_BYTES + KR_BYTES + r * VRB + ((swz ^ h) << 4);
#pragma unroll
        for (int dvb = 0; dvb < 4; ++dvb) vf[dvb] = lds_ld128((v0 ^ ((2 * ks) << 4)) + dvb * 32 * VRB);
    }
    static __device__ __forceinline__ void pv_mma(f32x16 (&o)[4], const bf16x8 (&vf)[4], bf16x8 pf) {
#pragma unroll
        for (int dvb = 0; dvb < 4; ++dvb) o[dvb] = MFMA32(vf[dvb], pf, o[dvb]);
    }
    static __device__ __forceinline__ void pv(const unsigned char* st, f32x16 (&o)[4], int ks, bf16x8 pf, int r, int h) {
        bf16x8 vf[4];
        vload(st, ks, vf, r, h);
        pv_mma(o, vf, pf);
    }
};
struct HalfBar { volatile LAS unsigned* ctr; unsigned target; };
__device__ __forceinline__ void half_bar(HalfBar& hb, int lane) {
    asm volatile("s_waitcnt lgkmcnt(0)" ::: "memory");
    hb.target += 4u;
    if (lane == 0) __hip_atomic_fetch_add((LAS unsigned*)hb.ctr, 1u, __ATOMIC_RELAXED, __HIP_MEMORY_SCOPE_WORKGROUP);
    while ((unsigned)__builtin_amdgcn_readfirstlane((int)*hb.ctr) < hb.target) __builtin_amdgcn_s_sleep(1);
    asm volatile("" ::: "memory");
}
#define DMA_WAIT_SYNC() do { asm volatile("s_waitcnt vmcnt(0)" ::: "memory"); __syncthreads(); } while (0)
__device__ __forceinline__ bf16x8 pfrag(const f32x16& s, int half) {
    const int b = half * 8;
    uint4 w = cvtpk8(s[b + 0], s[b + 1], s[b + 2], s[b + 3], s[b + 4], s[b + 5], s[b + 6], s[b + 7]);
    return *reinterpret_cast<bf16x8*>(&w);
}
template <int NKK> __device__ __forceinline__ void load_q(bf16x8 (&qf)[NKK], const bf16_t* qrow, int h) {
#pragma unroll
    for (int kk = 0; kk < NKK; ++kk) qf[kk] = *reinterpret_cast<const bf16x8*>(qrow + kk * 16 + h * 8);
}
__device__ __forceinline__ void store_pk16(bf16_t* orow, int dvb, int gp, uint2 X  , uint2 Y  , int h) {
    auto r0 = __builtin_amdgcn_permlane32_swap(X.x, Y.x, false, false), r1 = __builtin_amdgcn_permlane32_swap(X.y, Y.y, false, false);
    uint4 w; w.x = r0[0]; w.y = r1[0]; w.z = r0[1]; w.w = r1[1];
    *reinterpret_cast<uint4*>(orow + dvb * 32 + 8 * (2 * gp + h)) = w;
}
__device__ __forceinline__ void store_o(const f32x16 (&o)[4], bf16_t* orow, int h, float scale) {
#pragma unroll
    for (int dvb = 0; dvb < 4; ++dvb)
#pragma unroll
        for (int gp = 0; gp < 2; ++gp) {
            const int a = 8 * gp, c = 8 * gp + 4;
            uint2 X, Y;
            X.x = cvtpk(o[dvb][a] * scale, o[dvb][a + 1] * scale); X.y = cvtpk(o[dvb][a + 2] * scale, o[dvb][a + 3] * scale);
            Y.x = cvtpk(o[dvb][c] * scale, o[dvb][c + 1] * scale); Y.y = cvtpk(o[dvb][c + 2] * scale, o[dvb][c + 3] * scale);
            store_pk16(orow, dvb, gp, X, Y, h);
        }
}

template <int DQK, int KT, int MODE>
__device__ __forceinline__ void flash_loop(int tid, unsigned char* lds, const bf16x8* qf, f32x16 (&o)[4], float& m_run, float& l_half,
                                           const bf16_t* kbase, size_t ldk, const bf16_t* krbase, const bf16_t* vtbase, size_t ldv,
                                           int kt_lo, int kt_hi, int t  , int tw_min, int tw_max  , unsigned selmask, float C, int key_off = 0, HalfBar* hbp = nullptr) {
    typedef AT<DQK, KT> A;
    constexpr bool RING3 = (KT == 32);
    constexpr int NDMA = KT / 16 + KT / 16 + (DQK == 192 ? 1 : 0);
    auto tile_dma = [&](int stage, int kt) { A::dma(tid, lds + stage * A::STAGE, kbase + (size_t)kt * KT * ldk, ldk, krbase ? krbase + (size_t)kt * KT * 64 : nullptr, vtbase + (size_t)kt * KT, ldv); };
    if (RING3) { __builtin_amdgcn_s_waitcnt(0x0F70); tile_dma(0, kt_lo); if (kt_lo + 1 <= kt_hi) tile_dma(1, kt_lo + 1); }
    else { tile_dma(0, kt_lo); __builtin_amdgcn_s_waitcnt(0x0F70); __syncthreads(); }
    int stc = 0, stn = 2;
    for (int kt = kt_lo; kt <= kt_hi; ++kt) {
        asm volatile("" : "+v"(tid));
        const int lane = tid & 63, r = lane & 31, h = lane >> 5;
        const bool more = kt < kt_hi;
        const unsigned char* st;
        if (RING3) {
            if (more) { static_assert(!RING3 || NDMA == 5, "counted wait below is written for 5 DMA instructions per tile"); asm volatile("s_waitcnt vmcnt(5)" ::: "memory"); }
            else asm volatile("s_waitcnt vmcnt(0)" ::: "memory");
            if (hbp) half_bar(*hbp, lane); else __builtin_amdgcn_s_barrier();
            asm volatile("" ::: "memory");
            if (kt + 2 <= kt_hi) tile_dma(stn, kt + 2);
            st = lds + stc * A::STAGE;
            stc = (stc == 2) ? 0 : stc + 1; stn = (stn == 2) ? 0 : stn + 1;
        } else {
            const int cur = (kt - kt_lo) & 1;
            if (more) tile_dma(cur ^ 1, kt + 1);
            st = lds + cur * A::STAGE;
        }
        const int key0 = key_off + kt * KT;
        bool active = (key0 <= tw_max);
        if (MODE == 2) active = active && (key0 + KT - 1 > tw_min - 512);
        if (active) {
            f32x16 s[A::KB];
            bf16x8 vf[2][4];
            if constexpr (KT == 32) {
                bf16x8 kf[A::NKK];
                A::kload(st, 0, kf, r, h);
                __builtin_amdgcn_sched_barrier(0);
                s[0] = A::qk_mma(kf, qf);
                __builtin_amdgcn_sched_barrier(0);
                A::vload(st, 0, vf[0], r, h); A::vload(st, 1, vf[1], r, h);
            } else {
#pragma unroll
                for (int kb = 0; kb < A::KB; ++kb) s[kb] = A::qk(st, kb, qf, r, h);
            }
            const bool need_mask = (MODE == 1) || (key0 + KT - 1 > tw_min) || (MODE == 2 && key0 <= tw_max - 512);
            if (MODE == 1 && !(key0 + KT - 1 > tw_min)) {
                static_assert(MODE != 1 || KT == 64, "selected branch: tile = selection block");
                asm volatile("" ::: "memory");
                const float drop = ((selmask >> (key0 >> 6)) & 1u) ? 0.f : -__builtin_inff();
#pragma unroll
                for (int kb = 0; kb < A::KB; ++kb)
#pragma unroll
                    for (int q = 0; q < 16; ++q) s[kb][q] += drop;
            } else if (need_mask) {
                asm volatile("" ::: "memory");
#pragma unroll
                for (int kb = 0; kb < A::KB; ++kb)
#pragma unroll
                    for (int q = 0; q < 16; ++q) {
                        const int key = key0 + kb * 32 + crow(q, h);
                        bool ok = key <= t;
                        if (MODE == 1) ok = ok && ((selmask >> (key >> 6)) & 1u);
                        if (MODE == 2) ok = ok && (t - key < 512);
                        s[kb][q] = ok ? s[kb][q] : -__builtin_inff();
                    }
            }
            float mx = -__builtin_inff();
#pragma unroll
            for (int kb = 0; kb < A::KB; ++kb)
#pragma unroll
                for (int q = 0; q < 16; ++q) mx = fmaxf(mx, s[kb][q]);
            mx = xh_max(mx) * C;
            if (__any(mx > m_run + 8.f)) {
                const float mn = fmaxf(m_run, mx);
                const float alpha = __builtin_amdgcn_exp2f(m_run - mn);
                m_run = mn;
                l_half *= alpha;
#pragma unroll
                for (int dvb = 0; dvb < 4; ++dvb)
#pragma unroll
                    for (int q = 0; q < 16; ++q) o[dvb][q] *= alpha;
            }
            const float nm = -m_run;
            float ps = 0.f;
#pragma unroll
            for (int kb = 0; kb < A::KB; ++kb)
#pragma unroll
                for (int q = 0; q < 16; ++q) { const float e = __builtin_amdgcn_exp2f(__builtin_fmaf(s[kb][q], C, nm)); s[kb][q] = e; ps += e; }
            l_half += ps;
            if constexpr (KT == 32) { A::pv_mma(o, vf[0], pfrag(s[0], 0)); A::pv_mma(o, vf[1], pfrag(s[0], 1)); }
            else {
#pragma unroll
                for (int kb = 0; kb < A::KB; ++kb) { A::pv(st, o, kb * 2, pfrag(s[kb], 0), r, h); A::pv(st, o, kb * 2 + 1, pfrag(s[kb], 1), r, h); }
            }
        }
        if (!RING3) DMA_WAIT_SYNC();
    }
    if (RING3) { if (hbp) half_bar(*hbp, tid & 63); else __syncthreads(); }
}

__device__ __forceinline__ void mla_flash(int tid0, unsigned char* lds, const bf16x8* qf, f32x16 (&o)[4], float& m_run, float& l_half,
                                          const bf16_t* kbase, const bf16_t* krbase, const bf16_t* vtbase, int kt_hi, int t, int tw_min, float C) {
    typedef AT<192, 32> A;
    constexpr int KST = A::K_BYTES + A::KR_BYTES, VST = A::V_BYTES;
    static_assert(3 * KST + 4 * VST <= HALF_LDS, "rings");
    unsigned char* kring = lds; unsigned char* vring = lds + 3 * KST;
    auto tile_dma = [&](int tid, int kt) {
        unsigned char* ks = kring + (kt % 3) * KST; unsigned char* vs = vring + (kt & 3) * VST;
        const bf16_t* kp = kbase + (size_t)kt * 32 * 1024; const bf16_t* krp = krbase + (size_t)kt * 32 * 64; const bf16_t* vp = vtbase + (size_t)kt * 32;
        const int wid = tid >> 6, l = tid & 63;
#pragma unroll
        for (int i = 0; i < 2; ++i) { const int pi = wid + 4 * i, row = 4 * pi + (l >> 4), c = (l & 15) ^ (row & 15); dma16_asm_s(kp, (unsigned)(row * 1024 + c * 8) * 2u, ks + pi * 1024); }
        { const int pi = wid, row = 8 * pi + (l >> 3), c = (l & 7) ^ ((row >> 1) & 7); dma16_asm_s(krp, (unsigned)(row * 64 + c * 8) * 2u, ks + A::K_BYTES + pi * 1024); }
#pragma unroll
        for (int i = 0; i < 2; ++i) { const int pi = wid + 4 * i, row = 16 * pi + (l >> 2), c = (l & 3) ^ ((row >> 2) & 3); dma16_asm_s(vp, (unsigned)(row * SEQ + c * 8) * 2u, vs + pi * 1024); }
    };
    auto finish = [&](f32x16& sv, float mxraw, int kt, int h) {
        const int key0 = kt * 32;
        if (key0 + 31 > tw_min) {
            asm volatile("" ::: "memory");
            mxraw = -__builtin_inff();
#pragma unroll
            for (int q = 0; q < 16; ++q) { sv[q] = (key0 + crow(q, h) <= t) ? sv[q] : -__builtin_inff(); mxraw = fmaxf(mxraw, sv[q]); }
        }
        const float mx = xh_max(mxraw) * C;
        if (__any(mx > m_run + 8.f)) {
            const float mn = fmaxf(m_run, mx);
            const float alpha = __builtin_amdgcn_exp2f(m_run - mn);
            m_run = mn; l_half *= alpha;
#pragma unroll
            for (int dvb = 0; dvb < 4; ++dvb)
#pragma unroll
                for (int q = 0; q < 16; ++q) o[dvb][q] *= alpha;
        }
    };
    f32x16 sc;
    {
        int tid = tid0; asm volatile("" : "+v"(tid));
        tile_dma(tid, 0); if (kt_hi >= 1) tile_dma(tid, 1); if (kt_hi >= 2) tile_dma(tid, 2);
        __builtin_amdgcn_s_waitcnt(0x0F70);
        __builtin_amdgcn_s_barrier();
        asm volatile("" ::: "memory");
        const int lane = tid & 63, r = lane & 31, h = lane >> 5;
        bf16x8 kf[12];
        A::kload(kring, 0, kf, r, h);
        sc = A::qk_mma(kf, qf);
        float mxr = -__builtin_inff();
#pragma unroll
        for (int q = 0; q < 16; ++q) mxr = fmaxf(mxr, sc[q]);
        finish(sc, mxr, 0, h);
    }
    for (int kt = 0; kt <= kt_hi; ++kt) {
        const int tid = tid0, lane = tid & 63, r = lane & 31, h = lane >> 5;
        if (kt + 1 <= kt_hi) { if (kt + 2 <= kt_hi) asm volatile("s_waitcnt vmcnt(5)" ::: "memory"); else asm volatile("s_waitcnt vmcnt(0)" ::: "memory"); }
        __builtin_amdgcn_s_barrier();
        asm volatile("" ::: "memory");
        if (kt + 3 <= kt_hi) tile_dma(tid, kt + 3);
        const int kn = (kt + 1) % 3;
        bf16x8 kf[12];
        A::kload(kring + kn * KST, 0, kf, r, h);
        __builtin_amdgcn_sched_barrier(0);
        f32x16 sn = A::qk_mma(kf, qf);
        const float nm = -m_run;
        float ps = 0.f;
#pragma unroll
        for (int q = 0; q < 16; ++q) { const float e = __builtin_amdgcn_exp2f(__builtin_fmaf(sc[q], C, nm)); sc[q] = e; ps += e; }
        l_half += ps;
        const bf16x8 pf0 = pfrag(sc, 0), pf1 = pfrag(sc, 1);
        bf16x8 vf[2][4];
        const unsigned char* vadj = vring + (kt & 3) * VST - (A::K_BYTES + A::KR_BYTES);
        A::vload(vadj, 0, vf[0], r, h); A::vload(vadj, 1, vf[1], r, h);
        float mxr = -__builtin_inff();
#pragma unroll
        for (int q = 0; q < 16; ++q) mxr = fmaxf(mxr, sn[q]);
        A::pv_mma(o, vf[0], pf0); A::pv_mma(o, vf[1], pf1);
        if (kt + 1 <= kt_hi) finish(sn, mxr, kt + 1, h);
        sc = sn;
    }
    __syncthreads();
}

__device__ __forceinline__ void ph_mla_attn(PRef p) {
    unsigned char* lds = VLDS;
    const float C = 0.07216878364870322f * 1.4426950408889634f;
    for (int it = VB; it < 1024; it += NVB) {
        int tid = VT; asm volatile("" : "+v"(tid));
        const int lane = tid & 63, wid = tid >> 6, r = lane & 31, h = lane >> 5;
        const int vb_ = it & 511, xw_ = vb_ >> 4, pp = ((vb_ >> 1) & 7) * 64 + (((xw_ >> 3) * 2 + (vb_ & 1)) << 3) + (xw_ & 7), second = it >> 9, bh = pp >> 3, qt = second ? (pp & 7) : (15 - (pp & 7)), b = bh >> 3, hd = bh & 7;
        const int tw0 = qt * 128 + wid * 32, t = tw0 + r;
        const size_t tok = (size_t)b * SEQ + t;
        bf16x8 qf[12];
        load_q<12>(qf, p.qm + tok * 1536 + hd * 192, h);
        f32x16 o[4];
#pragma unroll
        for (int dvb = 0; dvb < 4; ++dvb)
#pragma unroll
            for (int q = 0; q < 16; ++q) o[dvb][q] = 0.f;
        float m_run = -1.0e30f, l_half = 0.f;
        mla_flash(tid, lds, qf, o, m_run, l_half, p.kn + (size_t)b * SEQ * 1024 + hd * 128, p.krope + (size_t)b * SEQ * 64,
                  p.vt + (size_t)(b * 8 + hd) * 128 * SEQ, (qt * 128 + 127) >> 5, t, tw0, C);
        const float l = xh_sum(l_half);
        store_o(o, p.obuf + tok * 1024 + hd * 128, h, l > 0.f ? 1.f / l : 0.f);
    }
}

__device__ __forceinline__ void acc_branch(uint2 (&ot)[16], const f32x16 (&o)[4], float sc, bool first) {
#pragma unroll
    for (int dvb = 0; dvb < 4; ++dvb)
#pragma unroll
        for (int g = 0; g < 4; ++g) {
            float a0 = o[dvb][4 * g] * sc, a1 = o[dvb][4 * g + 1] * sc, a2 = o[dvb][4 * g + 2] * sc, a3 = o[dvb][4 * g + 3] * sc;
            if (!first) { const uint2 pv = ot[dvb * 4 + g]; a0 += bf2f(pv.x & 0xffffu); a1 += bf2f(pv.x >> 16); a2 += bf2f(pv.y & 0xffffu); a3 += bf2f(pv.y >> 16); }
            ot[dvb * 4 + g] = make_uint2(cvtpk(a0, a1), cvtpk(a2, a3));
        }
}
__device__ __forceinline__ void ph_nsa_attn(PRef p) {
    unsigned char* lds = VLDS;
    typedef AT<128, 64> A;
    float* imp = reinterpret_cast<float*>(lds);
    unsigned* selm = reinterpret_cast<unsigned*>(lds + 2 * A::STAGE);
    const float C = 0.08838834764831845f * 1.4426950408889634f;
    for (int it = VB; it < 1024; it += NVB) {
        int tid = VT; asm volatile("" : "+v"(tid));
        const int lane = tid & 63, wid = tid >> 6, r = lane & 31, h = lane >> 5;
        const int vb_ = it & 511, pp = ((vb_ >> 1) & 7) * 64 + ((vb_ & 1) << 5) + (vb_ >> 4), second = it >> 9, bkh = pp >> 5, qc = second ? (pp & 31) : (63 - (pp & 31)), b = bkh >> 1, kh = bkh & 1;
        const int hd = kh * 4 + wid, t0 = qc * 32, t = t0 + r;
        const size_t tok = (size_t)b * SEQ + t;
        bf16x8 qf[8];
        load_q<8>(qf, p.qn + tok * 1024 + hd * 128, h);
        const f32x4 gate4 = *reinterpret_cast<const f32x4*>(p.gates + tok * 32 + hd * 4);
        uint2 ot[16];
        f32x16 o[4];
        {
            const bf16_t* kb_ = p.kcmp + (size_t)bkh * 128 * 128; const bf16_t* vb_ = p.vcmpt + (size_t)bkh * 128 * 128;
            A::dma(tid, lds, kb_, 128, nullptr, vb_, 128);
            A::dma(tid, lds + A::STAGE, kb_ + 64 * 128, 128, nullptr, vb_ + 64, 128);
            DMA_WAIT_SYNC();
            f32x16 s[4];
            s[0] = A::qk(lds, 0, qf, r, h); s[1] = A::qk(lds, 1, qf, r, h); s[2] = A::qk(lds + A::STAGE, 0, qf, r, h); s[3] = A::qk(lds + A::STAGE, 1, qf, r, h);
            float mx = -3.0e38f;
#pragma unroll
            for (int kb = 0; kb < 4; ++kb)
#pragma unroll
                for (int q = 0; q < 16; ++q) {
                    const int n = kb * 32 + crow(q, h);
                    const float v = (16 * n + 31 <= t) ? s[kb][q] * C : -__builtin_inff();
                    s[kb][q] = v; mx = fmaxf(mx, v);
                }
            mx = fmaxf(xh_max(mx), -1.0e30f);
            float ps = 0.f;
#pragma unroll
            for (int kb = 0; kb < 4; ++kb)
#pragma unroll
                for (int q = 0; q < 16; ++q) { const float e = __builtin_amdgcn_exp2f(s[kb][q] - mx); s[kb][q] = e; ps += e; }
            const float l = xh_sum(ps), inv = l > 0.f ? 1.f / l : 0.f;
#pragma unroll
            for (int kb = 0; kb < 4; ++kb)
#pragma unroll
                for (int q = 0; q < 16; ++q) s[kb][q] *= inv;
            float impv[16];
            {
                float prev = 0.f;
#pragma unroll
                for (int gi = 0; gi < 16; ++gi) {
                    const int kb = gi >> 2, rg = gi & 3;
                    const float p3 = 0.5f * s[kb][4 * rg + 3];
                    const float av = s[kb][4 * rg] + s[kb][4 * rg + 1] + s[kb][4 * rg + 2] + p3;
                    const float co = xh_other(p3, h);
                    impv[gi] = av + (h ? co : prev);
                    prev = co;
                }
            }
            bf16x8 pf[8];
#pragma unroll
            for (int kb = 0; kb < 4; ++kb) { pf[2 * kb] = pfrag(s[kb], 0); pf[2 * kb + 1] = pfrag(s[kb], 1); }
#pragma unroll
            for (int dvb = 0; dvb < 4; ++dvb)
#pragma unroll
                for (int q = 0; q < 16; ++q) o[dvb][q] = 0.f;
#pragma unroll
            for (int ks = 0; ks < 4; ++ks) A::pv(lds, o, ks, pf[ks], r, h);
#pragma unroll
            for (int ks = 0; ks < 4; ++ks) A::pv(lds + A::STAGE, o, ks, pf[4 + ks], r, h);
            acc_branch(ot, o, gate4[0], true);
            __syncthreads();
#pragma unroll
            for (int gi = 0; gi < 16; ++gi) imp[(wid * 32 + r) * 33 + (2 * gi + h)] = impv[gi];
            __syncthreads();
            if (tid < 32) {
                const int tq = t0 + tid, cur = tq >> 6;
                float val[32];
#pragma unroll
                for (int j = 0; j < 32; ++j) {
                    float v = imp[(0 * 32 + tid) * 33 + j] + imp[(1 * 32 + tid) * 33 + j] + imp[(2 * 32 + tid) * 33 + j] + imp[(3 * 32 + tid) * 33 + j];
                    if (j == 0 || j == cur || j == cur - 1) v += 1000.f;
                    val[j] = (64 * j <= tq) ? v : -__builtin_inff();
                }
                unsigned m = 0u;
                for (int k = 0; k < 8; ++k) {
                    float best = -__builtin_inff(); int bi = -1;
#pragma unroll
                    for (int j = 0; j < 32; ++j) { const bool free_ = !((m >> j) & 1u); if (free_ && (bi < 0 || val[j] > best)) { best = val[j]; bi = j; } }
                    m |= 1u << bi;
                }
                selm[tid] = m;
            }
            __syncthreads();
        }
        const unsigned sel = selm[r];
        load_q<8>(qf, p.qn + tok * 1024 + hd * 128, h);
        {
#pragma unroll
            for (int dvb = 0; dvb < 4; ++dvb)
#pragma unroll
                for (int q = 0; q < 16; ++q) o[dvb][q] = 0.f;
            float m_run = -1.0e30f, l_half = 0.f;
            flash_loop<128, 64, 1>(tid, lds, qf, o, m_run, l_half, p.ks + (size_t)bkh * SEQ * 128, 128, nullptr, p.vst + (size_t)bkh * 128 * SEQ, SEQ,
                                   0, (t0 + 31) >> 6, t, t0, t0 + 31, sel, C);
            const float l = xh_sum(l_half);
            acc_branch(ot, o, l > 0.f ? gate4[1] / l : 0.f, false);
        }
        {
#pragma unroll
            for (int dvb = 0; dvb < 4; ++dvb)
#pragma unroll
                for (int q = 0; q < 16; ++q) o[dvb][q] = 0.f;
            float m_run = -1.0e30f, l_half = 0.f;
            const int lo = (t0 - 511) > 0 ? ((t0 - 511) >> 6) : 0;
            flash_loop<128, 64, 2>(tid, lds, qf, o, m_run, l_half, p.kw + (size_t)bkh * SEQ * 128, 128, nullptr, p.vwt + (size_t)bkh * 128 * SEQ, SEQ,
                                   lo, (t0 + 31) >> 6, t, t0, t0 + 31, 0u, C);
            const float l = xh_sum(l_half);
            acc_branch(ot, o, l > 0.f ? gate4[2] / l : 0.f, false);
        }
        bf16_t* orow = p.obuf + tok * 1024 + hd * 128;
#pragma unroll
        for (int dvb = 0; dvb < 4; ++dvb)
#pragma unroll
            for (int gp = 0; gp < 2; ++gp) store_pk16(orow, dvb, gp, ot[dvb * 4 + 2 * gp], ot[dvb * 4 + 2 * gp + 1], h);
    }
}

__device__ __forceinline__ void ph_sb_attn(PRef p) {
    unsigned char* lds = VLDS;
    typedef AT<128, 64> A;
    const float SC = 0.08838834764831845f, L2E = 1.4426950408889634f, LN2 = 0.6931471805599453f;
    for (int it = VB; it < 1024; it += NVB) {
        int tid = VT; asm volatile("" : "+v"(tid));
        const int lane = tid & 63, wid = tid >> 6, r = lane & 31, h = lane >> 5;
        const int vb_ = it & 511, xw_ = vb_ >> 4, pp = ((vb_ >> 1) & 7) * 64 + (((xw_ >> 3) * 2 + (vb_ & 1)) << 3) + (xw_ & 7), second = it >> 9, bh = pp >> 3, qt = second ? (pp & 7) : (15 - (pp & 7)), b = bh >> 3, hd = bh & 7;
        const int tw0 = qt * 128 + wid * 32, t = tw0 + r;
        const size_t tok = (size_t)b * SEQ + t;
        bf16x8 qf[8];
        load_q<8>(qf, p.qs + tok * 1024 + hd * 128, h);
        f32x16 o[4];
#pragma unroll
        for (int dvb = 0; dvb < 4; ++dvb)
#pragma unroll
            for (int q = 0; q < 16; ++q) o[dvb][q] = 0.f;
        float R = 0.f;
        const bf16_t* kbase = p.ksb + (size_t)b * SEQ * 1024 + hd * 128; const bf16_t* vtbase = p.vt + (size_t)(b * 8 + hd) * 128 * SEQ;
        const int kt_hi = (qt * 128 + 127) >> 6;
        A::dma(tid, lds, kbase + (size_t)kt_hi * 64 * 1024, 1024, nullptr, vtbase + kt_hi * 64, SEQ);
        __builtin_amdgcn_s_waitcnt(0x0F70); __syncthreads();
        volatile int* done_f = reinterpret_cast<volatile int*>(smem + LDS_WORK + 2 * A::STAGE);
        const int rwave = VHALF * 4 + wid;
        bool wdone = false;
        for (int kt = kt_hi; kt >= 0; --kt) {
            const int cur = (kt_hi - kt) & 1;
            if (kt < kt_hi && (done_f[0] & done_f[1] & done_f[2] & done_f[3] & done_f[4] & done_f[5] & done_f[6] & done_f[7])) break;
            const bool more = kt > 0;
            if (more) A::dma(tid, lds + (cur ^ 1) * A::STAGE, kbase + (size_t)(kt - 1) * 64 * 1024, 1024, nullptr, vtbase + (kt - 1) * 64, SEQ);
            const unsigned char* st = lds + cur * A::STAGE;
            const int key0 = kt * 64;
            if (key0 < tw0 + 31 && !wdone) {
                f32x16 z[2];
                {
                    bf16x8 kf0[8], kf1[8];
                    A::kload(st, 0, kf0, r, h); A::kload(st, 1, kf1, r, h);
                    __builtin_amdgcn_sched_barrier(0);
                    z[0] = A::qk_mma(kf0, qf); z[1] = A::qk_mma(kf1, qf);
                }
                float run = 0.f;
                auto sb_body = [&](auto diag_c) {
                    constexpr bool DG = decltype(diag_c)::value;
                float T[8];
#pragma unroll
                for (int kb = 0; kb < 2; ++kb)
#pragma unroll
                    for (int rg = 0; rg < 4; ++rg) {
                        float suf = 0.f;
#pragma unroll
                        for (int i = 3; i >= 0; --i) {
                            const float zz = z[kb][4 * rg + i] * SC;
                            const float sp = fmaxf(zz, 0.f) + LN2 * __builtin_amdgcn_logf(1.f + __builtin_amdgcn_exp2f(-fabsf(zz) * L2E));
                            const bool ok = !DG || (key0 + kb * 32 + 8 * rg + 4 * h + i) < t;
                            suf += ok ? -sp : 0.f;
                            z[kb][4 * rg + i] = zz + suf;
                        }
                        T[kb * 4 + rg] = suf;
                    }
#pragma unroll
                for (int gq = 7; gq >= 0; --gq) {
                    const float U = xh_other(T[gq], h);
                    const float after = run + (h ? 0.f : U) + R;
                    const int kb = gq >> 2, rg = gq & 3;
#pragma unroll
                    for (int i = 0; i < 4; ++i) {
                        const bool ok = !DG || (key0 + kb * 32 + 8 * rg + 4 * h + i) < t;
                        const float a = __builtin_amdgcn_exp2f((z[kb][4 * rg + i] + after) * L2E);
                        z[kb][4 * rg + i] = ok ? a : 0.f;
                    }
                    run += T[gq] + U;
                }
                };
                if (key0 + 63 >= tw0) { asm volatile("" ::: "memory"); sb_body(std::true_type{}); } else sb_body(std::false_type{});
                R += run;
                A::pv(st, o, 0, pfrag(z[0], 0), r, h); A::pv(st, o, 1, pfrag(z[0], 1), r, h); A::pv(st, o, 2, pfrag(z[1], 0), r, h); A::pv(st, o, 3, pfrag(z[1], 1), r, h);
                wdone = __all(R < -105.f);
            }
            if (lane == 0) done_f[rwave] = wdone ? 1 : 0;
            DMA_WAIT_SYNC();
        }
        store_o(o, p.obuf + tok * 1024 + hd * 128, h, 1.f);
        __syncthreads();
    }
}


#define KARGP ((const __attribute__((address_space(4))) Params*)__builtin_amdgcn_kernarg_segment_ptr())
#define PH(call) do { if (pc >= lo && pc < hi) { { const __attribute__((address_space(4))) Params* q_ = KARGP; asm volatile("" : "+s"(q_)); PRef p = *q_; call; } if (pc + 1 < hi) xcd_barrier(bar); } ++pc; } while (0)
template <int L> __device__ __forceinline__ void ph_attn_conv(PRef p) {
    constexpr int kind = L % 3;
    const bool conv_first = false;
    (void)conv_first;
    if (kind == 0) ph_mla_attn(p); else if (kind == 1) ph_nsa_attn(p); else ph_sb_attn(p);
}
template <int L> __device__ __forceinline__ void ph_moe_a_conv(PRef p) {
    const bool conv_first = false;
    (void)conv_first;
    ph_moe_a(p, L);
    if (L == 0) convert_moe_steal(p, 0, 2);
    if (L + 1 < DEPTH) { convert_moe_steal(p, L + 1, 0); convert_moe_steal(p, L + 1, 1); }
}
template <int L> __device__ __forceinline__ void ph_moe_b_conv(PRef p) {
    const bool conv_first = false;
    (void)conv_first;
    ph_moe_b(p, L);
    if (L + 1 < DEPTH) convert_moe_steal(p, L + 1, 2);
}
template <int L> __device__ __forceinline__ void run_layer(PRef p, const XcdBarrier& bar, int lo, int hi, int& pc) {
    constexpr int kind = L % 3, j = L / 3;
    if (kind == 0) { PH(ph_mla_in(p, j)); PH(ph_mla_up(p, j)); }
    else if (kind == 1) { PH(ph_nsa_in(p)); PH(ph_nsa_cmp1(p)); PH(ph_nsa_cmp2(p)); }
    else { PH(ph_sb_in(p)); }
    PH(ph_attn_conv<L>(p));
    PH(ph_wo(p, L)); PH(ph_lna(p, L)); PH(ph_moe_a_conv<L>(p)); PH(ph_moe_b_conv<L>(p)); PH(ph_lnb(p, L));
}
__global__ void __launch_bounds__(512, 2) mega(Params pv, int lo, int hi) {
    (void)pv; PRef p = *KARGP;
    volatile LAS unsigned* stw = (volatile LAS unsigned*)smem;
    if (threadIdx.x == 0) { stw[0] = 0u; stw[1] = 0u; stw[2] = 0u; stw[3] = 0u; }
    __syncthreads();
    XcdBarrier bar; bar.bar = p.bar; bar.x = 0; bar.st = stw;
    if (hi - lo > 1) bar = xcd_barrier_post(p.bar, stw);
    int pc = 0;
    PH(ph_prologue(p));
    PH(ph_h0(p));
    run_layer<0>(p, bar, lo, hi, pc);
    run_layer<1>(p, bar, lo, hi, pc);
    run_layer<2>(p, bar, lo, hi, pc);
    run_layer<3>(p, bar, lo, hi, pc);
}
#undef PH
constexpr int N_PHASES = 2 + (3 + 5) + (4 + 5) + (2 + 5) + (3 + 5);

extern "C" void kernel_launch(void* const* d_in, const int* in_sizes, int n_in, void* d_out, int out_size, void* d_ws, size_t ws_size, hipStream_t stream) {
    (void)in_sizes; (void)n_in; (void)out_size;
    static int grid = 0;
    if (grid == 0) {
        int dev = 0, cus = 0, per_cu = 0;
        hipGetDevice(&dev);
        hipDeviceGetAttribute(&cus, hipDeviceAttributeMultiprocessorCount, dev);
        if (hipFuncSetAttribute((const void*)mega, hipFuncAttributeMaxDynamicSharedMemorySize, LDS_BYTES) != hipSuccess) { fprintf(stderr, "kernel_launch: hipFuncSetAttribute failed\n"); }
        if (hipOccupancyMaxActiveBlocksPerMultiprocessor(&per_cu, (const void*)mega, 2 * NTHR, LDS_BYTES) != hipSuccess) per_cu = 1;
        (void)hipGetLastError();
        if (per_cu < 1) per_cu = 1;
        if (per_cu > 1) per_cu = 1;
        if (cus <= 0) cus = 256;
        grid = cus * per_cu;
        if (grid >= 8) grid &= ~7;
    }
    Params p{};
    const float* const* in = (const float* const*)d_in;
    p.x = in[0]; p.c = in[1]; p.pos = (const int*)d_in[2]; p.ada_w = in[3]; p.ada_b = in[4]; p.ln_g = in[5]; p.ln_b = in[6];
    p.mla_w_in = in[7]; p.mla_g_q = in[8]; p.mla_w_uq = in[9]; p.mla_g_kv = in[10]; p.mla_w_ukv = in[11]; p.mla_w_o = in[12];
    p.nsa_w_in = in[13]; p.nsa_pe_k = in[14]; p.nsa_pe_v = in[15]; p.nsa_w_ck1 = in[16]; p.nsa_w_ck2 = in[17]; p.nsa_w_cv1 = in[18]; p.nsa_w_cv2 = in[19]; p.nsa_w_o = in[20];
    p.sb_w_qkv = in[21]; p.sb_w_o = in[22];
    p.moe_w_grp = in[23]; p.moe_b_grp = in[24]; p.moe_w_rt = in[25]; p.moe_b_rt = in[26]; p.moe_w_gate = in[27]; p.moe_w_up = in[28]; p.moe_w_down = in[29];
    p.out = (float*)d_out;
    unsigned char* ws = (unsigned char*)d_ws; size_t off = 0;
    auto take = [&](size_t bytes) { unsigned char* r = ws + off; off += (bytes + 255) & ~(size_t)255; return r; };
    p.bar = (unsigned*)take(XCD_BAR_WORDS * 4 + 16 * 2048); p.wq = (int*)(p.bar + XCD_BAR_WORDS); p.cnt = (int*)take(DEPTH * 32 * 64 * 4);
    p.mod = (float*)take((size_t)8 * 8 * 3072 * 4);
    p.cosm = (float*)take((size_t)T_TOK * 32 * 4); p.sinm = (float*)take((size_t)T_TOK * 32 * 4); p.cosn = (float*)take((size_t)T_TOK * 64 * 4); p.sinn = (float*)take((size_t)T_TOK * 64 * 4);
    p.bias1 = (float*)take(2 * 128 * 4); p.wr = (float*)take((size_t)DEPTH * 1024 * 48 * 4);
    p.xbuf = (f16_t*)take((size_t)T_TOK * 1024 * 4); p.zbuf = (f16_t*)take((size_t)T_TOK * 1024 * 4); p.hbuf = (bf16_t*)take((size_t)T_TOK * 1024 * 2);
    p.wt_mla_in = (bf16_t*)take((size_t)2 * 768 * 1024 * 2); p.wt_uq = (bf16_t*)take((size_t)2 * 1536 * 256 * 2); p.wt_ukv = (bf16_t*)take((size_t)2 * 2048 * 256 * 2);
    p.wt_mla_o = (bf16_t*)take((size_t)2 * 1024 * 1024 * 2); p.wt_nsa_in = (bf16_t*)take((size_t)2816 * 1024 * 2);
    p.wt_ck1 = (bf16_t*)take((size_t)128 * 4096 * 2); p.wt_cv1 = (bf16_t*)take((size_t)128 * 4096 * 2); p.wt_ck2 = (bf16_t*)take(128 * 128 * 2); p.wt_cv2 = (bf16_t*)take(128 * 128 * 2);
    p.wt_nsa_o = (bf16_t*)take((size_t)1024 * 1024 * 2); p.wt_sb_qkv = (bf16_t*)take((size_t)3072 * 1024 * 2); p.wt_sb_o = (bf16_t*)take((size_t)1024 * 1024 * 2);
    p.wt_gu = (bf16_t*)take((size_t)DEPTH * 32 * 1024 * 1024 * 2); p.wt_dn = (bf16_t*)take((size_t)DEPTH * 32 * 1024 * 512 * 2);
    p.obuf = (bf16_t*)take((size_t)T_TOK * 1024 * 2);
    p.list = (int*)take((size_t)32 * T_TOK * 4); p.listw = (float*)take((size_t)32 * T_TOK * 4);
    p.hmoe = (bf16_t*)take((size_t)(T_TOK * 2 + 32 * 256) * 512 * 2); p.ybuf = (bf16_t*)take((size_t)T_TOK * 2 * 1024 * 2);
    const size_t arena0 = off;
    p.cbuf = (bf16_t*)take((size_t)T_TOK * 512 * 2); p.rss = (float*)take((size_t)T_TOK * 8 * 4); p.krope = (bf16_t*)take((size_t)T_TOK * 64 * 2); p.qm = (bf16_t*)take((size_t)T_TOK * 1536 * 2);
    p.kn = (bf16_t*)take((size_t)T_TOK * 1024 * 2); p.vt = (bf16_t*)take((size_t)T_TOK * 1024 * 2);
    const size_t arena_mla = off; off = arena0;
    p.qn = (bf16_t*)take((size_t)T_TOK * 1024 * 2);
    p.kc = (bf16_t*)take((size_t)(16 * SEQ + 64) * 128 * 2); p.vc = (bf16_t*)take((size_t)(16 * SEQ + 64) * 128 * 2);
    p.ks = (bf16_t*)take((size_t)16 * SEQ * 128 * 2); p.kw = (bf16_t*)take((size_t)16 * SEQ * 128 * 2);
    p.vst = (bf16_t*)take((size_t)16 * SEQ * 128 * 2); p.vwt = (bf16_t*)take((size_t)16 * SEQ * 128 * 2);
    p.gates = (float*)take((size_t)T_TOK * 32 * 4); p.cpart = (float*)take((size_t)32 * 8 * 128 * 128 * 4); p.hid = (bf16_t*)take((size_t)32 * 128 * 128 * 2);
    p.kcmp = (bf16_t*)take((size_t)16 * 128 * 128 * 2); p.vcmpt = (bf16_t*)take((size_t)16 * 128 * 128 * 2);
    const size_t arena_nsa = off; off = arena0;
    p.qs = (bf16_t*)take((size_t)T_TOK * 1024 * 2); p.ksb = (bf16_t*)take((size_t)T_TOK * 1024 * 2);
    const size_t arena_sb = off; (void)arena_sb;
    off = arena_mla > arena_nsa ? arena_mla : arena_nsa;
    if (off > ws_size) { fprintf(stderr, "kernel_launch: workspace too small (%zu > %zu)\n", off, ws_size); }
    hipMemsetAsync(p.bar, 0, XCD_BAR_WORDS * 4 + 16 * 2048, stream);
#if MULTI_LAUNCH
    for (int ph = 0; ph < N_PHASES; ++ph) hipLaunchKernelGGL(mega, dim3(grid), dim3(2 * NTHR), LDS_BYTES, stream, p, ph, ph + 1);
#else
    hipLaunchKernelGGL(mega, dim3(grid), dim3(2 * NTHR), LDS_BYTES, stream, p, 0, N_PHASES);
#endif
}
```
